# Optimizing an MI355X kernel written in HIP

```python
import math
import jax, jax.numpy as jnp
from jax import lax
import numpy as np

D_MODEL = 1024
BATCH = 8
SEQ = 4096
DEPTH = 1

CHUNK = 64
EPS = 1e-6

RWKV_HEADS = 8
RWKV_HEAD_DIM = 64
RWKV_WIDTH = RWKV_HEADS * RWKV_HEAD_DIM
LORA_W = 64
LORA_A = 64
LORA_G = 128
GN_EPS = 64e-5
RWKV_SPLITS = [RWKV_WIDTH, 2 * RWKV_WIDTH, 3 * RWKV_WIDTH, 3 * RWKV_WIDTH + LORA_W, 3 * RWKV_WIDTH + LORA_W + LORA_A]
N_RWKV_COLS = 3 * RWKV_WIDTH + LORA_W + LORA_A + LORA_G

S5_GROUP = 16
S5_GROUPS = 32
S5_WIDTH = S5_GROUP * S5_GROUPS
S5_STATE = 64
DT_MIN = 1e-3
DT_MAX = 1e-1

N_IN_COLS = N_RWKV_COLS + S5_WIDTH + 2 * D_MODEL

PEER_HEADS = 8
PEER_KEYS = 128
PEER_EXPERTS = PEER_KEYS * PEER_KEYS
PEER_TOPK = 16
PEER_KEY_DIM = 128
PEER_HALF = PEER_KEY_DIM // 2
PEER_BLOCK = 128

kernel_name = 'hybrid_rwkv7_s5_peer_block'


def _rms_norm(x, gain):
    xf = x.astype(jnp.float32)
    y = xf * lax.rsqrt(jnp.mean(xf * xf, axis=-1, keepdims=True) + EPS)
    return (y * gain.astype(jnp.float32)).astype(x.dtype)


def _token_shift(p):
    return jnp.pad(p[:, :-1], ((0, 0), (1, 0), (0, 0)))


def _rwkv7_time_mix(p, mu, w_lora_up, w0, a_lora_up, a0, g_lora_up, k_k, k_a, r_k, ln_w, ln_b, w_o):
    f32 = jnp.float32
    B, S, _ = p.shape
    p = p.astype(f32)
    p = p + (_token_shift(p) - p) * mu.astype(f32)
    r, k, v, xw, xa, xg = jnp.split(p, RWKV_SPLITS, axis=-1)
    w_log = -jax.nn.softplus(-(w0.astype(f32) + jnp.tanh(xw) @ w_lora_up.astype(f32))) - 0.5
    decay = jnp.exp(-jnp.exp(w_log))
    a = jax.nn.sigmoid(a0.astype(f32) + xa @ a_lora_up.astype(f32))
    g = jax.nn.sigmoid(xg) @ g_lora_up.astype(f32)
    kk = k * k_k.astype(f32)
    k = k * (1.0 + (a - 1.0) * k_a.astype(f32))

    def heads(t):
        return t.reshape(B, S, RWKV_HEADS, RWKV_HEAD_DIM)

    r, k, v, decay, a, kk = heads(r), heads(k), heads(v), heads(decay), heads(a), heads(kk)
    kk = kk / jnp.maximum(jnp.sqrt(jnp.sum(kk * kk, axis=-1, keepdims=True)), 1e-12)

    def step(state, inp):
        r_t, k_t, v_t, w_t, kk_t, a_t = inp
        sa = jnp.einsum('bhvk,bhk->bhv', state, -kk_t)
        state = (state * w_t[:, :, None, :]
                 + sa[..., None] * (kk_t * a_t)[:, :, None, :]
                 + v_t[..., None] * k_t[:, :, None, :])
        y_t = jnp.einsum('bhvk,bhk->bhv', state, r_t)
        return state, y_t

    def seq_first(t):
        return jnp.swapaxes(t, 0, 1)

    state0 = jnp.zeros((B, RWKV_HEADS, RWKV_HEAD_DIM, RWKV_HEAD_DIM), f32)
    _, ys = lax.scan(step, state0, (seq_first(r), seq_first(k), seq_first(v),
                                    seq_first(decay), seq_first(kk), seq_first(a)))
    y = jnp.swapaxes(ys, 0, 1)
    mean = jnp.mean(y, axis=-1, keepdims=True)
    var = jnp.mean(jnp.square(y - mean), axis=-1, keepdims=True)
    y = ((y - mean) * lax.rsqrt(var + GN_EPS)).reshape(B, S, RWKV_WIDTH)
    y = y * ln_w.astype(f32) + ln_b.astype(f32)
    bonus = jnp.sum(r * k * r_k.astype(f32), axis=-1, keepdims=True) * v
    y = (y + bonus.reshape(B, S, RWKV_WIDTH)) * g
    return y @ w_o.astype(f32)


def _complex_linear_combine(e1, e2):
    a1r, a1i, b1r, b1i = e1
    a2r, a2i, b2r, b2i = e2
    ar = a2r * a1r - a2i * a1i
    ai = a2r * a1i + a2i * a1r
    br = a2r * b1r - a2i * b1i + b2r
    bi = a2r * b1i + a2i * b1r + b2i
    return ar, ai, br, bi


def _s5_ssm_glu(u, log_dt, a_re, a_im, b_re, b_im, c_re, c_im, d, w_glu):
    f32 = jnp.float32
    B, S, _ = u.shape
    uf = u.astype(f32).reshape(B, S, S5_GROUPS, S5_GROUP)
    a_re = a_re.astype(f32)
    a_im = a_im.astype(f32)
    dt = jnp.exp(log_dt.astype(f32))[:, None]
    mag = jnp.exp(a_re * dt)
    lam_re = mag * jnp.cos(a_im * dt)
    lam_im = mag * jnp.sin(a_im * dt)
    den = a_re * a_re + a_im * a_im
    num_re = lam_re - 1.0
    f_re = (num_re * a_re + lam_im * a_im) / den
    f_im = (lam_im * a_re - num_re * a_im) / den
    b_re = b_re.astype(f32)
    b_im = b_im.astype(f32)
    bb_re = f_re[..., None] * b_re - f_im[..., None] * b_im
    bb_im = f_re[..., None] * b_im + f_im[..., None] * b_re
    bu_re = jnp.einsum('bsgh,gph->bsgp', uf, bb_re)
    bu_im = jnp.einsum('bsgh,gph->bsgp', uf, bb_im)
    lam_re_t = jnp.broadcast_to(lam_re, (1, S, S5_GROUPS, S5_STATE))
    lam_im_t = jnp.broadcast_to(lam_im, (1, S, S5_GROUPS, S5_STATE))
    _, _, xs_re, xs_im = lax.associative_scan(
        _complex_linear_combine, (lam_re_t, lam_im_t, bu_re, bu_im), axis=1)
    y = (jnp.einsum('bsgp,ghp->bsgh', xs_re, c_re.astype(f32))
         - jnp.einsum('bsgp,ghp->bsgh', xs_im, c_im.astype(f32))
         + d.astype(f32) * uf)
    y = jax.nn.gelu(y.reshape(B, S, S5_WIDTH))
    z = y @ w_glu.astype(f32)
    z_val, z_gate = jnp.split(z, 2, axis=-1)
    return z_val * jax.nn.sigmoid(z_gate)


def _peer_ffn(xn, wq, subkeys, table_u, table_v):
    B, S, D = xn.shape
    xb = xn.reshape((B * S) // PEER_BLOCK, PEER_BLOCK, D)

    def block(xt):
        q = (xt @ wq).reshape(PEER_BLOCK, PEER_HEADS, 2, PEER_HALF).astype(jnp.float32)
        s = jnp.einsum('thcd,hcnd->thcn', q, subkeys.astype(jnp.float32))
        sv, si = lax.top_k(s, PEER_TOPK)
        cand = sv[:, :, 0, :, None] + sv[:, :, 1, None, :]
        cv, ci = lax.top_k(cand.reshape(PEER_BLOCK, PEER_HEADS, PEER_TOPK * PEER_TOPK), PEER_TOPK)
        i1 = jnp.take_along_axis(si[:, :, 0], ci // PEER_TOPK, axis=-1)
        i2 = jnp.take_along_axis(si[:, :, 1], ci % PEER_TOPK, axis=-1)
        e = i1 * PEER_KEYS + i2
        gate = jax.nn.softmax(cv, axis=-1)
        u_sel = table_u[e]
        hid = jax.nn.gelu(jnp.einsum('td,thkd->thk', xt, u_sel).astype(jnp.float32))
        return jnp.einsum('thk,thkd->td', (gate * hid).astype(xt.dtype), table_v[e])

    return lax.map(block, xb).reshape(B, S, D)


def setup_inputs(seed: int = 0) -> dict:
    key = jax.random.key(seed)
    ks = jax.random.split(key, 32)
    f32 = jnp.float32
    L = DEPTH

    def nrm(k, shape, scale):
        return jax.random.normal(k, shape, f32) * scale

    def gain(k, shape):
        return 1.0 + 0.02 * jax.random.normal(k, shape, f32)

    a_im_init = math.pi * jnp.arange(S5_STATE, dtype=f32)
    return {
        'x': jax.random.normal(ks[0], (BATCH, SEQ, D_MODEL), f32),
        'norm_mix': gain(ks[1], (L, D_MODEL)),
        'w_in': nrm(ks[2], (L, D_MODEL, N_IN_COLS), D_MODEL ** -0.5),
        'b_gate': nrm(ks[3], (L, 2 * D_MODEL), 0.1),
        'mu_rwkv': jax.random.uniform(ks[4], (L, N_RWKV_COLS), f32),
        'w_lora_up': nrm(ks[5], (L, LORA_W, RWKV_WIDTH), 0.1 * LORA_W ** -0.5),
        'w0': jax.random.uniform(ks[6], (L, RWKV_WIDTH), f32, -6.0, 1.0),
        'a_lora_up': nrm(ks[7], (L, LORA_A, RWKV_WIDTH), 0.1 * LORA_A ** -0.5),
        'a0': nrm(ks[8], (L, RWKV_WIDTH), 0.1),
        'g_lora_up': nrm(ks[9], (L, LORA_G, RWKV_WIDTH), LORA_G ** -0.5),
        'k_k': 0.85 + 0.02 * jax.random.normal(ks[10], (L, RWKV_WIDTH), f32),
        'k_a': gain(ks[11], (L, RWKV_WIDTH)),
        'r_k': nrm(ks[12], (L, RWKV_HEADS, RWKV_HEAD_DIM), 0.1),
        'ln_x_w': gain(ks[13], (L, RWKV_WIDTH)),
        'ln_x_b': nrm(ks[14], (L, RWKV_WIDTH), 0.02),
        'w_o_rwkv': nrm(ks[15], (L, RWKV_WIDTH, D_MODEL), RWKV_WIDTH ** -0.5),
        's5_log_dt': jax.random.uniform(ks[16], (L, S5_GROUPS), f32, math.log(DT_MIN), math.log(DT_MAX)),
        's5_a_re': -0.5 * jnp.exp(0.01 * jax.random.normal(ks[17], (L, S5_GROUPS, S5_STATE), f32)),
        's5_a_im': a_im_init + 0.01 * jax.random.normal(ks[18], (L, S5_GROUPS, S5_STATE), f32),
        's5_b_re': nrm(ks[19], (L, S5_GROUPS, S5_STATE, S5_GROUP), (2 * S5_GROUP) ** -0.5),
        's5_b_im': nrm(ks[20], (L, S5_GROUPS, S5_STATE, S5_GROUP), (2 * S5_GROUP) ** -0.5),
        's5_c_re': nrm(ks[21], (L, S5_GROUPS, S5_GROUP, S5_STATE), (2 * S5_STATE) ** -0.5),
        's5_c_im': nrm(ks[22], (L, S5_GROUPS, S5_GROUP, S5_STATE), (2 * S5_STATE) ** -0.5),
        's5_d': nrm(ks[23], (L, S5_GROUPS, S5_GROUP), 1.0),
        'w_glu_s5': nrm(ks[24], (L, S5_WIDTH, 2 * D_MODEL), S5_WIDTH ** -0.5),
        'w_out': nrm(ks[25], (L, D_MODEL, D_MODEL), D_MODEL ** -0.5),
        'norm_ffn': gain(ks[26], (L, D_MODEL)),
        'peer_wq': nrm(ks[27], (L, D_MODEL, PEER_HEADS * PEER_KEY_DIM), D_MODEL ** -0.5),
        'peer_subkeys': nrm(ks[28], (L, PEER_HEADS, 2, PEER_KEYS, PEER_HALF), PEER_HALF ** -0.5),
        'peer_u': nrm(ks[29], (L, PEER_EXPERTS, D_MODEL), D_MODEL ** -0.5),
        'peer_v': nrm(ks[30], (L, PEER_EXPERTS, D_MODEL), PEER_HEADS ** -0.5),
        'norm_final': gain(ks[31], (D_MODEL,)),
    }


def reference(x, norm_mix, w_in, b_gate, mu_rwkv, w_lora_up, w0, a_lora_up, a0, g_lora_up,
              k_k, k_a, r_k, ln_x_w, ln_x_b, w_o_rwkv, s5_log_dt, s5_a_re, s5_a_im,
              s5_b_re, s5_b_im, s5_c_re, s5_c_im, s5_d, w_glu_s5, w_out, norm_ffn,
              peer_wq, peer_subkeys, peer_u, peer_v, norm_final):
    h = x
    for l in range(DEPTH):
        xn = _rms_norm(h, norm_mix[l])
        p = xn @ w_in[l]
        p_rwkv = p[..., :N_RWKV_COLS]
        p_s5 = p[..., N_RWKV_COLS:N_RWKV_COLS + S5_WIDTH]
        p_gate = p[..., N_RWKV_COLS + S5_WIDTH:].astype(jnp.float32) + b_gate[l].astype(jnp.float32)
        y_a = _rwkv7_time_mix(p_rwkv, mu_rwkv[l], w_lora_up[l], w0[l], a_lora_up[l], a0[l],
                              g_lora_up[l], k_k[l], k_a[l], r_k[l], ln_x_w[l], ln_x_b[l], w_o_rwkv[l])
        y_b = _s5_ssm_glu(p_s5, s5_log_dt[l], s5_a_re[l], s5_a_im[l], s5_b_re[l], s5_b_im[l],
                          s5_c_re[l], s5_c_im[l], s5_d[l], w_glu_s5[l])
        g_a, g_b = jnp.split(jax.nn.sigmoid(p_gate), 2, axis=-1)
        mixed = (g_a * y_a + g_b * y_b).astype(h.dtype)
        h = h + mixed @ w_out[l]
        h = h + _peer_ffn(_rms_norm(h, norm_ffn[l]), peer_wq[l], peer_subkeys[l], peer_u[l], peer_v[l])
    return _rms_norm(h, norm_final)
```

```cpp
#include <hip/hip_runtime.h>
#include <cstdio>
#include <cstdint>

#define DEV __device__ __forceinline__
typedef unsigned short bf16_t;
typedef float f32x4 __attribute__((ext_vector_type(4)));
typedef unsigned u32x4 __attribute__((ext_vector_type(4)));
typedef unsigned u32x2 __attribute__((ext_vector_type(2)));

constexpr int T = 32768, SEQ = 4096, NB = 8, DM = 1024;
constexpr int NIN = 4352, NRW = 1792;
constexpr int NTHR = 512;
constexpr float EPS = 1e-6f;

constexpr size_t MiB = 1u << 20;
constexpr size_t WS_CTL = 0, CTL_BYTES = 1 * MiB;
constexpr size_t WS_RSS = 512 * 1024;
constexpr size_t WS_WIN = 1 * MiB;
constexpr size_t WS_BLK = 10 * MiB;
constexpr size_t WS_EBT = 11 * MiB;
constexpr size_t WS_YBT = 15 * MiB;
constexpr size_t WS_WGLU = 21 * MiB;
constexpr size_t WS_WO = 23 * MiB;
constexpr size_t WS_WOUT = 24 * MiB;
constexpr size_t WS_WQ = 26 * MiB;
constexpr size_t WS_SK = 28 * MiB;
constexpr size_t WS_XN = 32 * MiB;
constexpr size_t WS_E = 32 * MiB;
constexpr size_t WS_A2 = 64 * MiB;
constexpr size_t WS_YS = 32 * MiB;
constexpr size_t WS_YO = 64 * MiB;
constexpr size_t WS_H1B = 32 * MiB;
constexpr size_t WS_PRAW = 96 * MiB;
constexpr size_t WS_UC = 208 * MiB;
constexpr size_t WS_GATES = 256 * MiB;
constexpr size_t WS_DD = 384 * MiB;
constexpr size_t WS_AA = 416 * MiB;
constexpr size_t WS_GR = 448 * MiB;
constexpr size_t WS_YR = 480 * MiB;
constexpr size_t WS_Q = 384 * MiB;
constexpr size_t WS_IDS = 448 * MiB;
constexpr size_t WS_GW = 464 * MiB;
constexpr size_t WS_U16 = 256 * MiB;
constexpr size_t WS_V16 = 288 * MiB;
constexpr size_t WS_END = 512 * MiB;

enum { I_X = 0, I_NORM_MIX, I_W_IN, I_B_GATE, I_MU, I_W_LORA, I_W0, I_A_LORA, I_A0, I_G_LORA, I_KK, I_KA, I_RK, I_LNW, I_LNB, I_WO,
       I_LOGDT, I_ARE, I_AIM, I_BRE, I_BIM, I_CRE, I_CIM, I_SD, I_WGLU, I_WOUT, I_NORM_FFN, I_WQ, I_SUBK, I_PU, I_PV, I_NORM_FINAL, N_INPUTS };

struct Args { const float* in[N_INPUTS]; float* out; unsigned char* ws; int ph_lo, ph_hi; };

DEV float bf2f(bf16_t h) { return __uint_as_float(((unsigned)h) << 16); }
DEV bf16_t f2bf(float f) { unsigned u = __float_as_uint(f); return (bf16_t)((u + 0x7fffu + ((u >> 16) & 1u)) >> 16); }
DEV float sigmoidf_(float x) { return 1.0f / (1.0f + __expf(-x)); }
DEV float gelu_tanh(float x) { const float u = 0.7978845608028654f * (x + 0.044715f * x * x * x); return 0.5f * x * (1.0f + tanhf(u)); }
DEV float wave_sum(float v) {
#pragma unroll
    for (int o = 1; o < 64; o <<= 1) v += __shfl_xor(v, o);
    return v;
}
DEV float lerp_prev(const bf16_t* praw, int m, int col, float mu) {
    const float p = bf2f(praw[(size_t)m * NRW + col]);
    const float pv = ((m & (SEQ - 1)) == 0) ? 0.f : bf2f(praw[(size_t)(m - 1) * NRW + col]);
    return p + (pv - p) * mu;
}

template <class Epi, bool DUAL>
DEV void gemm_naive(float* lds, const bf16_t* A, int lda, const bf16_t* Bt, int ldb, int M, int N, int K, const Epi& E, int wg, int nwg) {
    float* As = lds;
    float* Bs = lds + 32 * 132;
    float* Bs2 = Bs + 32 * 68;
    const int tid = threadIdx.x, ty = tid >> 4, tx = tid & 15;
    const int ntm = M / 128, ntn = N / 64;
    for (int tile = wg; tile < ntm * ntn; tile += nwg) {
        const int m0 = (tile / ntn) * 128, n0 = (tile % ntn) * 64;
        float acc[4][4], acc2[4][4];
#pragma unroll
        for (int i = 0; i < 4; ++i)
#pragma unroll
            for (int j = 0; j < 4; ++j) { acc[i][j] = 0.f; acc2[i][j] = 0.f; }
        for (int k0 = 0; k0 < K; k0 += 32) {
            {
                const int r = tid >> 2, kc = (tid & 3) * 8;
                const u32x4 v = *(const u32x4*)(A + (size_t)(m0 + r) * lda + k0 + kc);
#pragma unroll
                for (int i = 0; i < 4; ++i) { As[(kc + 2 * i) * 132 + r] = __uint_as_float(v[i] << 16); As[(kc + 2 * i + 1) * 132 + r] = __uint_as_float(v[i] & 0xffff0000u); }
            }
            {
                const int t2 = tid & 255, r = t2 >> 2, kc = (t2 & 3) * 8;
                const int cabs = n0 + r;
                const int brow = DUAL ? ((cabs >> 7) * 256 + (cabs & 127) + ((tid >= 256) ? 128 : 0)) : cabs;
                if (DUAL || tid < 256) {
                    const u32x4 v = *(const u32x4*)(Bt + (size_t)brow * ldb + k0 + kc);
                    float* dst = (DUAL && tid >= 256) ? Bs2 : Bs;
#pragma unroll
                    for (int i = 0; i < 4; ++i) { dst[(kc + 2 * i) * 68 + r] = __uint_as_float(v[i] << 16); dst[(kc + 2 * i + 1) * 68 + r] = __uint_as_float(v[i] & 0xffff0000u); }
                }
            }
            __syncthreads();
#pragma unroll 8
            for (int kk = 0; kk < 32; ++kk) {
                const f32x4 a = *(const f32x4*)(As + kk * 132 + ty * 4);
                const f32x4 b = *(const f32x4*)(Bs + kk * 68 + tx * 4);
#pragma unroll
                for (int i = 0; i < 4; ++i)
#pragma unroll
                    for (int j = 0; j < 4; ++j) acc[i][j] += a[i] * b[j];
                if (DUAL) {
                    const f32x4 b2 = *(const f32x4*)(Bs2 + kk * 68 + tx * 4);
#pragma unroll
                    for (int i = 0; i < 4; ++i)
#pragma unroll
                        for (int j = 0; j < 4; ++j) acc2[i][j] += a[i] * b2[j];
                }
            }
            __syncthreads();
        }
#pragma unroll
        for (int i = 0; i < 4; ++i)
#pragma unroll
            for (int j = 0; j < 4; ++j) E.elem(m0 + ty * 4 + i, n0 + tx * 4 + j, acc[i][j], acc2[i][j]);
    }
}

struct Epi1 {
    bf16_t* praw; bf16_t* uc; bf16_t* gates; const float* b_gate;
    DEV void elem(int m, int n, float v, float) const {
        if (n < NRW) praw[(size_t)m * NRW + n] = f2bf(v);
        else if (n < NRW + 512) { const int c = n - NRW, g = c >> 4, h = c & 15; uc[((size_t)g * 2048 + (m >> 4)) * 384 + (m & 15) * 16 + h] = f2bf(v); }
        else { const int c = n - NRW - 512; gates[(size_t)m * 2048 + c] = f2bf(sigmoidf_(v + b_gate[c])); }
    }
};
struct EpiE {
    float* e;
    DEV void elem(int m, int n, float v, float) const { e[(size_t)m * 128 + n] = v; }
};
struct EpiLora {
    bf16_t* dd; bf16_t* aa; bf16_t* gr; const float* w0; const float* a0;
    DEV void elem(int m, int n, float v, float) const {
        if (n < 512) {
            const float wl = w0[n] + v, z = -wl;
            const float sp = (z > 20.f) ? z : log1pf(__expf(z));
            const float e = __expf(-sp - 0.5f);
            dd[(size_t)m * 512 + n] = f2bf(-expm1f(-e));
        } else if (n < 1024) aa[(size_t)m * 512 + n - 512] = f2bf(sigmoidf_(a0[n - 512] + v));
        else gr[(size_t)m * 512 + n - 1024] = f2bf(v);
    }
};
struct EpiY {
    bf16_t* ys; int g;
    DEV void elem(int m, int n, float v, float) const { ys[(size_t)(m * 16 + (n >> 4)) * 512 + g * 16 + (n & 15)] = f2bf(gelu_tanh(v)); }
};
struct EpiGlu {
    bf16_t* gates;
    DEV void elem(int m, int n, float v, float gt) const { bf16_t* p = gates + (size_t)m * 2048 + 1024 + n; *p = f2bf(bf2f(*p) * v * sigmoidf_(gt)); }
};
struct EpiYa {
    bf16_t* gates;
    DEV void elem(int m, int n, float v, float) const { bf16_t* p = gates + (size_t)m * 2048 + n; *p = f2bf(bf2f(*p) * v + bf2f(p[1024])); }
};
struct EpiOut {
    const float* x; bf16_t* h1b; float* rss;
    DEV void elem(int m, int n, float v, float) const { const float h = x[(size_t)m * DM + n] + v; h1b[(size_t)m * DM + n] = f2bf(h); atomicAdd(rss + m, h * h); }
};
struct EpiQ {
    bf16_t* q; const float* rss;
    DEV void elem(int m, int n, float v, float) const { q[(size_t)m * DM + n] = f2bf(v * rsqrtf(rss[m] * (1.0f / DM) + EPS)); }
};

struct S5p { float lr, li, fr, fi, adt, idt; };
DEV S5p s5_param(const Args& a, int g, int p) {
    S5p o; const float dt = __expf(a.in[I_LOGDT][g]); const float are = a.in[I_ARE][g * 64 + p], aim = a.in[I_AIM][g * 64 + p];
    o.adt = are * dt; o.idt = aim * dt;
    const float mag = __expf(o.adt); float s, c; sincosf(o.idt, &s, &c);
    o.lr = mag * c; o.li = mag * s;
    const float den = are * are + aim * aim, nr = o.lr - 1.0f;
    o.fr = (nr * are + o.li * aim) / den; o.fi = (o.li * are - nr * aim) / den;
    return o;
}
DEV void s5_pow(const S5p& q, int n, float& pr, float& pi) { const float mag = __expf(q.adt * (float)n); float s, c; sincosf(q.idt * (float)n, &s, &c); pr = mag * c; pi = mag * s; }

DEV void phase0(const Args& a, unsigned char* ws, int gtid, int gsize) {
    const int lane = threadIdx.x & 63, gw = gtid >> 6, ngw = gsize >> 6;
    {
        bf16_t* xn = (bf16_t*)(ws + WS_XN); const float* x = a.in[I_X]; const float* gain = a.in[I_NORM_MIX];
        for (int m = gw; m < T; m += ngw) {
            const f32x4* xr = (const f32x4*)(x + (size_t)m * DM) + lane; f32x4 v[4]; float s = 0.f;
#pragma unroll
            for (int j = 0; j < 4; ++j) { v[j] = xr[64 * j]; s += v[j][0] * v[j][0] + v[j][1] * v[j][1] + v[j][2] * v[j][2] + v[j][3] * v[j][3]; }
            const float rstd = rsqrtf(wave_sum(s) * (1.0f / DM) + EPS);
#pragma unroll
            for (int j = 0; j < 4; ++j) { const f32x4 gn = ((const f32x4*)gain)[lane + 64 * j];
                u32x2 o; o[0] = (unsigned)f2bf(v[j][0] * rstd * gn[0]) | ((unsigned)f2bf(v[j][1] * rstd * gn[1]) << 16); o[1] = (unsigned)f2bf(v[j][2] * rstd * gn[2]) | ((unsigned)f2bf(v[j][3] * rstd * gn[3]) << 16);
                ((u32x2*)(xn + (size_t)m * DM))[lane + 64 * j] = o; }
        }
    }
    { bf16_t* w = (bf16_t*)(ws + WS_WIN); const float* s = a.in[I_W_IN]; for (int i = gtid; i < NIN * 1024; i += gsize) { const int n = i >> 10, k = i & 1023; w[i] = f2bf(s[(size_t)k * NIN + n]); } }
    { bf16_t* w = (bf16_t*)(ws + WS_BLK); for (int i = gtid; i < 1536 * 256; i += gsize) { const int n = i >> 8, k = i & 255; float v = 0.f;
            if (n < 512) { if (k < 64) v = a.in[I_W_LORA][k * 512 + n]; }
            else if (n < 1024) { if (k >= 64 && k < 128) v = a.in[I_A_LORA][(k - 64) * 512 + n - 512]; }
            else { if (k >= 128) v = a.in[I_G_LORA][(k - 128) * 512 + n - 1024]; }
            w[i] = f2bf(v); } }
    { bf16_t* w = (bf16_t*)(ws + WS_WGLU); const float* s = a.in[I_WGLU]; for (int i = gtid; i < 2048 * 512; i += gsize) { const int n = i >> 9, k = i & 511; const int pn = n >> 8, j = n & 255;
            const int col = (j < 128) ? (128 * pn + j) : (1024 + 128 * pn + (j - 128)); w[i] = f2bf(s[(size_t)k * 2048 + col]); } }
    { bf16_t* w = (bf16_t*)(ws + WS_WO); const float* s = a.in[I_WO]; for (int i = gtid; i < 1024 * 512; i += gsize) { const int n = i >> 9, k = i & 511; w[i] = f2bf(s[(size_t)k * 1024 + n]); } }
    { bf16_t* w = (bf16_t*)(ws + WS_WOUT); const float* s = a.in[I_WOUT]; for (int i = gtid; i < 1024 * 1024; i += gsize) { const int n = i >> 10, k = i & 1023; w[i] = f2bf(s[(size_t)k * 1024 + n]); } }
    { bf16_t* w = (bf16_t*)(ws + WS_WQ); const float* s = a.in[I_WQ]; const float* gn = a.in[I_NORM_FFN]; for (int i = gtid; i < 1024 * 1024; i += gsize) { const int n = i >> 10, k = i & 1023; w[i] = f2bf(s[(size_t)k * 1024 + n] * gn[k]); } }
    { bf16_t* w = (bf16_t*)(ws + WS_SK); const float* s = a.in[I_SUBK]; for (int i = gtid; i < 8 * 2 * 128 * 64; i += gsize) w[i] = f2bf(s[i]); }
    {
        bf16_t* w = (bf16_t*)(ws + WS_EBT);
        for (int i = gtid; i < 32 * 256 * 256; i += gsize) { const int g = i >> 16, n = (i >> 8) & 255, k = i & 255; float v = 0.f;
            if (n < 128) { const int p = n & 63, sp = k >> 4, j = k & 15; const S5p q = s5_param(a, g, p);
                const float br = a.in[I_BRE][(g * 64 + p) * 16 + j], bi = a.in[I_BIM][(g * 64 + p) * 16 + j];
                const float bbr = q.fr * br - q.fi * bi, bbi = q.fr * bi + q.fi * br; float pr, pi; s5_pow(q, 15 - sp, pr, pi);
                v = (n < 64) ? (pr * bbr - pi * bbi) : (pr * bbi + pi * bbr); }
            w[i] = f2bf(v); }
    }
    {
        bf16_t* w = (bf16_t*)(ws + WS_YBT);
        for (int i = gtid; i < 32 * 256 * 384; i += gsize) { const int g = i / (256 * 384), r = i % (256 * 384), n = r / 384, k = r % 384; const int s = n >> 4, h = n & 15; float v = 0.f;
            if (k < 256) { const int sp = k >> 4, j = k & 15;
                if (sp <= s) { const int nn = s - sp; float acc = 0.f;
                    for (int p = 0; p < 64; ++p) { const S5p q = s5_param(a, g, p);
                        const float br = a.in[I_BRE][(g * 64 + p) * 16 + j], bi = a.in[I_BIM][(g * 64 + p) * 16 + j];
                        const float bbr = q.fr * br - q.fi * bi, bbi = q.fr * bi + q.fi * br; float pr, pi; s5_pow(q, nn, pr, pi);
                        const float zr = pr * bbr - pi * bbi, zi = pr * bbi + pi * bbr;
                        acc += a.in[I_CRE][(g * 16 + h) * 64 + p] * zr - a.in[I_CIM][(g * 16 + h) * 64 + p] * zi; }
                    if (nn == 0 && h == j) acc += a.in[I_SD][g * 16 + h];
                    v = acc; } }
            else { const int p = (k - 256) & 63; const S5p q = s5_param(a, g, p); float pr, pi; s5_pow(q, s + 1, pr, pi);
                const float cr = a.in[I_CRE][(g * 16 + h) * 64 + p], ci = a.in[I_CIM][(g * 16 + h) * 64 + p];
                v = (k < 320) ? (cr * pr - ci * pi) : -(cr * pi + ci * pr); }
            w[i] = f2bf(v); }
    }
}

DEV void phase2_prep(const Args& a, unsigned char* ws, int gtid, int gsize) {
    const bf16_t* praw = (const bf16_t*)(ws + WS_PRAW); bf16_t* a2 = (bf16_t*)(ws + WS_A2); const float* mu = a.in[I_MU];
    for (int i = gtid; i < T * 256; i += gsize) { const int m = i >> 8, c = i & 255; const float p = lerp_prev(praw, m, 1536 + c, mu[1536 + c]);
        a2[i] = f2bf(c < 64 ? tanhf(p) : (c < 128 ? p : sigmoidf_(p))); }
}

DEV void phase3_scan(const Args& a, unsigned char* ws, int gtid, int gsize) {
    const float* e = (const float*)(ws + WS_E); bf16_t* uc = (bf16_t*)(ws + WS_UC);
    for (int i = gtid; i < NB * 32 * 64; i += gsize) { const int b = i >> 11, g = (i >> 6) & 31, p = i & 63; const S5p q = s5_param(a, g, p); float lr, li; s5_pow(q, 16, lr, li);
        float xr = 0.f, xi = 0.f;
        for (int c = 0; c < 256; ++c) { const size_t crow = (size_t)g * 2048 + b * 256 + c;
            uc[crow * 384 + 256 + p] = f2bf(xr); uc[crow * 384 + 320 + p] = f2bf(xi);
            const float er = e[crow * 128 + p], ei = e[crow * 128 + 64 + p];
            const float nr = lr * xr - li * xi + er, ni = lr * xi + li * xr + ei; xr = nr; xi = ni; }
    }
}

DEV void phase4_wkv(const Args& a, unsigned char* ws, int wg, int nwg) {
    const bf16_t* praw = (const bf16_t*)(ws + WS_PRAW); const bf16_t* dd = (const bf16_t*)(ws + WS_DD); const bf16_t* aa = (const bf16_t*)(ws + WS_AA); bf16_t* yr = (bf16_t*)(ws + WS_YR);
    const float* mu = a.in[I_MU];
    const int tid = threadIdx.x, row = tid >> 5, ks = tid & 31;
    for (int item = wg; item < 256; item += nwg) {
        const int b = item >> 5, h = (item >> 2) & 7, qd = item & 3; const int v = qd * 16 + row;
        const int c0 = h * 64 + ks * 2;
        const float mur0 = mu[c0], mur1 = mu[c0 + 1], muk0 = mu[512 + c0], muk1 = mu[512 + c0 + 1], muv = mu[1024 + h * 64 + v];
        const float kk0 = a.in[I_KK][c0], kk1 = a.in[I_KK][c0 + 1], ka0 = a.in[I_KA][c0], ka1 = a.in[I_KA][c0 + 1];
        float s0 = 0.f, s1 = 0.f;
        float pr0 = 0.f, pr1 = 0.f, pk0 = 0.f, pk1 = 0.f, pv = 0.f;
        for (int t = 0; t < SEQ; ++t) { const size_t m = (size_t)b * SEQ + t;
            const unsigned rr = *(const unsigned*)(praw + m * NRW + c0), kr = *(const unsigned*)(praw + m * NRW + 512 + c0);
            const float vr = bf2f(praw[m * NRW + 1024 + h * 64 + v]);
            const unsigned dr = *(const unsigned*)(dd + m * 512 + c0), ar = *(const unsigned*)(aa + m * 512 + c0);
            const float r0 = __uint_as_float(rr << 16), r1 = __uint_as_float(rr & 0xffff0000u), k0 = __uint_as_float(kr << 16), k1 = __uint_as_float(kr & 0xffff0000u);
            const float d0 = __uint_as_float(dr << 16), d1 = __uint_as_float(dr & 0xffff0000u), a0_ = __uint_as_float(ar << 16), a1_ = __uint_as_float(ar & 0xffff0000u);
            const float rl0 = r0 + (pr0 - r0) * mur0, rl1 = r1 + (pr1 - r1) * mur1, kl0 = k0 + (pk0 - k0) * muk0, kl1 = k1 + (pk1 - k1) * muk1, vl = vr + (pv - vr) * muv;
            pr0 = r0; pr1 = r1; pk0 = k0; pk1 = k1; pv = vr;
            const float q0 = kl0 * kk0, q1 = kl1 * kk1; float n2 = q0 * q0 + q1 * q1;
#pragma unroll
            for (int o = 1; o < 32; o <<= 1) n2 += __shfl_xor(n2, o);
            const float inv = 1.0f / fmaxf(sqrtf(n2), 1e-12f); const float kn0 = q0 * inv, kn1 = q1 * inv;
            const float k20 = kl0 * (1.0f + (a0_ - 1.0f) * ka0), k21 = kl1 * (1.0f + (a1_ - 1.0f) * ka1);
            float sa = -(s0 * kn0 + s1 * kn1);
#pragma unroll
            for (int o = 1; o < 32; o <<= 1) sa += __shfl_xor(sa, o);
            s0 = s0 * (1.0f - d0) + sa * (kn0 * a0_) + vl * k20; s1 = s1 * (1.0f - d1) + sa * (kn1 * a1_) + vl * k21;
            float y = s0 * rl0 + s1 * rl1;
#pragma unroll
            for (int o = 1; o < 32; o <<= 1) y += __shfl_xor(y, o);
            if (ks == 0) yr[m * 512 + h * 64 + v] = f2bf(y);
        }
    }
}

DEV void phase5_post(const Args& a, unsigned char* ws, int gtid, int gsize) {
    const bf16_t* praw = (const bf16_t*)(ws + WS_PRAW); const bf16_t* aa = (const bf16_t*)(ws + WS_AA); const bf16_t* gr = (const bf16_t*)(ws + WS_GR); const bf16_t* yr = (const bf16_t*)(ws + WS_YR); bf16_t* yo = (bf16_t*)(ws + WS_YO);
    const float* mu = a.in[I_MU]; const int lane = threadIdx.x & 63, gw = gtid >> 6, ngw = gsize >> 6;
    for (int i = gw; i < T * 8; i += ngw) { const int m = i >> 3, h = i & 7, c = h * 64 + lane;
        const float y = bf2f(yr[(size_t)m * 512 + c]); const float mean = wave_sum(y) * (1.0f / 64.0f); const float dy = y - mean; const float var = wave_sum(dy * dy) * (1.0f / 64.0f);
        const float yn = dy * rsqrtf(var + 64e-5f) * a.in[I_LNW][c] + a.in[I_LNB][c];
        const float rl = lerp_prev(praw, m, c, mu[c]), kl = lerp_prev(praw, m, 512 + c, mu[512 + c]), vl = lerp_prev(praw, m, 1024 + c, mu[1024 + c]);
        const float av = bf2f(aa[(size_t)m * 512 + c]); const float k2 = kl * (1.0f + (av - 1.0f) * a.in[I_KA][c]);
        const float bonus = wave_sum(rl * k2 * a.in[I_RK][c]) * vl;
        yo[(size_t)m * 512 + c] = f2bf((yn + bonus) * bf2f(gr[(size_t)m * 512 + c]));
    }
}

DEV void phase8_tables(const Args& a, unsigned char* ws, int gtid, int gsize) {
    bf16_t* u16 = (bf16_t*)(ws + WS_U16); bf16_t* v16 = (bf16_t*)(ws + WS_V16); const float* pu = a.in[I_PU]; const float* pv = a.in[I_PV]; const float* gn = a.in[I_NORM_FFN];
    for (int i = gtid; i < 16384 * 1024 / 4; i += gsize) { const f32x4 u = ((const f32x4*)pu)[i], v = ((const f32x4*)pv)[i]; const f32x4 g = ((const f32x4*)gn)[i & 255];
        u32x2 o; o[0] = (unsigned)f2bf(u[0] * g[0]) | ((unsigned)f2bf(u[1] * g[1]) << 16); o[1] = (unsigned)f2bf(u[2] * g[2]) | ((unsigned)f2bf(u[3] * g[3]) << 16); ((u32x2*)u16)[i] = o;
        u32x2 p; p[0] = (unsigned)f2bf(v[0]) | ((unsigned)f2bf(v[1]) << 16); p[1] = (unsigned)f2bf(v[2]) | ((unsigned)f2bf(v[3]) << 16); ((u32x2*)v16)[i] = p; }
}

DEV void wave_argmax(float& v, int& idx) {
#pragma unroll
    for (int o = 1; o < 64; o <<= 1) { const float ov = __shfl_xor(v, o); const int oi = __shfl_xor(idx, o); if (ov > v || (ov == v && oi < idx)) { v = ov; idx = oi; } }
}

DEV void phase9_topk(const Args& a, unsigned char* ws, float* lds, int gtid, int gsize) {
    const bf16_t* q = (const bf16_t*)(ws + WS_Q); const bf16_t* sk = (const bf16_t*)(ws + WS_SK); int* ids = (int*)(ws + WS_IDS); float* gwt = (float*)(ws + WS_GW);
    const int lane = threadIdx.x & 63, wv = threadIdx.x >> 6, gw = gtid >> 6, ngw = gsize >> 6;
    float* svl = lds + wv * 64; int* sil = (int*)(lds + 512) + wv * 64;
    for (int i = gw; i < T * 8; i += ngw) { const int m = i >> 3, hh = i & 7;
        float sc[2][2];
#pragma unroll
        for (int c = 0; c < 2; ++c)
#pragma unroll
            for (int w2 = 0; w2 < 2; ++w2) { const int n = lane + 64 * w2; const bf16_t* qp = q + (size_t)m * DM + hh * 128 + c * 64; const bf16_t* kp = sk + ((size_t)(hh * 2 + c) * 128 + n) * 64; float s = 0.f;
                for (int d = 0; d < 64; ++d) s += bf2f(qp[d]) * bf2f(kp[d]);
                sc[c][w2] = s; }
#pragma unroll
        for (int c = 0; c < 2; ++c) { float c0 = sc[c][0], c1 = sc[c][1];
            for (int r = 0; r < 16; ++r) { float bv; int bi; if (c0 >= c1) { bv = c0; bi = lane; } else { bv = c1; bi = lane + 64; }
                wave_argmax(bv, bi);
                if (bi == lane) c0 = -INFINITY; if (bi == lane + 64) c1 = -INFINITY;
                if (lane == 0) { svl[c * 16 + r] = bv; sil[c * 16 + r] = bi; } } }
        __builtin_amdgcn_wave_barrier(); asm volatile("s_waitcnt lgkmcnt(0)" ::: "memory");
        float cd[4];
#pragma unroll
        for (int w4 = 0; w4 < 4; ++w4) { const int ci = lane + 64 * w4; cd[w4] = svl[ci >> 4] + svl[16 + (ci & 15)]; }
        float myv = 0.f; int mye = 0;
        for (int r = 0; r < 16; ++r) { float bv = cd[0]; int bi = lane;
#pragma unroll
            for (int w4 = 1; w4 < 4; ++w4) if (cd[w4] > bv) { bv = cd[w4]; bi = lane + 64 * w4; }
            wave_argmax(bv, bi);
#pragma unroll
            for (int w4 = 0; w4 < 4; ++w4) if (bi == lane + 64 * w4) cd[w4] = -INFINITY;
            if (lane == r) { myv = bv; mye = sil[bi >> 4] * 128 + sil[16 + (bi & 15)]; } }
        float mx = (lane < 16) ? myv : -INFINITY;
#pragma unroll
        for (int o = 1; o < 16; o <<= 1) mx = fmaxf(mx, __shfl_xor(mx, o));
        float ex = (lane < 16) ? __expf(myv - mx) : 0.f; float sm = ex;
#pragma unroll
        for (int o = 1; o < 16; o <<= 1) sm += __shfl_xor(sm, o);
        if (lane < 16) { ids[(size_t)m * 128 + hh * 16 + lane] = mye; gwt[(size_t)m * 128 + hh * 16 + lane] = ex / sm; }
        __builtin_amdgcn_wave_barrier(); asm volatile("s_waitcnt lgkmcnt(0)" ::: "memory");
    }
}

DEV void phase10_peer(const Args& a, unsigned char* ws, int gtid, int gsize) {
    const bf16_t* h1b = (const bf16_t*)(ws + WS_H1B); const bf16_t* u16 = (const bf16_t*)(ws + WS_U16); const bf16_t* v16 = (const bf16_t*)(ws + WS_V16);
    const int* ids = (const int*)(ws + WS_IDS); const float* gwt = (const float*)(ws + WS_GW); const float* rss = (const float*)(ws + WS_RSS); const float* nf = a.in[I_NORM_FINAL];
    const int lane = threadIdx.x & 63, gw = gtid >> 6, ngw = gsize >> 6, d0 = lane * 16;
    for (int m = gw; m < T; m += ngw) {
        float hb[16], acc[16];
        { const u32x4 x0 = *(const u32x4*)(h1b + (size_t)m * DM + d0), x1 = *(const u32x4*)(h1b + (size_t)m * DM + d0 + 8);
#pragma unroll
          for (int j = 0; j < 4; ++j) { hb[2 * j] = __uint_as_float(x0[j] << 16); hb[2 * j + 1] = __uint_as_float(x0[j] & 0xffff0000u); hb[8 + 2 * j] = __uint_as_float(x1[j] << 16); hb[8 + 2 * j + 1] = __uint_as_float(x1[j] & 0xffff0000u); } }
#pragma unroll
        for (int j = 0; j < 16; ++j) acc[j] = 0.f;
        const float rstd = rsqrtf(rss[m] * (1.0f / DM) + EPS);
        for (int i = 0; i < 128; ++i) { const int e = ids[(size_t)m * 128 + i]; const float gt = gwt[(size_t)m * 128 + i];
            const u32x4 u0 = *(const u32x4*)(u16 + (size_t)e * DM + d0), u1 = *(const u32x4*)(u16 + (size_t)e * DM + d0 + 8);
            float s = 0.f;
#pragma unroll
            for (int j = 0; j < 4; ++j) { s += hb[2 * j] * __uint_as_float(u0[j] << 16) + hb[2 * j + 1] * __uint_as_float(u0[j] & 0xffff0000u) + hb[8 + 2 * j] * __uint_as_float(u1[j] << 16) + hb[8 + 2 * j + 1] * __uint_as_float(u1[j] & 0xffff0000u); }
            const float hid = wave_sum(s) * rstd; const float w = gt * gelu_tanh(hid);
            const u32x4 v0 = *(const u32x4*)(v16 + (size_t)e * DM + d0), v1 = *(const u32x4*)(v16 + (size_t)e * DM + d0 + 8);
#pragma unroll
            for (int j = 0; j < 4; ++j) { acc[2 * j] += w * __uint_as_float(v0[j] << 16); acc[2 * j + 1] += w * __uint_as_float(v0[j] & 0xffff0000u); acc[8 + 2 * j] += w * __uint_as_float(v1[j] << 16); acc[8 + 2 * j + 1] += w * __uint_as_float(v1[j] & 0xffff0000u); }
        }
        float ss = 0.f;
#pragma unroll
        for (int j = 0; j < 16; ++j) { acc[j] += hb[j]; ss += acc[j] * acc[j]; }
        const float r2 = rsqrtf(wave_sum(ss) * (1.0f / DM) + EPS);
#pragma unroll
        for (int j = 0; j < 4; ++j) { const f32x4 g = *(const f32x4*)(nf + d0 + 4 * j); f32x4 o; o[0] = acc[4 * j] * r2 * g[0]; o[1] = acc[4 * j + 1] * r2 * g[1]; o[2] = acc[4 * j + 2] * r2 * g[2]; o[3] = acc[4 * j + 3] * r2 * g[3];
            *(f32x4*)(a.out + (size_t)m * DM + d0 + 4 * j) = o; }
    }
}

__global__ void __launch_bounds__(NTHR, 2) fwd_kernel(Args a) {
    __shared__ __attribute__((aligned(16))) float lds[32 * 132 + 2 * 32 * 68];
    unsigned char* ws = a.ws;
    const int wg = blockIdx.x, nwg = gridDim.x, gtid = wg * NTHR + threadIdx.x, gsize = nwg * NTHR;
    for (int ph = a.ph_lo; ph < a.ph_hi; ++ph) {
        switch (ph) {
        case 0: phase0(a, ws, gtid, gsize); break;
        case 1: { Epi1 E{(bf16_t*)(ws + WS_PRAW), (bf16_t*)(ws + WS_UC), (bf16_t*)(ws + WS_GATES), a.in[I_B_GATE]};
            gemm_naive<Epi1, false>(lds, (const bf16_t*)(ws + WS_XN), 1024, (const bf16_t*)(ws + WS_WIN), 1024, T, NIN, 1024, E, wg, nwg); } break;
        case 2: { phase2_prep(a, ws, gtid, gsize);
            for (int g = 0; g < 32; ++g) { EpiE E{(float*)(ws + WS_E) + (size_t)g * 2048 * 128};
                gemm_naive<EpiE, false>(lds, (const bf16_t*)(ws + WS_UC) + (size_t)g * 2048 * 384, 384, (const bf16_t*)(ws + WS_EBT) + (size_t)g * 256 * 256, 256, 2048, 128, 256, E, wg, nwg); } } break;
        case 3: { phase3_scan(a, ws, gtid, gsize);
            EpiLora E{(bf16_t*)(ws + WS_DD), (bf16_t*)(ws + WS_AA), (bf16_t*)(ws + WS_GR), a.in[I_W0], a.in[I_A0]};
            gemm_naive<EpiLora, false>(lds, (const bf16_t*)(ws + WS_A2), 256, (const bf16_t*)(ws + WS_BLK), 256, T, 1536, 256, E, wg, nwg); } break;
        case 4: { for (int g = 0; g < 32; ++g) { EpiY E{(bf16_t*)(ws + WS_YS), g};
                gemm_naive<EpiY, false>(lds, (const bf16_t*)(ws + WS_UC) + (size_t)g * 2048 * 384, 384, (const bf16_t*)(ws + WS_YBT) + (size_t)g * 256 * 384, 384, 2048, 256, 384, E, wg, nwg); }
            phase4_wkv(a, ws, wg, nwg); } break;
        case 5: { phase5_post(a, ws, gtid, gsize);
            EpiGlu E{(bf16_t*)(ws + WS_GATES)};
            gemm_naive<EpiGlu, true>(lds, (const bf16_t*)(ws + WS_YS), 512, (const bf16_t*)(ws + WS_WGLU), 512, T, 1024, 512, E, wg, nwg); } break;
        case 6: { EpiYa E{(bf16_t*)(ws + WS_GATES)};
            gemm_naive<EpiYa, false>(lds, (const bf16_t*)(ws + WS_YO), 512, (const bf16_t*)(ws + WS_WO), 512, T, 1024, 512, E, wg, nwg); } break;
        case 7: { EpiOut E{a.in[I_X], (bf16_t*)(ws + WS_H1B), (float*)(ws + WS_RSS)};
            gemm_naive<EpiOut, false>(lds, (const bf16_t*)(ws + WS_GATES), 2048, (const bf16_t*)(ws + WS_WOUT), 1024, T, 1024, 1024, E, wg, nwg); } break;
        case 8: { phase8_tables(a, ws, gtid, gsize);
            EpiQ E{(bf16_t*)(ws + WS_Q), (const float*)(ws + WS_RSS)};
            gemm_naive<EpiQ, false>(lds, (const bf16_t*)(ws + WS_H1B), 1024, (const bf16_t*)(ws + WS_WQ), 1024, T, 1024, 1024, E, wg, nwg); } break;
        case 9: phase9_topk(a, ws, lds, gtid, gsize); break;
        case 10: phase10_peer(a, ws, gtid, gsize); break;
        }
    }
}

extern "C" void kernel_launch(void* const* d_in, const int* in_sizes, int n_in, void* d_out, int out_size, void* d_ws, size_t ws_size, hipStream_t stream) {
    if (n_in != N_INPUTS || out_size != T * DM || ws_size < WS_END) { fprintf(stderr, "kernel_launch: unexpected shapes (n_in %d, out %d, ws %zu)\n", n_in, out_size, ws_size); return; }
    (void)in_sizes;
    hipMemsetAsync((char*)d_ws + WS_CTL, 0, CTL_BYTES, stream);
    Args a{};
    for (int i = 0; i < N_INPUTS; ++i) a.in[i] = (const float*)d_in[i];
    a.out = (float*)d_out; a.ws = (unsigned char*)d_ws;
    for (int ph = 0; ph <= 10; ++ph) { a.ph_lo = ph; a.ph_hi = ph + 1; hipLaunchKernelGGL(fwd_kernel, dim3(256), dim3(NTHR), 0, stream, a); }
}
```

```cpp
#include <hip/hip_runtime.h>
#include <cstdio>
#include <cstdint>

#define DEV __device__ __forceinline__
#define LAS __attribute__((address_space(3)))
typedef unsigned short bf16_t;
typedef float f32x4 __attribute__((ext_vector_type(4)));
typedef float f32x2 __attribute__((ext_vector_type(2)));
typedef unsigned u32x4 __attribute__((ext_vector_type(4)));
typedef unsigned u32x2 __attribute__((ext_vector_type(2)));

#ifndef PROBE_ABL
#define PROBE_ABL 0
#endif
#ifndef PROBE_PH
#define PROBE_PH -1
#endif
#ifndef PEER_CH
#define PEER_CH 8
#endif
#ifndef OPT_P0
#define OPT_P0 1
#endif
#ifndef OPT_TOPK
#define OPT_TOPK 1
#endif
#ifndef OPT_PEER
#define OPT_PEER 2
#endif
#ifndef TAB_FP8
#define TAB_FP8 1
#endif
#ifndef W6_ABL
#define W6_ABL 0
#endif
#ifndef OPT_WKV
#define OPT_WKV 6
#endif
#ifndef OPT_GEMM
#define OPT_GEMM 0x1FE
#endif
constexpr int T = 32768, SEQ = 4096, NB = 8, DM = 1024;
constexpr int NIN = 4352, NRW = 1792;
constexpr int NTHR = 512;
constexpr float EPS = 1e-6f;

constexpr int LDSCTL_OFF = 147456 - 256;
constexpr size_t MiB = 1u << 20;
constexpr size_t WS_CTL = 0, CTL_BYTES = 1 * MiB;
constexpr size_t WS_RSS = 512 * 1024;
constexpr size_t WS_WIN = 1 * MiB;
constexpr size_t WS_BLK = 10 * MiB;
constexpr size_t WS_EBT = 11 * MiB;
constexpr size_t WS_YBT = 15 * MiB;
constexpr size_t WS_WGLU = 21 * MiB;
constexpr size_t WS_WO = 23 * MiB;
constexpr size_t WS_WOUT = 24 * MiB;
constexpr size_t WS_WQ = 26 * MiB;
constexpr size_t WS_SK = 28 * MiB;
constexpr size_t WS_PAR = 29 * MiB;
constexpr int PAR_MU = 0, PAR_W0 = 1792, PAR_A0 = 2304, PAR_KK = 2816, PAR_KA = 3328, PAR_RK = 3840, PAR_LNW = 4352, PAR_LNB = 4864, PAR_BG = 5376, PAR_NF = 7424, PAR_LAM16 = 8448, PAR_END = 12544;
constexpr size_t WS_INVN = 31 * MiB;
constexpr size_t WS_XN = 32 * MiB;
constexpr size_t WS_E = 32 * MiB;
constexpr size_t WS_A2 = 64 * MiB;
constexpr size_t WS_YS = 32 * MiB;
constexpr size_t WS_YO = 208 * MiB;
constexpr size_t WS_H1B = 96 * MiB;
constexpr size_t WS_PRAW = 96 * MiB;
constexpr size_t WS_UC = 208 * MiB;
constexpr size_t WS_GATES = 256 * MiB;
constexpr size_t WS_DD = 384 * MiB;
constexpr size_t WS_AA = 416 * MiB;
constexpr size_t WS_GR = 448 * MiB;
constexpr size_t WS_YR = 480 * MiB;
constexpr size_t WS_Q = 384 * MiB;
constexpr size_t WS_IDS = 448 * MiB;
constexpr size_t WS_GW = 464 * MiB;
#if OPT_PEER == 2
constexpr size_t WS_U16 = 64 * MiB;
constexpr size_t WS_V16 = 80 * MiB;
#else
constexpr size_t WS_U16 = 256 * MiB;
constexpr size_t WS_V16 = 288 * MiB;
#endif
constexpr size_t WS_X8 = 160 * MiB;
constexpr float X8_SCALE = 16.0f, U8_SCALE = 768.0f;
constexpr size_t WS_H2B = 192 * MiB;
constexpr size_t WS_RSS2 = 640 * 1024;
constexpr size_t WS_W2 = 480 * MiB;
constexpr size_t WS_BONUS = 1 * MiB;
constexpr size_t WS_END = 512 * MiB;
__device__ __forceinline__ size_t da_off(size_t m, int c) { const int b = (int)(m >> 12), t = (int)(m & 4095), h = c >> 6, g8 = (c >> 3) & 7;
    return ((((size_t)(b * 8 + h) * 256 + (t >> 4)) * 2 + (g8 >> 2)) * 1024 + (size_t)(((t & 15) * 4 + (g8 & 3)) * 16)) / 2 + (c & 7); }
static_assert(SEQ == 4096, "da_off assumes 4096 tokens per batch row");
constexpr int PRV = 768;
__device__ __forceinline__ size_t pr_off(size_t m, int col) { return col < 1024 ? (size_t)(col >> 9) * ((size_t)32768 * 512) + da_off(m, col & 511) : (size_t)32768 * 1024 + m * PRV + (size_t)(col - 1024); }

enum { I_X = 0, I_NORM_MIX, I_W_IN, I_B_GATE, I_MU, I_W_LORA, I_W0, I_A_LORA, I_A0, I_G_LORA, I_KK, I_KA, I_RK, I_LNW, I_LNB, I_WO,
       I_LOGDT, I_ARE, I_AIM, I_BRE, I_BIM, I_CRE, I_CIM, I_SD, I_WGLU, I_WOUT, I_NORM_FFN, I_WQ, I_SUBK, I_PU, I_PV, I_NORM_FINAL, N_INPUTS };

struct Args { const float* in[N_INPUTS]; float* out; unsigned char* ws; int ph_lo, ph_hi; };

DEV float bf2f(bf16_t h) { return __uint_as_float(((unsigned)h) << 16); }
DEV bf16_t f2bf(float f) { unsigned u = __float_as_uint(f); return (bf16_t)((u + 0x7fffu + ((u >> 16) & 1u)) >> 16); }
DEV float sigmoidf_(float x) { return 1.0f / (1.0f + __expf(-x)); }
DEV float gelu_tanh(float x) { const float u = 1.5957691216057308f * (x + 0.044715f * x * x * x); return x / (1.0f + __expf(-u)); }
DEV float wave_sum(float v) {
#pragma unroll
    for (int o = 1; o < 64; o <<= 1) v += __shfl_xor(v, o);
    return v;
}
DEV float lerp_prev(const bf16_t* praw, int m, int col, float mu) {
    const float p = bf2f(praw[pr_off((size_t)((size_t)m), col)]);
    const float pv = ((m & (SEQ - 1)) == 0) ? 0.f : bf2f(praw[pr_off((size_t)((size_t)(m - 1)), col)]);
    return p + (pv - p) * mu;
}

DEV unsigned q8(float v) { return (unsigned)__float2int_rn(fminf(fmaxf(v, -127.0f), 127.0f)) & 0xffu; }
DEV unsigned q8x4(float a, float b, float c, float d) { return q8(a) | (q8(b) << 8) | (q8(c) << 16) | (q8(d) << 24); }
template <class Epi, bool DUAL>
DEV void gemm_naive(float* lds, const bf16_t* A, int lda, const bf16_t* Bt, int ldb, int M, int N, int K, const Epi& E, int wg, int nwg) {
    float* As = lds;
    float* Bs = lds + 32 * 132;
    float* Bs2 = Bs + 32 * 68;
    const int tid = threadIdx.x, ty = tid >> 4, tx = tid & 15;
    const int ntm = M / 128, ntn = N / 64;
    for (int tile = wg; tile < ntm * ntn; tile += nwg) {
        const int m0 = (tile / ntn) * 128, n0 = (tile % ntn) * 64;
        float acc[4][4], acc2[4][4];
#pragma unroll
        for (int i = 0; i < 4; ++i)
#pragma unroll
            for (int j = 0; j < 4; ++j) { acc[i][j] = 0.f; acc2[i][j] = 0.f; }
        for (int k0 = 0; k0 < K; k0 += 32) {
            {
                const int r = tid >> 2, kc = (tid & 3) * 8;
                const u32x4 v = *(const u32x4*)(A + (size_t)(m0 + r) * lda + k0 + kc);
#pragma unroll
                for (int i = 0; i < 4; ++i) { As[(kc + 2 * i) * 132 + r] = __uint_as_float(v[i] << 16); As[(kc + 2 * i + 1) * 132 + r] = __uint_as_float(v[i] & 0xffff0000u); }
            }
            {
                const int t2 = tid & 255, r = t2 >> 2, kc = (t2 & 3) * 8;
                const int cabs = n0 + r;
                const int brow = DUAL ? ((cabs >> 7) * 256 + (cabs & 127) + ((tid >= 256) ? 128 : 0)) : cabs;
                if (DUAL || tid < 256) {
                    const u32x4 v = *(const u32x4*)(Bt + (size_t)brow * ldb + k0 + kc);
                    float* dst = (DUAL && tid >= 256) ? Bs2 : Bs;
#pragma unroll
                    for (int i = 0; i < 4; ++i) { dst[(kc + 2 * i) * 68 + r] = __uint_as_float(v[i] << 16); dst[(kc + 2 * i + 1) * 68 + r] = __uint_as_float(v[i] & 0xffff0000u); }
                }
            }
            __syncthreads();
#pragma unroll 8
            for (int kk = 0; kk < 32; ++kk) {
                const f32x4 a = *(const f32x4*)(As + kk * 132 + ty * 4);
                const f32x4 b = *(const f32x4*)(Bs + kk * 68 + tx * 4);
#pragma unroll
                for (int i = 0; i < 4; ++i)
#pragma unroll
                    for (int j = 0; j < 4; ++j) acc[i][j] += a[i] * b[j];
                if (DUAL) {
                    const f32x4 b2 = *(const f32x4*)(Bs2 + kk * 68 + tx * 4);
#pragma unroll
                    for (int i = 0; i < 4; ++i)
#pragma unroll
                        for (int j = 0; j < 4; ++j) acc2[i][j] += a[i] * b2[j];
                }
            }
            __syncthreads();
        }
#pragma unroll
        for (int i = 0; i < 4; ++i)
#pragma unroll
            for (int j = 0; j < 4; ++j) E.elem(m0 + ty * 4 + i, n0 + tx * 4 + j, acc[i][j], acc2[i][j]);
    }
}

struct Epi1 {
    bf16_t* praw; bf16_t* uc; bf16_t* gates; const float* b_gate;
    DEV void elem(int m, int n, float v, float) const {
        if (n < NRW) praw[pr_off((size_t)((size_t)m), n)] = f2bf(v);
        else if (n < NRW + 512) { const int c = n - NRW, g = c >> 4, h = c & 15; uc[((size_t)g * 2048 + (m >> 4)) * 384 + (m & 15) * 16 + h] = f2bf(v); }
        else { const int c = n - NRW - 512; gates[(size_t)m * 2048 + c] = f2bf(sigmoidf_(v + b_gate[c])); }
    }
};
struct EpiE {
    float* e;
    DEV void elem(int m, int n, float v, float) const { e[(size_t)m * 128 + n] = v; }
};
struct EpiLora {
    bf16_t* dd; bf16_t* aa; bf16_t* gr; const float* w0; const float* a0;
    DEV void elem(int m, int n, float v, float) const {
        if (n < 512) {
            const float wl = w0[n] + v, z = -wl;
            const float sp = (z > 20.f) ? z : log1pf(__expf(z));
            const float e = __expf(-sp - 0.5f);
            dd[da_off((size_t)m, n)] = f2bf(-expm1f(-e));
        } else if (n < 1024) aa[da_off((size_t)m, n - 512)] = f2bf(sigmoidf_(a0[n - 512] + v));
        else gr[(size_t)m * 512 + n - 1024] = f2bf(v);
    }
};
struct EpiY {
    bf16_t* ys; int g;
    DEV void elem(int m, int n, float v, float) const { ys[(size_t)(m * 16 + (n >> 4)) * 512 + g * 16 + (n & 15)] = f2bf(gelu_tanh(v)); }
};
struct EpiGlu {
    bf16_t* gates;
    DEV void elem(int m, int n, float v, float gt) const { bf16_t* p = gates + (size_t)m * 2048 + 1024 + n; *p = f2bf(bf2f(*p) * v * sigmoidf_(gt)); }
};
struct EpiYa {
    bf16_t* gates;
    DEV void elem(int m, int n, float v, float) const { bf16_t* p = gates + (size_t)m * 2048 + n; *p = f2bf(bf2f(*p) * v + bf2f(p[1024])); }
};
struct EpiOut {
    const float* x; bf16_t* h1b; float* rss;
    DEV void elem(int m, int n, float v, float) const { const float h = x[(size_t)m * DM + n] + v; h1b[(size_t)m * DM + n] = f2bf(h); atomicAdd(rss + m, h * h); }
};
struct EpiQ {
    bf16_t* q; const float* rss;
    DEV void elem(int m, int n, float v, float) const { q[(size_t)m * DM + n] = f2bf(v * rsqrtf(rss[m] * (1.0f / DM) + EPS)); }
};


#define PG8_LAS __attribute__((address_space(3)))
typedef short bf16x8 __attribute__((ext_vector_type(8)));
constexpr int BM = 256, BK = 64, HALF = 128, HTB = HALF * BK * 2, STAGE_BYTES = 8 * HTB, NXCD = 8, WGM = 8;
__host__ __device__ __forceinline__ int lds_byte(int r, int c) { const int st = (r >> 4) * 2 + (c >> 5), rr = r & 15, cc = c & 31, ob = rr * 64 + cc * 2; return st * 1024 + (ob ^ (((ob >> 9) & 1) << 5)); }
__host__ __device__ __forceinline__ void stage_rc(int b, int& R, int& C) { const int st = b / 1024, sb = b % 1024, swz = sb ^ (((sb >> 9) & 1) << 5); R = (st >> 1) * 16 + swz / 64; C = (st & 1) * 32 + (swz % 64) / 2; }
__host__ __device__ __forceinline__ int perm32(int rho) { const int n = rho >> 4, i = rho & 15; return 8 * (i >> 2) + 4 * n + (i & 3); }
struct Unit { int pm, pn, g; };
struct Gemm { const bf16_t* A; const bf16_t* Bt; int lda, ldb, K; };
struct SchedStd {
    int nM, nN, nwg, G, c, lda, ldb;
    DEV void init(int M, int N, int G_, int c_, int lda_, int ldb_) { nM = M / BM; nN = N / BM; nwg = nM * nN; G = G_; c = c_; lda = lda_; ldb = ldb_; }
    DEV bool next(int i, Unit& u) const {
        const long L = (long)i * G + c; if (L >= nwg) return false;
        int wgid = (int)L; { const int q = nwg / NXCD, r = nwg % NXCD, xcd = wgid % NXCD, off = wgid / NXCD; wgid = (xcd < r ? xcd * (q + 1) : r * (q + 1) + (xcd - r) * q) + off; }
        const int nig = WGM * nN, gid = wgid / nig, fm = gid * WGM, gsz = (nM - fm) < WGM ? (nM - fm) : WGM;
        u.pm = fm + ((wgid % nig) % gsz); u.pn = (wgid % nig) / gsz; u.g = 0; return true;
    }
    DEV size_t aoff(const Unit& u) const { return (size_t)u.pm * BM * lda * 2; }
    DEV size_t boff(const Unit& u) const { return (size_t)u.pn * BM * ldb * 2; }
    DEV void a_ready(const Unit&) const {}
    DEV void done(const Unit&) const {}
};
struct SchedGrp {
    int G, c, lda; size_t ags, bgs;
    DEV bool next(int i, Unit& u) const { const int L = i * G + c; if (L >= 256) return false; u.g = L >> 3; u.pm = L & 7; u.pn = 0; return true; }
    DEV size_t aoff(const Unit& u) const { return ((size_t)u.g * ags + (size_t)u.pm * BM * lda) * 2; }
    DEV size_t boff(const Unit& u) const { return (size_t)u.g * bgs * 2; }
    DEV void a_ready(const Unit&) const {}
    DEV void done(const Unit&) const {}
};
DEV unsigned cvt_pk_bf16(float lo, float hi) { unsigned r; asm volatile("v_cvt_pk_bf16_f32 %0, %1, %2" : "=v"(r) : "v"(lo), "v"(hi)); return r; }
DEV u32x4 pack8(const f32x4 a, const f32x4 b) { u32x4 w; w[0] = cvt_pk_bf16(a[0], a[1]); w[1] = cvt_pk_bf16(a[2], a[3]); w[2] = cvt_pk_bf16(b[0], b[1]); w[3] = cvt_pk_bf16(b[2], b[3]); return w; }
DEV void unpack8(const u32x4 w, f32x4& a, f32x4& b) { a[0] = __uint_as_float(w[0] << 16); a[1] = __uint_as_float(w[0] & 0xffff0000u); a[2] = __uint_as_float(w[1] << 16); a[3] = __uint_as_float(w[1] & 0xffff0000u);
    b[0] = __uint_as_float(w[2] << 16); b[1] = __uint_as_float(w[2] & 0xffff0000u); b[2] = __uint_as_float(w[3] << 16); b[3] = __uint_as_float(w[3] & 0xffff0000u); }
DEV float decay_d(float wl) {
    const float e = 0.6065306597126334f / (1.0f + __expf(-wl)); return -expm1f(-e); }

#define EPI_LOOP_AM for (int ai = 0; ai < 2; ++ai) _Pragma("unroll") for (int m = 0; m < 4; ++m)
struct Epi1V { static constexpr bool PERM = true, AFTER_DRAIN = false; bf16_t* praw; bf16_t* uc; bf16_t* gates; const float* b_gate;
    DEV void operator()(const f32x4 (&acc)[2][2][4][2], const Unit& u, int wr, int wc, int fr, int fq) const {
        const int row0 = u.pm * BM + wr * 64 + fr;
        if (u.pn < 7) {
#pragma unroll
            EPI_LOOP_AM { const int row = row0 + ai * HALF + m * 16;
#pragma unroll
                for (int bj = 0; bj < 2; ++bj) *(u32x4*)(praw + pr_off((size_t)((size_t)row), u.pn * BM + bj * HALF + wc * 32 + 8 * fq)) = pack8(acc[ai][bj][m][0], acc[ai][bj][m][1]); }
        } else if (u.pn < 9) {
#pragma unroll
            for (int bj = 0; bj < 2; ++bj) { const int c = (u.pn - 7) * BM + bj * HALF + wc * 32 + 8 * fq, g = c >> 4, h0 = c & 15;
#pragma unroll
                EPI_LOOP_AM { const int row = row0 + ai * HALF + m * 16;
                    *(u32x4*)(uc + ((size_t)g * 2048 + (row >> 4)) * 384 + (row & 15) * 16 + h0) = pack8(acc[ai][bj][m][0], acc[ai][bj][m][1]); } }
        } else {
#pragma unroll
            for (int bj = 0; bj < 2; ++bj) { const int c = (u.pn - 9) * BM + bj * HALF + wc * 32 + 8 * fq; const f32x4 b0 = *(const f32x4*)(b_gate + c), b1 = *(const f32x4*)(b_gate + c + 4);
#pragma unroll
                EPI_LOOP_AM { const int row = row0 + ai * HALF + m * 16; f32x4 v0 = acc[ai][bj][m][0] + b0, v1 = acc[ai][bj][m][1] + b1;
#pragma unroll
                    for (int i = 0; i < 4; ++i) { v0[i] = sigmoidf_(v0[i]); v1[i] = sigmoidf_(v1[i]); }
                    *(u32x4*)(gates + (size_t)row * 2048 + c) = pack8(v0, v1); } }
        }
    }
};
struct EpiLoraV { static constexpr bool PERM = true, AFTER_DRAIN = false; bf16_t* dd; bf16_t* aa; bf16_t* gr; const float* w0; const float* a0;
    DEV void operator()(const f32x4 (&acc)[2][2][4][2], const Unit& u, int wr, int wc, int fr, int fq) const {
        const int row0 = u.pm * BM + wr * 64 + fr; const int kind = u.pn >> 1;
        if (kind == 0) {
#pragma unroll
            for (int bj = 0; bj < 2; ++bj) { const int c = (u.pn & 1) * BM + bj * HALF + wc * 32 + 8 * fq; const f32x4 b0 = *(const f32x4*)(w0 + c), b1 = *(const f32x4*)(w0 + c + 4);
#pragma unroll
                EPI_LOOP_AM { const int row = row0 + ai * HALF + m * 16; f32x4 v0 = acc[ai][bj][m][0] + b0, v1 = acc[ai][bj][m][1] + b1;
#pragma unroll
                    for (int i = 0; i < 4; ++i) { v0[i] = decay_d(v0[i]); v1[i] = decay_d(v1[i]); }
                    *(u32x4*)(dd + da_off((size_t)row, c)) = pack8(v0, v1); } }
        } else if (kind == 1) {
#pragma unroll
            for (int bj = 0; bj < 2; ++bj) { const int c = (u.pn & 1) * BM + bj * HALF + wc * 32 + 8 * fq; const f32x4 b0 = *(const f32x4*)(a0 + c), b1 = *(const f32x4*)(a0 + c + 4);
#pragma unroll
                EPI_LOOP_AM { const int row = row0 + ai * HALF + m * 16; f32x4 v0 = acc[ai][bj][m][0] + b0, v1 = acc[ai][bj][m][1] + b1;
#pragma unroll
                    for (int i = 0; i < 4; ++i) { v0[i] = sigmoidf_(v0[i]); v1[i] = sigmoidf_(v1[i]); }
                    *(u32x4*)(aa + da_off((size_t)row, c)) = pack8(v0, v1); } }
        } else {
#pragma unroll
            for (int bj = 0; bj < 2; ++bj) { const int c = (u.pn & 1) * BM + bj * HALF + wc * 32 + 8 * fq;
#pragma unroll
                EPI_LOOP_AM { const int row = row0 + ai * HALF + m * 16; *(u32x4*)(gr + (size_t)row * 512 + c) = pack8(acc[ai][bj][m][0], acc[ai][bj][m][1]); } }
        }
    }
};
struct EpiEV { static constexpr bool PERM = false, AFTER_DRAIN = false; float* e;
    DEV void operator()(const f32x4 (&acc)[2][2][4][2], const Unit& u, int wr, int wc, int fr, int fq) const {
        const int row0 = u.pm * BM + wr * 64 + fr;
#pragma unroll
        EPI_LOOP_AM { float* rowp = e + ((size_t)u.g * 2048 + row0 + ai * HALF + m * 16) * 128 + wc * 32 + 4 * fq;
#pragma unroll
            for (int n = 0; n < 2; ++n) *(f32x4*)(rowp + n * 16) = acc[ai][0][m][n]; }
    }
};
struct EpiYV { static constexpr bool PERM = true, AFTER_DRAIN = false; bf16_t* ys;
    DEV void operator()(const f32x4 (&acc)[2][2][4][2], const Unit& u, int wr, int wc, int fr, int fq) const {
        const int row0 = u.pm * BM + wr * 64 + fr;
#pragma unroll
        for (int bj = 0; bj < 2; ++bj) { const int c = bj * HALF + wc * 32 + 8 * fq, s = c >> 4, h0 = c & 15;
#pragma unroll
            EPI_LOOP_AM { const int crow = row0 + ai * HALF + m * 16; f32x4 v0 = acc[ai][bj][m][0], v1 = acc[ai][bj][m][1];
#pragma unroll
                for (int i = 0; i < 4; ++i) { v0[i] = gelu_tanh(v0[i]); v1[i] = gelu_tanh(v1[i]); }
                *(u32x4*)(ys + ((size_t)crow * 16 + s) * 512 + u.g * 16 + h0) = pack8(v0, v1); } }
    }
};
struct EpiGluV { static constexpr bool PERM = true, AFTER_DRAIN = false; bf16_t* gates;
    DEV void operator()(const f32x4 (&acc)[2][2][4][2], const Unit& u, int wr, int wc, int fr, int fq) const {
        const int row0 = u.pm * BM + wr * 64 + fr; const int c = u.pn * HALF + wc * 32 + 8 * fq;
#pragma unroll
        EPI_LOOP_AM { const int row = row0 + ai * HALF + m * 16; u32x4* p = (u32x4*)(gates + (size_t)row * 2048 + 1024 + c); f32x4 g0, g1; unpack8(*p, g0, g1);
            f32x4 v0 = acc[ai][0][m][0], v1 = acc[ai][0][m][1]; const f32x4 t0 = acc[ai][1][m][0], t1 = acc[ai][1][m][1];
#pragma unroll
            for (int i = 0; i < 4; ++i) { v0[i] = g0[i] * v0[i] * sigmoidf_(t0[i]); v1[i] = g1[i] * v1[i] * sigmoidf_(t1[i]); }
            *p = pack8(v0, v1); }
    }
};
struct EpiYaV { static constexpr bool PERM = true, AFTER_DRAIN = false; bf16_t* gates;
    DEV void operator()(const f32x4 (&acc)[2][2][4][2], const Unit& u, int wr, int wc, int fr, int fq) const {
        const int row0 = u.pm * BM + wr * 64 + fr;
#pragma unroll
        for (int bj = 0; bj < 2; ++bj) { const int c = u.pn * BM + bj * HALF + wc * 32 + 8 * fq;
#pragma unroll
            EPI_LOOP_AM { const int row = row0 + ai * HALF + m * 16; u32x4* p = (u32x4*)(gates + (size_t)row * 2048 + c); f32x4 g0, g1, y0, y1; unpack8(*p, g0, g1); unpack8(*(const u32x4*)((const bf16_t*)p + 1024), y0, y1);
                *p = pack8(g0 * acc[ai][bj][m][0] + y0, g1 * acc[ai][bj][m][1] + y1); } }
    }
};
struct EpiOutV { static constexpr bool PERM = true, AFTER_DRAIN = false; const float* x; bf16_t* h1b; float* rss; unsigned char* x8;
    DEV void operator()(const f32x4 (&acc)[2][2][4][2], const Unit& u, int wr, int wc, int fr, int fq) const {
        const int row0 = u.pm * BM + wr * 64 + fr;
#pragma unroll
        EPI_LOOP_AM { const int row = row0 + ai * HALF + m * 16; float s = 0.f;
#pragma unroll
            for (int bj = 0; bj < 2; ++bj) { const int c = u.pn * BM + bj * HALF + wc * 32 + 8 * fq; const f32x4 h0 = *(const f32x4*)(x + (size_t)row * DM + c) + acc[ai][bj][m][0], h1 = *(const f32x4*)(x + (size_t)row * DM + c + 4) + acc[ai][bj][m][1];
                *(u32x4*)(h1b + (size_t)row * DM + c) = pack8(h0, h1);
                *(u32x2*)(x8 + (size_t)row * DM + c) = (u32x2){q8x4(h0[0] * X8_SCALE, h0[1] * X8_SCALE, h0[2] * X8_SCALE, h0[3] * X8_SCALE), q8x4(h1[0] * X8_SCALE, h1[1] * X8_SCALE, h1[2] * X8_SCALE, h1[3] * X8_SCALE)};
                s += h0[0] * h0[0] + h0[1] * h0[1] + h0[2] * h0[2] + h0[3] * h0[3] + h1[0] * h1[0] + h1[1] * h1[1] + h1[2] * h1[2] + h1[3] * h1[3]; }
            s += __shfl_xor(s, 16); s += __shfl_xor(s, 32);
            if (fq == 0) atomicAdd(rss + row, s); }
    }
};
struct EpiQV { static constexpr bool PERM = true, AFTER_DRAIN = false; bf16_t* q; const float* rss;
    DEV void operator()(const f32x4 (&acc)[2][2][4][2], const Unit& u, int wr, int wc, int fr, int fq) const {
        const int row0 = u.pm * BM + wr * 64 + fr;
#pragma unroll
        EPI_LOOP_AM { const int row = row0 + ai * HALF + m * 16; const float rstd = rsqrtf(rss[row] * (1.0f / DM) + EPS);
#pragma unroll
            for (int bj = 0; bj < 2; ++bj) *(u32x4*)(q + (size_t)row * DM + u.pn * BM + bj * HALF + wc * 32 + 8 * fq) = pack8(acc[ai][bj][m][0] * rstd, acc[ai][bj][m][1] * rstd); }
    }
};

template <class Epi, class Sched, bool ALIGN_EPI = false, bool SP2 = false>
__device__ __forceinline__ void gemm_phase(PG8_LAS unsigned char* lds, const Gemm g, const Sched& S, const Epi& E) {
    const int tid = threadIdx.x, wid = __builtin_amdgcn_readfirstlane(tid >> 6), lane = tid & 63, wr = wid >> 2, wc = wid & 3, fr = lane & 15, fq = lane >> 4;
    const int K = g.K, nt = K / BK;
    unsigned voffA[2], voffB[2];
#pragma unroll
    for (int i = 0; i < 2; ++i) { int R, C; stage_rc(tid * 16 + i * 8192, R, C); const int Rb = Epi::PERM ? ((R & ~31) + perm32(R & 31)) : R;
        voffA[i] = (unsigned)(R * g.lda + C) * 2u; voffB[i] = (unsigned)(Rb * g.ldb + C) * 2u; }
    const size_t kstep = (size_t)(BK * 2);
    const size_t hstepA = (size_t)HALF * g.lda * 2, hstepB = (size_t)HALF * g.ldb * 2;
    const unsigned ldsw = (unsigned)wid * 1024u;
    const int aoff = lds_byte(wr * 64 + fr, fq * 8), boff = lds_byte(wc * 32 + fr, fq * 8);
#define PG8_SA(b, h) (((b) * 2 + (h)) * HTB)
#define PG8_SB(b, h) ((4 + (b) * 2 + (h)) * HTB)
#define PG8_STAGE(bufoff, gbase, voff) do { _Pragma("unroll") for (int _i = 0; _i < 2; ++_i) \
        __builtin_amdgcn_global_load_lds((const unsigned*)((const char*)(gbase) + (voff)[_i]), (PG8_LAS unsigned*)(lds + (bufoff) + ldsw + _i * 8192), 16, 0, 0); } while (0)
#define PG8_LDA(dst, b, h) do { _Pragma("unroll") for (int m = 0; m < 4; ++m) _Pragma("unroll") for (int k = 0; k < 2; ++k) dst[m][k] = *(const PG8_LAS bf16x8*)(lds + PG8_SA(b, h) + aoff + m * 2048 + k * 1024); } while (0)
#define PG8_LDB(dst, b, h) do { _Pragma("unroll") for (int n = 0; n < 2; ++n) _Pragma("unroll") for (int k = 0; k < 2; ++k) dst[n][k] = *(const PG8_LAS bf16x8*)(lds + PG8_SB(b, h) + boff + n * 2048 + k * 1024); } while (0)
#define PG8_MMA(ai, bj, At, Bt) do { __builtin_amdgcn_s_setprio(1); _Pragma("unroll") for (int m = 0; m < 4; ++m) _Pragma("unroll") for (int n = 0; n < 2; ++n) _Pragma("unroll") for (int k = 0; k < 2; ++k) \
        acc[ai][bj][m][n] = __builtin_amdgcn_mfma_f32_16x16x32_bf16(Bt[n][k], At[m][k], acc[ai][bj][m][n], 0, 0, 0); __builtin_amdgcn_s_setprio(0); } while (0)
#define PG8_WAIT_V(n) asm volatile("s_waitcnt vmcnt(" #n ")" ::: "memory")
#define PG8_WAIT_L(n) asm volatile("s_waitcnt lgkmcnt(" #n ")" ::: "memory")
#define PG8_BAR __builtin_amdgcn_s_barrier()
#define PG8_SCHED __builtin_amdgcn_sched_barrier(0)
    Unit cur, nxt; int ui = 0;
    if (!S.next(0, cur)) return;
    f32x4 acc[2][2][4][2];
#pragma unroll
    for (int a = 0; a < 2; ++a)
#pragma unroll
        for (int b = 0; b < 2; ++b)
#pragma unroll
            for (int m = 0; m < 4; ++m)
#pragma unroll
                for (int n = 0; n < 2; ++n) acc[a][b][m][n] = (f32x4){0.f, 0.f, 0.f, 0.f};
    bf16x8 At[4][2], B0[2][2], B1[2][2];
    const char* cA = (const char*)g.A + S.aoff(cur); const char* cB = (const char*)g.Bt + S.boff(cur);
    S.a_ready(cur);
    if constexpr (SP2) {
        PG8_STAGE(PG8_SB(0, 0), cB, voffB); PG8_STAGE(PG8_SB(0, 1), cB + hstepB, voffB); PG8_STAGE(PG8_SA(0, 0), cA, voffA); PG8_STAGE(PG8_SA(0, 1), cA + hstepA, voffA);
        if (wr == 1) PG8_BAR;
        PG8_WAIT_V(2); PG8_BAR;
        PG8_STAGE(PG8_SB(1, 0), cB + kstep, voffB); PG8_STAGE(PG8_SA(1, 0), cA + kstep, voffA); PG8_STAGE(PG8_SB(1, 1), cB + hstepB + kstep, voffB);
        PG8_WAIT_V(6); PG8_BAR;
    } else {
        PG8_STAGE(PG8_SB(0, 0), cB, voffB); PG8_STAGE(PG8_SA(0, 0), cA, voffA); PG8_STAGE(PG8_SB(0, 1), cB + hstepB, voffB); PG8_STAGE(PG8_SA(0, 1), cA + hstepA, voffA);
        if (wr == 1) PG8_BAR;
        PG8_WAIT_V(4); PG8_BAR;
        PG8_STAGE(PG8_SB(1, 0), cB + kstep, voffB); PG8_STAGE(PG8_SA(1, 0), cA + kstep, voffA); PG8_STAGE(PG8_SB(1, 1), cB + hstepB + kstep, voffB);
        PG8_WAIT_V(6); PG8_BAR;
    }
    for (;;) {
        const bool has_next = S.next(ui + 1, nxt);
        const char* nA = has_next ? (const char*)g.A + S.aoff(nxt) : cA; const char* nB = has_next ? (const char*)g.Bt + S.boff(nxt) : cB;
#pragma unroll 1
        for (int t = 0; t < nt; t += 2) {
            const bool last = (t == nt - 2);
            const char* a1 = cA + (size_t)(t + 1) * kstep;
            const char* a2 = last ? nA : cA + (size_t)(t + 2) * kstep; const char* b2 = last ? nB : cB + (size_t)(t + 2) * kstep;
            const char* a3 = a2 + kstep; const char* b3 = b2 + kstep;
            if (last && has_next) S.a_ready(nxt);
            if constexpr (SP2) {
            PG8_LDB(B0, 0, 0); PG8_LDB(B1, 0, 1); PG8_SCHED; PG8_LDA(At, 0, 0); PG8_STAGE(PG8_SA(1, 1), a1 + hstepA, voffA);
            PG8_WAIT_V(8); PG8_WAIT_L(0); PG8_BAR; PG8_MMA(0, 0, At, B0); PG8_MMA(0, 1, At, B1); PG8_BAR; PG8_SCHED;
            PG8_LDA(At, 0, 1); PG8_STAGE(PG8_SB(0, 0), b2, voffB); PG8_STAGE(PG8_SB(0, 1), b2 + hstepB, voffB); PG8_STAGE(PG8_SA(0, 0), a2, voffA);
            PG8_WAIT_V(8); PG8_WAIT_L(0); PG8_BAR; PG8_MMA(1, 0, At, B0); PG8_MMA(1, 1, At, B1); PG8_BAR; PG8_SCHED;
            PG8_LDB(B0, 1, 0); PG8_LDB(B1, 1, 1); PG8_SCHED; PG8_LDA(At, 1, 0); PG8_STAGE(PG8_SA(0, 1), a2 + hstepA, voffA);
            PG8_WAIT_V(8); PG8_WAIT_L(0); PG8_BAR; PG8_MMA(0, 0, At, B0); PG8_MMA(0, 1, At, B1); PG8_BAR; PG8_SCHED;
            PG8_LDA(At, 1, 1); PG8_STAGE(PG8_SB(1, 0), b3, voffB); PG8_STAGE(PG8_SB(1, 1), b3 + hstepB, voffB); PG8_STAGE(PG8_SA(1, 0), a3, voffA);
            PG8_WAIT_V(8); PG8_WAIT_L(0); PG8_BAR; PG8_MMA(1, 0, At, B0); PG8_MMA(1, 1, At, B1); PG8_BAR; PG8_SCHED;
            } else {
            PG8_LDB(B0, 0, 0); PG8_SCHED; PG8_LDA(At, 0, 0); PG8_STAGE(PG8_SA(1, 1), a1 + hstepA, voffA);
            PG8_WAIT_L(8); PG8_BAR; PG8_WAIT_L(0); PG8_MMA(0, 0, At, B0); PG8_BAR; PG8_SCHED;
            PG8_LDB(B1, 0, 1); PG8_STAGE(PG8_SB(0, 0), b2, voffB);
            PG8_BAR; PG8_WAIT_L(0); PG8_MMA(0, 1, At, B1); PG8_BAR;
            PG8_LDA(At, 0, 1); PG8_STAGE(PG8_SA(0, 0), a2, voffA);
            PG8_BAR; PG8_WAIT_L(0); PG8_MMA(1, 0, At, B0); PG8_BAR; PG8_SCHED;
            PG8_STAGE(PG8_SB(0, 1), b2 + hstepB, voffB);
            PG8_WAIT_V(6); PG8_BAR; PG8_MMA(1, 1, At, B1); PG8_BAR;
            PG8_LDB(B0, 1, 0); PG8_SCHED; PG8_LDA(At, 1, 0); PG8_STAGE(PG8_SA(0, 1), a2 + hstepA, voffA);
            PG8_WAIT_L(8); PG8_BAR; PG8_WAIT_L(0); PG8_MMA(0, 0, At, B0); PG8_BAR; PG8_SCHED;
            PG8_LDB(B1, 1, 1); PG8_STAGE(PG8_SB(1, 0), b3, voffB);
            PG8_BAR; PG8_WAIT_L(0); PG8_MMA(0, 1, At, B1); PG8_BAR;
            PG8_LDA(At, 1, 1); PG8_STAGE(PG8_SA(1, 0), a3, voffA);
            PG8_BAR; PG8_WAIT_L(0); PG8_MMA(1, 0, At, B0); PG8_BAR; PG8_SCHED;
            PG8_STAGE(PG8_SB(1, 1), b3 + hstepB, voffB);
            PG8_WAIT_V(6); PG8_BAR; PG8_MMA(1, 1, At, B1); PG8_BAR;
            }
        }
        if constexpr (ALIGN_EPI) { if (wr == 0) PG8_BAR; }
        if constexpr (!Epi::AFTER_DRAIN) { E(acc, cur, wr, wc, fr, fq); S.done(cur); }
        if (!has_next) break;
#pragma unroll
        for (int a = 0; a < 2; ++a)
#pragma unroll
            for (int b = 0; b < 2; ++b)
#pragma unroll
                for (int m = 0; m < 4; ++m)
#pragma unroll
                    for (int n = 0; n < 2; ++n) acc[a][b][m][n] = (f32x4){0.f, 0.f, 0.f, 0.f};
        cur = nxt; cA = nA; cB = nB; ++ui;
        if constexpr (ALIGN_EPI) { if (wr == 1) PG8_BAR; }
    }
    PG8_WAIT_V(0);
    if constexpr (!ALIGN_EPI) { if (wr == 0) PG8_BAR; }
    PG8_BAR;
    if constexpr (Epi::AFTER_DRAIN) { E.fused(acc, cur, wr, wc, fr, fq, lds, wid, lane); S.done(cur); }
#undef PG8_SA
#undef PG8_SB
#undef PG8_STAGE
#undef PG8_LDA
#undef PG8_LDB
#undef PG8_MMA
#undef PG8_WAIT_V
#undef PG8_WAIT_L
#undef PG8_BAR
#undef PG8_SCHED
}

struct S5p { float lr, li, fr, fi, adt, idt; };
DEV S5p s5_param(const Args& a, int g, int p) {
    S5p o; const float dt = __expf(a.in[I_LOGDT][g]); const float are = a.in[I_ARE][g * 64 + p], aim = a.in[I_AIM][g * 64 + p];
    o.adt = are * dt; o.idt = aim * dt;
    const float mag = __expf(o.adt); float s, c; sincosf(o.idt, &s, &c);
    o.lr = mag * c; o.li = mag * s;
    const float den = are * are + aim * aim, nr = o.lr - 1.0f;
    o.fr = (nr * are + o.li * aim) / den; o.fi = (o.li * are - nr * aim) / den;
    return o;
}
DEV void s5_pow(const S5p& q, int n, float& pr, float& pi) { const float mag = __expf(q.adt * (float)n); float s, c; sincosf(q.idt * (float)n, &s, &c); pr = mag * c; pi = mag * s; }

DEV void phase0(const Args& a, unsigned char* ws, int gtid, int gsize) {
    const int lane = threadIdx.x & 63, gw = gtid >> 6, ngw = gsize >> 6;
    {
        bf16_t* xn = (bf16_t*)(ws + WS_XN); const float* x = a.in[I_X]; const float* gain = a.in[I_NORM_MIX];
        for (int m = gw; m < T; m += ngw) {
            const f32x4* xr = (const f32x4*)(x + (size_t)m * DM) + lane; f32x4 v[4]; float s = 0.f;
#pragma unroll
            for (int j = 0; j < 4; ++j) { v[j] = xr[64 * j]; s += v[j][0] * v[j][0] + v[j][1] * v[j][1] + v[j][2] * v[j][2] + v[j][3] * v[j][3]; }
            const float rstd = rsqrtf(wave_sum(s) * (1.0f / DM) + EPS);
#pragma unroll
            for (int j = 0; j < 4; ++j) { const f32x4 gn = ((const f32x4*)gain)[lane + 64 * j];
                u32x2 o; o[0] = (unsigned)f2bf(v[j][0] * rstd * gn[0]) | ((unsigned)f2bf(v[j][1] * rstd * gn[1]) << 16); o[1] = (unsigned)f2bf(v[j][2] * rstd * gn[2]) | ((unsigned)f2bf(v[j][3] * rstd * gn[3]) << 16);
                ((u32x2*)(xn + (size_t)m * DM))[lane + 64 * j] = o; }
        }
    }
    { bf16_t* w = (bf16_t*)(ws + WS_WIN); const float* s = a.in[I_W_IN]; for (int i = gtid; i < NIN * 1024; i += gsize) { const int n = i >> 10, k = i & 1023; w[i] = f2bf(s[(size_t)k * NIN + n]); } }
    { bf16_t* w = (bf16_t*)(ws + WS_BLK); for (int i = gtid; i < 1536 * 256; i += gsize) { const int n = i >> 8, k = i & 255; float v = 0.f;
            if (n < 512) { if (k < 64) v = a.in[I_W_LORA][k * 512 + n]; }
            else if (n < 1024) { if (k >= 64 && k < 128) v = a.in[I_A_LORA][(k - 64) * 512 + n - 512]; }
            else { if (k >= 128) v = a.in[I_G_LORA][(k - 128) * 512 + n - 1024]; }
            w[i] = f2bf(v); } }
    { bf16_t* w = (bf16_t*)(ws + WS_WGLU); const float* s = a.in[I_WGLU]; for (int i = gtid; i < 2048 * 512; i += gsize) { const int n = i >> 9, k = i & 511; const int pn = n >> 8, j = n & 255;
            const int col = (j < 128) ? (128 * pn + j) : (1024 + 128 * pn + (j - 128)); w[i] = f2bf(s[(size_t)k * 2048 + col]); } }
    { bf16_t* w = (bf16_t*)(ws + WS_WO); const float* s = a.in[I_WO]; for (int i = gtid; i < 1024 * 512; i += gsize) { const int n = i >> 9, k = i & 511; w[i] = f2bf(s[(size_t)k * 1024 + n]); } }
    { bf16_t* w = (bf16_t*)(ws + WS_WOUT); const float* s = a.in[I_WOUT]; for (int i = gtid; i < 1024 * 1024; i += gsize) { const int n = i >> 10, k = i & 1023; w[i] = f2bf(s[(size_t)k * 1024 + n]); } }
    { bf16_t* w = (bf16_t*)(ws + WS_WQ); const float* s = a.in[I_WQ]; const float* gn = a.in[I_NORM_FFN]; for (int i = gtid; i < 1024 * 1024; i += gsize) { const int n = i >> 10, k = i & 1023; w[i] = f2bf(s[(size_t)k * 1024 + n] * gn[k]); } }
    { bf16_t* w = (bf16_t*)(ws + WS_SK); const float* s = a.in[I_SUBK]; for (int i = gtid; i < 8 * 2 * 128 * 64; i += gsize) w[i] = f2bf(s[i]); }
    { float* par = (float*)(ws + WS_PAR);
      for (int i = gtid; i < PAR_END; i += gsize) { float v;
        if (i < PAR_W0) v = a.in[I_MU][i]; else if (i < PAR_A0) v = a.in[I_W0][i - PAR_W0]; else if (i < PAR_KK) v = a.in[I_A0][i - PAR_A0]; else if (i < PAR_KA) v = a.in[I_KK][i - PAR_KK];
        else if (i < PAR_RK) v = a.in[I_KA][i - PAR_KA]; else if (i < PAR_LNW) v = a.in[I_RK][i - PAR_RK]; else if (i < PAR_LNB) v = a.in[I_LNW][i - PAR_LNW]; else if (i < PAR_BG) v = a.in[I_LNB][i - PAR_LNB];
        else if (i < PAR_NF) v = a.in[I_B_GATE][i - PAR_BG]; else if (i < PAR_LAM16) v = a.in[I_NORM_FINAL][i - PAR_NF];
        else { const int j = i - PAR_LAM16, gp = j >> 1; const S5p q = s5_param(a, gp >> 6, gp & 63); float pr, pi; s5_pow(q, 16, pr, pi); v = (j & 1) ? pi : pr; }
        par[i] = v; } }
    {
        bf16_t* w = (bf16_t*)(ws + WS_EBT);
        for (int i = gtid; i < 32 * 256 * 256; i += gsize) { const int g = i >> 16, n = (i >> 8) & 255, k = i & 255; float v = 0.f;
            if (n < 128) { const int p = n & 63, sp = k >> 4, j = k & 15; const S5p q = s5_param(a, g, p);
                const float br = a.in[I_BRE][(g * 64 + p) * 16 + j], bi = a.in[I_BIM][(g * 64 + p) * 16 + j];
                const float bbr = q.fr * br - q.fi * bi, bbi = q.fr * bi + q.fi * br; float pr, pi; s5_pow(q, 15 - sp, pr, pi);
                v = (n < 64) ? (pr * bbr - pi * bbi) : (pr * bbi + pi * bbr); }
            w[i] = f2bf(v); }
    }
    {
        bf16_t* w = (bf16_t*)(ws + WS_YBT);
        for (int i = gtid; i < 32 * 256 * 384; i += gsize) { const int g = i / (256 * 384), r = i % (256 * 384), n = r / 384, k = r % 384; const int s = n >> 4, h = n & 15; float v = 0.f;
            if (k < 256) { const int sp = k >> 4, j = k & 15;
                if (sp <= s) { const int nn = s - sp; float acc = 0.f;
                    for (int p = 0; p < 64; ++p) { const S5p q = s5_param(a, g, p);
                        const float br = a.in[I_BRE][(g * 64 + p) * 16 + j], bi = a.in[I_BIM][(g * 64 + p) * 16 + j];
                        const float bbr = q.fr * br - q.fi * bi, bbi = q.fr * bi + q.fi * br; float pr, pi; s5_pow(q, nn, pr, pi);
                        const float zr = pr * bbr - pi * bbi, zi = pr * bbi + pi * bbr;
                        acc += a.in[I_CRE][(g * 16 + h) * 64 + p] * zr - a.in[I_CIM][(g * 16 + h) * 64 + p] * zi; }
                    if (nn == 0 && h == j) acc += a.in[I_SD][g * 16 + h];
                    v = acc; } }
            else { const int p = (k - 256) & 63; const S5p q = s5_param(a, g, p); float pr, pi; s5_pow(q, s + 1, pr, pi);
                const float cr = a.in[I_CRE][(g * 16 + h) * 64 + p], ci = a.in[I_CIM][(g * 16 + h) * 64 + p];
                v = (k < 320) ? (cr * pr - ci * pi) : -(cr * pi + ci * pr); }
            w[i] = f2bf(v); }
    }
}

DEV void phase2_prep(unsigned char* ws, int gtid, int gsize) {
    const bf16_t* praw = (const bf16_t*)(ws + WS_PRAW); bf16_t* a2 = (bf16_t*)(ws + WS_A2); const float* mu = (const float*)(ws + WS_PAR) + PAR_MU;
    for (int i = gtid; i < T * 32; i += gsize) { const int m = i >> 5, c = (i & 31) * 8;
        f32x4 p0, p1, q0, q1; unpack8(*(const u32x4*)(praw + pr_off((size_t)m, 1536 + c)), p0, p1);
        if ((m & (SEQ - 1)) == 0) { q0 = (f32x4){0.f, 0.f, 0.f, 0.f}; q1 = q0; } else unpack8(*(const u32x4*)(praw + pr_off((size_t)(m - 1), 1536 + c)), q0, q1);
        f32x4 v0 = p0 + (q0 - p0) * *(const f32x4*)(mu + 1536 + c), v1 = p1 + (q1 - p1) * *(const f32x4*)(mu + 1536 + c + 4);
        if (c < 64) {
#pragma unroll
            for (int j = 0; j < 4; ++j) { v0[j] = tanhf(v0[j]); v1[j] = tanhf(v1[j]); }
        } else if (c >= 128) {
#pragma unroll
            for (int j = 0; j < 4; ++j) { v0[j] = sigmoidf_(v0[j]); v1[j] = sigmoidf_(v1[j]); }
        }
        *(u32x4*)(a2 + (size_t)m * 256 + c) = pack8(v0, v1); }
}

DEV void phase3_scan(unsigned char* ws, int gtid, int gsize) {
    const float* e = (const float*)(ws + WS_E); bf16_t* uc = (bf16_t*)(ws + WS_UC); const float* lam16 = (const float*)(ws + WS_PAR) + PAR_LAM16;
    for (int i = gtid; i < NB * 32 * 64; i += gsize) { const int b = i >> 11, g = (i >> 6) & 31, p = i & 63; const float lr = lam16[(g * 64 + p) * 2], li = lam16[(g * 64 + p) * 2 + 1];
        float xr = 0.f, xi = 0.f;
        for (int c = 0; c < 256; ++c) { const size_t crow = (size_t)g * 2048 + b * 256 + c;
            uc[crow * 384 + 256 + p] = f2bf(xr); uc[crow * 384 + 320 + p] = f2bf(xi);
            const float er = e[crow * 128 + p], ei = e[crow * 128 + 64 + p];
            const float nr = lr * xr - li * xi + er, ni = lr * xi + li * xr + ei; xr = nr; xi = ni; }
    }
}

DEV void phase4_wkv(unsigned char* ws, int wg, int nwg) {
    const bf16_t* praw = (const bf16_t*)(ws + WS_PRAW); const bf16_t* dd = (const bf16_t*)(ws + WS_DD); const bf16_t* aa = (const bf16_t*)(ws + WS_AA); bf16_t* yr = (bf16_t*)(ws + WS_YR);
    const float* par = (const float*)(ws + WS_PAR); const float* mu = par + PAR_MU;
    const int tid = threadIdx.x, row = tid >> 5, ks = tid & 31;
    for (int item = wg; item < 256; item += nwg) {
        const int b = item >> 5, h = (item >> 2) & 7, qd = item & 3; const int v = qd * 16 + row;
        const int c0 = h * 64 + ks * 2;
        const float mur0 = mu[c0], mur1 = mu[c0 + 1], muk0 = mu[512 + c0], muk1 = mu[512 + c0 + 1], muv = mu[1024 + h * 64 + v];
        const float kk0 = par[PAR_KK + c0], kk1 = par[PAR_KK + c0 + 1], ka0 = par[PAR_KA + c0], ka1 = par[PAR_KA + c0 + 1];
        float s0 = 0.f, s1 = 0.f;
        float pr0 = 0.f, pr1 = 0.f, pk0 = 0.f, pk1 = 0.f, pv = 0.f;
        for (int t = 0; t < SEQ; ++t) { const size_t m = (size_t)b * SEQ + t;
            const unsigned rr = *(const unsigned*)(praw + pr_off((size_t)(m), c0)), kr = *(const unsigned*)(praw + pr_off((size_t)(m), 512 + c0));
            const float vr = bf2f(praw[pr_off((size_t)(m), 1024 + h * 64 + v)]);
            const unsigned dr = *(const unsigned*)(dd + da_off(m, c0)), ar = *(const unsigned*)(aa + da_off(m, c0));
            const float r0 = __uint_as_float(rr << 16), r1 = __uint_as_float(rr & 0xffff0000u), k0 = __uint_as_float(kr << 16), k1 = __uint_as_float(kr & 0xffff0000u);
            const float d0 = __uint_as_float(dr << 16), d1 = __uint_as_float(dr & 0xffff0000u), a0_ = __uint_as_float(ar << 16), a1_ = __uint_as_float(ar & 0xffff0000u);
            const float rl0 = r0 + (pr0 - r0) * mur0, rl1 = r1 + (pr1 - r1) * mur1, kl0 = k0 + (pk0 - k0) * muk0, kl1 = k1 + (pk1 - k1) * muk1, vl = vr + (pv - vr) * muv;
            pr0 = r0; pr1 = r1; pk0 = k0; pk1 = k1; pv = vr;
            const float q0 = kl0 * kk0, q1 = kl1 * kk1; float n2 = q0 * q0 + q1 * q1;
#pragma unroll
            for (int o = 1; o < 32; o <<= 1) n2 += __shfl_xor(n2, o);
            const float inv = 1.0f / fmaxf(sqrtf(n2), 1e-12f); const float kn0 = q0 * inv, kn1 = q1 * inv;
            const float k20 = kl0 * (1.0f + (a0_ - 1.0f) * ka0), k21 = kl1 * (1.0f + (a1_ - 1.0f) * ka1);
            float sa = -(s0 * kn0 + s1 * kn1);
#pragma unroll
            for (int o = 1; o < 32; o <<= 1) sa += __shfl_xor(sa, o);
            s0 = s0 * (1.0f - d0) + sa * (kn0 * a0_) + vl * k20; s1 = s1 * (1.0f - d1) + sa * (kn1 * a1_) + vl * k21;
            float y = s0 * rl0 + s1 * rl1;
#pragma unroll
            for (int o = 1; o < 32; o <<= 1) y += __shfl_xor(y, o);
            if (ks == 0) yr[m * 512 + h * 64 + v] = f2bf(y);
        }
    }
}

struct TabGrp { f32x4 u, v; };
DEV void tab_cvt_load(TabGrp& t, const float* pu, const float* pv, int i) { t.u = ((const f32x4*)pu)[i]; t.v = ((const f32x4*)pv)[i]; }
DEV void tab_cvt_store(const TabGrp& t, const float* gn, unsigned char* ws, int i) {
    const f32x4 u = t.u, v = t.v; const f32x4 g = ((const f32x4*)gn)[i & 255];
    int pu_ = 0, pv_ = 0;
    pu_ = (int)q8x4(u[0] * g[0] * U8_SCALE, u[1] * g[1] * U8_SCALE, u[2] * g[2] * U8_SCALE, u[3] * g[3] * U8_SCALE);
    pv_ = __builtin_amdgcn_cvt_pk_fp8_f32(v[0] * 16.0f, v[1] * 16.0f, pv_, false); pv_ = __builtin_amdgcn_cvt_pk_fp8_f32(v[2] * 16.0f, v[3] * 16.0f, pv_, true);
    const size_t o = ((size_t)((i & 255) >> 5) * 16384 + (i >> 8)) * 32 + (i & 31);
    ((unsigned*)(ws + WS_U16))[o] = (unsigned)pu_; ((unsigned*)(ws + WS_V16))[o] = (unsigned)pv_;
}

constexpr int WK_TB = 32, WK_SF = 340, WK_BF = WK_TB * WK_SF, WK_YF = WK_TB * 16, WK_NBLK = SEQ / WK_TB;
template <int CTRL> DEV float dpp_f(float x) { return __builtin_bit_cast(float, __builtin_amdgcn_update_dpp(0, __builtin_bit_cast(int, x), CTRL, 0xf, 0xf, true)); }
DEV float red16(float x) { x += dpp_f<0xB1>(x); x += dpp_f<0x4E>(x); x += dpp_f<0x124>(x); x += dpp_f<0x128>(x); return x; }
struct WkLoad { u32x4 r, rp, k, kp, d, a, v, vp; };
DEV void wk_issue(WkLoad& L, const bf16_t* praw, const bf16_t* dd, const bf16_t* aa, int b, int h, int qd, int blk, int s, int kseg) {
    const int t = blk * WK_TB + s; const size_t m = (size_t)b * SEQ + t; const size_t mp = (t > 0) ? m - 1 : m; const int c = h * 64 + kseg * 8;
    L.r = *(const u32x4*)(praw + pr_off((size_t)(m), c)); L.rp = *(const u32x4*)(praw + pr_off((size_t)(mp), c));
    L.k = *(const u32x4*)(praw + pr_off((size_t)(m), 512 + c)); L.kp = *(const u32x4*)(praw + pr_off((size_t)(mp), 512 + c));
    L.d = *(const u32x4*)(dd + da_off(m, c)); L.a = *(const u32x4*)(aa + da_off(m, c));
    if (kseg < 2) { const int cv = 1024 + h * 64 + qd * 16 + kseg * 8; L.v = *(const u32x4*)(praw + pr_off((size_t)(m), cv)); L.vp = *(const u32x4*)(praw + pr_off((size_t)(mp), cv)); }
}
DEV void wk_produce(const WkLoad& L, LAS float* buf, int blk, int s, int kseg, const float (&mur)[8], const float (&muk)[8], const float (&kkc)[8], const float (&kac)[8], const float (&muv)[8]) {
    const bool first = (blk == 0 && s == 0);
    f32x4 r0, r1, p0, p1, k0, k1, q0, q1, d0, d1, a0, a1;
    unpack8(L.r, r0, r1); unpack8(L.rp, p0, p1); unpack8(L.k, k0, k1); unpack8(L.kp, q0, q1); unpack8(L.d, d0, d1); unpack8(L.a, a0, a1);
    float rl[8], kl[8], av[8], dv[8], qq[8]; float n2 = 0.f;
#pragma unroll
    for (int i = 0; i < 8; ++i) { const float r = (i < 4) ? r0[i & 3] : r1[i & 3], rp = first ? 0.f : ((i < 4) ? p0[i & 3] : p1[i & 3]); const float k = (i < 4) ? k0[i & 3] : k1[i & 3], kp = first ? 0.f : ((i < 4) ? q0[i & 3] : q1[i & 3]);
        rl[i] = r + (rp - r) * mur[i]; kl[i] = k + (kp - k) * muk[i]; av[i] = (i < 4) ? a0[i & 3] : a1[i & 3]; dv[i] = (i < 4) ? d0[i & 3] : d1[i & 3]; qq[i] = kl[i] * kkc[i]; n2 += qq[i] * qq[i]; }
    n2 += __shfl_xor(n2, 1); n2 += __shfl_xor(n2, 2); n2 += __shfl_xor(n2, 4);
    const float inv = 1.0f / fmaxf(sqrtf(n2), 1e-12f);
    LAS float* P = buf + s * WK_SF + kseg * 8;
    f32x4 o0, o1;
#pragma unroll
    for (int i = 0; i < 4; ++i) { o0[i] = 1.0f - dv[i]; o1[i] = 1.0f - dv[4 + i]; }
    *(LAS f32x4*)(P) = o0; *(LAS f32x4*)(P + 4) = o1;
#pragma unroll
    for (int i = 0; i < 4; ++i) { o0[i] = -qq[i] * inv; o1[i] = -qq[4 + i] * inv; }
    *(LAS f32x4*)(P + 64) = o0; *(LAS f32x4*)(P + 68) = o1;
#pragma unroll
    for (int i = 0; i < 4; ++i) { o0[i] = qq[i] * inv * av[i]; o1[i] = qq[4 + i] * inv * av[4 + i]; }
    *(LAS f32x4*)(P + 128) = o0; *(LAS f32x4*)(P + 132) = o1;
#pragma unroll
    for (int i = 0; i < 4; ++i) { o0[i] = kl[i] * (1.0f + (av[i] - 1.0f) * kac[i]); o1[i] = kl[4 + i] * (1.0f + (av[4 + i] - 1.0f) * kac[4 + i]); }
    *(LAS f32x4*)(P + 192) = o0; *(LAS f32x4*)(P + 196) = o1;
    float c1 = 0.f, c2 = 0.f;
#pragma unroll
    for (int i = 0; i < 8; ++i) { c1 += qq[i] * inv * av[i] * rl[i]; c2 += kl[i] * (1.0f + (av[i] - 1.0f) * kac[i]) * rl[i]; }
    c1 += __shfl_xor(c1, 1); c1 += __shfl_xor(c1, 2); c1 += __shfl_xor(c1, 4); c2 += __shfl_xor(c2, 1); c2 += __shfl_xor(c2, 2); c2 += __shfl_xor(c2, 4);
#pragma unroll
    for (int i = 0; i < 4; ++i) { o0[i] = rl[i] * (1.0f - dv[i]); o1[i] = rl[4 + i] * (1.0f - dv[4 + i]); }
    *(LAS f32x4*)(P + 256) = o0; *(LAS f32x4*)(P + 260) = o1;
    if (kseg == 0) { buf[s * WK_SF + 336] = c1; buf[s * WK_SF + 337] = c2; }
    if (kseg < 2) { f32x4 v0, v1, w0, w1; unpack8(L.v, v0, v1); unpack8(L.vp, w0, w1);
#pragma unroll
        for (int i = 0; i < 4; ++i) { const float vp0 = first ? 0.f : w0[i], vp1 = first ? 0.f : w1[i]; o0[i] = v0[i] + (vp0 - v0[i]) * muv[i]; o1[i] = v1[i] + (vp1 - v1[i]) * muv[4 + i]; }
        *(LAS f32x4*)(buf + s * WK_SF + 320 + kseg * 8) = o0; *(LAS f32x4*)(buf + s * WK_SF + 324 + kseg * 8) = o1; }
}
DEV void wk_flush(const LAS float* yb, bf16_t* yr, int b, int h, int qd, int blk, int s, int kseg) {
    const float y0 = yb[s * 16 + 2 * kseg], y1 = yb[s * 16 + 2 * kseg + 1];
    *(unsigned*)(yr + ((size_t)b * SEQ + blk * WK_TB + s) * 512 + h * 64 + qd * 16 + 2 * kseg) = cvt_pk_bf16(y0, y1);
}
struct WkOp { f32x4 w4, a4, b4, k4, q4; float vv, c1, c2; };
DEV void wk_ld(WkOp& o, const LAS float* P, int row, int ks) {
    o.w4 = *(const LAS f32x4*)(P + ks * 4); o.a4 = *(const LAS f32x4*)(P + 64 + ks * 4); o.b4 = *(const LAS f32x4*)(P + 128 + ks * 4); o.k4 = *(const LAS f32x4*)(P + 192 + ks * 4); o.q4 = *(const LAS f32x4*)(P + 256 + ks * 4);
    o.vv = P[320 + row]; o.c1 = P[336]; o.c2 = P[337];
}
DEV void wk_step(const WkOp& c, LAS float* yb, f32x4& S, int s, int row) {
    float sa = S[0] * c.a4[0] + S[1] * c.a4[1] + S[2] * c.a4[2] + S[3] * c.a4[3];
    float yy = S[0] * c.q4[0] + S[1] * c.q4[1] + S[2] * c.q4[2] + S[3] * c.q4[3];
    sa += dpp_f<0xB1>(sa); yy += dpp_f<0xB1>(yy); sa += dpp_f<0x4E>(sa); yy += dpp_f<0x4E>(yy); sa += dpp_f<0x124>(sa); yy += dpp_f<0x124>(yy); sa += dpp_f<0x128>(sa); yy += dpp_f<0x128>(yy);
    S = S * c.w4 + sa * c.b4 + c.vv * c.k4;
    yb[s * 16 + row] = yy + sa * c.c1 + c.vv * c.c2;
}
DEV void wk_consume(const LAS float* buf, LAS float* yb, f32x4& S, int row, int ks) {
    WkOp A, B; wk_ld(A, buf, row, ks);
#pragma unroll 2
    for (int s = 0; s < WK_TB; s += 2) {
        wk_ld(B, buf + (s + 1) * WK_SF, row, ks);
        wk_step(A, yb, S, s, row);
        __builtin_amdgcn_sched_barrier(0);
        if (s + 2 < WK_TB) wk_ld(A, buf + (s + 2) * WK_SF, row, ks);
        wk_step(B, yb, S, s + 1, row);
        __builtin_amdgcn_sched_barrier(0);
    }
}
DEV void phase4_wkv_opt(unsigned char* ws, LAS float* lds, int wg, int nwg, const float* pu, const float* pv, const float* gn) {
    const bf16_t* praw = (const bf16_t*)(ws + WS_PRAW); const bf16_t* dd = (const bf16_t*)(ws + WS_DD); const bf16_t* aa = (const bf16_t*)(ws + WS_AA); bf16_t* yr = (bf16_t*)(ws + WS_YR);
    const float* par = (const float*)(ws + WS_PAR);
    const int tid = threadIdx.x, wid = __builtin_amdgcn_readfirstlane(tid >> 6), lane = tid & 63; const bool producer = wid >= 4;
    LAS float* buf0 = lds; LAS float* buf1 = lds + WK_BF; LAS float* yb0 = lds + 2 * WK_BF; LAS float* yb1 = yb0 + WK_YF;
    const int p = tid & 255, s = p >> 3, kseg = p & 7;
    const int row = (wid & 3) * 4 + (lane >> 4), ks = lane & 15;
    for (int it = wg; it < 256; it += nwg) {
        const int bh = (it & 7) * 8 + ((it >> 3) >> 2), qd = (it >> 3) & 3, b = bh >> 3, h = bh & 7;
        if (producer) {
            __builtin_amdgcn_s_setprio(0);
            float mur[8], muk[8], kkc[8], kac[8], muv[8];
#pragma unroll
            for (int i = 0; i < 8; ++i) { const int c = h * 64 + kseg * 8 + i; mur[i] = par[PAR_MU + c]; muk[i] = par[PAR_MU + 512 + c]; kkc[i] = par[PAR_KK + c]; kac[i] = par[PAR_KA + c]; muv[i] = par[PAR_MU + 1024 + h * 64 + qd * 16 + (kseg & 1) * 8 + i]; }
            WkLoad L0, L1;
            wk_issue(L0, praw, dd, aa, b, h, qd, 0, s, kseg); wk_issue(L1, praw, dd, aa, b, h, qd, 1, s, kseg);
            wk_produce(L0, buf0, 0, s, kseg, mur, muk, kkc, kac, muv);
            wk_issue(L0, praw, dd, aa, b, h, qd, 2, s, kseg);
#if OPT_PEER == 2
            TabGrp tg; tab_cvt_load(tg, pu, pv, (it * 64) * 256 + p);
#endif
            __syncthreads();
            for (int blk = 0; blk < WK_NBLK; blk += 2) {
                wk_produce(L1, buf1, blk + 1, s, kseg, mur, muk, kkc, kac, muv);
                if (blk + 3 < WK_NBLK) wk_issue(L1, praw, dd, aa, b, h, qd, blk + 3, s, kseg);
                if (blk > 0) wk_flush(yb1, yr, b, h, qd, blk - 1, s, kseg);
                __syncthreads();
                if (blk + 2 < WK_NBLK) wk_produce(L0, buf0, blk + 2, s, kseg, mur, muk, kkc, kac, muv);
                if (blk + 4 < WK_NBLK) wk_issue(L0, praw, dd, aa, b, h, qd, blk + 4, s, kseg);
                wk_flush(yb0, yr, b, h, qd, blk, s, kseg);
#if OPT_PEER == 2
                { const int gi = (it * 64 + (blk >> 1)) * 256 + p; tab_cvt_store(tg, gn, ws, gi); if (blk + 2 < WK_NBLK) tab_cvt_load(tg, pu, pv, gi + 256); }
#endif
                __syncthreads();
            }
            wk_flush(yb1, yr, b, h, qd, WK_NBLK - 1, s, kseg);
        } else {
            f32x4 S = (f32x4){0.f, 0.f, 0.f, 0.f};
            __syncthreads();
            for (int blk = 0; blk < WK_NBLK; blk += 2) {
                wk_consume(buf0, yb0, S, row, ks);
                __syncthreads();
                wk_consume(buf1, yb1, S, row, ks);
                __syncthreads();
            }
        }
        __builtin_amdgcn_s_setprio(0);
        __syncthreads();
    }
}

constexpr int W2_PF = 624, W2_NP = 16, W2_BF = W2_NP * W2_PF;
struct Wk2Load { u32x2 r0, r1, r2, k0, k1, k2, d1, d2, a1, a2, v0, v1, v2; };
DEV void up4(const u32x2 w, f32x4& o) { o[0] = __uint_as_float(w[0] << 16); o[1] = __uint_as_float(w[0] & 0xffff0000u); o[2] = __uint_as_float(w[1] << 16); o[3] = __uint_as_float(w[1] & 0xffff0000u); }
DEV void wk2_issue(Wk2Load& L, const bf16_t* praw, const bf16_t* dd, const bf16_t* aa, int b, int h, int qd, int blk, int j, int q) {
    const int t1 = blk * 32 + 2 * j; const size_t m1 = (size_t)b * SEQ + t1, m2 = m1 + 1, m0 = (t1 > 0) ? m1 - 1 : m1; const int c = h * 64 + q * 4;
    L.r0 = *(const u32x2*)(praw + pr_off((size_t)(m0), c)); L.r1 = *(const u32x2*)(praw + pr_off((size_t)(m1), c)); L.r2 = *(const u32x2*)(praw + pr_off((size_t)(m2), c));
    L.k0 = *(const u32x2*)(praw + pr_off((size_t)(m0), 512 + c)); L.k1 = *(const u32x2*)(praw + pr_off((size_t)(m1), 512 + c)); L.k2 = *(const u32x2*)(praw + pr_off((size_t)(m2), 512 + c));
    L.d1 = *(const u32x2*)(dd + da_off(m1, c)); L.d2 = *(const u32x2*)(dd + da_off(m2, c)); L.a1 = *(const u32x2*)(aa + da_off(m1, c)); L.a2 = *(const u32x2*)(aa + da_off(m2, c));
    if (q < 4) { const int cv = 1024 + h * 64 + qd * 16 + q * 4; L.v0 = *(const u32x2*)(praw + pr_off((size_t)(m0), cv)); L.v1 = *(const u32x2*)(praw + pr_off((size_t)(m1), cv)); L.v2 = *(const u32x2*)(praw + pr_off((size_t)(m2), cv)); }
}
DEV void wk2_produce(const Wk2Load& L, LAS float* buf, int blk, int j, int q, const f32x4 mur, const f32x4 muk, const f32x4 kkc, const f32x4 kac, const f32x4 muv) {
    const bool first = (blk == 0 && j == 0);
    f32x4 r0, r1, r2, k0, k1, k2, d1, d2, a1, a2;
    up4(L.r0, r0); up4(L.r1, r1); up4(L.r2, r2); up4(L.k0, k0); up4(L.k1, k1); up4(L.k2, k2); up4(L.d1, d1); up4(L.d2, d2); up4(L.a1, a1); up4(L.a2, a2);
    if (first) { r0 = (f32x4){0.f, 0.f, 0.f, 0.f}; k0 = r0; }
    const f32x4 rl1 = r1 + (r0 - r1) * mur, rl2 = r2 + (r1 - r2) * mur, kl1 = k1 + (k0 - k1) * muk, kl2 = k2 + (k1 - k2) * muk;
    const f32x4 q1 = kl1 * kkc, q2 = kl2 * kkc;
    float n1 = (q1[0] * q1[0] + q1[1] * q1[1]) + (q1[2] * q1[2] + q1[3] * q1[3]), n2 = (q2[0] * q2[0] + q2[1] * q2[1]) + (q2[2] * q2[2] + q2[3] * q2[3]);
    n1 += dpp_f<0xB1>(n1); n2 += dpp_f<0xB1>(n2); n1 += dpp_f<0x4E>(n1); n2 += dpp_f<0x4E>(n2); n1 += dpp_f<0x124>(n1); n2 += dpp_f<0x124>(n2); n1 += dpp_f<0x128>(n1); n2 += dpp_f<0x128>(n2);
    const float i1 = 1.0f / fmaxf(sqrtf(n1), 1e-12f), i2 = 1.0f / fmaxf(sqrtf(n2), 1e-12f);
    const f32x4 kn1 = q1 * i1, kn2 = q2 * i2, ah1 = -kn1, ah2 = -kn2, bh1 = kn1 * a1, bh2 = kn2 * a2;
    const f32x4 k21 = kl1 * (1.0f + (a1 - 1.0f) * kac), k22 = kl2 * (1.0f + (a2 - 1.0f) * kac), w1 = 1.0f - d1, w2 = 1.0f - d2;
    const f32x4 A2 = w1 * ah2, Q1 = w1 * rl1, W12 = w1 * w2, Q2 = W12 * rl2, B1 = bh1 * w2, K1 = k21 * w2;
    LAS float* P = buf + j * W2_PF + q * 4;
    *(LAS f32x4*)(P) = ah1; *(LAS f32x4*)(P + 64) = A2; *(LAS f32x4*)(P + 128) = Q1; *(LAS f32x4*)(P + 192) = Q2; *(LAS f32x4*)(P + 256) = W12;
    *(LAS f32x4*)(P + 320) = B1; *(LAS f32x4*)(P + 384) = K1; *(LAS f32x4*)(P + 448) = bh2; *(LAS f32x4*)(P + 512) = k22;
#if OPT_WKV == 3
    float sc0, sc1; { const f32x4 t0 = bh1 * ah2, t1 = k21 * ah2; sc0 = (t0[0] + t0[1]) + (t0[2] + t0[3]); sc1 = (t1[0] + t1[1]) + (t1[2] + t1[3]); }
    sc0 += dpp_f<0xB1>(sc0); sc1 += dpp_f<0xB1>(sc1); sc0 += dpp_f<0x4E>(sc0); sc1 += dpp_f<0x4E>(sc1); sc0 += dpp_f<0x124>(sc0); sc1 += dpp_f<0x124>(sc1); sc0 += dpp_f<0x128>(sc0); sc1 += dpp_f<0x128>(sc1);
    if (q == 0) *(LAS f32x2*)(buf + j * W2_PF + 608) = (f32x2){sc0, sc1};
#else
    float sc[8]; { const f32x4 t0 = bh1 * ah2, t1 = k21 * ah2, t2 = bh1 * rl1, t3 = k21 * rl1, t4 = B1 * rl2, t5 = K1 * rl2, t6 = bh2 * rl2, t7 = k22 * rl2;
        sc[0] = (t0[0] + t0[1]) + (t0[2] + t0[3]); sc[1] = (t1[0] + t1[1]) + (t1[2] + t1[3]); sc[2] = (t2[0] + t2[1]) + (t2[2] + t2[3]); sc[3] = (t3[0] + t3[1]) + (t3[2] + t3[3]);
        sc[4] = (t4[0] + t4[1]) + (t4[2] + t4[3]); sc[5] = (t5[0] + t5[1]) + (t5[2] + t5[3]); sc[6] = (t6[0] + t6[1]) + (t6[2] + t6[3]); sc[7] = (t7[0] + t7[1]) + (t7[2] + t7[3]); }
#pragma unroll
    for (int i = 0; i < 8; ++i) sc[i] += dpp_f<0xB1>(sc[i]);
#pragma unroll
    for (int i = 0; i < 8; ++i) sc[i] += dpp_f<0x4E>(sc[i]);
#pragma unroll
    for (int i = 0; i < 8; ++i) sc[i] += dpp_f<0x124>(sc[i]);
#pragma unroll
    for (int i = 0; i < 8; ++i) sc[i] += dpp_f<0x128>(sc[i]);
    if (q == 0) { *(LAS f32x4*)(buf + j * W2_PF + 608) = (f32x4){sc[0], sc[1], sc[2], sc[3]}; *(LAS f32x4*)(buf + j * W2_PF + 612) = (f32x4){sc[4], sc[5], sc[6], sc[7]}; }
#endif
    if (q < 4) { f32x4 v0, v1, v2; up4(L.v0, v0); up4(L.v1, v1); up4(L.v2, v2); if (first) v0 = (f32x4){0.f, 0.f, 0.f, 0.f};
        *(LAS f32x4*)(buf + j * W2_PF + 576 + q * 4) = v1 + (v0 - v1) * muv; *(LAS f32x4*)(buf + j * W2_PF + 592 + q * 4) = v2 + (v1 - v2) * muv; }
}
struct Wk2Op { f32x4 a1, a2, q1, q2, w12, b1, k1, b2, k2, s0, s1; float v1, v2; };
DEV void wk2_ld(Wk2Op& o, const LAS float* P, int row, int ks) {
    o.a1 = *(const LAS f32x4*)(P + ks * 4); o.a2 = *(const LAS f32x4*)(P + 64 + ks * 4); o.q1 = *(const LAS f32x4*)(P + 128 + ks * 4); o.q2 = *(const LAS f32x4*)(P + 192 + ks * 4); o.w12 = *(const LAS f32x4*)(P + 256 + ks * 4);
    o.b1 = *(const LAS f32x4*)(P + 320 + ks * 4); o.k1 = *(const LAS f32x4*)(P + 384 + ks * 4); o.b2 = *(const LAS f32x4*)(P + 448 + ks * 4); o.k2 = *(const LAS f32x4*)(P + 512 + ks * 4);
    o.v1 = P[576 + row]; o.v2 = P[592 + row]; o.s0 = *(const LAS f32x4*)(P + 608); o.s1 = *(const LAS f32x4*)(P + 612);
}
DEV float dot4(const f32x4 a, const f32x4 b) { f32x2 t = (f32x2){a[0], a[1]} * (f32x2){b[0], b[1]}; t = __builtin_elementwise_fma((f32x2){a[2], a[3]}, (f32x2){b[2], b[3]}, t); return t[0] + t[1]; }
DEV void wk2_step(const Wk2Op& c, LAS float* yb, f32x4& S, int j, int row) {
    float p1 = dot4(S, c.a1), p2 = dot4(S, c.a2), p3 = dot4(S, c.q1), p4 = dot4(S, c.q2);
    p1 += dpp_f<0xB1>(p1); p2 += dpp_f<0xB1>(p2); p3 += dpp_f<0xB1>(p3); p4 += dpp_f<0xB1>(p4);
    p1 += dpp_f<0x4E>(p1); p2 += dpp_f<0x4E>(p2); p3 += dpp_f<0x4E>(p3); p4 += dpp_f<0x4E>(p4);
    p1 += dpp_f<0x124>(p1); p2 += dpp_f<0x124>(p2); p3 += dpp_f<0x124>(p3); p4 += dpp_f<0x124>(p4);
    p1 += dpp_f<0x128>(p1); p2 += dpp_f<0x128>(p2); p3 += dpp_f<0x128>(p3); p4 += dpp_f<0x128>(p4);
    const float sa1 = p1, sa2 = (p2 + c.v1 * c.s0[1]) + sa1 * c.s0[0];
    S = ((S * c.w12 + c.v1 * c.k1) + c.v2 * c.k2) + sa1 * c.b1 + sa2 * c.b2;
    yb[(2 * j) * 16 + row] = (p3 + c.v1 * c.s0[3]) + sa1 * c.s0[2];
    yb[(2 * j + 1) * 16 + row] = ((p4 + c.v1 * c.s1[1]) + c.v2 * c.s1[3]) + sa1 * c.s1[0] + sa2 * c.s1[2];
}
DEV void wk2_consume(const LAS float* buf, LAS float* yb, f32x4& S, int row, int ks) {
    Wk2Op A, B; wk2_ld(A, buf, row, ks);
#pragma unroll 2
    for (int j = 0; j < W2_NP; j += 2) {
        wk2_ld(B, buf + (j + 1) * W2_PF, row, ks);
        wk2_step(A, yb, S, j, row);
        __builtin_amdgcn_sched_barrier(0);
        if (j + 2 < W2_NP) wk2_ld(A, buf + (j + 2) * W2_PF, row, ks);
        wk2_step(B, yb, S, j + 1, row);
        __builtin_amdgcn_sched_barrier(0);
    }
}
DEV void phase4_wkv2(unsigned char* ws, LAS float* lds, int wg, int nwg, const float* pu, const float* pv, const float* gn) {
    const bf16_t* praw = (const bf16_t*)(ws + WS_PRAW); const bf16_t* dd = (const bf16_t*)(ws + WS_DD); const bf16_t* aa = (const bf16_t*)(ws + WS_AA); bf16_t* yr = (bf16_t*)(ws + WS_YR);
    const float* par = (const float*)(ws + WS_PAR);
    const int tid = threadIdx.x, wid = __builtin_amdgcn_readfirstlane(tid >> 6), lane = tid & 63; const bool producer = wid >= 4;
    LAS float* buf0 = lds; LAS float* buf1 = lds + W2_BF; LAS float* yb0 = lds + 2 * W2_BF; LAS float* yb1 = yb0 + WK_YF;
    const int p = tid & 255, j = p >> 4, q = p & 15, s = p >> 3, kseg = p & 7;
    const int row = (wid & 3) * 4 + (lane >> 4), ks = lane & 15;
    for (int it = wg; it < 256; it += nwg) {
        const int bh = (it & 7) * 8 + ((it >> 3) >> 2), qd = (it >> 3) & 3, b = bh >> 3, h = bh & 7;
        if (producer) {
            const int c = h * 64 + q * 4;
            const f32x4 mur = *(const f32x4*)(par + PAR_MU + c), muk = *(const f32x4*)(par + PAR_MU + 512 + c), kkc = *(const f32x4*)(par + PAR_KK + c), kac = *(const f32x4*)(par + PAR_KA + c);
            const f32x4 muv = *(const f32x4*)(par + PAR_MU + 1024 + h * 64 + qd * 16 + (q & 3) * 4);
            Wk2Load L0, L1;
            wk2_issue(L0, praw, dd, aa, b, h, qd, 0, j, q); wk2_issue(L1, praw, dd, aa, b, h, qd, 1, j, q);
            wk2_produce(L0, buf0, 0, j, q, mur, muk, kkc, kac, muv);
            wk2_issue(L0, praw, dd, aa, b, h, qd, 2, j, q);
#if OPT_PEER == 2
            TabGrp tg; tab_cvt_load(tg, pu, pv, (it * 64) * 256 + p);
#endif
            __syncthreads();
            for (int blk = 0; blk < WK_NBLK; blk += 2) {
                wk2_produce(L1, buf1, blk + 1, j, q, mur, muk, kkc, kac, muv);
                if (blk + 3 < WK_NBLK) wk2_issue(L1, praw, dd, aa, b, h, qd, blk + 3, j, q);
                if (blk > 0) wk_flush(yb1, yr, b, h, qd, blk - 1, s, kseg);
                __syncthreads();
                if (blk + 2 < WK_NBLK) wk2_produce(L0, buf0, blk + 2, j, q, mur, muk, kkc, kac, muv);
                if (blk + 4 < WK_NBLK) wk2_issue(L0, praw, dd, aa, b, h, qd, blk + 4, j, q);
                wk_flush(yb0, yr, b, h, qd, blk, s, kseg);
#if OPT_PEER == 2
                { const int gi = (it * 64 + (blk >> 1)) * 256 + p; tab_cvt_store(tg, gn, ws, gi); if (blk + 2 < WK_NBLK) tab_cvt_load(tg, pu, pv, gi + 256); }
#endif
                __syncthreads();
            }
            wk_flush(yb1, yr, b, h, qd, WK_NBLK - 1, s, kseg);
        } else {
            f32x4 S = (f32x4){0.f, 0.f, 0.f, 0.f};
            __syncthreads();
            for (int blk = 0; blk < WK_NBLK; blk += 2) {
                wk2_consume(buf0, yb0, S, row, ks);
                __syncthreads();
                wk2_consume(buf1, yb1, S, row, ks);
                __syncthreads();
            }
        }
        __syncthreads();
    }
}

constexpr int W3_SIDE0 = 79872, W3_SIDESZ = 15360, W3_BT = 4608, W3_KT = 9216, W3_VT = 13824;
constexpr int W3_SA0 = 110592, W3_SASZ = 2304, W3_H00 = 115200, W3_H0SZ = 4352, W3_GS0 = 123904, W3_GSSZ = 2560;
static_assert(W3_GS0 + 2 * W3_GSSZ <= 131072, "wkv3 LDS map");
template <int CTRL> DEV float dpp_shr_id1(float x) { return __builtin_bit_cast(float, __builtin_amdgcn_update_dpp(0x3f800000, __builtin_bit_cast(int, x), CTRL, 0xf, 0xf, false)); }
DEV bf16x8 f8_to_bf16x8(const f32x4 a, const f32x4 b) { const u32x4 w = pack8(a, b); return __builtin_bit_cast(bf16x8, w); }
struct Wk3Op { f32x4 a1, a2, w12, b1, k1, b2, k2; float v1, v2, be, ka; };
DEV void wk3_ld(Wk3Op& o, const LAS float* P, int row, int ks) {
    o.a1 = *(const LAS f32x4*)(P + ks * 4); o.a2 = *(const LAS f32x4*)(P + 64 + ks * 4); o.w12 = *(const LAS f32x4*)(P + 256 + ks * 4);
    o.b1 = *(const LAS f32x4*)(P + 320 + ks * 4); o.k1 = *(const LAS f32x4*)(P + 384 + ks * 4); o.b2 = *(const LAS f32x4*)(P + 448 + ks * 4); o.k2 = *(const LAS f32x4*)(P + 512 + ks * 4);
    o.v1 = P[576 + row]; o.v2 = P[592 + row]; const f32x2 s = *(const LAS f32x2*)(P + 608); o.be = s[0]; o.ka = s[1];
}
DEV void wk3_step(const Wk3Op& c, LAS float* sa, f32x4& S, int j) {
    float p1 = dot4(S, c.a1), p2 = dot4(S, c.a2);
    p1 += dpp_f<0xB1>(p1); p2 += dpp_f<0xB1>(p2); p1 += dpp_f<0x4E>(p1); p2 += dpp_f<0x4E>(p2); p1 += dpp_f<0x124>(p1); p2 += dpp_f<0x124>(p2); p1 += dpp_f<0x128>(p1); p2 += dpp_f<0x128>(p2);
    const float sa1 = p1, sa2 = (p2 + c.v1 * c.ka) + sa1 * c.be;
    S = ((S * c.w12 + c.v1 * c.k1) + c.v2 * c.k2) + sa1 * c.b1 + sa2 * c.b2;
    *(LAS f32x2*)(sa + 2 * j) = (f32x2){sa1, sa2};
}
DEV void wk3_consume(const LAS float* buf, LAS unsigned char* sab, LAS unsigned char* h0b, f32x4& S, int row, int ks) {
    *(LAS f32x4*)(h0b + row * 272 + ks * 16) = S;
    LAS float* sa = (LAS float*)(sab + row * 144);
    Wk3Op A, B; wk3_ld(A, buf, row, ks);
#pragma unroll 2
    for (int j = 0; j < W2_NP; j += 2) {
        wk3_ld(B, buf + (j + 1) * W2_PF, row, ks);
        wk3_step(A, sa, S, j);
        __builtin_amdgcn_sched_barrier(0);
        if (j + 2 < W2_NP) wk3_ld(A, buf + (j + 2) * W2_PF, row, ks);
        wk3_step(B, sa, S, j + 1);
        __builtin_amdgcn_sched_barrier(0);
    }
}
DEV void wk3_side(const LAS float* buf, LAS unsigned char* side, int pw, int lane) {
    const int qq = lane >> 4, j = lane & 15, kq = 4 * pw + qq; const LAS float* P = buf + j * W2_PF + kq * 4;
    const f32x4 Q1 = *(const LAS f32x4*)(P + 128), Q2 = *(const LAS f32x4*)(P + 192), W12 = *(const LAS f32x4*)(P + 256), B1 = *(const LAS f32x4*)(P + 320), K1 = *(const LAS f32x4*)(P + 384), B2 = *(const LAS f32x4*)(P + 448), K2 = *(const LAS f32x4*)(P + 512);
    f32x4 g2 = W12;
#pragma unroll
    for (int c = 0; c < 4; ++c) { float x = g2[c]; x *= dpp_shr_id1<0x111>(x); x *= dpp_shr_id1<0x112>(x); x *= dpp_shr_id1<0x114>(x); x *= dpp_shr_id1<0x118>(x); g2[c] = x; }
    f32x4 g0, inv;
#pragma unroll
    for (int c = 0; c < 4; ++c) { g0[c] = dpp_shr_id1<0x111>(g2[c]); inv[c] = 1.0f / g2[c]; }
    const f32x4 r1 = g0 * Q1, r2 = g0 * Q2, b1 = B1 * inv, k1 = K1 * inv, b2 = B2 * inv, k2 = K2 * inv;
    LAS unsigned char* o = side + (2 * j) * 144 + kq * 8;
    *(LAS u32x2*)(o) = (u32x2){cvt_pk_bf16(r1[0], r1[1]), cvt_pk_bf16(r1[2], r1[3])}; *(LAS u32x2*)(o + 144) = (u32x2){cvt_pk_bf16(r2[0], r2[1]), cvt_pk_bf16(r2[2], r2[3])};
    *(LAS u32x2*)(o + W3_BT) = (u32x2){cvt_pk_bf16(b1[0], b1[1]), cvt_pk_bf16(b1[2], b1[3])}; *(LAS u32x2*)(o + W3_BT + 144) = (u32x2){cvt_pk_bf16(b2[0], b2[1]), cvt_pk_bf16(b2[2], b2[3])};
    *(LAS u32x2*)(o + W3_KT) = (u32x2){cvt_pk_bf16(k1[0], k1[1]), cvt_pk_bf16(k1[2], k1[3])}; *(LAS u32x2*)(o + W3_KT + 144) = (u32x2){cvt_pk_bf16(k2[0], k2[1]), cvt_pk_bf16(k2[2], k2[3])};
    if (pw == 0) { const f32x4 v1 = *(const LAS f32x4*)(buf + j * W2_PF + 576 + 4 * qq), v2 = *(const LAS f32x4*)(buf + j * W2_PF + 592 + 4 * qq);
#pragma unroll
        for (int rr = 0; rr < 4; ++rr) *(LAS unsigned*)(side + W3_VT + (4 * qq + rr) * 80 + (2 * j) * 2) = cvt_pk_bf16(v1[rr], v2[rr]); }
}
DEV void wk3_ymma(const LAS unsigned char* side, const LAS unsigned char* sab, const LAS unsigned char* h0b, LAS unsigned char* gs, bf16_t* yrow, int mt, int lane) {
    const int tl = lane & 15, lq = lane >> 4; const f32x4 z4 = (f32x4){0.f, 0.f, 0.f, 0.f};
    bf16x8 fR[2];
#pragma unroll
    for (int ks = 0; ks < 2; ++ks) fR[ks] = *(const LAS bf16x8*)(side + (16 * mt + tl) * 144 + (32 * ks + 8 * lq) * 2);
#pragma unroll
    for (int nt = 0; nt < 2; ++nt) { f32x4 g1 = z4, g2 = z4;
        if (nt <= mt) {
#pragma unroll
            for (int ks = 0; ks < 2; ++ks) { const bf16x8 fB = *(const LAS bf16x8*)(side + W3_BT + (16 * nt + tl) * 144 + (32 * ks + 8 * lq) * 2), fK = *(const LAS bf16x8*)(side + W3_KT + (16 * nt + tl) * 144 + (32 * ks + 8 * lq) * 2);
                g1 = __builtin_amdgcn_mfma_f32_16x16x32_bf16(fB, fR[ks], g1, 0, 0, 0); g2 = __builtin_amdgcn_mfma_f32_16x16x32_bf16(fK, fR[ks], g2, 0, 0, 0); } }
#pragma unroll
        for (int i = 0; i < 4; ++i) { const bool keep = (nt <= mt) && (16 * nt + 4 * lq + i <= 16 * mt + tl); g1[i] = keep ? g1[i] : 0.f; g2[i] = keep ? g2[i] : 0.f; }
        *(LAS u32x2*)(gs + tl * 80 + (16 * nt + 4 * lq) * 2) = (u32x2){cvt_pk_bf16(g1[0], g1[1]), cvt_pk_bf16(g1[2], g1[3])};
        *(LAS u32x2*)(gs + 1280 + tl * 80 + (16 * nt + 4 * lq) * 2) = (u32x2){cvt_pk_bf16(g2[0], g2[1]), cvt_pk_bf16(g2[2], g2[3])}; }
    asm volatile("s_waitcnt lgkmcnt(0)" ::: "memory");
    const bf16x8 fG1 = *(const LAS bf16x8*)(gs + tl * 80 + (8 * lq) * 2), fG2 = *(const LAS bf16x8*)(gs + 1280 + tl * 80 + (8 * lq) * 2);
    const LAS float* sp = (const LAS float*)(sab + tl * 144) + 8 * lq; const bf16x8 fS = f8_to_bf16x8(*(const LAS f32x4*)sp, *(const LAS f32x4*)(sp + 4));
    const bf16x8 fV = *(const LAS bf16x8*)(side + W3_VT + tl * 80 + (8 * lq) * 2);
    f32x4 y = __builtin_amdgcn_mfma_f32_16x16x32_bf16(fS, fG1, z4, 0, 0, 0);
    y = __builtin_amdgcn_mfma_f32_16x16x32_bf16(fV, fG2, y, 0, 0, 0);
#pragma unroll
    for (int ks = 0; ks < 2; ++ks) { const LAS float* hp = (const LAS float*)(h0b + tl * 272) + 32 * ks + 8 * lq; const bf16x8 fH = f8_to_bf16x8(*(const LAS f32x4*)hp, *(const LAS f32x4*)(hp + 4));
        y = __builtin_amdgcn_mfma_f32_16x16x32_bf16(fH, fR[ks], y, 0, 0, 0); }
    asm volatile("s_nop 15" : "+v"(y));
    *(u32x2*)(yrow + (size_t)(16 * mt + tl) * 512 + 4 * lq) = (u32x2){cvt_pk_bf16(y[0], y[1]), cvt_pk_bf16(y[2], y[3])};
    asm volatile("s_waitcnt lgkmcnt(0)" ::: "memory");
}
DEV void phase4_wkv3(unsigned char* ws, LAS float* lds, int wg, int nwg, const float* pu, const float* pv, const float* gn) {
    const bf16_t* praw = (const bf16_t*)(ws + WS_PRAW); const bf16_t* dd = (const bf16_t*)(ws + WS_DD); const bf16_t* aa = (const bf16_t*)(ws + WS_AA); bf16_t* yr = (bf16_t*)(ws + WS_YR);
    const float* par = (const float*)(ws + WS_PAR); LAS unsigned char* lb = (LAS unsigned char*)lds;
    const int tid = threadIdx.x, wid = __builtin_amdgcn_readfirstlane(tid >> 6), lane = tid & 63; const bool producer = wid >= 4; const int pw = wid & 3;
    LAS float* buf0 = lds; LAS float* buf1 = lds + W2_BF;
    const int p = tid & 255, j = p >> 4, q = p & 15;
    const int row = (wid & 3) * 4 + (lane >> 4), ks = lane & 15;
    for (int it = wg; it < 256; it += nwg) {
        const int bh = (it & 7) * 8 + ((it >> 3) >> 2), qd = (it >> 3) & 3, b = bh >> 3, h = bh & 7;
        bf16_t* ybase = yr + (size_t)b * SEQ * 512 + h * 64 + qd * 16;
        if (producer) {
            const int c = h * 64 + q * 4;
            const f32x4 mur = *(const f32x4*)(par + PAR_MU + c), muk = *(const f32x4*)(par + PAR_MU + 512 + c), kkc = *(const f32x4*)(par + PAR_KK + c), kac = *(const f32x4*)(par + PAR_KA + c);
            const f32x4 muv = *(const f32x4*)(par + PAR_MU + 1024 + h * 64 + qd * 16 + (q & 3) * 4);
            Wk2Load L0, L1;
            wk2_issue(L0, praw, dd, aa, b, h, qd, 0, j, q); wk2_issue(L1, praw, dd, aa, b, h, qd, 1, j, q);
            wk2_produce(L0, buf0, 0, j, q, mur, muk, kkc, kac, muv);
            wk2_issue(L0, praw, dd, aa, b, h, qd, 2, j, q);
#if OPT_PEER == 2
            TabGrp tg; tab_cvt_load(tg, pu, pv, (it * 64) * 256 + p);
#endif
            __syncthreads();
            for (int blk = 0; blk < WK_NBLK; blk += 2) {
                wk2_produce(L1, buf1, blk + 1, j, q, mur, muk, kkc, kac, muv);
                if (blk + 3 < WK_NBLK) wk2_issue(L1, praw, dd, aa, b, h, qd, blk + 3, j, q);
                wk3_side(buf0, lb + W3_SIDE0, pw, lane);
                if (blk > 0 && pw < 2) wk3_ymma(lb + W3_SIDE0 + W3_SIDESZ, lb + W3_SA0 + W3_SASZ, lb + W3_H00 + W3_H0SZ, lb + W3_GS0 + pw * W3_GSSZ, ybase + (size_t)(blk - 1) * WK_TB * 512, pw, lane);
                __syncthreads();
                if (blk + 2 < WK_NBLK) wk2_produce(L0, buf0, blk + 2, j, q, mur, muk, kkc, kac, muv);
                if (blk + 4 < WK_NBLK) wk2_issue(L0, praw, dd, aa, b, h, qd, blk + 4, j, q);
                wk3_side(buf1, lb + W3_SIDE0 + W3_SIDESZ, pw, lane);
                if (pw < 2) wk3_ymma(lb + W3_SIDE0, lb + W3_SA0, lb + W3_H00, lb + W3_GS0 + pw * W3_GSSZ, ybase + (size_t)blk * WK_TB * 512, pw, lane);
#if OPT_PEER == 2
                { const int gi = (it * 64 + (blk >> 1)) * 256 + p; tab_cvt_store(tg, gn, ws, gi); if (blk + 2 < WK_NBLK) tab_cvt_load(tg, pu, pv, gi + 256); }
#endif
                __syncthreads();
            }
            if (pw < 2) wk3_ymma(lb + W3_SIDE0 + W3_SIDESZ, lb + W3_SA0 + W3_SASZ, lb + W3_H00 + W3_H0SZ, lb + W3_GS0 + pw * W3_GSSZ, ybase + (size_t)(WK_NBLK - 1) * WK_TB * 512, pw, lane);
        } else {
            f32x4 S = (f32x4){0.f, 0.f, 0.f, 0.f};
            __syncthreads();
            for (int blk = 0; blk < WK_NBLK; blk += 2) {
                wk3_consume(buf0, lb + W3_SA0, lb + W3_H00, S, row, ks);
                __syncthreads();
                wk3_consume(buf1, lb + W3_SA0 + W3_SASZ, lb + W3_H00 + W3_H0SZ, S, row, ks);
                __syncthreads();
            }
        }
        __syncthreads();
    }
}

DEV void phase3_invn(unsigned char* ws, int gtid, int gsize) {
    const bf16_t* praw = (const bf16_t*)(ws + WS_PRAW); float* invn = (float*)(ws + WS_INVN); const float* par = (const float*)(ws + WS_PAR);
    const int lane = threadIdx.x & 63, gw = gtid >> 6, ngw = gsize >> 6, c0 = lane * 8;
    f32x4 muk[2], kkc[2];
#pragma unroll
    for (int j = 0; j < 2; ++j) { muk[j] = *(const f32x4*)(par + PAR_MU + 512 + c0 + 4 * j); kkc[j] = *(const f32x4*)(par + PAR_KK + c0 + 4 * j); }
    for (int m = gw; m < T; m += ngw) { const bool first = (m & (SEQ - 1)) == 0; const size_t mp = first ? m : m - 1;
        f32x4 k[2], kp[2]; unpack8(*(const u32x4*)(praw + pr_off((size_t)((size_t)m), 512 + c0)), k[0], k[1]); unpack8(*(const u32x4*)(praw + pr_off((size_t)(mp), 512 + c0)), kp[0], kp[1]);
        float n2 = 0.f;
#pragma unroll
        for (int j = 0; j < 2; ++j) { if (first) kp[j] = (f32x4){0.f, 0.f, 0.f, 0.f}; const f32x4 q = (k[j] + (kp[j] - k[j]) * muk[j]) * kkc[j]; n2 += (q[0] * q[0] + q[1] * q[1]) + (q[2] * q[2] + q[3] * q[3]); }
        n2 += dpp_f<0xB1>(n2); n2 += dpp_f<0x4E>(n2); n2 += dpp_f<0x141>(n2);
        if ((lane & 7) == 0) invn[(size_t)m * 8 + (lane >> 3)] = 1.0f / fmaxf(sqrtf(n2), 1e-12f);
    }
}

constexpr int W4_AT = 0, W4_BT = 2304, W4_KT = 4608, W4_RT = 6912, W4_BTT = 9216, W4_KTT = 12288, W4_VT = 15360, W4_GL = 16128, W4_SLOT = 16384;
constexpr int W4_PO = 3 * W4_SLOT, W4_POSZ = 3072, W4_PT = 0, W4_PM = 768, W4_PG1 = 1536, W4_PG2 = 2304;
constexpr int W4_PS = W4_PO + 2 * W4_POSZ, W4_NR = 0, W4_PR = 768, W4_VB = 1536, W4_SS = W4_PS + 2304, W4_RB = 0, W4_SB = 768, W4_HB = 1536, W4_NBLK = SEQ / 16;
static_assert(W4_SS + W4_HB + 2304 <= 131072, "wkv4 LDS map");
DEV bf16x8 ld16(const LAS unsigned char* base, int tl, int lq) { const bf16x8 v = *(const LAS bf16x8*)(base + tl * 48 + (lq & 1) * 16); const bf16x8 z = {0, 0, 0, 0, 0, 0, 0, 0}; return (lq < 2) ? v : z; }
typedef __bf16 bf16x4n __attribute__((ext_vector_type(4)));
DEV u32x2 cvt4(f32x4 x) { return __builtin_bit_cast(u32x2, __builtin_convertvector(x, bf16x4n)); }
DEV void wr16(LAS unsigned char* base, f32x4 x, int tl, int lq) { *(LAS u32x2*)(base + tl * 48 + lq * 8) = cvt4(x); }
DEV f32x4 mm(const bf16x8 a, const bf16x8 b, const f32x4 c) { return __builtin_amdgcn_mfma_f32_16x16x32_bf16(a, b, c, 0, 0, 0); }
struct W4Load { u32x2 r0, r1, k0, k1, d, a, v0, v1; float inv; };
DEV void wk4_issue(W4Load& L, const bf16_t* praw, const bf16_t* dd, const bf16_t* aa, const float* invn, int b, int h, int qd, int bi, int s, int kq, int qq, int pw) {
    const int t = min(bi, W4_NBLK - 1) * 16 + s; const size_t m = (size_t)b * SEQ + t, mp = (t > 0) ? m - 1 : m; const int c = h * 64 + kq * 4;
    L.r1 = *(const u32x2*)(praw + pr_off((size_t)(m), c)); L.r0 = *(const u32x2*)(praw + pr_off((size_t)(mp), c)); L.k1 = *(const u32x2*)(praw + pr_off((size_t)(m), 512 + c)); L.k0 = *(const u32x2*)(praw + pr_off((size_t)(mp), 512 + c));
    L.d = *(const u32x2*)(dd + da_off(m, c)); L.a = *(const u32x2*)(aa + da_off(m, c)); L.inv = invn[m * 8 + h];
    { const int cv = 1024 + h * 64 + qd * 16 + qq * 4; L.v1 = *(const u32x2*)(praw + pr_off((size_t)(m), cv)); L.v0 = *(const u32x2*)(praw + pr_off((size_t)(mp), cv)); }
}
DEV void wk4_produce(const W4Load& L, LAS unsigned char* slot, int bi, int s, int kq, int qq, int pw, const f32x4 mur, const f32x4 muk, const f32x4 kkc, const f32x4 kac, const f32x4 muv) {
    const bool first = (bi == 0 && s == 0);
    f32x4 r0, r1, k0, k1, d, a; up4(L.r0, r0); up4(L.r1, r1); up4(L.k0, k0); up4(L.k1, k1); up4(L.d, d); up4(L.a, a);
    if (first) { r0 = (f32x4){0.f, 0.f, 0.f, 0.f}; k0 = r0; }
    const f32x4 rl = r1 + (r0 - r1) * mur, kl = k1 + (k0 - k1) * muk, kk = kl * kkc * L.inv;
    const f32x4 bh = kk * a, k2 = kl * (1.0f + (a - 1.0f) * kac), w = 1.0f - d;
    f32x4 g = w, gx, ig;
#pragma unroll
    for (int c = 0; c < 4; ++c) { float x = g[c]; x *= dpp_shr_id1<0x111>(x); x *= dpp_shr_id1<0x112>(x); x *= dpp_shr_id1<0x114>(x); x *= dpp_shr_id1<0x118>(x); g[c] = x; gx[c] = dpp_shr_id1<0x111>(x); ig[c] = 1.0f / x; }
    const f32x4 at = -(kk * gx), bt = bh * ig, kt = k2 * ig, rt = rl * g;
    LAS unsigned char* o = slot + s * 144 + kq * 8;
    *(LAS u32x2*)(o + W4_AT) = (u32x2){cvt_pk_bf16(at[0], at[1]), cvt_pk_bf16(at[2], at[3])}; *(LAS u32x2*)(o + W4_BT) = (u32x2){cvt_pk_bf16(bt[0], bt[1]), cvt_pk_bf16(bt[2], bt[3])};
    *(LAS u32x2*)(o + W4_KT) = (u32x2){cvt_pk_bf16(kt[0], kt[1]), cvt_pk_bf16(kt[2], kt[3])}; *(LAS u32x2*)(o + W4_RT) = (u32x2){cvt_pk_bf16(rt[0], rt[1]), cvt_pk_bf16(rt[2], rt[3])};
#pragma unroll
    for (int c = 0; c < 4; ++c) { *(LAS bf16_t*)(slot + W4_BTT + (4 * kq + c) * 48 + s * 2) = f2bf(bt[c]); *(LAS bf16_t*)(slot + W4_KTT + (4 * kq + c) * 48 + s * 2) = f2bf(kt[c]); }
    if (s == 15) *(LAS f32x4*)(slot + W4_GL + kq * 16) = g;
    if (pw == 0) { f32x4 v0, v1; up4(L.v0, v0); up4(L.v1, v1); if (first) v0 = (f32x4){0.f, 0.f, 0.f, 0.f}; const f32x4 vl = v1 + (v0 - v1) * muv;
#pragma unroll
        for (int c = 0; c < 4; ++c) *(LAS bf16_t*)(slot + W4_VT + (4 * qq + c) * 48 + s * 2) = f2bf(vl[c]); }
}
DEV bf16x8 fa(f32x4 x) { const u32x2 c = cvt4(x); const u32x4 w = (u32x4){c[0], c[1], 0u, 0u}; return __builtin_bit_cast(bf16x8, w); }
DEV bf16x8 ld16p(const LAS unsigned char* base, int tl, int lq) { const u32x2 v = *(const LAS u32x2*)(base + tl * 48 + lq * 8); const u32x4 w = (u32x4){v[0], v[1], 0u, 0u}; return __builtin_bit_cast(bf16x8, w); }
DEV bf16x8 ld64p(const LAS unsigned char* rowbase, int ks, int lq) { const u32x2 a = *(const LAS u32x2*)(rowbase + (32 * ks + 4 * lq) * 2), b = *(const LAS u32x2*)(rowbase + (32 * ks + 16 + 4 * lq) * 2); const u32x4 w = (u32x4){a[0], a[1], b[0], b[1]}; return __builtin_bit_cast(bf16x8, w); }
DEV void wk4_prep(const LAS unsigned char* slot, LAS unsigned char* po, int lane) {
    const int tl = lane & 15, lq = lane >> 4; const f32x4 z4 = (f32x4){0.f, 0.f, 0.f, 0.f};
    f32x4 aN = z4, aP = z4, aM = z4, aG1 = z4, aG2 = z4;
#pragma unroll
    for (int ks = 0; ks < 2; ++ks) { const int off = tl * 144 + (32 * ks + 8 * lq) * 2;
        const bf16x8 fA = *(const LAS bf16x8*)(slot + W4_AT + off), fB = *(const LAS bf16x8*)(slot + W4_BT + off), fK = *(const LAS bf16x8*)(slot + W4_KT + off), fR = *(const LAS bf16x8*)(slot + W4_RT + off);
        aN = mm(fA, fB, aN); aP = mm(fB, fA, aP); aM = mm(fK, fA, aM); aG1 = mm(fB, fR, aG1); aG2 = mm(fK, fR, aG2); }
    f32x4 aV;
#pragma unroll
    for (int i = 0; i < 4; ++i) { const int r = 4 * lq + i;
        aN[i] = (tl < r) ? aN[i] : 0.f;
        aP[i] = (r < tl) ? aP[i] : 0.f;
        aM[i] = (r < tl) ? aM[i] : 0.f;
        aG1[i] = (r <= tl) ? aG1[i] : 0.f; aG2[i] = (r <= tl) ? aG2[i] : 0.f;
        aV[i] = aP[i] + ((r == tl) ? 1.0f : 0.f); }
    wr16(po + W4_PM, aM, tl, lq); wr16(po + W4_PG1, aG1, tl, lq); wr16(po + W4_PG2, aG2, tl, lq);
#pragma unroll
    for (int lv = 1; lv <= 3; ++lv) {
        const bf16x8 fN = fa(aN), fP = fa(aP);
        aN = mm(fP, fN, z4);
        if (lv < 3) aP = mm(fN, fP, z4);
        aV = mm(fa(aN), fa(aV), aV);
    }
    wr16(po + W4_PT, aV, tl, lq);
    asm volatile("s_waitcnt lgkmcnt(0)" ::: "memory");
}
DEV void wk4_solve(const LAS unsigned char* slot, const LAS unsigned char* po, f32x4 (&H)[4], bf16_t* yrow, int lane) {
    const int tl = lane & 15, lq = lane >> 4; const f32x4 z4 = (f32x4){0.f, 0.f, 0.f, 0.f};
    bf16x8 fH[2], fA[2], fR[2];
#pragma unroll
    for (int ks = 0; ks < 2; ++ks) { fA[ks] = ld64p(slot + W4_AT + tl * 144, ks, lq); fR[ks] = ld64p(slot + W4_RT + tl * 144, ks, lq);
        const u32x2 c0 = cvt4(H[2 * ks]), c1 = cvt4(H[2 * ks + 1]); const u32x4 w = (u32x4){c0[0], c0[1], c1[0], c1[1]}; fH[ks] = __builtin_bit_cast(bf16x8, w); }
    const bf16x8 fM = ld16p(po + W4_PM, tl, lq), fT = ld16p(po + W4_PT, tl, lq), fG1 = ld16p(po + W4_PG1, tl, lq), fG2 = ld16p(po + W4_PG2, tl, lq), fV = ld16p(slot + W4_VT, tl, lq);
    f32x4 rhs = mm(fA[0], fH[0], z4); rhs = mm(fA[1], fH[1], rhs); rhs = mm(fM, fV, rhs);
    const f32x4 sa = mm(fT, fa(rhs), z4);
    const bf16x8 fS = fa(sa);
    f32x4 y = mm(fS, fG1, z4); y = mm(fV, fG2, y); y = mm(fH[0], fR[0], y); y = mm(fH[1], fR[1], y);
#pragma unroll
    for (int kt = 0; kt < 4; ++kt) { H[kt] = mm(ld16p(slot + W4_BTT + kt * 768, tl, lq), fS, H[kt]); H[kt] = mm(ld16p(slot + W4_KTT + kt * 768, tl, lq), fV, H[kt]);
        H[kt] = H[kt] * *(const LAS f32x4*)(slot + W4_GL + (16 * kt + 4 * lq) * 4); }
    *(u32x2*)(yrow + (size_t)tl * 512 + 4 * lq) = cvt4(y);
}
DEV void phase4_wkv4(unsigned char* ws, LAS float* lds, int wg, int nwg, const float* pu, const float* pv, const float* gn, const int abl) {
    const bf16_t* praw = (const bf16_t*)(ws + WS_PRAW); const bf16_t* dd = (const bf16_t*)(ws + WS_DD); const bf16_t* aa = (const bf16_t*)(ws + WS_AA); bf16_t* yr = (bf16_t*)(ws + WS_YR);
    const float* par = (const float*)(ws + WS_PAR); const float* invn = (const float*)(ws + WS_INVN); LAS unsigned char* lb = (LAS unsigned char*)lds;
    const int tid = threadIdx.x, wid = __builtin_amdgcn_readfirstlane(tid >> 6), lane = tid & 63; const int pw = wid & 3, qq = lane >> 4, s = lane & 15, kq = 4 * pw + qq;
    const bool producer = wid >= 4;
    for (int it = wg; it < 256; it += nwg) {
        const int bh = (it & 7) * 8 + ((it >> 3) >> 2), qd = (it >> 3) & 3, b = bh >> 3, h = bh & 7;
        bf16_t* ybase = yr + (size_t)b * SEQ * 512 + h * 64 + qd * 16;
        const int c = h * 64 + kq * 4;
        const f32x4 mur = *(const f32x4*)(par + PAR_MU + c), muk = *(const f32x4*)(par + PAR_MU + 512 + c), kkc = *(const f32x4*)(par + PAR_KK + c), kac = *(const f32x4*)(par + PAR_KA + c);
        const f32x4 muv = *(const f32x4*)(par + PAR_MU + 1024 + h * 64 + qd * 16 + qq * 4);
        W4Load La, Lb; f32x4 H[4];
#pragma unroll
        for (int kt = 0; kt < 4; ++kt) H[kt] = (f32x4){0.f, 0.f, 0.f, 0.f};
#if OPT_PEER == 2
        TabGrp tg0, tg1, tg2, tg3; const int p2 = tid & 127;
#endif
        if (producer) {
            wk4_issue(La, praw, dd, aa, invn, b, h, qd, 0, s, kq, qq, pw); wk4_issue(Lb, praw, dd, aa, invn, b, h, qd, 1, s, kq, qq, pw);
            wk4_produce(La, lb, 0, s, kq, qq, pw, mur, muk, kkc, kac, muv); wk4_issue(La, praw, dd, aa, invn, b, h, qd, 2, s, kq, qq, pw);
            __syncthreads();
            wk4_produce(Lb, lb + W4_SLOT, 1, s, kq, qq, pw, mur, muk, kkc, kac, muv); wk4_issue(Lb, praw, dd, aa, invn, b, h, qd, 3, s, kq, qq, pw);
            __syncthreads();
            int s0 = 0, s2 = 2;
            for (int bi = 0; bi < W4_NBLK; bi += 2) {
                if (!(abl & 4)) wk4_produce(La, lb + s2 * W4_SLOT, bi + 2, s, kq, qq, pw, mur, muk, kkc, kac, muv); if (!(abl & 8)) wk4_issue(La, praw, dd, aa, invn, b, h, qd, bi + 4, s, kq, qq, pw);
                __syncthreads();
                if (!(abl & 4)) wk4_produce(Lb, lb + s0 * W4_SLOT, bi + 3, s, kq, qq, pw, mur, muk, kkc, kac, muv); if (!(abl & 8)) wk4_issue(Lb, praw, dd, aa, invn, b, h, qd, bi + 5, s, kq, qq, pw);
                __syncthreads();
                const int s1 = 3 - s0 - s2, t0 = s0; s0 = s2; s2 = s1; (void)t0;
            }
        } else if (wid == 1) {
            __syncthreads();
            wk4_prep(lb, lb + W4_PO, lane);
            __syncthreads();
            int s1 = 1, s2 = 2;
            for (int bi = 0; bi < W4_NBLK; bi += 2) {
                if (!(abl & 2)) wk4_prep(lb + s1 * W4_SLOT, lb + W4_PO + W4_POSZ, lane);
                __syncthreads();
                if (!(abl & 2)) wk4_prep(lb + s2 * W4_SLOT, lb + W4_PO, lane);
                __syncthreads();
                const int s0 = 3 - s1 - s2; s2 = s1; s1 = s0;
            }
        } else if (wid == 0) {
            __syncthreads();
            __syncthreads();
            int s0 = 0, s1 = 1;
            for (int bi = 0; bi < W4_NBLK; bi += 2) {
                if (!(abl & 1)) wk4_solve(lb + s0 * W4_SLOT, lb + W4_PO, H, ybase + (size_t)bi * 16 * 512, lane);
                __syncthreads();
                if (!(abl & 1)) wk4_solve(lb + s1 * W4_SLOT, lb + W4_PO + W4_POSZ, H, ybase + (size_t)(bi + 1) * 16 * 512, lane);
                __syncthreads();
                const int s2 = 3 - s0 - s1; s1 = s0; s0 = s2;
            }
        } else {
#if OPT_PEER == 2
            { const int gi = (it * 128) * 128 + p2; tab_cvt_load(tg0, pu, pv, gi); tab_cvt_load(tg1, pu, pv, gi + 128); tab_cvt_load(tg2, pu, pv, gi + 256); tab_cvt_load(tg3, pu, pv, gi + 384); }
#endif
            __syncthreads();
            __syncthreads();
            for (int bi = 0; bi < W4_NBLK; bi += 2) {
#if OPT_PEER == 2
                if ((bi & 7) == 0 && !(abl & 16)) { const int gi = (it * 128 + (bi >> 1)) * 128 + p2;
                    tab_cvt_store(tg0, gn, ws, gi); tab_cvt_store(tg1, gn, ws, gi + 128); tab_cvt_store(tg2, gn, ws, gi + 256); tab_cvt_store(tg3, gn, ws, gi + 384);
                    if (bi + 8 < W4_NBLK) { tab_cvt_load(tg0, pu, pv, gi + 512); tab_cvt_load(tg1, pu, pv, gi + 640); tab_cvt_load(tg2, pu, pv, gi + 768); tab_cvt_load(tg3, pu, pv, gi + 896); } }
#endif
                __syncthreads();
                __syncthreads();
            }
        }
        __syncthreads();
    }
}

struct XcdBarrier; DEV void xcd_barrier(const XcdBarrier& b);
constexpr int W5_NBH = 128, W5_STEPS = W5_NBH + 8, W5_NCH = 256 / W5_NBH;
constexpr int R_FA = 0, R_FR = 2048, R_FBT = 4096, R_FKT = 6144, R_FM = 8192, R_FT = 8704, R_FG1 = 9216, R_FG2 = 9728, R_GL = 10240, R_FV = 10752, R_SIZE = 10752, W5_SLOT = 11264;
constexpr int P5_AT = 0, P5_BT = 2304, P5_KT = 4608, P5_RT = 6912, P5_BS = 9216, P5_KS = 11520, P5_VT = 13824, P5_GL = 16128, P5_SIZE = 16384;
typedef short bf16x4s __attribute__((ext_vector_type(4)));
DEV f32x4 mm16(const u32x2 a, const u32x2 b, const f32x4 c) { return __builtin_amdgcn_mfma_f32_16x16x16bf16_1k(__builtin_bit_cast(bf16x4s, a), __builtin_bit_cast(bf16x4s, b), c, 0, 0, 0); }
DEV f32x4 mm16p(const u32x2 a, const u32x2 b, const f32x4 c) { const u32x4 a4 = (u32x4){a[0], a[1], 0u, 0u}, b4 = (u32x4){b[0], b[1], 0u, 0u}; return __builtin_amdgcn_mfma_f32_16x16x32_bf16(__builtin_bit_cast(bf16x8, a4), __builtin_bit_cast(bf16x8, b4), c, 0, 0, 0); }
DEV f32x4 mm32(const u32x4 a, const u32x4 b, const f32x4 c) { return __builtin_amdgcn_mfma_f32_16x16x32_bf16(__builtin_bit_cast(bf16x8, a), __builtin_bit_cast(bf16x8, b), c, 0, 0, 0); }
struct W5Load { u32x4 r0, r1, k0, k1, d, a; };
constexpr int P5_CONST = 131072 + 1024;
DEV void wk5_issue(W5Load& L, const bf16_t* praw, const bf16_t* dd, const bf16_t* aa, const float* invn, int b, int h, int blk, int s, int g8) {
    const int t = blk * 16 + s; const size_t m = (size_t)b * SEQ + t, mp = (t > 0) ? m - 1 : m; const int c = h * 64 + g8 * 8;
    L.r1 = *(const u32x4*)(praw + pr_off((size_t)(m), c)); L.k1 = *(const u32x4*)(praw + pr_off((size_t)(m), 512 + c));
    if (s == 0) { L.r0 = *(const u32x4*)(praw + pr_off((size_t)(mp), c)); L.k0 = *(const u32x4*)(praw + pr_off((size_t)(mp), 512 + c)); }
    L.d = *(const u32x4*)(dd + da_off(m, c)); L.a = *(const u32x4*)(aa + da_off(m, c)); (void)invn;
}
struct W5Half { f32x4 g, at, bt, kt, rt; float bsum; };
DEV void wk5_math(W5Half& R, const u32x2 r0w, const u32x2 r1w, const u32x2 k0w, const u32x2 k1w, const u32x2 dw, const u32x2 aw, const float inv, const bool first, const LAS float* cst, const int kq) {
    const f32x4 mur = *(const LAS f32x4*)(cst + kq * 4), muk = *(const LAS f32x4*)(cst + 64 + kq * 4), kkc = *(const LAS f32x4*)(cst + 192 + kq * 4), kac = *(const LAS f32x4*)(cst + 256 + kq * 4);
    f32x4 r0, r1, k0, k1, d, a; up4(r0w, r0); up4(r1w, r1); up4(k0w, k0); up4(k1w, k1); up4(dw, d); up4(aw, a);
    if (first) { r0 = (f32x4){0.f, 0.f, 0.f, 0.f}; k0 = r0; }
    const f32x4 rl = r1 + (r0 - r1) * mur, kl = k1 + (k0 - k1) * muk, kk = kl * kkc * inv;
    const f32x4 bh = kk * a, k2 = kl * (1.0f + (a - 1.0f) * kac), w = 1.0f - d;
    { const f32x4 tb = rl * k2 * *(const LAS f32x4*)(cst + 320 + kq * 4); R.bsum = (tb[0] + tb[1]) + (tb[2] + tb[3]); }
    f32x4 g = w, gx, ig;
#pragma unroll
    for (int c = 0; c < 4; ++c) { float x = g[c]; x *= dpp_shr_id1<0x111>(x); x *= dpp_shr_id1<0x112>(x); x *= dpp_shr_id1<0x114>(x); x *= dpp_shr_id1<0x118>(x); g[c] = x; gx[c] = dpp_shr_id1<0x111>(x); ig[c] = __builtin_amdgcn_rcpf(x); }
    R.g = g; R.at = -(kk * gx); R.bt = bh * ig; R.kt = k2 * ig; R.rt = rl * g;
}
DEV float wk5_knorm2(const W5Load& L, const LAS float* cst, const bool first, const int g8) {
    float n2 = 0.f;
#pragma unroll
    for (int hf = 0; hf < 2; ++hf) { const int kq = 2 * g8 + hf;
        const f32x4 muk = *(const LAS f32x4*)(cst + 64 + kq * 4), kkc = *(const LAS f32x4*)(cst + 192 + kq * 4);
        u32x2 k0w, k1w = (u32x2){L.k1[2 * hf], L.k1[2 * hf + 1]};
        k0w[0] = (unsigned)__builtin_amdgcn_update_dpp((int)L.k0[2 * hf], (int)L.k1[2 * hf], 0x111, 0xf, 0xf, false); k0w[1] = (unsigned)__builtin_amdgcn_update_dpp((int)L.k0[2 * hf + 1], (int)L.k1[2 * hf + 1], 0x111, 0xf, 0xf, false);
        f32x4 k0, k1; up4(k0w, k0); up4(k1w, k1); if (first) k0 = (f32x4){0.f, 0.f, 0.f, 0.f};
        const f32x4 q = (k1 + (k0 - k1) * muk) * kkc; n2 += (q[0] * q[0] + q[1] * q[1]) + (q[2] * q[2] + q[3] * q[3]); }
    return n2;
}
DEV u32x4 pk8(const f32x4 lo, const f32x4 hi) { const u32x2 a = cvt4(lo), b = cvt4(hi); return (u32x4){a[0], a[1], b[0], b[1]}; }
DEV float wk5_produce(const W5Load& L, const float inv, LAS unsigned char* pl, const LAS float* cst, unsigned char* rec, int blk, int s, int g8) {
    const bool first = (blk == 0 && s == 0);
    W5Half A, B; u32x4 r0, k0;
#pragma unroll
    for (int i = 0; i < 4; ++i) { r0[i] = (unsigned)__builtin_amdgcn_update_dpp((int)L.r0[i], (int)L.r1[i], 0x111, 0xf, 0xf, false); k0[i] = (unsigned)__builtin_amdgcn_update_dpp((int)L.k0[i], (int)L.k1[i], 0x111, 0xf, 0xf, false); }
    wk5_math(A, (u32x2){r0[0], r0[1]}, (u32x2){L.r1[0], L.r1[1]}, (u32x2){k0[0], k0[1]}, (u32x2){L.k1[0], L.k1[1]}, (u32x2){L.d[0], L.d[1]}, (u32x2){L.a[0], L.a[1]}, inv, first, cst, 2 * g8);
    wk5_math(B, (u32x2){r0[2], r0[3]}, (u32x2){L.r1[2], L.r1[3]}, (u32x2){k0[2], k0[3]}, (u32x2){L.k1[2], L.k1[3]}, (u32x2){L.d[2], L.d[3]}, (u32x2){L.a[2], L.a[3]}, inv, first, cst, 2 * g8 + 1);
    if (s == 15) { *(LAS f32x4*)(pl + P5_GL + g8 * 32) = A.g; *(LAS f32x4*)(pl + P5_GL + g8 * 32 + 16) = B.g; *(f32x4*)(rec + R_GL + g8 * 32) = A.g; *(f32x4*)(rec + R_GL + g8 * 32 + 16) = B.g; }
    LAS unsigned char* o = pl + s * 144 + g8 * 16;
    *(LAS u32x4*)(o + P5_AT) = pk8(A.at, B.at); *(LAS u32x4*)(o + P5_BT) = pk8(A.bt, B.bt); *(LAS u32x4*)(o + P5_KT) = pk8(A.kt, B.kt); *(LAS u32x4*)(o + P5_RT) = pk8(A.rt, B.rt);
    asm volatile("" ::: "memory");
    const f32x4 gl0 = *(const LAS f32x4*)(pl + P5_GL + g8 * 32), gl1 = *(const LAS f32x4*)(pl + P5_GL + g8 * 32 + 16);
    *(LAS u32x4*)(o + P5_BS) = pk8(A.bt * gl0, B.bt * gl1); *(LAS u32x4*)(o + P5_KS) = pk8(A.kt * gl0, B.kt * gl1);
    float bs = A.bsum + B.bsum; bs += __shfl_xor(bs, 16); bs += __shfl_xor(bs, 32); return bs;
}
DEV u32x2 ld4t(const LAS unsigned char* tab, int lq, int col) {
    const LAS unsigned char* p = tab + (4 * lq) * 144 + col * 2;
    const unsigned x0 = *(const LAS unsigned short*)(p), x1 = *(const LAS unsigned short*)(p + 144), x2 = *(const LAS unsigned short*)(p + 288), x3 = *(const LAS unsigned short*)(p + 432);
    return (u32x2){x0 | (x1 << 16), x2 | (x3 << 16)};
}
DEV u32x4 ld64q(const LAS unsigned char* rowbase, int ks, int lq) { const u32x2 a = *(const LAS u32x2*)(rowbase + (32 * ks + 4 * lq) * 2), b = *(const LAS u32x2*)(rowbase + (32 * ks + 16 + 4 * lq) * 2); return (u32x4){a[0], a[1], b[0], b[1]}; }
DEV void wk5_emit(const LAS unsigned char* pl, unsigned char* rec, int lane) {
    const int tl = lane & 15, lq = lane >> 4; const f32x4 z4 = (f32x4){0.f, 0.f, 0.f, 0.f};
    f32x4 aN = z4, aP = z4, aM = z4, aG1 = z4, aG2 = z4;
#pragma unroll
    for (int ks = 0; ks < 2; ++ks) { const int off = tl * 144 + (32 * ks + 8 * lq) * 2;
        const bf16x8 fA = *(const LAS bf16x8*)(pl + P5_AT + off), fB = *(const LAS bf16x8*)(pl + P5_BT + off), fK = *(const LAS bf16x8*)(pl + P5_KT + off), fR = *(const LAS bf16x8*)(pl + P5_RT + off);
        aN = mm(fA, fB, aN); aP = mm(fB, fA, aP); aM = mm(fK, fA, aM); aG1 = mm(fB, fR, aG1); aG2 = mm(fK, fR, aG2); }
    f32x4 aV;
#pragma unroll
    for (int i = 0; i < 4; ++i) { const int r = 4 * lq + i;
        aN[i] = (tl < r) ? aN[i] : 0.f;
        aP[i] = (r < tl) ? aP[i] : 0.f;
        aM[i] = (r < tl) ? aM[i] : 0.f;
        aG1[i] = (r <= tl) ? aG1[i] : 0.f; aG2[i] = (r <= tl) ? aG2[i] : 0.f;
        aV[i] = aP[i] + ((r == tl) ? 1.0f : 0.f); }
#pragma unroll
    for (int lv = 1; lv <= 3; ++lv) {
        const u32x2 fN = cvt4(aN), fP = cvt4(aP);
        aN = mm16p(fP, fN, z4);
        if (lv < 3) aP = mm16p(fN, fP, z4);
        aV = mm16p(cvt4(aN), cvt4(aV), aV);
    }
    const u32x2 fM = cvt4(aM), fT = cvt4(aV), fG1 = cvt4(aG1), fG2 = cvt4(aG2);
    const unsigned one = 0x3F80u, jsel = (unsigned)(tl & 7), lsel = (unsigned)(tl >> 3);
    u32x4 slo, shi;
#pragma unroll
    for (int p = 0; p < 4; ++p) { const unsigned e0 = (jsel == 2u * p) ? one : 0u, e1 = (jsel == 2u * p + 1u) ? (one << 16) : 0u; slo[p] = ((unsigned)lq == lsel) ? (e0 | e1) : 0u; shi[p] = ((unsigned)lq == lsel + 2u) ? (e0 | e1) : 0u; }
    u32x2 fb[4], fk[4];
#pragma unroll
    for (int ks = 0; ks < 2; ++ks) { const u32x4 xb = *(const LAS u32x4*)(pl + P5_BS + tl * 144 + (32 * ks + 8 * lq) * 2), xk = *(const LAS u32x4*)(pl + P5_KS + tl * 144 + (32 * ks + 8 * lq) * 2);
        fb[2 * ks] = cvt4(mm32(xb, slo, z4)); fb[2 * ks + 1] = cvt4(mm32(xb, shi, z4)); fk[2 * ks] = cvt4(mm32(xk, slo, z4)); fk[2 * ks + 1] = cvt4(mm32(xk, shi, z4)); }
    unsigned char* o = rec + lane * 16;
    *(u32x4*)(o) = ld64q(pl + P5_AT + tl * 144, 0, lq); *(u32x4*)(o + 1024) = ld64q(pl + P5_AT + tl * 144, 1, lq);
    *(u32x4*)(o + 2048) = ld64q(pl + P5_RT + tl * 144, 0, lq); *(u32x4*)(o + 3072) = ld64q(pl + P5_RT + tl * 144, 1, lq);
    *(u32x4*)(o + 4096) = (u32x4){fb[0][0], fb[0][1], fb[1][0], fb[1][1]}; *(u32x4*)(o + 5120) = (u32x4){fb[2][0], fb[2][1], fb[3][0], fb[3][1]};
    *(u32x4*)(o + 6144) = (u32x4){fk[0][0], fk[0][1], fk[1][0], fk[1][1]}; *(u32x4*)(o + 7168) = (u32x4){fk[2][0], fk[2][1], fk[3][0], fk[3][1]};
    *(u32x4*)(o + 8192) = (u32x4){fM[0], fM[1], fT[0], fT[1]}; *(u32x4*)(o + 9216) = (u32x4){fG1[0], fG1[1], fG2[0], fG2[1]};
}
struct W5Ops { u32x4 fA0, fA1; };
DEV void wk5_ld(W5Ops& P, const LAS unsigned char* slot, int lane) { P.fA0 = *(const LAS u32x4*)(slot + R_FA + lane * 16); P.fA1 = *(const LAS u32x4*)(slot + R_FA + 1024 + lane * 16); }
DEV void mm16_guard(f32x4& x) { asm volatile("s_nop 15\n\ts_nop 3" : "+v"(x)); }
DEV void wk5_block(const W5Ops& P, const LAS unsigned char* slot, f32x4 (&H)[4], bf16_t* yrow, int lane) {
    const int tl = lane & 15, lq = lane >> 4; const f32x4 z4 = (f32x4){0.f, 0.f, 0.f, 0.f};
    const u32x2 c0 = cvt4(H[0]), c1 = cvt4(H[1]), c2 = cvt4(H[2]), c3 = cvt4(H[3]);
    const u32x4 fH0 = (u32x4){c0[0], c0[1], c1[0], c1[1]}, fH1 = (u32x4){c2[0], c2[1], c3[0], c3[1]};
    const LAS unsigned char* sl = slot + lane * 16;
    const u32x2 fV = *(const LAS u32x2*)(slot + R_FV + lane * 8);
    const u32x4 mt = *(const LAS u32x4*)(sl + 8192);
    f32x4 rhs = mm32(P.fA0, fH0, z4); rhs = mm32(P.fA1, fH1, rhs); rhs = mm16p((u32x2){mt[0], mt[1]}, fV, rhs);
    const u32x4 k01 = *(const LAS u32x4*)(sl + 6144), k23 = *(const LAS u32x4*)(sl + 7168);
    H[0] = mm16p((u32x2){k01[0], k01[1]}, fV, H[0] * *(const LAS f32x4*)(slot + R_GL + (4 * lq) * 4));
    H[1] = mm16p((u32x2){k01[2], k01[3]}, fV, H[1] * *(const LAS f32x4*)(slot + R_GL + (16 + 4 * lq) * 4));
    H[2] = mm16p((u32x2){k23[0], k23[1]}, fV, H[2] * *(const LAS f32x4*)(slot + R_GL + (32 + 4 * lq) * 4));
    H[3] = mm16p((u32x2){k23[2], k23[3]}, fV, H[3] * *(const LAS f32x4*)(slot + R_GL + (48 + 4 * lq) * 4));
    const u32x4 g12 = *(const LAS u32x4*)(sl + 9216);
    f32x4 y = mm32(fH0, *(const LAS u32x4*)(sl + 2048), z4); y = mm32(fH1, *(const LAS u32x4*)(sl + 3072), y);
    y = mm16p(fV, (u32x2){g12[2], g12[3]}, y);
    const f32x4 sa = mm16p((u32x2){mt[2], mt[3]}, cvt4(rhs), z4);
    const u32x2 fS = cvt4(sa);
    const u32x4 b01 = *(const LAS u32x4*)(sl + 4096), b23 = *(const LAS u32x4*)(sl + 5120);
    H[0] = mm16p((u32x2){b01[0], b01[1]}, fS, H[0]); H[1] = mm16p((u32x2){b01[2], b01[3]}, fS, H[1]); H[2] = mm16p((u32x2){b23[0], b23[1]}, fS, H[2]); H[3] = mm16p((u32x2){b23[2], b23[3]}, fS, H[3]);
    y = mm16p(fS, (u32x2){g12[0], g12[1]}, y);
    *(u32x2*)(yrow + (size_t)tl * 512 + 4 * lq) = cvt4(y);
}
struct W5Rec { u32x4 c0, c1, c2, c3, c4, c5, c6, c7, c8, c9, c10; };
DEV void wk5_rissue(W5Rec& L, const unsigned char* rec0, int B, int lane, int off10) {
    const unsigned char* r = rec0 + (size_t)min(B, W5_NBH - 1) * R_SIZE + lane * 16;
    L.c0 = *(const u32x4*)(r); L.c1 = *(const u32x4*)(r + 1024); L.c2 = *(const u32x4*)(r + 2048); L.c3 = *(const u32x4*)(r + 3072); L.c4 = *(const u32x4*)(r + 4096); L.c5 = *(const u32x4*)(r + 5120);
    L.c6 = *(const u32x4*)(r + 6144); L.c7 = *(const u32x4*)(r + 7168); L.c8 = *(const u32x4*)(r + 8192); L.c9 = *(const u32x4*)(r + 9216); L.c10 = *(const u32x4*)(r + off10);
}
DEV void wk5_rwrite(const W5Rec& L, LAS unsigned char* slot, int lane) {
    LAS unsigned char* o = slot + lane * 16;
    *(LAS u32x4*)(o) = L.c0; *(LAS u32x4*)(o + 1024) = L.c1; *(LAS u32x4*)(o + 2048) = L.c2; *(LAS u32x4*)(o + 3072) = L.c3; *(LAS u32x4*)(o + 4096) = L.c4; *(LAS u32x4*)(o + 5120) = L.c5;
    *(LAS u32x4*)(o + 6144) = L.c6; *(LAS u32x4*)(o + 7168) = L.c7; *(LAS u32x4*)(o + 8192) = L.c8; *(LAS u32x4*)(o + 9216) = L.c9; *(LAS u32x4*)(o + 10240) = L.c10;
}
DEV void phase5_post_b(unsigned char* ws, int gw, int ngw, int t_lo, int t_hi);
constexpr int W6_LOADER = 1;
constexpr int W6_NBH = 64, W6_NCH = 256 / W6_NBH, W6_UNITS = 8 * (W6_NBH / 32), W6_HTAB = 4 * W5_SLOT, W6_CONST = W6_HTAB + 6 * P5_SIZE, W6_FLAGS = W6_CONST + 1536;
static_assert(W6_FLAGS + 32 <= LDSCTL_OFF, "wkv6 LDS map overruns the barrier words");
constexpr size_t W6_BUF = (size_t)64 * W6_NBH * R_SIZE;
constexpr int W6_TPOST = (W6_NCH - 1) * W6_NBH * 16;
DEV void w6_wait_ge(const volatile LAS unsigned* p, int need) { while ((int)*p < need) __builtin_amdgcn_s_sleep(1); asm volatile("" ::: "memory"); }
template <bool TAB> DEV void wk6_units(unsigned char* ws, unsigned char* rbuf, LAS unsigned char* pl, const LAS float* cst, int wg, int c, int q0, int qstep, int lane, const float* pu, const float* pv, const float* gn, int tabbase) {
    const bf16_t* praw = (const bf16_t*)(ws + WS_PRAW); const bf16_t* dd = (const bf16_t*)(ws + WS_DD); const bf16_t* aa = (const bf16_t*)(ws + WS_AA); const float* invn = (const float*)(ws + WS_INVN);
    const int qq = lane >> 4, s = lane & 15, b = wg & 7, lwb = (wg >> 3) * 8, h = lwb >> 5;
    unsigned char* rec0 = rbuf + (size_t)(b * 8 + h) * W6_NBH * R_SIZE;
    int bl = ((lwb + (q0 & 7)) & 31) + 32 * (q0 >> 3);
    W5Load La, Lb;
    wk5_issue(La, praw, dd, aa, invn, b, h, c * W6_NBH + bl, s, qq); wk5_issue(Lb, praw, dd, aa, invn, b, h, c * W6_NBH + bl, s, 4 + qq);
    for (int q = q0; q < W6_UNITS; q += qstep) {
        const int qn = min(q + qstep, W6_UNITS - 1), bn = ((lwb + (qn & 7)) & 31) + 32 * (qn >> 3);
        const int blk = c * W6_NBH + bl, bln = c * W6_NBH + bn;
        unsigned char* rec = rec0 + (size_t)bl * R_SIZE;
        TabGrp tg0, tg1; const int ti = tabbase + q * 256 + lane;
        if (TAB) { tab_cvt_load(tg0, pu, pv, ti); tab_cvt_load(tg1, pu, pv, ti + 64); }
        float n2 = wk5_knorm2(La, cst, blk == 0 && s == 0, qq) + wk5_knorm2(Lb, cst, blk == 0 && s == 0, 4 + qq); n2 += __shfl_xor(n2, 16); n2 += __shfl_xor(n2, 32);
        const float inv = 1.0f / fmaxf(sqrtf(n2), 1e-12f);
        float bonus = wk5_produce(La, inv, pl, cst, rec, blk, s, qq);     wk5_issue(La, praw, dd, aa, invn, b, h, bln, s, qq);
        if (TAB) { tab_cvt_store(tg0, gn, ws, ti); tab_cvt_store(tg1, gn, ws, ti + 64); tab_cvt_load(tg0, pu, pv, ti + 128); tab_cvt_load(tg1, pu, pv, ti + 192); }
        bonus += wk5_produce(Lb, inv, pl, cst, rec, blk, s, 4 + qq); wk5_issue(Lb, praw, dd, aa, invn, b, h, bln, s, 4 + qq);
        if (qq == 0) ((float*)(ws + WS_BONUS))[((size_t)b * SEQ + blk * 16 + s) * 8 + h] = bonus;
        asm volatile("s_waitcnt lgkmcnt(0)" ::: "memory");
        wk5_emit(pl, rec, lane);
        asm volatile("s_waitcnt lgkmcnt(0)" ::: "memory");
        if (TAB) { tab_cvt_store(tg0, gn, ws, ti + 128); tab_cvt_store(tg1, gn, ws, ti + 192); }
        bl = bn;
    }
}
DEV void wk6_rissue(W5Rec& L, const unsigned char* rec0, int B, int lane, int off10) {
    const unsigned char* r = rec0 + (size_t)min(B, W6_NBH - 1) * R_SIZE + lane * 16;
    L.c0 = *(const u32x4*)(r); L.c1 = *(const u32x4*)(r + 1024); L.c2 = *(const u32x4*)(r + 2048); L.c3 = *(const u32x4*)(r + 3072); L.c4 = *(const u32x4*)(r + 4096); L.c5 = *(const u32x4*)(r + 5120);
    L.c6 = *(const u32x4*)(r + 6144); L.c7 = *(const u32x4*)(r + 7168); L.c8 = *(const u32x4*)(r + 8192); L.c9 = *(const u32x4*)(r + 9216); L.c10 = *(const u32x4*)(r + off10);
}
struct W6V { unsigned p, a, b, c, d; };
DEV void wk6_vissue(W6V& V, const bf16_t* vcol, int gB, int lq) {
    const int t0 = gB * 16 + 4 * lq; const bf16_t* q = vcol + (size_t)t0 * PRV;
    V.p = q[(t0 > 0) ? -PRV : 0]; V.a = q[0]; V.b = q[PRV]; V.c = q[2 * PRV]; V.d = q[3 * PRV];
}
DEV void wk6_hand(const W5Rec& L, const W6V& V, float muv, LAS unsigned char* lb, const volatile LAS unsigned* fl, int slot, int gB, int lane) {
    const int lq = lane >> 4;
    const float vp = (gB == 0 && lq == 0) ? 0.f : __uint_as_float(V.p << 16), va = __uint_as_float(V.a << 16), vb = __uint_as_float(V.b << 16), vc = __uint_as_float(V.c << 16), vd = __uint_as_float(V.d << 16);
    const f32x4 vl = (f32x4){va + (vp - va) * muv, vb + (va - vb) * muv, vc + (vb - vc) * muv, vd + (vc - vd) * muv};
    w6_wait_ge(fl + 4, gB - 3);
    wk5_rwrite(L, lb + slot * W5_SLOT, lane); *(LAS u32x2*)(lb + slot * W5_SLOT + R_FV + lane * 8) = cvt4(vl);
    asm volatile("s_waitcnt lgkmcnt(0)" ::: "memory"); *(volatile LAS unsigned*)(fl + slot) = (unsigned)(gB + 1);
}
DEV void phase4_wkv6(unsigned char* ws, unsigned char* recbase, LAS float* lds, const int wg_in, const float* pu, const float* pv, const float* gn, const XcdBarrier& bar) {
    bf16_t* yr = (bf16_t*)(ws + WS_YR); LAS unsigned char* lb = (LAS unsigned char*)lds; const float* par = (const float*)(ws + WS_PAR);
    const int tid = threadIdx.x, wid = __builtin_amdgcn_readfirstlane(tid >> 6), lane_in = tid & 63;
    asm volatile("s_waitcnt vmcnt(0)" ::: "memory");
    __syncthreads();
    { const int h = ((wg_in >> 3) * 8) >> 5;
      if (tid < 384) { const int v = tid >> 6, c = tid & 63; ((LAS float*)(lb + W6_CONST))[tid] = par[(v < 3 ? PAR_MU + 512 * v : (v == 3 ? PAR_KK : (v == 4 ? PAR_KA : PAR_RK))) + h * 64 + c]; }
      if (tid < 8) *(volatile LAS unsigned*)(lb + W6_FLAGS + tid * 4) = 0u; }
    __syncthreads();
    const LAS float* cst = (const LAS float*)(lb + W6_CONST);
    wk6_units<false>(ws, recbase, lb + wid * P5_SIZE, cst, wg_in, 0, wid, 8, lane_in, pu, pv, gn, 0);
    f32x4 H[4];
#pragma unroll
    for (int kt = 0; kt < 4; ++kt) H[kt] = (f32x4){0.f, 0.f, 0.f, 0.f};
    for (int c = 0; c < W6_NCH; ++c) {
        xcd_barrier(bar);
        int lane = lane_in, wg = wg_in; asm volatile("" : "+v"(lane), "+s"(wg));
        const int it = wg, bh = (it & 7) * 8 + ((it >> 3) >> 2), qd = (it >> 3) & 3, b = bh >> 3, h = bh & 7;
        const unsigned char* rec0 = recbase + (size_t)(c & 1) * W6_BUF + (size_t)bh * W6_NBH * R_SIZE;
        const volatile LAS unsigned* fl = (const volatile LAS unsigned*)(lb + W6_FLAGS);
        const int g0 = c * W6_NBH;
        if (wid == W6_LOADER) {
            const int o10 = (lane < 32) ? 10240 : 10240 - 512;
            const int tl = lane & 15, lq = lane >> 4;
            const bf16_t* vcol = (const bf16_t*)(ws + WS_PRAW) + pr_off((size_t)b * SEQ, 1024 + h * 64 + qd * 16 + tl);
            const float muv = par[PAR_MU + 1024 + h * 64 + qd * 16 + tl];
            W5Rec La, Lb, Lc, Ld; W6V Va, Vb, Vc, Vd;
            wk6_rissue(La, rec0, 0, lane, o10); wk6_vissue(Va, vcol, g0, lq); wk6_rissue(Lb, rec0, 1, lane, o10); wk6_vissue(Vb, vcol, g0 + 1, lq);
            wk6_rissue(Lc, rec0, 2, lane, o10); wk6_vissue(Vc, vcol, g0 + 2, lq); wk6_rissue(Ld, rec0, 3, lane, o10); wk6_vissue(Vd, vcol, g0 + 3, lq);
            for (int B = 0; B < W6_NBH; B += 4) {
                wk6_hand(La, Va, muv, lb, fl, 0, g0 + B, lane);     wk6_rissue(La, rec0, B + 4, lane, o10); wk6_vissue(Va, vcol, g0 + min(B + 4, W6_NBH - 1), lq);
                wk6_hand(Lb, Vb, muv, lb, fl, 1, g0 + B + 1, lane); wk6_rissue(Lb, rec0, B + 5, lane, o10); wk6_vissue(Vb, vcol, g0 + min(B + 5, W6_NBH - 1), lq);
                wk6_hand(Lc, Vc, muv, lb, fl, 2, g0 + B + 2, lane); wk6_rissue(Lc, rec0, B + 6, lane, o10); wk6_vissue(Vc, vcol, g0 + min(B + 6, W6_NBH - 1), lq);
                wk6_hand(Ld, Vd, muv, lb, fl, 3, g0 + B + 3, lane); wk6_rissue(Ld, rec0, B + 7, lane, o10); wk6_vissue(Vd, vcol, g0 + min(B + 7, W6_NBH - 1), lq);
            }
        } else if (wid == 0) {
            W5Ops P0, P1; bf16_t* yh = yr + (size_t)b * SEQ * 512 + h * 64 + qd * 16 + (size_t)g0 * 16 * 512;
            volatile LAS unsigned* done = (volatile LAS unsigned*)(lb + W6_FLAGS + 16);
            w6_wait_ge(fl, g0 + 1); wk5_ld(P0, lb, lane);
            for (int B = 0; B < W6_NBH; B += 2) {
                w6_wait_ge(fl + ((B + 1) & 3), g0 + B + 2); wk5_ld(P1, lb + ((B + 1) & 3) * W5_SLOT, lane);
                wk5_block(P0, lb + (B & 3) * W5_SLOT, H, yh + (size_t)B * 16 * 512, lane);
                asm volatile("s_waitcnt lgkmcnt(0)" ::: "memory"); *done = (unsigned)(g0 + B + 1);
                if (B + 2 < W6_NBH) { w6_wait_ge(fl + ((B + 2) & 3), g0 + B + 3); wk5_ld(P0, lb + ((B + 2) & 3) * W5_SLOT, lane); }
                wk5_block(P1, lb + ((B + 1) & 3) * W5_SLOT, H, yh + (size_t)(B + 1) * 16 * 512, lane);
                asm volatile("s_waitcnt lgkmcnt(0)" ::: "memory"); *done = (unsigned)(g0 + B + 2);
            }
        } else {
            const int hw = (wid < W6_LOADER) ? wid - 1 : wid - 2;
            if (c + 1 < W6_NCH) wk6_units<false>(ws, recbase + (size_t)((c + 1) & 1) * W6_BUF, lb + W6_HTAB + hw * P5_SIZE, cst, wg, c + 1, hw, 6, lane, pu, pv, gn, 0);
            else { unsigned char* ws2 = ws; asm volatile("" : "+s"(ws2)); phase5_post_b(ws2, wg * 6 + hw, 256 * 6, 0, W6_TPOST); }
        }
    }
    __syncthreads();
}

DEV void phase5_post(unsigned char* ws, int gtid, int gsize) {
    const bf16_t* praw = (const bf16_t*)(ws + WS_PRAW); const bf16_t* aa = (const bf16_t*)(ws + WS_AA); const bf16_t* gr = (const bf16_t*)(ws + WS_GR); const bf16_t* yr = (const bf16_t*)(ws + WS_YR); bf16_t* yo = (bf16_t*)(ws + WS_YO);
    const float* par = (const float*)(ws + WS_PAR); const float* mu = par + PAR_MU; const int lane = threadIdx.x & 63, gw = gtid >> 6, ngw = gsize >> 6;
    for (int i = gw; i < T * 8; i += ngw) { const int m = i >> 3, h = i & 7, c = h * 64 + lane;
        const float y = bf2f(yr[(size_t)m * 512 + c]); const float mean = wave_sum(y) * (1.0f / 64.0f); const float dy = y - mean; const float var = wave_sum(dy * dy) * (1.0f / 64.0f);
        const float yn = dy * rsqrtf(var + 64e-5f) * par[PAR_LNW + c] + par[PAR_LNB + c];
        const float rl = lerp_prev(praw, m, c, mu[c]), kl = lerp_prev(praw, m, 512 + c, mu[512 + c]), vl = lerp_prev(praw, m, 1024 + c, mu[1024 + c]);
        const float av = bf2f(aa[da_off((size_t)m, c)]); const float k2 = kl * (1.0f + (av - 1.0f) * par[PAR_KA + c]);
        const float bonus = wave_sum(rl * k2 * par[PAR_RK + c]) * vl;
        yo[(size_t)m * 512 + c] = f2bf((yn + bonus) * bf2f(gr[(size_t)m * 512 + c]));
    }
}

DEV void phase8_tables(const float* pu, const float* pv, const float* gn, unsigned char* ws, int gtid, int gsize) {
#if TAB_FP8 && OPT_PEER
    unsigned* u8 = (unsigned*)(ws + WS_U16); unsigned* v8 = (unsigned*)(ws + WS_V16);
    for (int i = gtid; i < 16384 * 1024 / 4; i += gsize) { const f32x4 u = ((const f32x4*)pu)[i], v = ((const f32x4*)pv)[i]; const f32x4 g = ((const f32x4*)gn)[i & 255];
        int pu_ = 0, pv_ = 0;
#if OPT_PEER == 2
        pu_ = (int)q8x4(u[0] * g[0] * U8_SCALE, u[1] * g[1] * U8_SCALE, u[2] * g[2] * U8_SCALE, u[3] * g[3] * U8_SCALE);
#else
        pu_ = __builtin_amdgcn_cvt_pk_fp8_f32(u[0] * g[0] * 256.0f, u[1] * g[1] * 256.0f, pu_, false); pu_ = __builtin_amdgcn_cvt_pk_fp8_f32(u[2] * g[2] * 256.0f, u[3] * g[3] * 256.0f, pu_, true);
#endif
        pv_ = __builtin_amdgcn_cvt_pk_fp8_f32(v[0] * 16.0f, v[1] * 16.0f, pv_, false); pv_ = __builtin_amdgcn_cvt_pk_fp8_f32(v[2] * 16.0f, v[3] * 16.0f, pv_, true);
#if OPT_PEER == 2
        { const size_t o = ((size_t)((i & 255) >> 5) * 16384 + (i >> 8)) * 32 + (i & 31); u8[o] = (unsigned)pu_; v8[o] = (unsigned)pv_; }
    }
#else
        u8[i] = (unsigned)pu_; v8[i] = (unsigned)pv_; }
#endif
#else
    bf16_t* u16 = (bf16_t*)(ws + WS_U16); bf16_t* v16 = (bf16_t*)(ws + WS_V16);
    for (int i = gtid; i < 16384 * 1024 / 4; i += gsize) { const f32x4 u = ((const f32x4*)pu)[i], v = ((const f32x4*)pv)[i]; const f32x4 g = ((const f32x4*)gn)[i & 255];
        u32x2 o; o[0] = (unsigned)f2bf(u[0] * g[0]) | ((unsigned)f2bf(u[1] * g[1]) << 16); o[1] = (unsigned)f2bf(u[2] * g[2]) | ((unsigned)f2bf(u[3] * g[3]) << 16); ((u32x2*)u16)[i] = o;
        u32x2 p; p[0] = (unsigned)f2bf(v[0]) | ((unsigned)f2bf(v[1]) << 16); p[1] = (unsigned)f2bf(v[2]) | ((unsigned)f2bf(v[3]) << 16); ((u32x2*)v16)[i] = p; }
#endif
}

DEV void wave_argmax(float& v, int& idx) {
#pragma unroll
    for (int o = 1; o < 64; o <<= 1) { const float ov = __shfl_xor(v, o); const int oi = __shfl_xor(idx, o); if (ov > v || (ov == v && oi < idx)) { v = ov; idx = oi; } }
}

DEV void phase9_topk(unsigned char* ws, float* lds, int gtid, int gsize) {
    const bf16_t* q = (const bf16_t*)(ws + WS_Q); const bf16_t* sk = (const bf16_t*)(ws + WS_SK); int* ids = (int*)(ws + WS_IDS); float* gwt = (float*)(ws + WS_GW);
    const int lane = threadIdx.x & 63, wv = threadIdx.x >> 6, gw = gtid >> 6, ngw = gsize >> 6;
    float* svl = lds + wv * 64; int* sil = (int*)(lds + 512) + wv * 64;
    for (int i = gw; i < T * 8; i += ngw) { const int m = i >> 3, hh = i & 7;
        float sc[2][2];
#pragma unroll
        for (int c = 0; c < 2; ++c)
#pragma unroll
            for (int w2 = 0; w2 < 2; ++w2) { const int n = lane + 64 * w2; const bf16_t* qp = q + (size_t)m * DM + hh * 128 + c * 64; const bf16_t* kp = sk + ((size_t)(hh * 2 + c) * 128 + n) * 64; float s = 0.f;
                for (int d = 0; d < 64; ++d) s += bf2f(qp[d]) * bf2f(kp[d]);
                sc[c][w2] = s; }
#pragma unroll
        for (int c = 0; c < 2; ++c) { float c0 = sc[c][0], c1 = sc[c][1];
            for (int r = 0; r < 16; ++r) { float bv; int bi; if (c0 >= c1) { bv = c0; bi = lane; } else { bv = c1; bi = lane + 64; }
                wave_argmax(bv, bi);
                if (bi == lane) c0 = -INFINITY; if (bi == lane + 64) c1 = -INFINITY;
                if (lane == 0) { svl[c * 16 + r] = bv; sil[c * 16 + r] = bi; } } }
        __builtin_amdgcn_wave_barrier(); asm volatile("s_waitcnt lgkmcnt(0)" ::: "memory");
        float cd[4];
#pragma unroll
        for (int w4 = 0; w4 < 4; ++w4) { const int ci = lane + 64 * w4; cd[w4] = svl[ci >> 4] + svl[16 + (ci & 15)]; }
        float myv = 0.f; int mye = 0;
        for (int r = 0; r < 16; ++r) { float bv = cd[0]; int bi = lane;
#pragma unroll
            for (int w4 = 1; w4 < 4; ++w4) if (cd[w4] > bv) { bv = cd[w4]; bi = lane + 64 * w4; }
            wave_argmax(bv, bi);
#pragma unroll
            for (int w4 = 0; w4 < 4; ++w4) if (bi == lane + 64 * w4) cd[w4] = -INFINITY;
            if (lane == r) { myv = bv; mye = sil[bi >> 4] * 128 + sil[16 + (bi & 15)]; } }
        float mx = (lane < 16) ? myv : -INFINITY;
#pragma unroll
        for (int o = 1; o < 16; o <<= 1) mx = fmaxf(mx, __shfl_xor(mx, o));
        float ex = (lane < 16) ? __expf(myv - mx) : 0.f; float sm = ex;
#pragma unroll
        for (int o = 1; o < 16; o <<= 1) sm += __shfl_xor(sm, o);
        if (lane < 16) { ids[(size_t)m * 128 + hh * 16 + lane] = mye; gwt[(size_t)m * 128 + hh * 16 + lane] = ex / sm; }
        __builtin_amdgcn_wave_barrier(); asm volatile("s_waitcnt lgkmcnt(0)" ::: "memory");
    }
}

DEV void phase10_peer(float* out, unsigned char* ws, int gtid, int gsize) {
    const bf16_t* h1b = (const bf16_t*)(ws + WS_H1B); const bf16_t* u16 = (const bf16_t*)(ws + WS_U16); const bf16_t* v16 = (const bf16_t*)(ws + WS_V16);
    const int* ids = (const int*)(ws + WS_IDS); const float* gwt = (const float*)(ws + WS_GW); const float* rss = (const float*)(ws + WS_RSS); const float* nf = (const float*)(ws + WS_PAR) + PAR_NF;
    const int lane = threadIdx.x & 63, gw = gtid >> 6, ngw = gsize >> 6, d0 = lane * 16;
    for (int m = gw; m < T; m += ngw) {
        float hb[16], acc[16];
        { const u32x4 x0 = *(const u32x4*)(h1b + (size_t)m * DM + d0), x1 = *(const u32x4*)(h1b + (size_t)m * DM + d0 + 8);
#pragma unroll
          for (int j = 0; j < 4; ++j) { hb[2 * j] = __uint_as_float(x0[j] << 16); hb[2 * j + 1] = __uint_as_float(x0[j] & 0xffff0000u); hb[8 + 2 * j] = __uint_as_float(x1[j] << 16); hb[8 + 2 * j + 1] = __uint_as_float(x1[j] & 0xffff0000u); } }
#pragma unroll
        for (int j = 0; j < 16; ++j) acc[j] = 0.f;
        const float rstd = rsqrtf(rss[m] * (1.0f / DM) + EPS);
        for (int i = 0; i < 128; ++i) { const int e = ids[(size_t)m * 128 + i]; const float gt = gwt[(size_t)m * 128 + i];
            const u32x4 u0 = *(const u32x4*)(u16 + (size_t)e * DM + d0), u1 = *(const u32x4*)(u16 + (size_t)e * DM + d0 + 8);
            float s = 0.f;
#pragma unroll
            for (int j = 0; j < 4; ++j) { s += hb[2 * j] * __uint_as_float(u0[j] << 16) + hb[2 * j + 1] * __uint_as_float(u0[j] & 0xffff0000u) + hb[8 + 2 * j] * __uint_as_float(u1[j] << 16) + hb[8 + 2 * j + 1] * __uint_as_float(u1[j] & 0xffff0000u); }
            const float hid = wave_sum(s) * rstd; const float w = gt * gelu_tanh(hid);
            const u32x4 v0 = *(const u32x4*)(v16 + (size_t)e * DM + d0), v1 = *(const u32x4*)(v16 + (size_t)e * DM + d0 + 8);
#pragma unroll
            for (int j = 0; j < 4; ++j) { acc[2 * j] += w * __uint_as_float(v0[j] << 16); acc[2 * j + 1] += w * __uint_as_float(v0[j] & 0xffff0000u); acc[8 + 2 * j] += w * __uint_as_float(v1[j] << 16); acc[8 + 2 * j + 1] += w * __uint_as_float(v1[j] & 0xffff0000u); }
        }
        float ss = 0.f;
#pragma unroll
        for (int j = 0; j < 16; ++j) { acc[j] += hb[j]; ss += acc[j] * acc[j]; }
        const float r2 = rsqrtf(wave_sum(ss) * (1.0f / DM) + EPS);
#pragma unroll
        for (int j = 0; j < 4; ++j) { const f32x4 g = *(const f32x4*)(nf + d0 + 4 * j); f32x4 o; o[0] = acc[4 * j] * r2 * g[0]; o[1] = acc[4 * j + 1] * r2 * g[1]; o[2] = acc[4 * j + 2] * r2 * g[2]; o[3] = acc[4 * j + 3] * r2 * g[3];
            *(f32x4*)(out + (size_t)m * DM + d0 + 4 * j) = o; }
    }
}


constexpr size_t WS_KT = 30 * MiB;
struct RowId { DEV int operator()(int n0) const { return n0; } };
struct RowGlu { DEV int operator()(int n0) const { return (n0 < 1024) ? (256 * (n0 >> 7) + (n0 & 127)) : (256 * ((n0 - 1024) >> 7) + 128 + ((n0 - 1024) & 127)); } };
template <class RowMap> DEV void p0_transpose_item(const float* W, int K, int N, bf16_t* WT, LAS float* scr, int item, int lane, const float* kscale, RowMap rm) {
    const int nblk = N / 32, kb = item / nblk, nb = item % nblk, k0 = 64 * kb, n0 = 32 * nb;
#pragma unroll 8
    for (int i = 0; i < 32; ++i) { const int kk = 2 * i + (lane >> 5); float v = W[(size_t)(k0 + kk) * N + n0 + (lane & 31)]; if (kscale) v *= kscale[k0 + kk]; scr[kk * 33 + (lane & 31)] = v; }
    asm volatile("s_waitcnt lgkmcnt(0)" ::: "memory");
    const int c = lane & 7; const int r0 = rm(n0);
#pragma unroll
    for (int j = 0; j < 4; ++j) { const int n = (lane >> 3) + 8 * j; const LAS float* s = scr + (8 * c) * 33 + n;
        u32x4 o; o[0] = cvt_pk_bf16(s[0], s[33]); o[1] = cvt_pk_bf16(s[2 * 33], s[3 * 33]); o[2] = cvt_pk_bf16(s[4 * 33], s[5 * 33]); o[3] = cvt_pk_bf16(s[6 * 33], s[7 * 33]);
        *(u32x4*)(WT + (size_t)(r0 + n) * K + k0 + 8 * c) = o; }
    asm volatile("s_waitcnt lgkmcnt(0)" ::: "memory");
}
DEV void phase0_opt(const Args& a, unsigned char* ws, LAS float* lds, int gtid, int gsize) {
    const int lane = threadIdx.x & 63, wv = threadIdx.x >> 6, gw = gtid >> 6, ngw = gsize >> 6;
    {
        LAS float* scr = lds + wv * (64 * 33);
        constexpr int I_IN = 16 * 136, I_O = 8 * 32, I_GLU = 8 * 64, I_OUT = 16 * 32, I_Q = 16 * 32, NIT = I_IN + I_O + I_GLU + I_OUT + I_Q;
        for (int it = gw; it < NIT; it += ngw) { int r = it;
            if (r < I_IN) { p0_transpose_item(a.in[I_W_IN], 1024, NIN, (bf16_t*)(ws + WS_WIN), scr, r, lane, nullptr, RowId()); continue; } r -= I_IN;
            if (r < I_O) { p0_transpose_item(a.in[I_WO], 512, 1024, (bf16_t*)(ws + WS_WO), scr, r, lane, nullptr, RowId()); continue; } r -= I_O;
            if (r < I_GLU) { p0_transpose_item(a.in[I_WGLU], 512, 2048, (bf16_t*)(ws + WS_WGLU), scr, r, lane, nullptr, RowGlu()); continue; } r -= I_GLU;
            if (r < I_OUT) { p0_transpose_item(a.in[I_WOUT], 1024, 1024, (bf16_t*)(ws + WS_WOUT), scr, r, lane, nullptr, RowId()); continue; } r -= I_OUT;
            p0_transpose_item(a.in[I_WQ], 1024, 1024, (bf16_t*)(ws + WS_WQ), scr, r, lane, a.in[I_NORM_FFN], RowId()); }
    }
    {
        bf16_t* xn = (bf16_t*)(ws + WS_XN); const float* x = a.in[I_X]; const float* gain = a.in[I_NORM_MIX];
        f32x4 gn[4];
#pragma unroll
        for (int j = 0; j < 4; ++j) gn[j] = ((const f32x4*)gain)[lane + 64 * j];
        for (int m = gw; m < T; m += ngw) {
            const f32x4* xr = (const f32x4*)(x + (size_t)m * DM) + lane; f32x4 v[4]; float s = 0.f;
#pragma unroll
            for (int j = 0; j < 4; ++j) { v[j] = xr[64 * j]; s += v[j][0] * v[j][0] + v[j][1] * v[j][1] + v[j][2] * v[j][2] + v[j][3] * v[j][3]; }
            const float rstd = rsqrtf(wave_sum(s) * (1.0f / DM) + EPS);
#pragma unroll
            for (int j = 0; j < 4; ++j) { u32x2 o; o[0] = cvt_pk_bf16(v[j][0] * rstd * gn[j][0], v[j][1] * rstd * gn[j][1]); o[1] = cvt_pk_bf16(v[j][2] * rstd * gn[j][2], v[j][3] * rstd * gn[j][3]);
                ((u32x2*)(xn + (size_t)m * DM))[lane + 64 * j] = o; }
        }
    }
    { bf16_t* w = (bf16_t*)(ws + WS_BLK); for (int i = gtid; i < 1536 * 256; i += gsize) { const int n = i >> 8, k = i & 255; float v = 0.f;
            if (n < 512) { if (k < 64) v = a.in[I_W_LORA][k * 512 + n]; }
            else if (n < 1024) { if (k >= 64 && k < 128) v = a.in[I_A_LORA][(k - 64) * 512 + n - 512]; }
            else { if (k >= 128) v = a.in[I_G_LORA][(k - 128) * 512 + n - 1024]; }
            w[i] = f2bf(v); } }
    { bf16_t* w = (bf16_t*)(ws + WS_SK); const float* s = a.in[I_SUBK]; for (int i = gtid; i < 8 * 2 * 128 * 64; i += gsize) w[i] = f2bf(s[i]); }
    { float* par = (float*)(ws + WS_PAR);
      for (int i = gtid; i < PAR_END; i += gsize) { float v;
        if (i < PAR_W0) v = a.in[I_MU][i]; else if (i < PAR_A0) v = a.in[I_W0][i - PAR_W0]; else if (i < PAR_KK) v = a.in[I_A0][i - PAR_A0]; else if (i < PAR_KA) v = a.in[I_KK][i - PAR_KK];
        else if (i < PAR_RK) v = a.in[I_KA][i - PAR_KA]; else if (i < PAR_LNW) v = a.in[I_RK][i - PAR_RK]; else if (i < PAR_LNB) v = a.in[I_LNW][i - PAR_LNW]; else if (i < PAR_BG) v = a.in[I_LNB][i - PAR_LNB];
        else if (i < PAR_NF) v = a.in[I_B_GATE][i - PAR_BG]; else if (i < PAR_LAM16) v = a.in[I_NORM_FINAL][i - PAR_NF];
        else { const int j = i - PAR_LAM16, gp = j >> 1; const S5p q = s5_param(a, gp >> 6, gp & 63); float pr, pi; s5_pow(q, 16, pr, pi); v = (j & 1) ? pi : pr; }
        par[i] = v; } }
    {
        bf16_t* w = (bf16_t*)(ws + WS_EBT);
        for (int i = gtid; i < 32 * 256 * 256; i += gsize) { const int g = i >> 16, n = (i >> 8) & 255, k = i & 255; float v = 0.f;
            if (n < 128) { const int p = n & 63, sp = k >> 4, j = k & 15; const S5p q = s5_param(a, g, p);
                const float br = a.in[I_BRE][(g * 64 + p) * 16 + j], bi = a.in[I_BIM][(g * 64 + p) * 16 + j];
                const float bbr = q.fr * br - q.fi * bi, bbi = q.fr * bi + q.fi * br; float pr, pi; s5_pow(q, 15 - sp, pr, pi);
                v = (n < 64) ? (pr * bbr - pi * bbi) : (pr * bbi + pi * bbr); }
            w[i] = f2bf(v); }
    }
    {
        float* kt = (float*)(ws + WS_KT);
        for (int i4 = gtid; i4 < 32 * 256 * 4; i4 += gsize) { const int i = i4 >> 2, pc = i4 & 3; const int g = i >> 8, h = (i >> 4) & 15, j = i & 15; float acc[16];
#pragma unroll
            for (int n = 0; n < 16; ++n) acc[n] = 0.f;
            for (int pi = 0; pi < 16; ++pi) { const int p = pc * 16 + pi; const S5p q = s5_param(a, g, p);
                const float br = a.in[I_BRE][(g * 64 + p) * 16 + j], bi = a.in[I_BIM][(g * 64 + p) * 16 + j];
                const float bbr = q.fr * br - q.fi * bi, bbi = q.fr * bi + q.fi * br;
                const float cr = a.in[I_CRE][(g * 16 + h) * 64 + p], ci = a.in[I_CIM][(g * 16 + h) * 64 + p];
                float zr = cr * bbr - ci * bbi, zi = cr * bbi + ci * bbr;
#pragma unroll
                for (int n = 0; n < 16; ++n) { acc[n] += zr; const float t = zr * q.lr - zi * q.li; zi = zr * q.li + zi * q.lr; zr = t; } }
#pragma unroll
            for (int n = 0; n < 16; ++n) { acc[n] += dpp_f<0xB1>(acc[n]); acc[n] += dpp_f<0x4E>(acc[n]); }
            if (pc == 0) { if (h == j) acc[0] += a.in[I_SD][g * 16 + h];
#pragma unroll
                for (int n = 0; n < 16; ++n) kt[(((size_t)g * 16 + n) * 16 + h) * 16 + j] = acc[n]; } }
    }
    {
        bf16_t* w = (bf16_t*)(ws + WS_YBT);
        for (int i = gtid; i < 32 * 256 * 64; i += gsize) { const int g = i >> 14, n = (i >> 6) & 255, p = i & 63; const int s = n >> 4, h = n & 15;
            const S5p q = s5_param(a, g, p); float pr, pi; s5_pow(q, s + 1, pr, pi);
            const float cr = a.in[I_CRE][(g * 16 + h) * 64 + p], ci = a.in[I_CIM][(g * 16 + h) * 64 + p];
            w[((size_t)g * 256 + n) * 384 + 256 + p] = f2bf(cr * pr - ci * pi); w[((size_t)g * 256 + n) * 384 + 320 + p] = f2bf(-(cr * pi + ci * pr)); }
    }
}
DEV void phase2_ybt(unsigned char* ws, int gtid, int gsize) {
    const float* kt = (const float*)(ws + WS_KT); bf16_t* w = (bf16_t*)(ws + WS_YBT);
    for (int i = gtid; i < 32 * 256 * 32; i += gsize) { const int g = i >> 13, n = (i >> 5) & 255, k8 = (i & 31) * 8; const int s = n >> 4, h = n & 15, sp = k8 >> 4, j0 = k8 & 15;
        u32x4 o = (u32x4){0u, 0u, 0u, 0u};
        if (sp <= s) { const float* src = kt + (((size_t)g * 16 + (s - sp)) * 16 + h) * 16 + j0; const f32x4 v0 = *(const f32x4*)src, v1 = *(const f32x4*)(src + 4); o = pack8(v0, v1); }
        *(u32x4*)(w + ((size_t)g * 256 + n) * 384 + k8) = o; }
}
DEV void phase3_scan_opt(unsigned char* ws, int gtid, int gsize) {
    const float* e = (const float*)(ws + WS_E); bf16_t* uc = (bf16_t*)(ws + WS_UC); const float* lam16 = (const float*)(ws + WS_PAR) + PAR_LAM16;
    for (int i = gtid; i < NB * 32 * 64; i += gsize) { const int b = i >> 11, g = (i >> 6) & 31, p = i & 63; const float lr = lam16[(g * 64 + p) * 2], li = lam16[(g * 64 + p) * 2 + 1];
        float xr = 0.f, xi = 0.f;
        for (int c0 = 0; c0 < 256; c0 += 16) { float er[16], ei[16];
#pragma unroll
            for (int c = 0; c < 16; ++c) { const size_t crow = (size_t)g * 2048 + b * 256 + c0 + c; er[c] = e[crow * 128 + p]; ei[c] = e[crow * 128 + 64 + p]; }
#pragma unroll
            for (int c = 0; c < 16; ++c) { const size_t crow = (size_t)g * 2048 + b * 256 + c0 + c;
                uc[crow * 384 + 256 + p] = f2bf(xr); uc[crow * 384 + 320 + p] = f2bf(xi);
                const float nr = lr * xr - li * xi + er[c], ni = lr * xi + li * xr + ei[c]; xr = nr; xi = ni; } }
    }
}
DEV void phase3_scan_seg(unsigned char* ws, LAS float* lds, int wg, int nwg) {
    const float* e = (const float*)(ws + WS_E); bf16_t* uc = (bf16_t*)(ws + WS_UC); const float* lam16 = (const float*)(ws + WS_PAR) + PAR_LAM16;
    const int w = threadIdx.x >> 6, p = threadIdx.x & 63;
    for (int pair = wg; pair < NB * 32; pair += nwg) { const int b = pair >> 5, g = pair & 31; const float lr = lam16[(g * 64 + p) * 2], li = lam16[(g * 64 + p) * 2 + 1];
        const size_t crow0 = (size_t)g * 2048 + b * 256 + w * 32;
        float er[32], ei[32];
#pragma unroll
        for (int c = 0; c < 32; ++c) { er[c] = e[(crow0 + c) * 128 + p]; ei[c] = e[(crow0 + c) * 128 + 64 + p]; }
        float xr = 0.f, xi = 0.f;
#pragma unroll
        for (int c = 0; c < 32; ++c) { const float nr = lr * xr - li * xi + er[c], ni = lr * xi + li * xr + ei[c]; xr = nr; xi = ni; }
        __syncthreads();
        lds[(w * 64 + p) * 2] = xr; lds[(w * 64 + p) * 2 + 1] = xi;
        __syncthreads();
        float ar = lr, ai = li;
#pragma unroll
        for (int q = 0; q < 5; ++q) { const float nr = ar * ar - ai * ai, ni = 2.0f * ar * ai; ar = nr; ai = ni; }
        xr = 0.f; xi = 0.f;
        for (int j = 0; j < w; ++j) { const float pr = lds[(j * 64 + p) * 2], pi = lds[(j * 64 + p) * 2 + 1]; const float nr = ar * xr - ai * xi + pr, ni = ar * xi + ai * xr + pi; xr = nr; xi = ni; }
#pragma unroll
        for (int c = 0; c < 32; ++c) { uc[(crow0 + c) * 384 + 256 + p] = f2bf(xr); uc[(crow0 + c) * 384 + 320 + p] = f2bf(xi);
            const float nr = lr * xr - li * xi + er[c], ni = lr * xi + li * xr + ei[c]; xr = nr; xi = ni; }
    }
}
DEV void phase5_post_b(unsigned char* ws, int gw, int ngw, int t_lo, int t_hi) {
    const bf16_t* praw = (const bf16_t*)(ws + WS_PRAW); const bf16_t* gr = (const bf16_t*)(ws + WS_GR); const bf16_t* yr = (const bf16_t*)(ws + WS_YR); bf16_t* yo = (bf16_t*)(ws + WS_YO);
    const float* par = (const float*)(ws + WS_PAR); const float* bonus = (const float*)(ws + WS_BONUS); const int lane = threadIdx.x & 63, c0 = lane * 8, nt = t_hi - t_lo;
    f32x4 muv[2], lw[2], lb[2];
#pragma unroll
    for (int j = 0; j < 2; ++j) { muv[j] = *(const f32x4*)(par + PAR_MU + 1024 + c0 + 4 * j); lw[j] = *(const f32x4*)(par + PAR_LNW + c0 + 4 * j); lb[j] = *(const f32x4*)(par + PAR_LNB + c0 + 4 * j); }
    for (int idx = gw; idx < NB * nt; idx += ngw) { const int m = (idx / nt) * SEQ + t_lo + idx % nt; const bool first = (m & (SEQ - 1)) == 0; const size_t mp = first ? m : m - 1;
        f32x4 y[2], v[2], vp[2], gg[2];
        unpack8(*(const u32x4*)(yr + (size_t)m * 512 + c0), y[0], y[1]); unpack8(*(const u32x4*)(gr + (size_t)m * 512 + c0), gg[0], gg[1]);
        unpack8(*(const u32x4*)(praw + pr_off((size_t)((size_t)m), 1024 + c0)), v[0], v[1]); unpack8(*(const u32x4*)(praw + pr_off((size_t)(mp), 1024 + c0)), vp[0], vp[1]);
        const float bs = bonus[(size_t)m * 8 + (lane >> 3)];
        float sy = 0.f; f32x4 vl[2];
#pragma unroll
        for (int j = 0; j < 2; ++j) { if (first) vp[j] = (f32x4){0.f, 0.f, 0.f, 0.f};
            vl[j] = v[j] + (vp[j] - v[j]) * muv[j]; sy += (y[j][0] + y[j][1]) + (y[j][2] + y[j][3]); }
        sy += dpp_f<0xB1>(sy); sy += dpp_f<0x4E>(sy); sy += dpp_f<0x141>(sy);
        const float mean = sy * (1.0f / 64.0f); float q = 0.f;
#pragma unroll
        for (int j = 0; j < 2; ++j) { const f32x4 d = y[j] - mean; y[j] = d; q += (d[0] * d[0] + d[1] * d[1]) + (d[2] * d[2] + d[3] * d[3]); }
        q += dpp_f<0xB1>(q); q += dpp_f<0x4E>(q); q += dpp_f<0x141>(q);
        const float rs = rsqrtf(q * (1.0f / 64.0f) + 64e-5f);
        const f32x4 o0 = (y[0] * rs * lw[0] + lb[0] + bs * vl[0]) * gg[0], o1 = (y[1] * rs * lw[1] + lb[1] + bs * vl[1]) * gg[1];
        *(u32x4*)(yo + (size_t)m * 512 + c0) = pack8(o0, o1);
    }
}
DEV void phase5_post_opt(unsigned char* ws, int gtid, int gsize) {
    const bf16_t* praw = (const bf16_t*)(ws + WS_PRAW); const bf16_t* aa = (const bf16_t*)(ws + WS_AA); const bf16_t* gr = (const bf16_t*)(ws + WS_GR); const bf16_t* yr = (const bf16_t*)(ws + WS_YR); bf16_t* yo = (bf16_t*)(ws + WS_YO);
    const float* par = (const float*)(ws + WS_PAR); const int lane = threadIdx.x & 63, gw = gtid >> 6, ngw = gsize >> 6, c0 = lane * 8;
    f32x4 mur[2], muk[2], muv[2], ka[2], rk[2], lw[2], lb[2];
#pragma unroll
    for (int j = 0; j < 2; ++j) { mur[j] = *(const f32x4*)(par + PAR_MU + c0 + 4 * j); muk[j] = *(const f32x4*)(par + PAR_MU + 512 + c0 + 4 * j); muv[j] = *(const f32x4*)(par + PAR_MU + 1024 + c0 + 4 * j);
        ka[j] = *(const f32x4*)(par + PAR_KA + c0 + 4 * j); rk[j] = *(const f32x4*)(par + PAR_RK + c0 + 4 * j); lw[j] = *(const f32x4*)(par + PAR_LNW + c0 + 4 * j); lb[j] = *(const f32x4*)(par + PAR_LNB + c0 + 4 * j); }
    for (int m = gw; m < T; m += ngw) { const bool first = (m & (SEQ - 1)) == 0; const size_t mp = first ? m : m - 1;
        f32x4 y[2], r[2], rp[2], k[2], kp[2], v[2], vp[2], av[2], gg[2];
        unpack8(*(const u32x4*)(yr + (size_t)m * 512 + c0), y[0], y[1]); unpack8(*(const u32x4*)(aa + da_off((size_t)m, c0)), av[0], av[1]); unpack8(*(const u32x4*)(gr + (size_t)m * 512 + c0), gg[0], gg[1]);
        unpack8(*(const u32x4*)(praw + pr_off((size_t)((size_t)m), c0)), r[0], r[1]); unpack8(*(const u32x4*)(praw + pr_off((size_t)(mp), c0)), rp[0], rp[1]);
        unpack8(*(const u32x4*)(praw + pr_off((size_t)((size_t)m), 512 + c0)), k[0], k[1]); unpack8(*(const u32x4*)(praw + pr_off((size_t)(mp), 512 + c0)), kp[0], kp[1]);
        unpack8(*(const u32x4*)(praw + pr_off((size_t)((size_t)m), 1024 + c0)), v[0], v[1]); unpack8(*(const u32x4*)(praw + pr_off((size_t)(mp), 1024 + c0)), vp[0], vp[1]);
        float sy = 0.f, bs = 0.f; f32x4 vl[2];
#pragma unroll
        for (int j = 0; j < 2; ++j) { if (first) { rp[j] = (f32x4){0.f, 0.f, 0.f, 0.f}; kp[j] = rp[j]; vp[j] = rp[j]; }
            const f32x4 rl = r[j] + (rp[j] - r[j]) * mur[j], kl = k[j] + (kp[j] - k[j]) * muk[j]; vl[j] = v[j] + (vp[j] - v[j]) * muv[j];
            const f32x4 k2 = kl * (1.0f + (av[j] - 1.0f) * ka[j]), t = rl * k2 * rk[j];
            sy += (y[j][0] + y[j][1]) + (y[j][2] + y[j][3]); bs += (t[0] + t[1]) + (t[2] + t[3]); }
        sy += dpp_f<0xB1>(sy); bs += dpp_f<0xB1>(bs); sy += dpp_f<0x4E>(sy); bs += dpp_f<0x4E>(bs); sy += dpp_f<0x141>(sy); bs += dpp_f<0x141>(bs);
        const float mean = sy * (1.0f / 64.0f); float q = 0.f;
#pragma unroll
        for (int j = 0; j < 2; ++j) { const f32x4 d = y[j] - mean; y[j] = d; q += (d[0] * d[0] + d[1] * d[1]) + (d[2] * d[2] + d[3] * d[3]); }
        q += dpp_f<0xB1>(q); q += dpp_f<0x4E>(q); q += dpp_f<0x141>(q);
        const float rs = rsqrtf(q * (1.0f / 64.0f) + 64e-5f);
        const f32x4 o0 = (y[0] * rs * lw[0] + lb[0] + bs * vl[0]) * gg[0], o1 = (y[1] * rs * lw[1] + lb[1] + bs * vl[1]) * gg[1];
        *(u32x4*)(yo + (size_t)m * 512 + c0) = pack8(o0, o1);
    }
}

template <int CTRL> DEV unsigned dpp_u(unsigned x) { return (unsigned)__builtin_amdgcn_update_dpp(0, (int)x, CTRL, 0xf, 0xf, true); }
DEV unsigned umax_(unsigned a, unsigned b) { return a > b ? a : b; }
DEV unsigned umin_(unsigned a, unsigned b) { return a < b ? a : b; }
DEV unsigned red16max(unsigned x) { x = umax_(x, dpp_u<0xB1>(x)); x = umax_(x, dpp_u<0x4E>(x)); x = umax_(x, dpp_u<0x124>(x)); x = umax_(x, dpp_u<0x128>(x)); return x; }
DEV unsigned f2key(float s) { const unsigned u = __float_as_uint(s); return u ^ ((unsigned)((int)u >> 31) | 0x80000000u); }
DEV float key2f(unsigned k) { return __uint_as_float((k & 0x80000000u) ? (k ^ 0x80000000u) : ~k); }
#define CE_(a, b) { const unsigned hi_ = umax_(a, b), lo_ = umin_(a, b); a = hi_; b = lo_; }
DEV unsigned top16_of_128(unsigned (&k)[8], int l15) {
    CE_(k[0], k[1]) CE_(k[2], k[3]) CE_(k[4], k[5]) CE_(k[6], k[7]) CE_(k[0], k[2]) CE_(k[1], k[3]) CE_(k[4], k[6]) CE_(k[5], k[7]) CE_(k[1], k[2]) CE_(k[5], k[6])
    CE_(k[0], k[4]) CE_(k[1], k[5]) CE_(k[2], k[6]) CE_(k[3], k[7]) CE_(k[2], k[4]) CE_(k[3], k[5]) CE_(k[1], k[2]) CE_(k[3], k[4]) CE_(k[5], k[6])
    unsigned mine = 0u;
#pragma unroll
    for (int r = 0; r < 16; ++r) { const unsigned w = red16max(k[0]); mine = (l15 == r) ? w : mine; const bool pop = (k[0] == w);
#pragma unroll
        for (int i = 0; i < 7; ++i) k[i] = pop ? k[i + 1] : k[i];
        k[7] = pop ? 0u : k[7]; }
    return mine;
}
DEV unsigned top16_of_64(unsigned (&k)[4], int l15) {
    CE_(k[0], k[1]) CE_(k[2], k[3]) CE_(k[0], k[2]) CE_(k[1], k[3]) CE_(k[1], k[2])
    unsigned mine = 0u;
#pragma unroll
    for (int r = 0; r < 16; ++r) { const unsigned w = red16max(k[0]); mine = (l15 == r) ? w : mine; const bool pop = (k[0] == w);
        k[0] = pop ? k[1] : k[0]; k[1] = pop ? k[2] : k[1]; k[2] = pop ? k[3] : k[2]; k[3] = pop ? 0u : k[3]; }
    return mine;
}
DEV void top16x4_of_128(unsigned (&k)[4][8], int l15, unsigned (&mine)[4]) {
#pragma unroll
    for (int t = 0; t < 4; ++t) {
        CE_(k[t][0], k[t][1]) CE_(k[t][2], k[t][3]) CE_(k[t][4], k[t][5]) CE_(k[t][6], k[t][7]) CE_(k[t][0], k[t][2]) CE_(k[t][1], k[t][3]) CE_(k[t][4], k[t][6]) CE_(k[t][5], k[t][7]) CE_(k[t][1], k[t][2]) CE_(k[t][5], k[t][6])
        CE_(k[t][0], k[t][4]) CE_(k[t][1], k[t][5]) CE_(k[t][2], k[t][6]) CE_(k[t][3], k[t][7]) CE_(k[t][2], k[t][4]) CE_(k[t][3], k[t][5]) CE_(k[t][1], k[t][2]) CE_(k[t][3], k[t][4]) CE_(k[t][5], k[t][6])
        mine[t] = 0u; }
#pragma unroll
    for (int r = 0; r < 16; ++r) { unsigned w[4];
#pragma unroll
        for (int t = 0; t < 4; ++t) w[t] = umax_(k[t][0], dpp_u<0xB1>(k[t][0]));
#pragma unroll
        for (int t = 0; t < 4; ++t) w[t] = umax_(w[t], dpp_u<0x4E>(w[t]));
#pragma unroll
        for (int t = 0; t < 4; ++t) w[t] = umax_(w[t], dpp_u<0x124>(w[t]));
#pragma unroll
        for (int t = 0; t < 4; ++t) w[t] = umax_(w[t], dpp_u<0x128>(w[t]));
#pragma unroll
        for (int t = 0; t < 4; ++t) { mine[t] = (l15 == r) ? w[t] : mine[t]; const bool pop = (k[t][0] == w[t]);
#pragma unroll
            for (int i = 0; i < 7; ++i) k[t][i] = pop ? k[t][i + 1] : k[t][i];
            k[t][7] = pop ? 0u : k[t][7]; } }
}
DEV void top16x4_of_64(unsigned (&k)[4][4], int l15, unsigned (&mine)[4]) {
#pragma unroll
    for (int t = 0; t < 4; ++t) { CE_(k[t][0], k[t][1]) CE_(k[t][2], k[t][3]) CE_(k[t][0], k[t][2]) CE_(k[t][1], k[t][3]) CE_(k[t][1], k[t][2]) mine[t] = 0u; }
#pragma unroll
    for (int r = 0; r < 16; ++r) { unsigned w[4];
#pragma unroll
        for (int t = 0; t < 4; ++t) w[t] = umax_(k[t][0], dpp_u<0xB1>(k[t][0]));
#pragma unroll
        for (int t = 0; t < 4; ++t) w[t] = umax_(w[t], dpp_u<0x4E>(w[t]));
#pragma unroll
        for (int t = 0; t < 4; ++t) w[t] = umax_(w[t], dpp_u<0x124>(w[t]));
#pragma unroll
        for (int t = 0; t < 4; ++t) w[t] = umax_(w[t], dpp_u<0x128>(w[t]));
#pragma unroll
        for (int t = 0; t < 4; ++t) { mine[t] = (l15 == r) ? w[t] : mine[t]; const bool pop = (k[t][0] == w[t]);
            k[t][0] = pop ? k[t][1] : k[t][0]; k[t][1] = pop ? k[t][2] : k[t][1]; k[t][2] = pop ? k[t][3] : k[t][2]; k[t][3] = pop ? 0u : k[t][3]; } }
}
#define T9_TAB (OPT_PEER == 2 && OPT_WKV == 6)
template <bool FUSED> DEV void phase9_topk_opt(unsigned char* ws, LAS unsigned char* lds, int wg, int nwg, const float* pu, const float* pv, const float* gn) {
#if T9_TAB
    constexpr int NTG = 16384 * 256; const int tstride = nwg * NTHR; int te = wg * NTHR + (int)threadIdx.x; TabGrp tg;
    if (te < NTG) tab_cvt_load(tg, pu, pv, te);
#define T9_STEP { if (te < NTG) { tab_cvt_store(tg, gn, ws, te); te += tstride; if (te < NTG) tab_cvt_load(tg, pu, pv, te); } }
#else
#define T9_STEP
#endif
    const bf16_t* q = (const bf16_t*)(ws + WS_Q); const bf16_t* sk = (const bf16_t*)(ws + WS_SK); int* ids = (int*)(ws + WS_IDS); float* gwt = (float*)(ws + WS_GW);
    const int tid = threadIdx.x, lane = tid & 63, wv = tid >> 6, l15 = lane & 15, quad = lane >> 4;
    const int i3 = (l15 < 5) ? 2 : (l15 < 9) ? 3 : (l15 < 12) ? 4 : (l15 < 14) ? 5 : 6;
    const int j3 = (l15 < 5) ? l15 : (l15 < 9) ? l15 - 5 : (l15 < 12) ? l15 - 9 : (l15 < 14) ? l15 - 12 : l15 - 14;
    const bool grp = (nwg & 7) == 0; const int nh = grp ? 1 : 8, wix = grp ? ((wg >> 3) * 8 + wv) : (wg * 8 + wv), nwx = grp ? ((nwg >> 3) * 8) : (nwg * 8);
    SchedStd S; S.init(T, 1024, nwg, wg, 1024, 1024);
    const int nout = FUSED ? 2 * ((wg < 512) ? (512 - wg + nwg - 1) / nwg : 0) : nh;
    for (int hi = 0; hi < nout; ++hi) { int hh, t0, t1, ts, mb;
        if (FUSED) { Unit u; S.next(hi >> 1, u); hh = 2 * u.pn + (hi & 1); t0 = wv; t1 = 16; ts = 8; mb = u.pm * 256; }
        else { hh = grp ? (wg & 7) : hi; t0 = wix; t1 = T / 16; ts = nwx; mb = 0; }
        __syncthreads();
        for (int i = tid; i < 256 * 8; i += NTHR) { const int key = i >> 3, ch = i & 7; *(LAS u32x4*)(lds + key * 144 + ch * 16) = *(const u32x4*)(sk + ((size_t)hh * 256 + key) * 64 + ch * 8); }
        __syncthreads();
        for (int tile = t0; tile < t1; tile += ts) { const int m0 = mb + tile * 16;
            bf16x8 aq[2][2];
#pragma unroll
            for (int c = 0; c < 2; ++c)
#pragma unroll
                for (int ks = 0; ks < 2; ++ks) aq[c][ks] = *(const bf16x8*)(q + (size_t)(m0 + l15) * DM + hh * 128 + c * 64 + ks * 32 + quad * 8);
            unsigned win[2][4];
#pragma unroll
            for (int c = 0; c < 2; ++c) {
                f32x4 acc[8];
#pragma unroll
                for (int nt = 0; nt < 8; ++nt) acc[nt] = (f32x4){0.f, 0.f, 0.f, 0.f};
#pragma unroll
                for (int ks = 0; ks < 2; ++ks) {
#pragma unroll
                    for (int nt = 0; nt < 8; ++nt) { const bf16x8 bfr = *(const LAS bf16x8*)(lds + (c * 128 + nt * 16 + l15) * 144 + ks * 64 + quad * 16);
                        acc[nt] = __builtin_amdgcn_mfma_f32_16x16x32_bf16(aq[c][ks], bfr, acc[nt], 0, 0, 0); } }
                __builtin_amdgcn_sched_barrier(0);
                { unsigned k[4][8];
#pragma unroll
                  for (int i = 0; i < 4; ++i)
#pragma unroll
                    for (int nt = 0; nt < 8; ++nt) k[i][nt] = (f2key(acc[nt][i]) & 0xFFFFFF80u) | (unsigned)(127 - (nt * 16 + l15));
                  top16x4_of_128(k, l15, win[c]); }
                __builtin_amdgcn_sched_barrier(0);
                T9_STEP
            }
            const int base = lane & 48; unsigned k2[4][4], wk[4];
#pragma unroll
            for (int i = 0; i < 4; ++i) {
                const float sv0 = key2f(win[0][i] & 0xFFFFFF80u), sv1 = key2f(win[1][i] & 0xFFFFFF80u);
                const float s00 = __shfl(sv0, base), s01 = __shfl(sv0, base + 1), s10 = __shfl(sv1, base), s07 = __shfl(sv0, base + 7);
                const float s0i3 = __shfl(sv0, base + i3), s1j3 = __shfl(sv1, base + j3);
                k2[i][0] = (f2key(s00 + sv1) & 0xFFFFFF00u) | (unsigned)(255 - l15);
                k2[i][1] = (l15 < 8) ? ((f2key(s01 + sv1) & 0xFFFFFF00u) | (unsigned)(255 - (16 + l15))) : ((f2key(sv0 + s10) & 0xFFFFFF00u) | (unsigned)(255 - l15 * 16));
                k2[i][2] = (f2key(s0i3 + s1j3) & 0xFFFFFF00u) | (unsigned)(255 - (i3 * 16 + j3));
                k2[i][3] = (l15 < 2) ? ((f2key(s07 + sv1) & 0xFFFFFF00u) | (unsigned)(255 - (7 * 16 + l15))) : 0u; }
            top16x4_of_64(k2, l15, wk);
            T9_STEP
#pragma unroll
            for (int i = 0; i < 4; ++i) {
                const float cv = key2f(wk[i] & 0xFFFFFF00u); const int ci = 255 - (int)(wk[i] & 255u);
                const unsigned k0 = (unsigned)__shfl((int)win[0][i], base + (ci >> 4)), k1 = (unsigned)__shfl((int)win[1][i], base + (ci & 15));
                const int e = (127 - (int)(k0 & 127u)) * 128 + (127 - (int)(k1 & 127u));
                const float mx = __shfl(cv, base); float ex = __expf(cv - mx); float sm = ex;
                sm += dpp_f<0xB1>(sm); sm += dpp_f<0x4E>(sm); sm += dpp_f<0x124>(sm); sm += dpp_f<0x128>(sm);
                const size_t o = (size_t)(m0 + quad * 4 + i) * 128 + hh * 16 + l15;
                ids[o] = e; gwt[o] = ex / sm;
            }
            T9_STEP
        }
    }
#if T9_TAB
    while (te < NTG) T9_STEP
#endif
}

#if TAB_FP8
constexpr float TAB_USCALE = 256.0f, TAB_VSCALE = 16.0f;
typedef u32x4 tabrow_t;
DEV tabrow_t tab_ld(const unsigned char* tab, int e, int lane) { return *(const u32x4*)(tab + (size_t)e * 1024 + lane * 16); }
DEV void tab_dec(const tabrow_t& r, float (&f)[16]) {
#pragma unroll
    for (int i = 0; i < 4; ++i) { const auto lo = __builtin_amdgcn_cvt_pk_f32_fp8((int)r[i], false), hi = __builtin_amdgcn_cvt_pk_f32_fp8((int)r[i], true); f[4 * i] = lo[0]; f[4 * i + 1] = lo[1]; f[4 * i + 2] = hi[0]; f[4 * i + 3] = hi[1]; }
}
#else
constexpr float TAB_USCALE = 1.0f, TAB_VSCALE = 1.0f;
struct tabrow_t { u32x4 a, b; };
DEV tabrow_t tab_ld(const unsigned char* tab, int e, int lane) { tabrow_t r; const u32x4* p = (const u32x4*)(tab + (size_t)e * 2048 + lane * 32); r.a = p[0]; r.b = p[1]; return r; }
DEV void tab_dec(const tabrow_t& r, float (&f)[16]) {
#pragma unroll
    for (int i = 0; i < 4; ++i) { f[2 * i] = __uint_as_float(r.a[i] << 16); f[2 * i + 1] = __uint_as_float(r.a[i] & 0xffff0000u); f[8 + 2 * i] = __uint_as_float(r.b[i] << 16); f[8 + 2 * i + 1] = __uint_as_float(r.b[i] & 0xffff0000u); }
}
#endif
DEV float wave_total(float x) { x = red16(x); x += __shfl_xor(x, 16); x += __shfl_xor(x, 32); return x; }
DEV void phase10_peer_opt(float* out, unsigned char* ws, int gtid, int gsize) {
    const bf16_t* h1b = (const bf16_t*)(ws + WS_H1B); const unsigned char* utab = ws + WS_U16; const unsigned char* vtab = ws + WS_V16;
    const int* ids = (const int*)(ws + WS_IDS); const float* gwt = (const float*)(ws + WS_GW); const float* rss = (const float*)(ws + WS_RSS); const float* nf = (const float*)(ws + WS_PAR) + PAR_NF;
    const int lane = threadIdx.x & 63, gw = gtid >> 6, ngw = gsize >> 6, d0 = lane * 16;
    for (int m = gw; m < T; m += ngw) {
        float xf[16];
        { const u32x4 x0 = *(const u32x4*)(h1b + (size_t)m * DM + d0), x1 = *(const u32x4*)(h1b + (size_t)m * DM + d0 + 8); f32x4 a, b, c, d; unpack8(x0, a, b); unpack8(x1, c, d);
#pragma unroll
          for (int j = 0; j < 4; ++j) { xf[j] = a[j]; xf[4 + j] = b[j]; xf[8 + j] = c[j]; xf[12 + j] = d[j]; } }
        const int id0 = ids[(size_t)m * 128 + lane], id1 = ids[(size_t)m * 128 + 64 + lane];
        const float g0 = gwt[(size_t)m * 128 + lane], g1 = gwt[(size_t)m * 128 + 64 + lane];
        const float rstd = rsqrtf(rss[m] * (1.0f / DM) + EPS);
        float hid0 = 0.f, hid1 = 0.f;
        for (int c = 0; c < 128 / PEER_CH; ++c) {
            const int idv = (c * PEER_CH < 64) ? id0 : id1; tabrow_t rows[PEER_CH];
#pragma unroll
            for (int j = 0; j < PEER_CH; ++j) { const int e = __builtin_amdgcn_readlane(idv, (c * PEER_CH + j) & 63); rows[j] = tab_ld(utab, e, lane); }
            float hv = 0.f;
#pragma unroll
            for (int j = 0; j < PEER_CH; ++j) { float f[16]; tab_dec(rows[j], f); float s = 0.f;
#pragma unroll
                for (int i = 0; i < 16; ++i) s += xf[i] * f[i];
                s = wave_total(s); hv = (lane == ((c * PEER_CH + j) & 63)) ? s : hv; }
            if (c * PEER_CH < 64) hid0 += hv; else hid1 += hv;
        }
        const float w0 = g0 * gelu_tanh(hid0 * (rstd / TAB_USCALE)) * (1.0f / TAB_VSCALE), w1 = g1 * gelu_tanh(hid1 * (rstd / TAB_USCALE)) * (1.0f / TAB_VSCALE);
        float acc[16];
#pragma unroll
        for (int i = 0; i < 16; ++i) acc[i] = 0.f;
        for (int c = 0; c < 128 / PEER_CH; ++c) {
            const int idv = (c * PEER_CH < 64) ? id0 : id1; const float wv = (c * PEER_CH < 64) ? w0 : w1; tabrow_t rows[PEER_CH];
#pragma unroll
            for (int j = 0; j < PEER_CH; ++j) { const int e = __builtin_amdgcn_readlane(idv, (c * PEER_CH + j) & 63); rows[j] = tab_ld(vtab, e, lane); }
#pragma unroll
            for (int j = 0; j < PEER_CH; ++j) { const float w = __builtin_bit_cast(float, __builtin_amdgcn_readlane(__builtin_bit_cast(int, wv), (c * PEER_CH + j) & 63)); float f[16]; tab_dec(rows[j], f);
#pragma unroll
                for (int i = 0; i < 16; ++i) acc[i] += w * f[i]; }
        }
        float ss = 0.f;
#pragma unroll
        for (int i = 0; i < 16; ++i) { acc[i] += xf[i]; ss += acc[i] * acc[i]; }
        const float r2 = rsqrtf(wave_total(ss) * (1.0f / DM) + EPS);
#pragma unroll
        for (int j = 0; j < 4; ++j) { const f32x4 g = *(const f32x4*)(nf + d0 + 4 * j); f32x4 o; o[0] = acc[4 * j] * r2 * g[0]; o[1] = acc[4 * j + 1] * r2 * g[1]; o[2] = acc[4 * j + 2] * r2 * g[2]; o[3] = acc[4 * j + 3] * r2 * g[3];
            *(f32x4*)(out + (size_t)m * DM + d0 + 4 * j) = o; }
    }
}

#if TAB_FP8
DEV void peer_dec16(const u32x4& r, float (&f)[16]) {
#pragma unroll
    for (int i = 0; i < 4; ++i) { const auto lo = __builtin_amdgcn_cvt_pk_f32_fp8((int)r[i], false), hi = __builtin_amdgcn_cvt_pk_f32_fp8((int)r[i], true); f[4 * i] = lo[0]; f[4 * i + 1] = lo[1]; f[4 * i + 2] = hi[0]; f[4 * i + 3] = hi[1]; }
}
constexpr size_t WS_PART = 256 * MiB;
DEV void phase10a_part(unsigned char* ws, LAS float* lds, int wg, int nwg) {
    const unsigned char* x8 = ws + WS_X8; const unsigned char* utab = ws + WS_U16;
    const int* ids = (const int*)(ws + WS_IDS); float* part = (float*)(ws + WS_PART);
    const int lane = threadIdx.x & 63, wv = threadIdx.x >> 6, g = lane >> 3, p = lane & 7; const bool grp = (nwg & 7) == 0;
    const int nsl = grp ? 1 : 8, wix = grp ? ((wg >> 3) * 8 + wv) : (wg * 8 + wv), nwx = grp ? ((nwg >> 3) * 8) : (nwg * 8);
    LAS int* il = (LAS int*)(lds + wv * 1024);
    for (int sl = 0; sl < nsl; ++sl) { const int x = grp ? (wg & 7) : sl; const unsigned char* us = utab + (size_t)x * 16384 * 128 + p * 16;
        for (int tile = wix; tile < T / 8; tile += nwx) { const int m0 = tile * 8;
            { const u32x4* si = (const u32x4*)(ids + (size_t)m0 * 128);
#pragma unroll
              for (int i = 0; i < 4; ++i) *(LAS u32x4*)(il + (i * 64 + lane) * 4) = si[i * 64 + lane]; }
            const int m = m0 + g; const u32x4 xq = *(const u32x4*)(x8 + (size_t)m * DM + x * 128 + p * 16);
            int pt[16];
#pragma unroll
            for (int i = 0; i < 16; ++i) pt[i] = 0;
            asm volatile("s_waitcnt lgkmcnt(0)" ::: "memory");
            for (int pp = 0; pp < 8; ++pp) {
#pragma unroll
                for (int cc = 0; cc < 2; ++cc) { u32x4 rows[8];
#pragma unroll
                    for (int h = 0; h < 2; ++h) { const u32x4 e4 = *(const LAS u32x4*)(il + g * 128 + pp * 16 + cc * 8 + h * 4);
#pragma unroll
                        for (int r = 0; r < 4; ++r) rows[h * 4 + r] = *(const u32x4*)(us + (size_t)e4[r] * 128); }
#pragma unroll
                    for (int r = 0; r < 8; ++r) { int s = __builtin_amdgcn_sdot4((int)rows[r][0], (int)xq[0], 0, false); s = __builtin_amdgcn_sdot4((int)rows[r][1], (int)xq[1], s, false);
                        s = __builtin_amdgcn_sdot4((int)rows[r][2], (int)xq[2], s, false); s = __builtin_amdgcn_sdot4((int)rows[r][3], (int)xq[3], s, false);
                        s += (int)dpp_u<0xB1>((unsigned)s); s += (int)dpp_u<0x4E>((unsigned)s); s += (int)dpp_u<0x141>((unsigned)s);
                        pt[cc * 8 + r] = (p == pp) ? s : pt[cc * 8 + r]; } }
            }
            { bf16_t* d16 = (bf16_t*)part + ((size_t)x * T + m) * 128 + p * 16;
              *(u32x4*)(d16) = pack8((f32x4){(float)pt[0], (float)pt[1], (float)pt[2], (float)pt[3]}, (f32x4){(float)pt[4], (float)pt[5], (float)pt[6], (float)pt[7]});
              *(u32x4*)(d16 + 8) = pack8((f32x4){(float)pt[8], (float)pt[9], (float)pt[10], (float)pt[11]}, (f32x4){(float)pt[12], (float)pt[13], (float)pt[14], (float)pt[15]}); }
        }
    }
}
DEV void phase10r_reduce(unsigned char* ws, int gtid, int gsize) {
    const bf16_t* part = (const bf16_t*)(ws + WS_PART); const float* gwt = (const float*)(ws + WS_GW); const float* rss = (const float*)(ws + WS_RSS); float* w2 = (float*)(ws + WS_W2);
    for (int i8 = gtid; i8 < T * 16; i8 += gsize) { const int m = i8 >> 4; f32x4 s0 = (f32x4){0.f, 0.f, 0.f, 0.f}, s1 = s0;
#pragma unroll
        for (int x = 0; x < 8; ++x) { f32x4 a, b; unpack8(*(const u32x4*)(part + (size_t)x * T * 128 + (size_t)i8 * 8), a, b); s0 += a; s1 += b; }
        const float sc = rsqrtf(rss[m] * (1.0f / DM) + EPS) / (U8_SCALE * X8_SCALE); const f32x4 g0 = *(const f32x4*)(gwt + (size_t)i8 * 8), g1 = *(const f32x4*)(gwt + (size_t)i8 * 8 + 4); f32x4 o0, o1;
#pragma unroll
        for (int i = 0; i < 4; ++i) { o0[i] = g0[i] * gelu_tanh(s0[i] * sc) * (1.0f / TAB_VSCALE); o1[i] = g1[i] * gelu_tanh(s1[i] * sc) * (1.0f / TAB_VSCALE); }
        *(f32x4*)(w2 + (size_t)i8 * 8) = o0; *(f32x4*)(w2 + (size_t)i8 * 8 + 4) = o1; }
}
DEV void phase10b_out(float* out, unsigned char* ws, LAS float* lds, int wg, int nwg) {
    const bf16_t* h1b = (const bf16_t*)(ws + WS_H1B); const unsigned char* vtab = ws + WS_V16;
    const int* ids = (const int*)(ws + WS_IDS); const float* w2 = (const float*)(ws + WS_W2); float* rss2 = (float*)(ws + WS_RSS2);
    const int lane = threadIdx.x & 63, wv = threadIdx.x >> 6, g = lane >> 3, p = lane & 7; const bool grp = (nwg & 7) == 0;
    const int nsl = grp ? 1 : 8, wix = grp ? ((wg >> 3) * 8 + wv) : (wg * 8 + wv), nwx = grp ? ((nwg >> 3) * 8) : (nwg * 8);
    LAS float* wl = lds + wv * 2048; LAS int* il = (LAS int*)(lds + wv * 2048 + 1024);
    for (int sl = 0; sl < nsl; ++sl) { const int x = grp ? (wg & 7) : sl; const unsigned char* vs = vtab + (size_t)x * 16384 * 128 + p * 16;
        for (int tile = wix; tile < T / 8; tile += nwx) { const int m0 = tile * 8;
            {
                const f32x4* sw = (const f32x4*)(w2 + (size_t)m0 * 128); const u32x4* si = (const u32x4*)(ids + (size_t)m0 * 128);
#pragma unroll
                for (int i = 0; i < 4; ++i) { *(LAS f32x4*)(wl + (i * 64 + lane) * 4) = sw[i * 64 + lane]; *(LAS u32x4*)(il + (i * 64 + lane) * 4) = si[i * 64 + lane]; }
            }
            const int m = m0 + g;
            const u32x4 hx0 = *(const u32x4*)(h1b + (size_t)m * DM + x * 128 + p * 16), hx1 = *(const u32x4*)(h1b + (size_t)m * DM + x * 128 + p * 16 + 8);
            float acc[16];
#pragma unroll
            for (int i = 0; i < 16; ++i) acc[i] = 0.f;
            asm volatile("s_waitcnt lgkmcnt(0)" ::: "memory");
            for (int c = 0; c < 16; ++c) { u32x4 rows[8]; f32x4 wq[2];
#pragma unroll
                for (int h = 0; h < 2; ++h) { const u32x4 e4 = *(const LAS u32x4*)(il + g * 128 + c * 8 + h * 4); wq[h] = *(const LAS f32x4*)(wl + g * 128 + c * 8 + h * 4);
#pragma unroll
                    for (int r = 0; r < 4; ++r) rows[h * 4 + r] = *(const u32x4*)(vs + (size_t)e4[r] * 128); }
#pragma unroll
                for (int r = 0; r < 8; ++r) { float f[16]; peer_dec16(rows[r], f); const float w = wq[r >> 2][r & 3];
#pragma unroll
                    for (int i = 0; i < 16; ++i) acc[i] += w * f[i]; }
            }
            f32x4 a0, a1, a2, a3; unpack8(hx0, a0, a1); unpack8(hx1, a2, a3);
            f32x4 o0, o1, o2, o3; float ss = 0.f;
#pragma unroll
            for (int i = 0; i < 4; ++i) { o0[i] = a0[i] + acc[i]; o1[i] = a1[i] + acc[4 + i]; o2[i] = a2[i] + acc[8 + i]; o3[i] = a3[i] + acc[12 + i]; ss += o0[i] * o0[i] + o1[i] * o1[i] + o2[i] * o2[i] + o3[i] * o3[i]; }
            bf16_t* op = (bf16_t*)(ws + WS_H2B) + (size_t)m * DM + x * 128 + p * 16;
            *(u32x4*)(op) = pack8(o0, o1); *(u32x4*)(op + 8) = pack8(o2, o3);
            ss += dpp_f<0xB1>(ss); ss += dpp_f<0x4E>(ss); ss += dpp_f<0x141>(ss);
            if (p == 0) atomicAdd(rss2 + m, ss);
        }
    }
}
DEV void phase10c_norm(float* out, unsigned char* ws, int gtid, int gsize) {
    const float* rss2 = (const float*)(ws + WS_RSS2); const float* nf = (const float*)(ws + WS_PAR) + PAR_NF; const bf16_t* h2 = (const bf16_t*)(ws + WS_H2B);
    for (int i = gtid; i < T * DM / 8; i += gsize) { const int m = i >> 7, c8 = i & 127; const float r2 = rsqrtf(rss2[m] * (1.0f / DM) + EPS); const f32x4 g0 = ((const f32x4*)nf)[2 * c8], g1 = ((const f32x4*)nf)[2 * c8 + 1];
        f32x4 a, b; unpack8(((const u32x4*)h2)[i], a, b); ((f32x4*)out)[2 * i] = a * r2 * g0; ((f32x4*)out)[2 * i + 1] = b * r2 * g1; }
}
#endif

#define XB_TMO      128
#define XB_XCNT(j)  (256  + 64 * (j))
#define XB_XSUB(j)  (1280 + 64 * (j))
#define XB_XGEN(j)  (2304 + 64 * (j))
#define XB_TOP      3328
#define XB_TOPGEN   3392
#define XCD_BAR_WORDS 3456
#define XB_SPIN_CAP (1u << 20)
DEV unsigned xb_ld(unsigned* p)              { return __hip_atomic_load(p, __ATOMIC_RELAXED, __HIP_MEMORY_SCOPE_AGENT); }
DEV unsigned xb_add(unsigned* p, unsigned v) { return __hip_atomic_fetch_add(p, v, __ATOMIC_RELAXED, __HIP_MEMORY_SCOPE_AGENT); }
DEV unsigned xb_xcc_id() { return (unsigned)__builtin_amdgcn_s_getreg((3 << 11) | 20) & 0xFu; }
#define XB_SPIN(cond, bar) do { unsigned _sp = 0; while (cond) { __builtin_amdgcn_s_sleep(1); \
    if ((++_sp & 255u) == 0u) { if (xb_ld(&(bar)[XB_TMO])) break; if (_sp > XB_SPIN_CAP) { atomicAdd(&(bar)[XB_TMO], 1u); break; } } } } while (0)
struct XcdBarrier { unsigned* bar; unsigned x; volatile LAS unsigned* st; };
DEV XcdBarrier xcd_barrier_post(unsigned* bar, volatile LAS unsigned* st) {
    XcdBarrier b; b.bar = bar; b.x = xb_xcc_id(); b.st = st;
    if (threadIdx.x == 0) (void)xb_add(&bar[XB_XCNT(b.x)], 1u);
    return b;
}
DEV void xcd_barrier_complete(unsigned* bar, unsigned x, unsigned& nloc, unsigned& nx) {
    const unsigned G = gridDim.x * gridDim.y * gridDim.z;
    unsigned sum, cnt, mine, sp = 0u;
    for (;;) {
        sum = 0u; cnt = 0u; mine = 0u;
#pragma unroll
        for (unsigned j = 0; j < 16; ++j) { const unsigned c = xb_ld(&bar[XB_XCNT(j)]); sum += c; cnt += (c > 0u) ? 1u : 0u; mine = (j == x) ? c : mine; }
        if (sum == G) break;
        __builtin_amdgcn_s_sleep(1);
        if ((++sp & 255u) == 0u) { if (xb_ld(&bar[XB_TMO])) break; if (sp > XB_SPIN_CAP) { atomicAdd(&bar[XB_TMO], 1u); break; } }
    }
    nloc = mine > 0u ? mine : 1u; nx = cnt > 0u ? cnt : 1u;
}
DEV void xcd_barrier(const XcdBarrier& b) {
    asm volatile("s_waitcnt vmcnt(0)" ::: "memory");
    __syncthreads();
    if (threadIdx.x == 0) {
        unsigned* bar = b.bar;
        __builtin_amdgcn_s_waitcnt(0);
        unsigned nloc = b.st[0], nx = b.st[1];
        if (nloc == 0u) { xcd_barrier_complete(bar, b.x, nloc, nx); b.st[0] = nloc; b.st[1] = nx; }
        const unsigned old = xb_add(&bar[XB_XSUB(b.x)], 1u);
        const unsigned gen = old / nloc;
        if (old + 1u == (gen + 1u) * nloc) {
            __builtin_amdgcn_fence(__ATOMIC_RELEASE, "agent");
            asm volatile("s_waitcnt vmcnt(0)" ::: "memory");
            const unsigned og = xb_add(&bar[XB_TOP], 1u);
            const unsigned tg = og / nx;
            if (og + 1u == (tg + 1u) * nx) xb_add(&bar[XB_TOPGEN], 1u);
            else XB_SPIN(xb_ld(&bar[XB_TOPGEN]) == tg, bar);
            __builtin_amdgcn_fence(__ATOMIC_ACQUIRE, "agent");
            xb_add(&bar[XB_XGEN(b.x)], 1u);
            asm volatile("s_waitcnt vmcnt(0)" ::: "memory");
        } else {
            XB_SPIN(xb_ld(&bar[XB_XGEN(b.x)]) == gen, bar);
            __builtin_amdgcn_fence(__ATOMIC_ACQUIRE, "agent");
            asm volatile("s_waitcnt vmcnt(0)" ::: "memory");
        }
    }
    __syncthreads();
}
constexpr int LDS_BYTES = 147456;
constexpr int CW_BAR = 4096;

__global__ void __launch_bounds__(NTHR, 2) fwd_kernel(Args a) {
    extern __shared__ __attribute__((aligned(16))) unsigned char lds_raw[];
    float* lds = (float*)lds_raw;
    PG8_LAS unsigned char* ldsl = (PG8_LAS unsigned char*)lds_raw;
    unsigned char* ws = a.ws;
    const int wg = blockIdx.x, nwg = gridDim.x, gtid = wg * NTHR + threadIdx.x, gsize = nwg * NTHR;
    volatile LAS unsigned* misc = (volatile LAS unsigned*)((LAS unsigned char*)lds_raw + LDSCTL_OFF);
    if (threadIdx.x < 64) misc[threadIdx.x] = 0u;
    __syncthreads();
    XcdBarrier bar = xcd_barrier_post((unsigned*)(ws + WS_CTL) + CW_BAR, misc + 8);
#if PROBE_PH >= 0
    const int abl = a.ph_lo >> 8, phlo = a.ph_lo & 255;
#else
    constexpr int abl = 0; const int phlo = a.ph_lo;
#endif
#define PH(k) if (phlo <= (k) && (k) < a.ph_hi)
#define SEAM(k) if (phlo <= (k) && (k) + 1 < a.ph_hi) xcd_barrier(bar)
    const float* par = (const float*)(ws + WS_PAR);
#if OPT_P0
    PH(0) { phase0_opt(a, ws, (LAS float*)lds_raw, gtid, gsize); }
#else
    PH(0) { phase0(a, ws, gtid, gsize); }
#endif
    SEAM(0);
    PH(1) {
#if (OPT_GEMM >> 1) & 1
            SchedStd S; S.init(T, NIN, nwg, wg, 1024, 1024); Epi1V E{(bf16_t*)(ws + WS_PRAW), (bf16_t*)(ws + WS_UC), (bf16_t*)(ws + WS_GATES), par + PAR_BG};
            gemm_phase<Epi1V, SchedStd, true, true>(ldsl, Gemm{(const bf16_t*)(ws + WS_XN), (const bf16_t*)(ws + WS_WIN), 1024, 1024, 1024}, S, E);
#else
            Epi1 E{(bf16_t*)(ws + WS_PRAW), (bf16_t*)(ws + WS_UC), (bf16_t*)(ws + WS_GATES), par + PAR_BG};
            gemm_naive<Epi1, false>(lds, (const bf16_t*)(ws + WS_XN), 1024, (const bf16_t*)(ws + WS_WIN), 1024, T, NIN, 1024, E, wg, nwg);
#endif
            }
    SEAM(1);
    PH(2) { phase2_prep(ws, gtid, gsize);
#if OPT_P0
            phase2_ybt(ws, gtid, gsize);
#endif
#if (OPT_GEMM >> 2) & 1
            __syncthreads();
            SchedGrp S{nwg, wg, 384, (size_t)2048 * 384, (size_t)256 * 256}; EpiEV E{(float*)(ws + WS_E)};
            gemm_phase<EpiEV, SchedGrp, true, true>(ldsl, Gemm{(const bf16_t*)(ws + WS_UC), (const bf16_t*)(ws + WS_EBT), 384, 256, 256}, S, E);
#else
            for (int g = 0; g < 32; ++g) { EpiE E{(float*)(ws + WS_E) + (size_t)g * 2048 * 128};
                gemm_naive<EpiE, false>(lds, (const bf16_t*)(ws + WS_UC) + (size_t)g * 2048 * 384, 384, (const bf16_t*)(ws + WS_EBT) + (size_t)g * 256 * 256, 256, 2048, 128, 256, E, wg, nwg); }
#endif
            }
    SEAM(2);
    PH(3) { phase3_scan_seg(ws, (LAS float*)lds_raw, wg, nwg);
#if OPT_WKV >= 4
            if (OPT_WKV != 6 || nwg != 256) phase3_invn(ws, gtid, gsize);
#endif
#if (OPT_GEMM >> 3) & 1
            __syncthreads();
            SchedStd S; S.init(T, 1536, nwg, wg, 256, 256); EpiLoraV E{(bf16_t*)(ws + WS_DD), (bf16_t*)(ws + WS_AA), (bf16_t*)(ws + WS_GR), par + PAR_W0, par + PAR_A0};
            gemm_phase<EpiLoraV, SchedStd, true, true>(ldsl, Gemm{(const bf16_t*)(ws + WS_A2), (const bf16_t*)(ws + WS_BLK), 256, 256, 256}, S, E);
#else
            EpiLora E{(bf16_t*)(ws + WS_DD), (bf16_t*)(ws + WS_AA), (bf16_t*)(ws + WS_GR), par + PAR_W0, par + PAR_A0};
            gemm_naive<EpiLora, false>(lds, (const bf16_t*)(ws + WS_A2), 256, (const bf16_t*)(ws + WS_BLK), 256, T, 1536, 256, E, wg, nwg);
#endif
            }
    SEAM(3);
    PH(4) {
#if (OPT_GEMM >> 4) & 1
            if (!(abl & 32)) { SchedGrp S{nwg, wg, 384, (size_t)2048 * 384, (size_t)256 * 384}; EpiYV E{(bf16_t*)(ws + WS_YS)};
              gemm_phase<EpiYV, SchedGrp, true, true>(ldsl, Gemm{(const bf16_t*)(ws + WS_UC), (const bf16_t*)(ws + WS_YBT), 384, 384, 384}, S, E); }
            __syncthreads();
#else
            for (int g = 0; g < 32; ++g) { EpiY E{(bf16_t*)(ws + WS_YS), g};
                gemm_naive<EpiY, false>(lds, (const bf16_t*)(ws + WS_UC) + (size_t)g * 2048 * 384, 384, (const bf16_t*)(ws + WS_YBT) + (size_t)g * 256 * 384, 384, 2048, 256, 384, E, wg, nwg); }
#endif
#if OPT_WKV == 6
#if W6_ABL
            if (nwg == 256) { phase4_wkv6(ws, (unsigned char*)a.out, (LAS float*)lds_raw, wg, a.in[I_PU], a.in[I_PV], a.in[I_NORM_FFN], bar); xcd_barrier(bar); phase4_wkv4(ws, (LAS float*)lds_raw, wg, nwg, a.in[I_PU], a.in[I_PV], a.in[I_NORM_FFN], 0); }
#else
            if (nwg == 256) phase4_wkv6(ws, (unsigned char*)a.out, (LAS float*)lds_raw, wg, a.in[I_PU], a.in[I_PV], a.in[I_NORM_FFN], bar);
#endif
            else phase4_wkv4(ws, (LAS float*)lds_raw, wg, nwg, a.in[I_PU], a.in[I_PV], a.in[I_NORM_FFN], 0); }
#elif OPT_WKV == 4
            phase4_wkv4(ws, (LAS float*)lds_raw, wg, nwg, a.in[I_PU], a.in[I_PV], a.in[I_NORM_FFN], abl); }
#elif OPT_WKV == 3
            phase4_wkv3(ws, (LAS float*)lds_raw, wg, nwg, a.in[I_PU], a.in[I_PV], a.in[I_NORM_FFN]); }
#elif OPT_WKV == 2
            phase4_wkv2(ws, (LAS float*)lds_raw, wg, nwg, a.in[I_PU], a.in[I_PV], a.in[I_NORM_FFN]); }
#elif OPT_WKV
            phase4_wkv_opt(ws, (LAS float*)lds_raw, wg, nwg, a.in[I_PU], a.in[I_PV], a.in[I_NORM_FFN]); }
#else
            phase4_wkv(ws, wg, nwg); }
#endif
    SEAM(4);
    PH(5) {
#if OPT_WKV == 6
            if (nwg == 256) phase5_post_b(ws, gtid >> 6, gsize >> 6, W6_TPOST, SEQ);
            else
#endif
            phase5_post_opt(ws, gtid, gsize);
#if (OPT_GEMM >> 5) & 1
            __syncthreads();
            SchedStd S; S.init(T, 2048, nwg, wg, 512, 512); EpiGluV E{(bf16_t*)(ws + WS_GATES)};
            gemm_phase<EpiGluV, SchedStd, true, true>(ldsl, Gemm{(const bf16_t*)(ws + WS_YS), (const bf16_t*)(ws + WS_WGLU), 512, 512, 512}, S, E);
#else
            EpiGlu E{(bf16_t*)(ws + WS_GATES)};
            gemm_naive<EpiGlu, true>(lds, (const bf16_t*)(ws + WS_YS), 512, (const bf16_t*)(ws + WS_WGLU), 512, T, 1024, 512, E, wg, nwg);
#endif
            }
    SEAM(5);
    PH(6) {
#if (OPT_GEMM >> 6) & 1
            SchedStd S; S.init(T, 1024, nwg, wg, 512, 512); EpiYaV E{(bf16_t*)(ws + WS_GATES)};
            gemm_phase<EpiYaV, SchedStd, true, true>(ldsl, Gemm{(const bf16_t*)(ws + WS_YO), (const bf16_t*)(ws + WS_WO), 512, 512, 512}, S, E);
#else
            EpiYa E{(bf16_t*)(ws + WS_GATES)};
            gemm_naive<EpiYa, false>(lds, (const bf16_t*)(ws + WS_YO), 512, (const bf16_t*)(ws + WS_WO), 512, T, 1024, 512, E, wg, nwg);
#endif
            }
    SEAM(6);
    PH(7) {
#if (OPT_GEMM >> 7) & 1
            SchedStd S; S.init(T, 1024, nwg, wg, 2048, 1024); EpiOutV E{a.in[I_X], (bf16_t*)(ws + WS_H1B), (float*)(ws + WS_RSS), ws + WS_X8};
            gemm_phase<EpiOutV, SchedStd, true, true>(ldsl, Gemm{(const bf16_t*)(ws + WS_GATES), (const bf16_t*)(ws + WS_WOUT), 2048, 1024, 1024}, S, E);
#else
            EpiOut E{a.in[I_X], (bf16_t*)(ws + WS_H1B), (float*)(ws + WS_RSS)};
            gemm_naive<EpiOut, false>(lds, (const bf16_t*)(ws + WS_GATES), 2048, (const bf16_t*)(ws + WS_WOUT), 1024, T, 1024, 1024, E, wg, nwg);
#endif
            }
    SEAM(7);
    PH(8) {
#if !(OPT_PEER == 2 && OPT_WKV)
            phase8_tables(a.in[I_PU], a.in[I_PV], a.in[I_NORM_FFN], ws, gtid, gsize);
#endif
#if (OPT_GEMM >> 8) & 1
            __syncthreads();
            SchedStd S; S.init(T, 1024, nwg, wg, 1024, 1024); EpiQV E{(bf16_t*)(ws + WS_Q), (const float*)(ws + WS_RSS)};
            gemm_phase<EpiQV, SchedStd, true, true>(ldsl, Gemm{(const bf16_t*)(ws + WS_H1B), (const bf16_t*)(ws + WS_WQ), 1024, 1024, 1024}, S, E);
#if OPT_TOPK
            asm volatile("s_waitcnt vmcnt(0)" ::: "memory"); __syncthreads();
            phase9_topk_opt<true>(ws, (LAS unsigned char*)lds_raw, wg, nwg, a.in[I_PU], a.in[I_PV], a.in[I_NORM_FFN]);
#endif
#else
            EpiQ E{(bf16_t*)(ws + WS_Q), (const float*)(ws + WS_RSS)};
            gemm_naive<EpiQ, false>(lds, (const bf16_t*)(ws + WS_H1B), 1024, (const bf16_t*)(ws + WS_WQ), 1024, T, 1024, 1024, E, wg, nwg);
#endif
            }
#if OPT_TOPK && ((OPT_GEMM >> 8) & 1)
    PH(9) { }
#elif OPT_TOPK
    SEAM(8);
    PH(9) { phase9_topk_opt<false>(ws, (LAS unsigned char*)lds_raw, wg, nwg, a.in[I_PU], a.in[I_PV], a.in[I_NORM_FFN]); }
#else
    SEAM(8);
    PH(9) { phase9_topk(ws, lds, gtid, gsize); }
#endif
    SEAM(9);
#if OPT_PEER == 2
    PH(10) { phase10a_part(ws, (LAS float*)lds_raw, wg, nwg); }
    SEAM(10);
    PH(11) { phase10r_reduce(ws, gtid, gsize); }
    SEAM(11);
    PH(12) { phase10b_out(a.out, ws, (LAS float*)lds_raw, wg, nwg); }
    SEAM(12);
    PH(13) { phase10c_norm(a.out, ws, gtid, gsize); }
#elif OPT_PEER
    PH(10) { phase10_peer_opt(a.out, ws, gtid, gsize); }
#else
    PH(10) { phase10_peer(a.out, ws, gtid, gsize); }
#endif
#undef PH
#undef SEAM
}

extern "C" void kernel_launch(void* const* d_in, const int* in_sizes, int n_in, void* d_out, int out_size, void* d_ws, size_t ws_size, hipStream_t stream) {
    if (n_in != N_INPUTS || out_size != T * DM || ws_size < WS_END) { fprintf(stderr, "kernel_launch: unexpected shapes (n_in %d, out %d, ws %zu)\n", n_in, out_size, ws_size); return; }
    (void)in_sizes;
    static int grid = 0;
    if (grid == 0) {
        int dev = 0, cus = 0, per_cu = 0;
        if (hipGetDevice(&dev) != hipSuccess || hipDeviceGetAttribute(&cus, hipDeviceAttributeMultiprocessorCount, dev) != hipSuccess) { fprintf(stderr, "kernel_launch: device query failed\n"); grid = -1; return; }
        if (hipFuncSetAttribute((const void*)fwd_kernel, hipFuncAttributeMaxDynamicSharedMemorySize, LDS_BYTES) != hipSuccess) { fprintf(stderr, "kernel_launch: hipFuncSetAttribute failed\n"); grid = -1; return; }
        if (hipOccupancyMaxActiveBlocksPerMultiprocessor(&per_cu, (const void*)fwd_kernel, NTHR, LDS_BYTES) != hipSuccess || per_cu < 1) { fprintf(stderr, "kernel_launch: occupancy query says %d blocks per CU\n", per_cu); (void)hipGetLastError(); }
        grid = cus;
    }
    if (grid < 0) return;
    if (hipMemsetAsync((char*)d_ws + WS_CTL, 0, CTL_BYTES, stream) != hipSuccess) { fprintf(stderr, "kernel_launch: memset failed\n"); return; }
    Args a{};
    for (int i = 0; i < N_INPUTS; ++i) a.in[i] = (const float*)d_in[i];
    a.out = (float*)d_out; a.ws = (unsigned char*)d_ws; a.ph_lo = 0; a.ph_hi = 14;
    void* kargs[] = {&a};
    hipError_t e = hipLaunchCooperativeKernel((const void*)fwd_kernel, dim3(grid), dim3(NTHR), kargs, LDS_BYTES, stream);
    if (e != hipSuccess) { fprintf(stderr, "kernel_launch: cooperative launch failed: %s (grid %d)\n", hipGetErrorString(e), grid); }
#if PROBE_PH >= 0
    a.ph_lo = PROBE_PH | (PROBE_ABL << 8); a.ph_hi = PROBE_PH + 1; (void)hipLaunchCooperativeKernel((const void*)fwd_kernel, dim3(grid), dim3(NTHR), kargs, LDS_BYTES, stream);
#endif
}
```

```cpp
#include <hip/hip_runtime.h>
#include <cstdio>
#include <cstdint>

#define DEV __device__ __forceinline__
#define LAS __attribute__((address_space(3)))
typedef unsigned short bf16_t;
typedef float f32x4 __attribute__((ext_vector_type(4)));
typedef float f32x2 __attribute__((ext_vector_type(2)));
typedef unsigned u32x4 __attribute__((ext_vector_type(4)));
typedef unsigned u32x2 __attribute__((ext_vector_type(2)));

#ifndef PROBE_ABL
#define PROBE_ABL 0
#endif
#ifndef PROBE_PH
#define PROBE_PH -1
#endif
#ifndef PEER_CH
#define PEER_CH 8
#endif
#ifndef OPT_P0
#define OPT_P0 1
#endif
#ifndef OPT_TOPK
#define OPT_TOPK 1
#endif
#ifndef OPT_PEER
#define OPT_PEER 2
#endif
#ifndef TAB_FP8
#define TAB_FP8 1
#endif
#ifndef W6_ABL
#define W6_ABL 0
#endif
#ifndef OPT_WKV
#define OPT_WKV 6
#endif
#ifndef OPT_GEMM
#define OPT_GEMM 0x1FE
#endif
constexpr int T = 32768, SEQ = 4096, NB = 8, DM = 1024;
constexpr int NIN = 4352, NRW = 1792;
constexpr int NTHR = 512;
constexpr float EPS = 1e-6f;

constexpr int LDSCTL_OFF = 147456 - 256;
constexpr size_t MiB = 1u << 20;
constexpr size_t WS_CTL = 0, CTL_BYTES = 1 * MiB;
constexpr size_t WS_RSS = 512 * 1024;
constexpr size_t WS_WIN = 1 * MiB;
constexpr size_t WS_BLK = 10 * MiB;
constexpr size_t WS_EBT = 11 * MiB;
constexpr size_t WS_YBT = 15 * MiB;
constexpr size_t WS_WGLU = 21 * MiB;
constexpr size_t WS_WO = 23 * MiB;
constexpr size_t WS_WOUT = 24 * MiB;
constexpr size_t WS_WQ = 26 * MiB;
constexpr size_t WS_SK = 28 * MiB;
constexpr size_t WS_PAR = 29 * MiB;
constexpr int PAR_MU = 0, PAR_W0 = 1792, PAR_A0 = 2304, PAR_KK = 2816, PAR_KA = 3328, PAR_RK = 3840, PAR_LNW = 4352, PAR_LNB = 4864, PAR_BG = 5376, PAR_NF = 7424, PAR_LAM16 = 8448, PAR_END = 12544;
constexpr size_t WS_INVN = 31 * MiB;
constexpr size_t WS_XN = 32 * MiB;
constexpr size_t WS_E = 32 * MiB;
constexpr size_t WS_A2 = 64 * MiB;
constexpr size_t WS_YS = 32 * MiB;
constexpr size_t WS_YO = 208 * MiB;
constexpr size_t WS_H1B = 96 * MiB;
constexpr size_t WS_PRAW = 96 * MiB;
constexpr size_t WS_UC = 208 * MiB;
constexpr size_t WS_GATES = 256 * MiB;
constexpr size_t WS_DD = 384 * MiB;
constexpr size_t WS_AA = 416 * MiB;
constexpr size_t WS_GR = 448 * MiB;
constexpr size_t WS_YR = 480 * MiB;
constexpr size_t WS_Q = 384 * MiB;
constexpr size_t WS_IDS = 448 * MiB;
constexpr size_t WS_GW = 464 * MiB;
#if OPT_PEER == 2
constexpr size_t WS_U16 = 64 * MiB;
constexpr size_t WS_V16 = 80 * MiB;
#else
constexpr size_t WS_U16 = 256 * MiB;
constexpr size_t WS_V16 = 288 * MiB;
#endif
constexpr size_t WS_X8 = 160 * MiB;
constexpr float X8_SCALE = 16.0f, U8_SCALE = 768.0f;
constexpr size_t WS_H2B = 192 * MiB;
constexpr size_t WS_RSS2 = 640 * 1024;
constexpr size_t WS_W2 = 480 * MiB;
constexpr size_t WS_BONUS = 1 * MiB;
constexpr size_t WS_END = 512 * MiB;
__device__ __forceinline__ size_t da_off(size_t m, int c) { const int b = (int)(m >> 12), t = (int)(m & 4095), h = c >> 6, g8 = (c >> 3) & 7;
    return ((((size_t)(b * 8 + h) * 256 + (t >> 4)) * 2 + (g8 >> 2)) * 1024 + (size_t)(((t & 15) * 4 + (g8 & 3)) * 16)) / 2 + (c & 7); }
static_assert(SEQ == 4096, "da_off assumes 4096 tokens per batch row");
constexpr int PRV = 768;
__device__ __forceinline__ size_t pr_off(size_t m, int col) { return col < 1024 ? (size_t)(col >> 9) * ((size_t)32768 * 512) + da_off(m, col & 511) : (size_t)32768 * 1024 + m * PRV + (size_t)(col - 1024); }

enum { I_X = 0, I_NORM_MIX, I_W_IN, I_B_GATE, I_MU, I_W_LORA, I_W0, I_A_LORA, I_A0, I_G_LORA, I_KK, I_KA, I_RK, I_LNW, I_LNB, I_WO,
       I_LOGDT, I_ARE, I_AIM, I_BRE, I_BIM, I_CRE, I_CIM, I_SD, I_WGLU, I_WOUT, I_NORM_FFN, I_WQ, I_SUBK, I_PU, I_PV, I_NORM_FINAL, N_INPUTS };

struct Args { const float* in[N_INPUTS]; float* out; unsigned char* ws; int ph_lo, ph_hi; };

DEV float bf2f(bf16_t h) { return __uint_as_float(((unsigned)h) << 16); }
DEV bf16_t f2bf(float f) { unsigned u = __float_as_uint(f); return (bf16_t)((u + 0x7fffu + ((u >> 16) & 1u)) >> 16); }
DEV float sigmoidf_(float x) { return 1.0f / (1.0f + __expf(-x)); }
DEV float gelu_tanh(float x) { const float u = 1.5957691216057308f * (x + 0.044715f * x * x * x); return x / (1.0f + __expf(-u)); }
DEV float wave_sum(float v) {
#pragma unroll
    for (int o = 1; o < 64; o <<= 1) v += __shfl_xor(v, o);
    return v;
}
DEV float lerp_prev(const bf16_t* praw, int m, int col, float mu) {
    const float p = bf2f(praw[pr_off((size_t)((size_t)m), col)]);
    const float pv = ((m & (SEQ - 1)) == 0) ? 0.f : bf2f(praw[pr_off((size_t)((size_t)(m - 1)), col)]);
    return p + (pv - p) * mu;
}

DEV unsigned q8(float v) { return (unsigned)__float2int_rn(fminf(fmaxf(v, -127.0f), 127.0f)) & 0xffu; }
DEV unsigned q8x4(float a, float b, float c, float d) { return q8(a) | (q8(b) << 8) | (q8(c) << 16) | (q8(d) << 24); }
template <class Epi, bool DUAL>
DEV void gemm_naive(float* lds, const bf16_t* A, int lda, const bf16_t* Bt, int ldb, int M, int N, int K, const Epi& E, int wg, int nwg) {
    float* As = lds;
    float* Bs = lds + 32 * 132;
    float* Bs2 = Bs + 32 * 68;
    const int tid = threadIdx.x, ty = tid >> 4, tx = tid & 15;
    const int ntm = M / 128, ntn = N / 64;
    for (int tile = wg; tile < ntm * ntn; tile += nwg) {
        const int m0 = (tile / ntn) * 128, n0 = (tile % ntn) * 64;
        float acc[4][4], acc2[4][4];
#pragma unroll
        for (int i = 0; i < 4; ++i)
#pragma unroll
            for (int j = 0; j < 4; ++j) { acc[i][j] = 0.f; acc2[i][j] = 0.f; }
        for (int k0 = 0; k0 < K; k0 += 32) {
            {
                const int r = tid >> 2, kc = (tid & 3) * 8;
                const u32x4 v = *(const u32x4*)(A + (size_t)(m0 + r) * lda + k0 + kc);
#pragma unroll
                for (int i = 0; i < 4; ++i) { As[(kc + 2 * i) * 132 + r] = __uint_as_float(v[i] << 16); As[(kc + 2 * i + 1) * 132 + r] = __uint_as_float(v[i] & 0xffff0000u); }
            }
            {
                const int t2 = tid & 255, r = t2 >> 2, kc = (t2 & 3) * 8;
                const int cabs = n0 + r;
                const int brow = DUAL ? ((cabs >> 7) * 256 + (cabs & 127) + ((tid >= 256) ? 128 : 0)) : cabs;
                if (DUAL || tid < 256) {
                    const u32x4 v = *(const u32x4*)(Bt + (size_t)brow * ldb + k0 + kc);
                    float* dst = (DUAL && tid >= 256) ? Bs2 : Bs;
#pragma unroll
                    for (int i = 0; i < 4; ++i) { dst[(kc + 2 * i) * 68 + r] = __uint_as_float(v[i] << 16); dst[(kc + 2 * i + 1) * 68 + r] = __uint_as_float(v[i] & 0xffff0000u); }
                }
            }
            __syncthreads();
#pragma unroll 8
            for (int kk = 0; kk < 32; ++kk) {
                const f32x4 a = *(const f32x4*)(As + kk * 132 + ty * 4);
                const f32x4 b = *(const f32x4*)(Bs + kk * 68 + tx * 4);
#pragma unroll
                for (int i = 0; i < 4; ++i)
#pragma unroll
                    for (int j = 0; j < 4; ++j) acc[i][j] += a[i] * b[j];
                if (DUAL) {
                    const f32x4 b2 = *(const f32x4*)(Bs2 + kk * 68 + tx * 4);
#pragma unroll
                    for (int i = 0; i < 4; ++i)
#pragma unroll
                        for (int j = 0; j < 4; ++j) acc2[i][j] += a[i] * b2[j];
                }
            }
            __syncthreads();
        }
#pragma unroll
        for (int i = 0; i < 4; ++i)
#pragma unroll
            for (int j = 0; j < 4; ++j) E.elem(m0 + ty * 4 + i, n0 + tx * 4 + j, acc[i][j], acc2[i][j]);
    }
}

struct Epi1 {
    bf16_t* praw; bf16_t* uc; bf16_t* gates; const float* b_gate;
    DEV void elem(int m, int n, float v, float) const {
        if (n < NRW) praw[pr_off((size_t)((size_t)m), n)] = f2bf(v);
        else if (n < NRW + 512) { const int c = n - NRW, g = c >> 4, h = c & 15; uc[((size_t)g * 2048 + (m >> 4)) * 384 + (m & 15) * 16 + h] = f2bf(v); }
        else { const int c = n - NRW - 512; gates[(size_t)m * 2048 + c] = f2bf(sigmoidf_(v + b_gate[c])); }
    }
};
struct EpiE {
    float* e;
    DEV void elem(int m, int n, float v, float) const { e[(size_t)m * 128 + n] = v; }
};
struct EpiLora {
    bf16_t* dd; bf16_t* aa; bf16_t* gr; const float* w0; const float* a0;
    DEV void elem(int m, int n, float v, float) const {
        if (n < 512) {
            const float wl = w0[n] + v, z = -wl;
            const float sp = (z > 20.f) ? z : log1pf(__expf(z));
            const float e = __expf(-sp - 0.5f);
            dd[da_off((size_t)m, n)] = f2bf(-expm1f(-e));
        } else if (n < 1024) aa[da_off((size_t)m, n - 512)] = f2bf(sigmoidf_(a0[n - 512] + v));
        else gr[(size_t)m * 512 + n - 1024] = f2bf(v);
    }
};
struct EpiY {
    bf16_t* ys; int g;
    DEV void elem(int m, int n, float v, float) const { ys[(size_t)(m * 16 + (n >> 4)) * 512 + g * 16 + (n & 15)] = f2bf(gelu_tanh(v)); }
};
struct EpiGlu {
    bf16_t* gates;
    DEV void elem(int m, int n, float v, float gt) const { bf16_t* p = gates + (size_t)m * 2048 + 1024 + n; *p = f2bf(bf2f(*p) * v * sigmoidf_(gt)); }
};
struct EpiYa {
    bf16_t* gates;
    DEV void elem(int m, int n, float v, float) const { bf16_t* p = gates + (size_t)m * 2048 + n; *p = f2bf(bf2f(*p) * v + bf2f(p[1024])); }
};
struct EpiOut {
    const float* x; bf16_t* h1b; float* rss;
    DEV void elem(int m, int n, float v, float) const { const float h = x[(size_t)m * DM + n] + v; h1b[(size_t)m * DM + n] = f2bf(h); atomicAdd(rss + m, h * h); }
};
struct EpiQ {
    bf16_t* q; const float* rss;
    DEV void elem(int m, int n, float v, float) const { q[(size_t)m * DM + n] = f2bf(v * rsqrtf(rss[m] * (1.0f / DM) + EPS)); }
};


#define PG8_LAS __attribute__((address_space(3)))
typedef short bf16x8 __attribute__((ext_vector_type(8)));
constexpr int BM = 256, BK = 64, HALF = 128, HTB = HALF * BK * 2, STAGE_BYTES = 8 * HTB, NXCD = 8, WGM = 8;
__host__ __device__ __forceinline__ int lds_byte(int r, int c) { const int st = (r >> 4) * 2 + (c >> 5), rr = r & 15, cc = c & 31, ob = rr * 64 + cc * 2; return st * 1024 + (ob ^ (((ob >> 9) & 1) << 5)); }
__host__ __device__ __forceinline__ void stage_rc(int b, int& R, int& C) { const int st = b / 1024, sb = b % 1024, swz = sb ^ (((sb >> 9) & 1) << 5); R = (st >> 1) * 16 + swz / 64; C = (st & 1) * 32 + (swz % 64) / 2; }
__host__ __device__ __forceinline__ int perm32(int rho) { const int n = rho >> 4, i = rho & 15; return 8 * (i >> 2) + 4 * n + (i & 3); }
struct Unit { int pm, pn, g; };
struct Gemm { const bf16_t* A; const bf16_t* Bt; int lda, ldb, K; };
struct SchedStd {
    int nM, nN, nwg, G, c, lda, ldb;
    DEV void init(int M, int N, int G_, int c_, int lda_, int ldb_) { nM = M / BM; nN = N / BM; nwg = nM * nN; G = G_; c = c_; lda = lda_; ldb = ldb_; }
    DEV bool next(int i, Unit& u) const {
        const long L = (long)i * G + c; if (L >= nwg) return false;
        int wgid = (int)L; { const int q = nwg / NXCD, r = nwg % NXCD, xcd = wgid % NXCD, off = wgid / NXCD; wgid = (xcd < r ? xcd * (q + 1) : r * (q + 1) + (xcd - r) * q) + off; }
        const int nig = WGM * nN, gid = wgid / nig, fm = gid * WGM, gsz = (nM - fm) < WGM ? (nM - fm) : WGM;
        u.pm = fm + ((wgid % nig) % gsz); u.pn = (wgid % nig) / gsz; u.g = 0; return true;
    }
    DEV size_t aoff(const Unit& u) const { return (size_t)u.pm * BM * lda * 2; }
    DEV size_t boff(const Unit& u) const { return (size_t)u.pn * BM * ldb * 2; }
    DEV void a_ready(const Unit&) const {}
    DEV void done(const Unit&) const {}
};
struct SchedGrp {
    int G, c, lda; size_t ags, bgs;
    DEV bool next(int i, Unit& u) const { const int L = i * G + c; if (L >= 256) return false; u.g = L >> 3; u.pm = L & 7; u.pn = 0; return true; }
    DEV size_t aoff(const Unit& u) const { return ((size_t)u.g * ags + (size_t)u.pm * BM * lda) * 2; }
    DEV size_t boff(const Unit& u) const { return (size_t)u.g * bgs * 2; }
    DEV void a_ready(const Unit&) const {}
    DEV void done(const Unit&) const {}
};
DEV unsigned cvt_pk_bf16(float lo, float hi) { unsigned r; asm volatile("v_cvt_pk_bf16_f32 %0, %1, %2" : "=v"(r) : "v"(lo), "v"(hi)); return r; }
DEV u32x4 pack8(const f32x4 a, const f32x4 b) { u32x4 w; w[0] = cvt_pk_bf16(a[0], a[1]); w[1] = cvt_pk_bf16(a[2], a[3]); w[2] = cvt_pk_bf16(b[0], b[1]); w[3] = cvt_pk_bf16(b[2], b[3]); return w; }
DEV void unpack8(const u32x4 w, f32x4& a, f32x4& b) { a[0] = __uint_as_float(w[0] << 16); a[1] = __uint_as_float(w[0] & 0xffff0000u); a[2] = __uint_as_float(w[1] << 16); a[3] = __uint_as_float(w[1] & 0xffff0000u);
    b[0] = __uint_as_float(w[2] << 16); b[1] = __uint_as_float(w[2] & 0xffff0000u); b[2] = __uint_as_float(w[3] << 16); b[3] = __uint_as_float(w[3] & 0xffff0000u); }
DEV float decay_d(float wl) {
    const float e = 0.6065306597126334f / (1.0f + __expf(-wl)); return -expm1f(-e); }

#define EPI_LOOP_AM for (int ai = 0; ai < 2; ++ai) _Pragma("unroll") for (int m = 0; m < 4; ++m)
struct Epi1V { static constexpr bool PERM = true, AFTER_DRAIN = false; bf16_t* praw; bf16_t* uc; bf16_t* gates; const float* b_gate;
    DEV void operator()(const f32x4 (&acc)[2][2][4][2], const Unit& u, int wr, int wc, int fr, int fq) const {
        const int row0 = u.pm * BM + wr * 64 + fr;
        if (u.pn < 7) {
#pragma unroll
            EPI_LOOP_AM { const int row = row0 + ai * HALF + m * 16;
#pragma unroll
                for (int bj = 0; bj < 2; ++bj) *(u32x4*)(praw + pr_off((size_t)((size_t)row), u.pn * BM + bj * HALF + wc * 32 + 8 * fq)) = pack8(acc[ai][bj][m][0], acc[ai][bj][m][1]); }
        } else if (u.pn < 9) {
#pragma unroll
            for (int bj = 0; bj < 2; ++bj) { const int c = (u.pn - 7) * BM + bj * HALF + wc * 32 + 8 * fq, g = c >> 4, h0 = c & 15;
#pragma unroll
                EPI_LOOP_AM { const int row = row0 + ai * HALF + m * 16;
                    *(u32x4*)(uc + ((size_t)g * 2048 + (row >> 4)) * 384 + (row & 15) * 16 + h0) = pack8(acc[ai][bj][m][0], acc[ai][bj][m][1]); } }
        } else {
#pragma unroll
            for (int bj = 0; bj < 2; ++bj) { const int c = (u.pn - 9) * BM + bj * HALF + wc * 32 + 8 * fq; const f32x4 b0 = *(const f32x4*)(b_gate + c), b1 = *(const f32x4*)(b_gate + c + 4);
#pragma unroll
                EPI_LOOP_AM { const int row = row0 + ai * HALF + m * 16; f32x4 v0 = acc[ai][bj][m][0] + b0, v1 = acc[ai][bj][m][1] + b1;
#pragma unroll
                    for (int i = 0; i < 4; ++i) { v0[i] = sigmoidf_(v0[i]); v1[i] = sigmoidf_(v1[i]); }
                    *(u32x4*)(gates + (size_t)row * 2048 + c) = pack8(v0, v1); } }
        }
    }
};
struct EpiLoraV { static constexpr bool PERM = true, AFTER_DRAIN = false; bf16_t* dd; bf16_t* aa; bf16_t* gr; const float* w0; const float* a0;
    DEV void operator()(const f32x4 (&acc)[2][2][4][2], const Unit& u, int wr, int wc, int fr, int fq) const {
        const int row0 = u.pm * BM + wr * 64 + fr; const int kind = u.pn >> 1;
        if (kind == 0) {
#pragma unroll
            for (int bj = 0; bj < 2; ++bj) { const int c = (u.pn & 1) * BM + bj * HALF + wc * 32 + 8 * fq; const f32x4 b0 = *(const f32x4*)(w0 + c), b1 = *(const f32x4*)(w0 + c + 4);
#pragma unroll
                EPI_LOOP_AM { const int row = row0 + ai * HALF + m * 16; f32x4 v0 = acc[ai][bj][m][0] + b0, v1 = acc[ai][bj][m][1] + b1;
#pragma unroll
                    for (int i = 0; i < 4; ++i) { v0[i] = decay_d(v0[i]); v1[i] = decay_d(v1[i]); }
                    *(u32x4*)(dd + da_off((size_t)row, c)) = pack8(v0, v1); } }
        } else if (kind == 1) {
#pragma unroll
            for (int bj = 0; bj < 2; ++bj) { const int c = (u.pn & 1) * BM + bj * HALF + wc * 32 + 8 * fq; const f32x4 b0 = *(const f32x4*)(a0 + c), b1 = *(const f32x4*)(a0 + c + 4);
#pragma unroll
                EPI_LOOP_AM { const int row = row0 + ai * HALF + m * 16; f32x4 v0 = acc[ai][bj][m][0] + b0, v1 = acc[ai][bj][m][1] + b1;
#pragma unroll
                    for (int i = 0; i < 4; ++i) { v0[i] = sigmoidf_(v0[i]); v1[i] = sigmoidf_(v1[i]); }
                    *(u32x4*)(aa + da_off((size_t)row, c)) = pack8(v0, v1); } }
        } else {
#pragma unroll
            for (int bj = 0; bj < 2; ++bj) { const int c = (u.pn & 1) * BM + bj * HALF + wc * 32 + 8 * fq;
#pragma unroll
                EPI_LOOP_AM { const int row = row0 + ai * HALF + m * 16; *(u32x4*)(gr + (size_t)row * 512 + c) = pack8(acc[ai][bj][m][0], acc[ai][bj][m][1]); } }
        }
    }
};
struct EpiEV { static constexpr bool PERM = false, AFTER_DRAIN = false; float* e;
    DEV void operator()(const f32x4 (&acc)[2][2][4][2], const Unit& u, int wr, int wc, int fr, int fq) const {
        const int row0 = u.pm * BM + wr * 64 + fr;
#pragma unroll
        EPI_LOOP_AM { float* rowp = e + ((size_t)u.g * 2048 + row0 + ai * HALF + m * 16) * 128 + wc * 32 + 4 * fq;
#pragma unroll
            for (int n = 0; n < 2; ++n) *(f32x4*)(rowp + n * 16) = acc[ai][0][m][n]; }
    }
};
struct EpiYV { static constexpr bool PERM = true, AFTER_DRAIN = false; bf16_t* ys;
    DEV void operator()(const f32x4 (&acc)[2][2][4][2], const Unit& u, int wr, int wc, int fr, int fq) const {
        const int row0 = u.pm * BM + wr * 64 + fr;
#pragma unroll
        for (int bj = 0; bj < 2; ++bj) { const int c = bj * HALF + wc * 32 + 8 * fq, s = c >> 4, h0 = c & 15;
#pragma unroll
            EPI_LOOP_AM { const int crow = row0 + ai * HALF + m * 16; f32x4 v0 = acc[ai][bj][m][0], v1 = acc[ai][bj][m][1];
#pragma unroll
                for (int i = 0; i < 4; ++i) { v0[i] = gelu_tanh(v0[i]); v1[i] = gelu_tanh(v1[i]); }
                *(u32x4*)(ys + ((size_t)crow * 16 + s) * 512 + u.g * 16 + h0) = pack8(v0, v1); } }
    }
};
struct EpiGluV { static constexpr bool PERM = true, AFTER_DRAIN = false; bf16_t* gates;
    DEV void operator()(const f32x4 (&acc)[2][2][4][2], const Unit& u, int wr, int wc, int fr, int fq) const {
        const int row0 = u.pm * BM + wr * 64 + fr; const int c = u.pn * HALF + wc * 32 + 8 * fq;
#pragma unroll
        EPI_LOOP_AM { const int row = row0 + ai * HALF + m * 16; u32x4* p = (u32x4*)(gates + (size_t)row * 2048 + 1024 + c); f32x4 g0, g1; unpack8(*p, g0, g1);
            f32x4 v0 = acc[ai][0][m][0], v1 = acc[ai][0][m][1]; const f32x4 t0 = acc[ai][1][m][0], t1 = acc[ai][1][m][1];
#pragma unroll
            for (int i = 0; i < 4; ++i) { v0[i] = g0[i] * v0[i] * sigmoidf_(t0[i]); v1[i] = g1[i] * v1[i] * sigmoidf_(t1[i]); }
            *p = pack8(v0, v1); }
    }
};
struct EpiYaV { static constexpr bool PERM = true, AFTER_DRAIN = false; bf16_t* gates;
    DEV void operator()(const f32x4 (&acc)[2][2][4][2], const Unit& u, int wr, int wc, int fr, int fq) const {
        const int row0 = u.pm * BM + wr * 64 + fr;
#pragma unroll
        for (int bj = 0; bj < 2; ++bj) { const int c = u.pn * BM + bj * HALF + wc * 32 + 8 * fq;
#pragma unroll
            EPI_LOOP_AM { const int row = row0 + ai * HALF + m * 16; u32x4* p = (u32x4*)(gates + (size_t)row * 2048 + c); f32x4 g0, g1, y0, y1; unpack8(*p, g0, g1); unpack8(*(const u32x4*)((const bf16_t*)p + 1024), y0, y1);
                *p = pack8(g0 * acc[ai][bj][m][0] + y0, g1 * acc[ai][bj][m][1] + y1); } }
    }
};
struct EpiOutV { static constexpr bool PERM = true, AFTER_DRAIN = false; const float* x; bf16_t* h1b; float* rss; unsigned char* x8;
    DEV void operator()(const f32x4 (&acc)[2][2][4][2], const Unit& u, int wr, int wc, int fr, int fq) const {
        const int row0 = u.pm * BM + wr * 64 + fr;
#pragma unroll
        EPI_LOOP_AM { const int row = row0 + ai * HALF + m * 16; float s = 0.f;
#pragma unroll
            for (int bj = 0; bj < 2; ++bj) { const int c = u.pn * BM + bj * HALF + wc * 32 + 8 * fq; const f32x4 h0 = *(const f32x4*)(x + (size_t)row * DM + c) + acc[ai][bj][m][0], h1 = *(const f32x4*)(x + (size_t)row * DM + c + 4) + acc[ai][bj][m][1];
                *(u32x4*)(h1b + (size_t)row * DM + c) = pack8(h0, h1);
                *(u32x2*)(x8 + (size_t)row * DM + c) = (u32x2){q8x4(h0[0] * X8_SCALE, h0[1] * X8_SCALE, h0[2] * X8_SCALE, h0[3] * X8_SCALE), q8x4(h1[0] * X8_SCALE, h1[1] * X8_SCALE, h1[2] * X8_SCALE, h1[3] * X8_SCALE)};
                s += h0[0] * h0[0] + h0[1] * h0[1] + h0[2] * h0[2] + h0[3] * h0[3] + h1[0] * h1[0] + h1[1] * h1[1] + h1[2] * h1[2] + h1[3] * h1[3]; }
            s += __shfl_xor(s, 16); s += __shfl_xor(s, 32);
            if (fq == 0) atomicAdd(rss + row, s); }
    }
};
struct EpiQV { static constexpr bool PERM = true, AFTER_DRAIN = false; bf16_t* q; const float* rss;
    DEV void operator()(const f32x4 (&acc)[2][2][4][2], const Unit& u, int wr, int wc, int fr, int fq) const {
        const int row0 = u.pm * BM + wr * 64 + fr;
#pragma unroll
        EPI_LOOP_AM { const int row = row0 + ai * HALF + m * 16; const float rstd = rsqrtf(rss[row] * (1.0f / DM) + EPS);
#pragma unroll
            for (int bj = 0; bj < 2; ++bj) *(u32x4*)(q + (size_t)row * DM + u.pn * BM + bj * HALF + wc * 32 + 8 * fq) = pack8(acc[ai][bj][m][0] * rstd, acc[ai][bj][m][1] * rstd); }
    }
};

template <class Epi, class Sched, bool ALIGN_EPI = false, bool SP2 = false>
__device__ __forceinline__ void gemm_phase(PG8_LAS unsigned char* lds, const Gemm g, const Sched& S, const Epi& E) {
    const int tid = threadIdx.x, wid = __builtin_amdgcn_readfirstlane(tid >> 6), lane = tid & 63, wr = wid >> 2, wc = wid & 3, fr = lane & 15, fq = lane >> 4;
    const int K = g.K, nt = K / BK;
    unsigned voffA[2], voffB[2];
#pragma unroll
    for (int i = 0; i < 2; ++i) { int R, C; stage_rc(tid * 16 + i * 8192, R, C); const int Rb = Epi::PERM ? ((R & ~31) + perm32(R & 31)) : R;
        voffA[i] = (unsigned)(R * g.lda + C) * 2u; voffB[i] = (unsigned)(Rb * g.ldb + C) * 2u; }
    const size_t kstep = (size_t)(BK * 2);
    const size_t hstepA = (size_t)HALF * g.lda * 2, hstepB = (size_t)HALF * g.ldb * 2;
    const unsigned ldsw = (unsigned)wid * 1024u;
    const int aoff = lds_byte(wr * 64 + fr, fq * 8), boff = lds_byte(wc * 32 + fr, fq * 8);
#define PG8_SA(b, h) (((b) * 2 + (h)) * HTB)
#define PG8_SB(b, h) ((4 + (b) * 2 + (h)) * HTB)
#define PG8_STAGE(bufoff, gbase, voff) do { _Pragma("unroll") for (int _i = 0; _i < 2; ++_i) \
        __builtin_amdgcn_global_load_lds((const unsigned*)((const char*)(gbase) + (voff)[_i]), (PG8_LAS unsigned*)(lds + (bufoff) + ldsw + _i * 8192), 16, 0, 0); } while (0)
#define PG8_LDA(dst, b, h) do { _Pragma("unroll") for (int m = 0; m < 4; ++m) _Pragma("unroll") for (int k = 0; k < 2; ++k) dst[m][k] = *(const PG8_LAS bf16x8*)(lds + PG8_SA(b, h) + aoff + m * 2048 + k * 1024); } while (0)
#define PG8_LDB(dst, b, h) do { _Pragma("unroll") for (int n = 0; n < 2; ++n) _Pragma("unroll") for (int k = 0; k < 2; ++k) dst[n][k] = *(const PG8_LAS bf16x8*)(lds + PG8_SB(b, h) + boff + n * 2048 + k * 1024); } while (0)
#define PG8_MMA(ai, bj, At, Bt) do { __builtin_amdgcn_s_setprio(1); _Pragma("unroll") for (int m = 0; m < 4; ++m) _Pragma("unroll") for (int n = 0; n < 2; ++n) _Pragma("unroll") for (int k = 0; k < 2; ++k) \
        acc[ai][bj][m][n] = __builtin_amdgcn_mfma_f32_16x16x32_bf16(Bt[n][k], At[m][k], acc[ai][bj][m][n], 0, 0, 0); __builtin_amdgcn_s_setprio(0); } while (0)
#define PG8_WAIT_V(n) asm volatile("s_waitcnt vmcnt(" #n ")" ::: "memory")
#define PG8_WAIT_L(n) asm volatile("s_waitcnt lgkmcnt(" #n ")" ::: "memory")
#define PG8_BAR __builtin_amdgcn_s_barrier()
#define PG8_SCHED __builtin_amdgcn_sched_barrier(0)
    Unit cur, nxt; int ui = 0;
    if (!S.next(0, cur)) return;
    f32x4 acc[2][2][4][2];
#pragma unroll
    for (int a = 0; a < 2; ++a)
#pragma unroll
        for (int b = 0; b < 2; ++b)
#pragma unroll
            for (int m = 0; m < 4; ++m)
#pragma unroll
                for (int n = 0; n < 2; ++n) acc[a][b][m][n] = (f32x4){0.f, 0.f, 0.f, 0.f};
    bf16x8 At[4][2], B0[2][2], B1[2][2];
    const char* cA = (const char*)g.A + S.aoff(cur); const char* cB = (const char*)g.Bt + S.boff(cur);
    S.a_ready(cur);
    if constexpr (SP2) {
        PG8_STAGE(PG8_SB(0, 0), cB, voffB); PG8_STAGE(PG8_SB(0, 1), cB + hstepB, voffB); PG8_STAGE(PG8_SA(0, 0), cA, voffA); PG8_STAGE(PG8_SA(0, 1), cA + hstepA, voffA);
        if (wr == 1) PG8_BAR;
        PG8_WAIT_V(2); PG8_BAR;
        PG8_STAGE(PG8_SB(1, 0), cB + kstep, voffB); PG8_STAGE(PG8_SA(1, 0), cA + kstep, voffA); PG8_STAGE(PG8_SB(1, 1), cB + hstepB + kstep, voffB);
        PG8_WAIT_V(6); PG8_BAR;
    } else {
        PG8_STAGE(PG8_SB(0, 0), cB, voffB); PG8_STAGE(PG8_SA(0, 0), cA, voffA); PG8_STAGE(PG8_SB(0, 1), cB + hstepB, voffB); PG8_STAGE(PG8_SA(0, 1), cA + hstepA, voffA);
        if (wr == 1) PG8_BAR;
        PG8_WAIT_V(4); PG8_BAR;
        PG8_STAGE(PG8_SB(1, 0), cB + kstep, voffB); PG8_STAGE(PG8_SA(1, 0), cA + kstep, voffA); PG8_STAGE(PG8_SB(1, 1), cB + hstepB + kstep, voffB);
        PG8_WAIT_V(6); PG8_BAR;
    }
    for (;;) {
        const bool has_next = S.next(ui + 1, nxt);
        const char* nA = has_next ? (const char*)g.A + S.aoff(nxt) : cA; const char* nB = has_next ? (const char*)g.Bt + S.boff(nxt) : cB;
#pragma unroll 1
        for (int t = 0; t < nt; t += 2) {
            const bool last = (t == nt - 2);
            const char* a1 = cA + (size_t)(t + 1) * kstep;
            const char* a2 = last ? nA : cA + (size_t)(t + 2) * kstep; const char* b2 = last ? nB : cB + (size_t)(t + 2) * kstep;
            const char* a3 = a2 + kstep; const char* b3 = b2 + kstep;
            if (last && has_next) S.a_ready(nxt);
            if constexpr (SP2) {
            PG8_LDB(B0, 0, 0); PG8_LDB(B1, 0, 1); PG8_SCHED; PG8_LDA(At, 0, 0); PG8_STAGE(PG8_SA(1, 1), a1 + hstepA, voffA);
            PG8_WAIT_V(8); PG8_WAIT_L(0); PG8_BAR; PG8_MMA(0, 0, At, B0); PG8_MMA(0, 1, At, B1); PG8_BAR; PG8_SCHED;
            PG8_LDA(At, 0, 1); PG8_STAGE(PG8_SB(0, 0), b2, voffB); PG8_STAGE(PG8_SB(0, 1), b2 + hstepB, voffB); PG8_STAGE(PG8_SA(0, 0), a2, voffA);
            PG8_WAIT_V(8); PG8_WAIT_L(0); PG8_BAR; PG8_MMA(1, 0, At, B0); PG8_MMA(1, 1, At, B1); PG8_BAR; PG8_SCHED;
            PG8_LDB(B0, 1, 0); PG8_LDB(B1, 1, 1); PG8_SCHED; PG8_LDA(At, 1, 0); PG8_STAGE(PG8_SA(0, 1), a2 + hstepA, voffA);
            PG8_WAIT_V(8); PG8_WAIT_L(0); PG8_BAR; PG8_MMA(0, 0, At, B0); PG8_MMA(0, 1, At, B1); PG8_BAR; PG8_SCHED;
            PG8_LDA(At, 1, 1); PG8_STAGE(PG8_SB(1, 0), b3, voffB); PG8_STAGE(PG8_SB(1, 1), b3 + hstepB, voffB); PG8_STAGE(PG8_SA(1, 0), a3, voffA);
            PG8_WAIT_V(8); PG8_WAIT_L(0); PG8_BAR; PG8_MMA(1, 0, At, B0); PG8_MMA(1, 1, At, B1); PG8_BAR; PG8_SCHED;
            } else {
            PG8_LDB(B0, 0, 0); PG8_SCHED; PG8_LDA(At, 0, 0); PG8_STAGE(PG8_SA(1, 1), a1 + hstepA, voffA);
            PG8_WAIT_L(8); PG8_BAR; PG8_WAIT_L(0); PG8_MMA(0, 0, At, B0); PG8_BAR; PG8_SCHED;
            PG8_LDB(B1, 0, 1); PG8_STAGE(PG8_SB(0, 0), b2, voffB);
            PG8_BAR; PG8_WAIT_L(0); PG8_MMA(0, 1, At, B1); PG8_BAR;
            PG8_LDA(At, 0, 1); PG8_STAGE(PG8_SA(0, 0), a2, voffA);
            PG8_BAR; PG8_WAIT_L(0); PG8_MMA(1, 0, At, B0); PG8_BAR; PG8_SCHED;
            PG8_STAGE(PG8_SB(0, 1), b2 + hstepB, voffB);
            PG8_WAIT_V(6); PG8_BAR; PG8_MMA(1, 1, At, B1); PG8_BAR;
            PG8_LDB(B0, 1, 0); PG8_SCHED; PG8_LDA(At, 1, 0); PG8_STAGE(PG8_SA(0, 1), a2 + hstepA, voffA);
            PG8_WAIT_L(8); PG8_BAR; PG8_WAIT_L(0); PG8_MMA(0, 0, At, B0); PG8_BAR; PG8_SCHED;
            PG8_LDB(B1, 1, 1); PG8_STAGE(PG8_SB(1, 0), b3, voffB);
            PG8_BAR; PG8_WAIT_L(0); PG8_MMA(0, 1, At, B1); PG8_BAR;
            PG8_LDA(At, 1, 1); PG8_STAGE(PG8_SA(1, 0), a3, voffA);
            PG8_BAR; PG8_WAIT_L(0); PG8_MMA(1, 0, At, B0); PG8_BAR; PG8_SCHED;
            PG8_STAGE(PG8_SB(1, 1), b3 + hstepB, voffB);
            PG8_WAIT_V(6); PG8_BAR; PG8_MMA(1, 1, At, B1); PG8_BAR;
            }
        }
        if constexpr (ALIGN_EPI) { if (wr == 0) PG8_BAR; }
        if constexpr (!Epi::AFTER_DRAIN) { E(acc, cur, wr, wc, fr, fq); S.done(cur); }
        if (!has_next) break;
#pragma unroll
        for (int a = 0; a < 2; ++a)
#pragma unroll
            for (int b = 0; b < 2; ++b)
#pragma unroll
                for (int m = 0; m < 4; ++m)
#pragma unroll
                    for (int n = 0; n < 2; ++n) acc[a][b][m][n] = (f32x4){0.f, 0.f, 0.f, 0.f};
        cur = nxt; cA = nA; cB = nB; ++ui;
        if constexpr (ALIGN_EPI) { if (wr == 1) PG8_BAR; }
    }
    PG8_WAIT_V(0);
    if constexpr (!ALIGN_EPI) { if (wr == 0) PG8_BAR; }
    PG8_BAR;
    if constexpr (Epi::AFTER_DRAIN) { E.fused(acc, cur, wr, wc, fr, fq, lds, wid, lane); S.done(cur); }
#undef PG8_SA
#undef PG8_SB
#undef PG8_STAGE
#undef PG8_LDA
#undef PG8_LDB
#undef PG8_MMA
#undef PG8_WAIT_V
#undef PG8_WAIT_L
#undef PG8_BAR
#undef PG8_SCHED
}

struct S5p { float lr, li, fr, fi, adt, idt; };
DEV S5p s5_param(const Args& a, int g, int p) {
    S5p o; const float dt = __expf(a.in[I_LOGDT][g]); const float are = a.in[I_ARE][g * 64 + p], aim = a.in[I_AIM][g * 64 + p];
    o.adt = are * dt; o.idt = aim * dt;
    const float mag = __expf(o.adt); float s, c; sincosf(o.idt, &s, &c);
    o.lr = mag * c; o.li = mag * s;
    const float den = are * are + aim * aim, nr = o.lr - 1.0f;
    o.fr = (nr * are + o.li * aim) / den; o.fi = (o.li * are - nr * aim) / den;
    return o;
}
DEV void s5_pow(const S5p& q, int n, float& pr, float& pi) { const float mag = __expf(q.adt * (float)n); float s, c; sincosf(q.idt * (float)n, &s, &c); pr = mag * c; pi = mag * s; }

DEV void phase0(const Args& a, unsigned char* ws, int gtid, int gsize) {
    const int lane = threadIdx.x & 63, gw = gtid >> 6, ngw = gsize >> 6;
    {
        bf16_t* xn = (bf16_t*)(ws + WS_XN); const float* x = a.in[I_X]; const float* gain = a.in[I_NORM_MIX];
        for (int m = gw; m < T; m += ngw) {
            const f32x4* xr = (const f32x4*)(x + (size_t)m * DM) + lane; f32x4 v[4]; float s = 0.f;
#pragma unroll
            for (int j = 0; j < 4; ++j) { v[j] = xr[64 * j]; s += v[j][0] * v[j][0] + v[j][1] * v[j][1] + v[j][2] * v[j][2] + v[j][3] * v[j][3]; }
            const float rstd = rsqrtf(wave_sum(s) * (1.0f / DM) + EPS);
#pragma unroll
            for (int j = 0; j < 4; ++j) { const f32x4 gn = ((const f32x4*)gain)[lane + 64 * j];
                u32x2 o; o[0] = (unsigned)f2bf(v[j][0] * rstd * gn[0]) | ((unsigned)f2bf(v[j][1] * rstd * gn[1]) << 16); o[1] = (unsigned)f2bf(v[j][2] * rstd * gn[2]) | ((unsigned)f2bf(v[j][3] * rstd * gn[3]) << 16);
                ((u32x2*)(xn + (size_t)m * DM))[lane + 64 * j] = o; }
        }
    }
    { bf16_t* w = (bf16_t*)(ws + WS_WIN); const float* s = a.in[I_W_IN]; for (int i = gtid; i < NIN * 1024; i += gsize) { const int n = i >> 10, k = i & 1023; w[i] = f2bf(s[(size_t)k * NIN + n]); } }
    { bf16_t* w = (bf16_t*)(ws + WS_BLK); for (int i = gtid; i < 1536 * 256; i += gsize) { const int n = i >> 8, k = i & 255; float v = 0.f;
            if (n < 512) { if (k < 64) v = a.in[I_W_LORA][k * 512 + n]; }
            else if (n < 1024) { if (k >= 64 && k < 128) v = a.in[I_A_LORA][(k - 64) * 512 + n - 512]; }
            else { if (k >= 128) v = a.in[I_G_LORA][(k - 128) * 512 + n - 1024]; }
            w[i] = f2bf(v); } }
    { bf16_t* w = (bf16_t*)(ws + WS_WGLU); const float* s = a.in[I_WGLU]; for (int i = gtid; i < 2048 * 512; i += gsize) { const int n = i >> 9, k = i & 511; const int pn = n >> 8, j = n & 255;
            const int col = (j < 128) ? (128 * pn + j) : (1024 + 128 * pn + (j - 128)); w[i] = f2bf(s[(size_t)k * 2048 + col]); } }
    { bf16_t* w = (bf16_t*)(ws + WS_WO); const float* s = a.in[I_WO]; for (int i = gtid; i < 1024 * 512; i += gsize) { const int n = i >> 9, k = i & 511; w[i] = f2bf(s[(size_t)k * 1024 + n]); } }
    { bf16_t* w = (bf16_t*)(ws + WS_WOUT); const float* s = a.in[I_WOUT]; for (int i = gtid; i < 1024 * 1024; i += gsize) { const int n = i >> 10, k = i & 1023; w[i] = f2bf(s[(size_t)k * 1024 + n]); } }
    { bf16_t* w = (bf16_t*)(ws + WS_WQ); const float* s = a.in[I_WQ]; const float* gn = a.in[I_NORM_FFN]; for (int i = gtid; i < 1024 * 1024; i += gsize) { const int n = i >> 10, k = i & 1023; w[i] = f2bf(s[(size_t)k * 1024 + n] * gn[k]); } }
    { bf16_t* w = (bf16_t*)(ws + WS_SK); const float* s = a.in[I_SUBK]; for (int i = gtid; i < 8 * 2 * 128 * 64; i += gsize) w[i] = f2bf(s[i]); }
    { float* par = (float*)(ws + WS_PAR);
      for (int i = gtid; i < PAR_END; i += gsize) { float v;
        if (i < PAR_W0) v = a.in[I_MU][i]; else if (i < PAR_A0) v = a.in[I_W0][i - PAR_W0]; else if (i < PAR_KK) v = a.in[I_A0][i - PAR_A0]; else if (i < PAR_KA) v = a.in[I_KK][i - PAR_KK];
        else if (i < PAR_RK) v = a.in[I_KA][i - PAR_KA]; else if (i < PAR_LNW) v = a.in[I_RK][i - PAR_RK]; else if (i < PAR_LNB) v = a.in[I_LNW][i - PAR_LNW]; else if (i < PAR_BG) v = a.in[I_LNB][i - PAR_LNB];
        else if (i < PAR_NF) v = a.in[I_B_GATE][i - PAR_BG]; else if (i < PAR_LAM16) v = a.in[I_NORM_FINAL][i - PAR_NF];
        else { const int j = i - PAR_LAM16, gp = j >> 1; const S5p q = s5_param(a, gp >> 6, gp & 63); float pr, pi; s5_pow(q, 16, pr, pi); v = (j & 1) ? pi : pr; }
        par[i] = v; } }
    {
        bf16_t* w = (bf16_t*)(ws + WS_EBT);
        for (int i = gtid; i < 32 * 256 * 256; i += gsize) { const int g = i >> 16, n = (i >> 8) & 255, k = i & 255; float v = 0.f;
            if (n < 128) { const int p = n & 63, sp = k >> 4, j = k & 15; const S5p q = s5_param(a, g, p);
                const float br = a.in[I_BRE][(g * 64 + p) * 16 + j], bi = a.in[I_BIM][(g * 64 + p) * 16 + j];
                const float bbr = q.fr * br - q.fi * bi, bbi = q.fr * bi + q.fi * br; float pr, pi; s5_pow(q, 15 - sp, pr, pi);
                v = (n < 64) ? (pr * bbr - pi * bbi) : (pr * bbi + pi * bbr); }
            w[i] = f2bf(v); }
    }
    {
        bf16_t* w = (bf16_t*)(ws + WS_YBT);
        for (int i = gtid; i < 32 * 256 * 384; i += gsize) { const int g = i / (256 * 384), r = i % (256 * 384), n = r / 384, k = r % 384; const int s = n >> 4, h = n & 15; float v = 0.f;
            if (k < 256) { const int sp = k >> 4, j = k & 15;
                if (sp <= s) { const int nn = s - sp; float acc = 0.f;
                    for (int p = 0; p < 64; ++p) { const S5p q = s5_param(a, g, p);
                        const float br = a.in[I_BRE][(g * 64 + p) * 16 + j], bi = a.in[I_BIM][(g * 64 + p) * 16 + j];
                        const float bbr = q.fr * br - q.fi * bi, bbi = q.fr * bi + q.fi * br; float pr, pi; s5_pow(q, nn, pr, pi);
                        const float zr = pr * bbr - pi * bbi, zi = pr * bbi + pi * bbr;
                        acc += a.in[I_CRE][(g * 16 + h) * 64 + p] * zr - a.in[I_CIM][(g * 16 + h) * 64 + p] * zi; }
                    if (nn == 0 && h == j) acc += a.in[I_SD][g * 16 + h];
                    v = acc; } }
            else { const int p = (k - 256) & 63; const S5p q = s5_param(a, g, p); float pr, pi; s5_pow(q, s + 1, pr, pi);
                const float cr = a.in[I_CRE][(g * 16 + h) * 64 + p], ci = a.in[I_CIM][(g * 16 + h) * 64 + p];
                v = (k < 320) ? (cr * pr - ci * pi) : -(cr * pi + ci * pr); }
            w[i] = f2bf(v); }
    }
}

DEV void phase2_prep(unsigned char* ws, int gtid, int gsize) {
    const bf16_t* praw = (const bf16_t*)(ws + WS_PRAW); bf16_t* a2 = (bf16_t*)(ws + WS_A2); const float* mu = (const float*)(ws + WS_PAR) + PAR_MU;
    for (int i = gtid; i < T * 32; i += gsize) { const int m = i >> 5, c = (i & 31) * 8;
        f32x4 p0, p1, q0, q1; unpack8(*(const u32x4*)(praw + pr_off((size_t)m, 1536 + c)), p0, p1);
        if ((m & (SEQ - 1)) == 0) { q0 = (f32x4){0.f, 0.f, 0.f, 0.f}; q1 = q0; } else unpack8(*(const u32x4*)(praw + pr_off((size_t)(m - 1), 1536 + c)), q0, q1);
        f32x4 v0 = p0 + (q0 - p0) * *(const f32x4*)(mu + 1536 + c), v1 = p1 + (q1 - p1) * *(const f32x4*)(mu + 1536 + c + 4);
        if (c < 64) {
#pragma unroll
            for (int j = 0; j < 4; ++j) { v0[j] = tanhf(v0[j]); v1[j] = tanhf(v1[j]); }
        } else if (c >= 128) {
#pragma unroll
            for (int j = 0; j < 4; ++j) { v0[j] = sigmoidf_(v0[j]); v1[j] = sigmoidf_(v1[j]); }
        }
        *(u32x4*)(a2 + (size_t)m * 256 + c) = pack8(v0, v1); }
}

DEV void phase3_scan(unsigned char* ws, int gtid, int gsize) {
    const float* e = (const float*)(ws + WS_E); bf16_t* uc = (bf16_t*)(ws + WS_UC); const float* lam16 = (const float*)(ws + WS_PAR) + PAR_LAM16;
    for (int i = gtid; i < NB * 32 * 64; i += gsize) { const int b = i >> 11, g = (i >> 6) & 31, p = i & 63; const float lr = lam16[(g * 64 + p) * 2], li = lam16[(g * 64 + p) * 2 + 1];
        float xr = 0.f, xi = 0.f;
        for (int c = 0; c < 256; ++c) { const size_t crow = (size_t)g * 2048 + b * 256 + c;
            uc[crow * 384 + 256 + p] = f2bf(xr); uc[crow * 384 + 320 + p] = f2bf(xi);
            const float er = e[crow * 128 + p], ei = e[crow * 128 + 64 + p];
            const float nr = lr * xr - li * xi + er, ni = lr * xi + li * xr + ei; xr = nr; xi = ni; }
    }
}

DEV void phase4_wkv(unsigned char* ws, int wg, int nwg) {
    const bf16_t* praw = (const bf16_t*)(ws + WS_PRAW); const bf16_t* dd = (const bf16_t*)(ws + WS_DD); const bf16_t* aa = (const bf16_t*)(ws + WS_AA); bf16_t* yr = (bf16_t*)(ws + WS_YR);
    const float* par = (const float*)(ws + WS_PAR); const float* mu = par + PAR_MU;
    const int tid = threadIdx.x, row = tid >> 5, ks = tid & 31;
    for (int item = wg; item < 256; item += nwg) {
        const int b = item >> 5, h = (item >> 2) & 7, qd = item & 3; const int v = qd * 16 + row;
        const int c0 = h * 64 + ks * 2;
        const float mur0 = mu[c0], mur1 = mu[c0 + 1], muk0 = mu[512 + c0], muk1 = mu[512 + c0 + 1], muv = mu[1024 + h * 64 + v];
        const float kk0 = par[PAR_KK + c0], kk1 = par[PAR_KK + c0 + 1], ka0 = par[PAR_KA + c0], ka1 = par[PAR_KA + c0 + 1];
        float s0 = 0.f, s1 = 0.f;
        float pr0 = 0.f, pr1 = 0.f, pk0 = 0.f, pk1 = 0.f, pv = 0.f;
        for (int t = 0; t < SEQ; ++t) { const size_t m = (size_t)b * SEQ + t;
            const unsigned rr = *(const unsigned*)(praw + pr_off((size_t)(m), c0)), kr = *(const unsigned*)(praw + pr_off((size_t)(m), 512 + c0));
            const float vr = bf2f(praw[pr_off((size_t)(m), 1024 + h * 64 + v)]);
            const unsigned dr = *(const unsigned*)(dd + da_off(m, c0)), ar = *(const unsigned*)(aa + da_off(m, c0));
            const float r0 = __uint_as_float(rr << 16), r1 = __uint_as_float(rr & 0xffff0000u), k0 = __uint_as_float(kr << 16), k1 = __uint_as_float(kr & 0xffff0000u);
            const float d0 = __uint_as_float(dr << 16), d1 = __uint_as_float(dr & 0xffff0000u), a0_ = __uint_as_float(ar << 16), a1_ = __uint_as_float(ar & 0xffff0000u);
            const float rl0 = r0 + (pr0 - r0) * mur0, rl1 = r1 + (pr1 - r1) * mur1, kl0 = k0 + (pk0 - k0) * muk0, kl1 = k1 + (pk1 - k1) * muk1, vl = vr + (pv - vr) * muv;
            pr0 = r0; pr1 = r1; pk0 = k0; pk1 = k1; pv = vr;
            const float q0 = kl0 * kk0, q1 = kl1 * kk1; float n2 = q0 * q0 + q1 * q1;
#pragma unroll
            for (int o = 1; o < 32; o <<= 1) n2 += __shfl_xor(n2, o);
            const float inv = 1.0f / fmaxf(sqrtf(n2), 1e-12f); const float kn0 = q0 * inv, kn1 = q1 * inv;
            const float k20 = kl0 * (1.0f + (a0_ - 1.0f) * ka0), k21 = kl1 * (1.0f + (a1_ - 1.0f) * ka1);
            float sa = -(s0 * kn0 + s1 * kn1);
#pragma unroll
            for (int o = 1; o < 32; o <<= 1) sa += __shfl_xor(sa, o);
            s0 = s0 * (1.0f - d0) + sa * (kn0 * a0_) + vl * k20; s1 = s1 * (1.0f - d1) + sa * (kn1 * a1_) + vl * k21;
            float y = s0 * rl0 + s1 * rl1;
#pragma unroll
            for (int o = 1; o < 32; o <<= 1) y += __shfl_xor(y, o);
            if (ks == 0) yr[m * 512 + h * 64 + v] = f2bf(y);
        }
    }
}

struct TabGrp { f32x4 u, v; };
DEV void tab_cvt_load(TabGrp& t, const float* pu, const float* pv, int i) { t.u = ((const f32x4*)pu)[i]; t.v = ((const f32x4*)pv)[i]; }
DEV void tab_cvt_store(const TabGrp& t, const float* gn, unsigned char* ws, int i) {
    const f32x4 u = t.u, v = t.v; const f32x4 g = ((const f32x4*)gn)[i & 255];
    int pu_ = 0, pv_ = 0;
    pu_ = (int)q8x4(u[0] * g[0] * U8_SCALE, u[1] * g[1] * U8_SCALE, u[2] * g[2] * U8_SCALE, u[3] * g[3] * U8_SCALE);
    pv_ = __builtin_amdgcn_cvt_pk_fp8_f32(v[0] * 16.0f, v[1] * 16.0f, pv_, false); pv_ = __builtin_amdgcn_cvt_pk_fp8_f32(v[2] * 16.0f, v[3] * 16.0f, pv_, true);
    const size_t o = ((size_t)((i & 255) >> 5) * 16384 + (i >> 8)) * 32 + (i & 31);
    ((unsigned*)(ws + WS_U16))[o] = (unsigned)pu_; ((unsigned*)(ws + WS_V16))[o] = (unsigned)pv_;
}

constexpr int WK_TB = 32, WK_SF = 340, WK_BF = WK_TB * WK_SF, WK_YF = WK_TB * 16, WK_NBLK = SEQ / WK_TB;
template <int CTRL> DEV float dpp_f(float x) { return __builtin_bit_cast(float, __builtin_amdgcn_update_dpp(0, __builtin_bit_cast(int, x), CTRL, 0xf, 0xf, true)); }
DEV float red16(float x) { x += dpp_f<0xB1>(x); x += dpp_f<0x4E>(x); x += dpp_f<0x124>(x); x += dpp_f<0x128>(x); return x; }
struct WkLoad { u32x4 r, rp, k, kp, d, a, v, vp; };
DEV void wk_issue(WkLoad& L, const bf16_t* praw, const bf16_t* dd, const bf16_t* aa, int b, int h, int qd, int blk, int s, int kseg) {
    const int t = blk * WK_TB + s; const size_t m = (size_t)b * SEQ + t; const size_t mp = (t > 0) ? m - 1 : m; const int c = h * 64 + kseg * 8;
    L.r = *(const u32x4*)(praw + pr_off((size_t)(m), c)); L.rp = *(const u32x4*)(praw + pr_off((size_t)(mp), c));
    L.k = *(const u32x4*)(praw + pr_off((size_t)(m), 512 + c)); L.kp = *(const u32x4*)(praw + pr_off((size_t)(mp), 512 + c));
    L.d = *(const u32x4*)(dd + da_off(m, c)); L.a = *(const u32x4*)(aa + da_off(m, c));
    if (kseg < 2) { const int cv = 1024 + h * 64 + qd * 16 + kseg * 8; L.v = *(const u32x4*)(praw + pr_off((size_t)(m), cv)); L.vp = *(const u32x4*)(praw + pr_off((size_t)(mp), cv)); }
}
DEV void wk_produce(const WkLoad& L, LAS float* buf, int blk, int s, int kseg, const float (&mur)[8], const float (&muk)[8], const float (&kkc)[8], const float (&kac)[8], const float (&muv)[8]) {
    const bool first = (blk == 0 && s == 0);
    f32x4 r0, r1, p0, p1, k0, k1, q0, q1, d0, d1, a0, a1;
    unpack8(L.r, r0, r1); unpack8(L.rp, p0, p1); unpack8(L.k, k0, k1); unpack8(L.kp, q0, q1); unpack8(L.d, d0, d1); unpack8(L.a, a0, a1);
    float rl[8], kl[8], av[8], dv[8], qq[8]; float n2 = 0.f;
#pragma unroll
    for (int i = 0; i < 8; ++i) { const float r = (i < 4) ? r0[i & 3] : r1[i & 3], rp = first ? 0.f : ((i < 4) ? p0[i & 3] : p1[i & 3]); const float k = (i < 4) ? k0[i & 3] : k1[i & 3], kp = first ? 0.f : ((i < 4) ? q0[i & 3] : q1[i & 3]);
        rl[i] = r + (rp - r) * mur[i]; kl[i] = k + (kp - k) * muk[i]; av[i] = (i < 4) ? a0[i & 3] : a1[i & 3]; dv[i] = (i < 4) ? d0[i & 3] : d1[i & 3]; qq[i] = kl[i] * kkc[i]; n2 += qq[i] * qq[i]; }
    n2 += __shfl_xor(n2, 1); n2 += __shfl_xor(n2, 2); n2 += __shfl_xor(n2, 4);
    const float inv = 1.0f / fmaxf(sqrtf(n2), 1e-12f);
    LAS float* P = buf + s * WK_SF + kseg * 8;
    f32x4 o0, o1;
#pragma unroll
    for (int i = 0; i < 4; ++i) { o0[i] = 1.0f - dv[i]; o1[i] = 1.0f - dv[4 + i]; }
    *(LAS f32x4*)(P) = o0; *(LAS f32x4*)(P + 4) = o1;
#pragma unroll
    for (int i = 0; i < 4; ++i) { o0[i] = -qq[i] * inv; o1[i] = -qq[4 + i] * inv; }
    *(LAS f32x4*)(P + 64) = o0; *(LAS f32x4*)(P + 68) = o1;
#pragma unroll
    for (int i = 0; i < 4; ++i) { o0[i] = qq[i] * inv * av[i]; o1[i] = qq[4 + i] * inv * av[4 + i]; }
    *(LAS f32x4*)(P + 128) = o0; *(LAS f32x4*)(P + 132) = o1;
#pragma unroll
    for (int i = 0; i < 4; ++i) { o0[i] = kl[i] * (1.0f + (av[i] - 1.0f) * kac[i]); o1[i] = kl[4 + i] * (1.0f + (av[4 + i] - 1.0f) * kac[4 + i]); }
    *(LAS f32x4*)(P + 192) = o0; *(LAS f32x4*)(P + 196) = o1;
    float c1 = 0.f, c2 = 0.f;
#pragma unroll
    for (int i = 0; i < 8; ++i) { c1 += qq[i] * inv * av[i] * rl[i]; c2 += kl[i] * (1.0f + (av[i] - 1.0f) * kac[i]) * rl[i]; }
    c1 += __shfl_xor(c1, 1); c1 += __shfl_xor(c1, 2); c1 += __shfl_xor(c1, 4); c2 += __shfl_xor(c2, 1); c2 += __shfl_xor(c2, 2); c2 += __shfl_xor(c2, 4);
#pragma unroll
    for (int i = 0; i < 4; ++i) { o0[i] = rl[i] * (1.0f - dv[i]); o1[i] = rl[4 + i] * (1.0f - dv[4 + i]); }
    *(LAS f32x4*)(P + 256) = o0; *(LAS f32x4*)(P + 260) = o1;
    if (kseg == 0) { buf[s * WK_SF + 336] = c1; buf[s * WK_SF + 337] = c2; }
    if (kseg < 2) { f32x4 v0, v1, w0, w1; unpack8(L.v, v0, v1); unpack8(L.vp, w0, w1);
#pragma unroll
        for (int i = 0; i < 4; ++i) { const float vp0 = first ? 0.f : w0[i], vp1 = first ? 0.f : w1[i]; o0[i] = v0[i] + (vp0 - v0[i]) * muv[i]; o1[i] = v1[i] + (vp1 - v1[i]) * muv[4 + i]; }
        *(LAS f32x4*)(buf + s * WK_SF + 320 + kseg * 8) = o0; *(LAS f32x4*)(buf + s * WK_SF + 324 + kseg * 8) = o1; }
}
DEV void wk_flush(const LAS float* yb, bf16_t* yr, int b, int h, int qd, int blk, int s, int kseg) {
    const float y0 = yb[s * 16 + 2 * kseg], y1 = yb[s * 16 + 2 * kseg + 1];
    *(unsigned*)(yr + ((size_t)b * SEQ + blk * WK_TB + s) * 512 + h * 64 + qd * 16 + 2 * kseg) = cvt_pk_bf16(y0, y1);
}
struct WkOp { f32x4 w4, a4, b4, k4, q4; float vv, c1, c2; };
DEV void wk_ld(WkOp& o, const LAS float* P, int row, int ks) {
    o.w4 = *(const LAS f32x4*)(P + ks * 4); o.a4 = *(const LAS f32x4*)(P + 64 + ks * 4); o.b4 = *(const LAS f32x4*)(P + 128 + ks * 4); o.k4 = *(const LAS f32x4*)(P + 192 + ks * 4); o.q4 = *(const LAS f32x4*)(P + 256 + ks * 4);
    o.vv = P[320 + row]; o.c1 = P[336]; o.c2 = P[337];
}
DEV void wk_step(const WkOp& c, LAS float* yb, f32x4& S, int s, int row) {
    float sa = S[0] * c.a4[0] + S[1] * c.a4[1] + S[2] * c.a4[2] + S[3] * c.a4[3];
    float yy = S[0] * c.q4[0] + S[1] * c.q4[1] + S[2] * c.q4[2] + S[3] * c.q4[3];
    sa += dpp_f<0xB1>(sa); yy += dpp_f<0xB1>(yy); sa += dpp_f<0x4E>(sa); yy += dpp_f<0x4E>(yy); sa += dpp_f<0x124>(sa); yy += dpp_f<0x124>(yy); sa += dpp_f<0x128>(sa); yy += dpp_f<0x128>(yy);
    S = S * c.w4 + sa * c.b4 + c.vv * c.k4;
    yb[s * 16 + row] = yy + sa * c.c1 + c.vv * c.c2;
}
DEV void wk_consume(const LAS float* buf, LAS float* yb, f32x4& S, int row, int ks) {
    WkOp A, B; wk_ld(A, buf, row, ks);
#pragma unroll 2
    for (int s = 0; s < WK_TB; s += 2) {
        wk_ld(B, buf + (s + 1) * WK_SF, row, ks);
        wk_step(A, yb, S, s, row);
        __builtin_amdgcn_sched_barrier(0);
        if (s + 2 < WK_TB) wk_ld(A, buf + (s + 2) * WK_SF, row, ks);
        wk_step(B, yb, S, s + 1, row);
        __builtin_amdgcn_sched_barrier(0);
    }
}
DEV void phase4_wkv_opt(unsigned char* ws, LAS float* lds, int wg, int nwg, const float* pu, const float* pv, const float* gn) {
    const bf16_t* praw = (const bf16_t*)(ws + WS_PRAW); const bf16_t* dd = (const bf16_t*)(ws + WS_DD); const bf16_t* aa = (const bf16_t*)(ws + WS_AA); bf16_t* yr = (bf16_t*)(ws + WS_YR);
    const float* par = (const float*)(ws + WS_PAR);
    const int tid = threadIdx.x, wid = __builtin_amdgcn_readfirstlane(tid >> 6), lane = tid & 63; const bool producer = wid >= 4;
    LAS float* buf0 = lds; LAS float* buf1 = lds + WK_BF; LAS float* yb0 = lds + 2 * WK_BF; LAS float* yb1 = yb0 + WK_YF;
    const int p = tid & 255, s = p >> 3, kseg = p & 7;
    const int row = (wid & 3) * 4 + (lane >> 4), ks = lane & 15;
    for (int it = wg; it < 256; it += nwg) {
        const int bh = (it & 7) * 8 + ((it >> 3) >> 2), qd = (it >> 3) & 3, b = bh >> 3, h = bh & 7;
        if (producer) {
            __builtin_amdgcn_s_setprio(0);
            float mur[8], muk[8], kkc[8], kac[8], muv[8];
#pragma unroll
            for (int i = 0; i < 8; ++i) { const int c = h * 64 + kseg * 8 + i; mur[i] = par[PAR_MU + c]; muk[i] = par[PAR_MU + 512 + c]; kkc[i] = par[PAR_KK + c]; kac[i] = par[PAR_KA + c]; muv[i] = par[PAR_MU + 1024 + h * 64 + qd * 16 + (kseg & 1) * 8 + i]; }
            WkLoad L0, L1;
            wk_issue(L0, praw, dd, aa, b, h, qd, 0, s, kseg); wk_issue(L1, praw, dd, aa, b, h, qd, 1, s, kseg);
            wk_produce(L0, buf0, 0, s, kseg, mur, muk, kkc, kac, muv);
            wk_issue(L0, praw, dd, aa, b, h, qd, 2, s, kseg);
#if OPT_PEER == 2
            TabGrp tg; tab_cvt_load(tg, pu, pv, (it * 64) * 256 + p);
#endif
            __syncthreads();
            for (int blk = 0; blk < WK_NBLK; blk += 2) {
                wk_produce(L1, buf1, blk + 1, s, kseg, mur, muk, kkc, kac, muv);
                if (blk + 3 < WK_NBLK) wk_issue(L1, praw, dd, aa, b, h, qd, blk + 3, s, kseg);
                if (blk > 0) wk_flush(yb1, yr, b, h, qd, blk - 1, s, kseg);
                __syncthreads();
                if (blk + 2 < WK_NBLK) wk_produce(L0, buf0, blk + 2, s, kseg, mur, muk, kkc, kac, muv);
                if (blk + 4 < WK_NBLK) wk_issue(L0, praw, dd, aa, b, h, qd, blk + 4, s, kseg);
                wk_flush(yb0, yr, b, h, qd, blk, s, kseg);
#if OPT_PEER == 2
                { const int gi = (it * 64 + (blk >> 1)) * 256 + p; tab_cvt_store(tg, gn, ws, gi); if (blk + 2 < WK_NBLK) tab_cvt_load(tg, pu, pv, gi + 256); }
#endif
                __syncthreads();
            }
            wk_flush(yb1, yr, b, h, qd, WK_NBLK - 1, s, kseg);
        } else {
            f32x4 S = (f32x4){0.f, 0.f, 0.f, 0.f};
            __syncthreads();
            for (int blk = 0; blk < WK_NBLK; blk += 2) {
                wk_consume(buf0, yb0, S, row, ks);
                __syncthreads();
                wk_consume(buf1, yb1, S, row, ks);
                __syncthreads();
            }
        }
        __builtin_amdgcn_s_setprio(0);
        __syncthreads();
    }
}

constexpr int W2_PF = 624, W2_NP = 16, W2_BF = W2_NP * W2_PF;
struct Wk2Load { u32x2 r0, r1, r2, k0, k1, k2, d1, d2, a1, a2, v0, v1, v2; };
DEV void up4(const u32x2 w, f32x4& o) { o[0] = __uint_as_float(w[0] << 16); o[1] = __uint_as_float(w[0] & 0xffff0000u); o[2] = __uint_as_float(w[1] << 16); o[3] = __uint_as_float(w[1] & 0xffff0000u); }
DEV void wk2_issue(Wk2Load& L, const bf16_t* praw, const bf16_t* dd, const bf16_t* aa, int b, int h, int qd, int blk, int j, int q) {
    const int t1 = blk * 32 + 2 * j; const size_t m1 = (size_t)b * SEQ + t1, m2 = m1 + 1, m0 = (t1 > 0) ? m1 - 1 : m1; const int c = h * 64 + q * 4;
    L.r0 = *(const u32x2*)(praw + pr_off((size_t)(m0), c)); L.r1 = *(const u32x2*)(praw + pr_off((size_t)(m1), c)); L.r2 = *(const u32x2*)(praw + pr_off((size_t)(m2), c));
    L.k0 = *(const u32x2*)(praw + pr_off((size_t)(m0), 512 + c)); L.k1 = *(const u32x2*)(praw + pr_off((size_t)(m1), 512 + c)); L.k2 = *(const u32x2*)(praw + pr_off((size_t)(m2), 512 + c));
    L.d1 = *(const u32x2*)(dd + da_off(m1, c)); L.d2 = *(const u32x2*)(dd + da_off(m2, c)); L.a1 = *(const u32x2*)(aa + da_off(m1, c)); L.a2 = *(const u32x2*)(aa + da_off(m2, c));
    if (q < 4) { const int cv = 1024 + h * 64 + qd * 16 + q * 4; L.v0 = *(const u32x2*)(praw + pr_off((size_t)(m0), cv)); L.v1 = *(const u32x2*)(praw + pr_off((size_t)(m1), cv)); L.v2 = *(const u32x2*)(praw + pr_off((size_t)(m2), cv)); }
}
DEV void wk2_produce(const Wk2Load& L, LAS float* buf, int blk, int j, int q, const f32x4 mur, const f32x4 muk, const f32x4 kkc, const f32x4 kac, const f32x4 muv) {
    const bool first = (blk == 0 && j == 0);
    f32x4 r0, r1, r2, k0, k1, k2, d1, d2, a1, a2;
    up4(L.r0, r0); up4(L.r1, r1); up4(L.r2, r2); up4(L.k0, k0); up4(L.k1, k1); up4(L.k2, k2); up4(L.d1, d1); up4(L.d2, d2); up4(L.a1, a1); up4(L.a2, a2);
    if (first) { r0 = (f32x4){0.f, 0.f, 0.f, 0.f}; k0 = r0; }
    const f32x4 rl1 = r1 + (r0 - r1) * mur, rl2 = r2 + (r1 - r2) * mur, kl1 = k1 + (k0 - k1) * muk, kl2 = k2 + (k1 - k2) * muk;
    const f32x4 q1 = kl1 * kkc, q2 = kl2 * kkc;
    float n1 = (q1[0] * q1[0] + q1[1] * q1[1]) + (q1[2] * q1[2] + q1[3] * q1[3]), n2 = (q2[0] * q2[0] + q2[1] * q2[1]) + (q2[2] * q2[2] + q2[3] * q2[3]);
    n1 += dpp_f<0xB1>(n1); n2 += dpp_f<0xB1>(n2); n1 += dpp_f<0x4E>(n1); n2 += dpp_f<0x4E>(n2); n1 += dpp_f<0x124>(n1); n2 += dpp_f<0x124>(n2); n1 += dpp_f<0x128>(n1); n2 += dpp_f<0x128>(n2);
    const float i1 = 1.0f / fmaxf(sqrtf(n1), 1e-12f), i2 = 1.0f / fmaxf(sqrtf(n2), 1e-12f);
    const f32x4 kn1 = q1 * i1, kn2 = q2 * i2, ah1 = -kn1, ah2 = -kn2, bh1 = kn1 * a1, bh2 = kn2 * a2;
    const f32x4 k21 = kl1 * (1.0f + (a1 - 1.0f) * kac), k22 = kl2 * (1.0f + (a2 - 1.0f) * kac), w1 = 1.0f - d1, w2 = 1.0f - d2;
    const f32x4 A2 = w1 * ah2, Q1 = w1 * rl1, W12 = w1 * w2, Q2 = W12 * rl2, B1 = bh1 * w2, K1 = k21 * w2;
    LAS float* P = buf + j * W2_PF + q * 4;
    *(LAS f32x4*)(P) = ah1; *(LAS f32x4*)(P + 64) = A2; *(LAS f32x4*)(P + 128) = Q1; *(LAS f32x4*)(P + 192) = Q2; *(LAS f32x4*)(P + 256) = W12;
    *(LAS f32x4*)(P + 320) = B1; *(LAS f32x4*)(P + 384) = K1; *(LAS f32x4*)(P + 448) = bh2; *(LAS f32x4*)(P + 512) = k22;
#if OPT_WKV == 3
    float sc0, sc1; { const f32x4 t0 = bh1 * ah2, t1 = k21 * ah2; sc0 = (t0[0] + t0[1]) + (t0[2] + t0[3]); sc1 = (t1[0] + t1[1]) + (t1[2] + t1[3]); }
    sc0 += dpp_f<0xB1>(sc0); sc1 += dpp_f<0xB1>(sc1); sc0 += dpp_f<0x4E>(sc0); sc1 += dpp_f<0x4E>(sc1); sc0 += dpp_f<0x124>(sc0); sc1 += dpp_f<0x124>(sc1); sc0 += dpp_f<0x128>(sc0); sc1 += dpp_f<0x128>(sc1);
    if (q == 0) *(LAS f32x2*)(buf + j * W2_PF + 608) = (f32x2){sc0, sc1};
#else
    float sc[8]; { const f32x4 t0 = bh1 * ah2, t1 = k21 * ah2, t2 = bh1 * rl1, t3 = k21 * rl1, t4 = B1 * rl2, t5 = K1 * rl2, t6 = bh2 * rl2, t7 = k22 * rl2;
        sc[0] = (t0[0] + t0[1]) + (t0[2] + t0[3]); sc[1] = (t1[0] + t1[1]) + (t1[2] + t1[3]); sc[2] = (t2[0] + t2[1]) + (t2[2] + t2[3]); sc[3] = (t3[0] + t3[1]) + (t3[2] + t3[3]);
        sc[4] = (t4[0] + t4[1]) + (t4[2] + t4[3]); sc[5] = (t5[0] + t5[1]) + (t5[2] + t5[3]); sc[6] = (t6[0] + t6[1]) + (t6[2] + t6[3]); sc[7] = (t7[0] + t7[1]) + (t7[2] + t7[3]); }
#pragma unroll
    for (int i = 0; i < 8; ++i) sc[i] += dpp_f<0xB1>(sc[i]);
#pragma unroll
    for (int i = 0; i < 8; ++i) sc[i] += dpp_f<0x4E>(sc[i]);
#pragma unroll
    for (int i = 0; i < 8; ++i) sc[i] += dpp_f<0x124>(sc[i]);
#pragma unroll
    for (int i = 0; i < 8; ++i) sc[i] += dpp_f<0x128>(sc[i]);
    if (q == 0) { *(LAS f32x4*)(buf + j * W2_PF + 608) = (f32x4){sc[0], sc[1], sc[2], sc[3]}; *(LAS f32x4*)(buf + j * W2_PF + 612) = (f32x4){sc[4], sc[5], sc[6], sc[7]}; }
#endif
    if (q < 4) { f32x4 v0, v1, v2; up4(L.v0, v0); up4(L.v1, v1); up4(L.v2, v2); if (first) v0 = (f32x4){0.f, 0.f, 0.f, 0.f};
        *(LAS f32x4*)(buf + j * W2_PF + 576 + q * 4) = v1 + (v0 - v1) * muv; *(LAS f32x4*)(buf + j * W2_PF + 592 + q * 4) = v2 + (v1 - v2) * muv; }
}
struct Wk2Op { f32x4 a1, a2, q1, q2, w12, b1, k1, b2, k2, s0, s1; float v1, v2; };
DEV void wk2_ld(Wk2Op& o, const LAS float* P, int row, int ks) {
    o.a1 = *(const LAS f32x4*)(P + ks * 4); o.a2 = *(const LAS f32x4*)(P + 64 + ks * 4); o.q1 = *(const LAS f32x4*)(P + 128 + ks * 4); o.q2 = *(const LAS f32x4*)(P + 192 + ks * 4); o.w12 = *(const LAS f32x4*)(P + 256 + ks * 4);
    o.b1 = *(const LAS f32x4*)(P + 320 + ks * 4); o.k1 = *(const LAS f32x4*)(P + 384 + ks * 4); o.b2 = *(const LAS f32x4*)(P + 448 + ks * 4); o.k2 = *(const LAS f32x4*)(P + 512 + ks * 4);
    o.v1 = P[576 + row]; o.v2 = P[592 + row]; o.s0 = *(const LAS f32x4*)(P + 608); o.s1 = *(const LAS f32x4*)(P + 612);
}
DEV float dot4(const f32x4 a, const f32x4 b) { f32x2 t = (f32x2){a[0], a[1]} * (f32x2){b[0], b[1]}; t = __builtin_elementwise_fma((f32x2){a[2], a[3]}, (f32x2){b[2], b[3]}, t); return t[0] + t[1]; }
DEV void wk2_step(const Wk2Op& c, LAS float* yb, f32x4& S, int j, int row) {
    float p1 = dot4(S, c.a1), p2 = dot4(S, c.a2), p3 = dot4(S, c.q1), p4 = dot4(S, c.q2);
    p1 += dpp_f<0xB1>(p1); p2 += dpp_f<0xB1>(p2); p3 += dpp_f<0xB1>(p3); p4 += dpp_f<0xB1>(p4);
    p1 += dpp_f<0x4E>(p1); p2 += dpp_f<0x4E>(p2); p3 += dpp_f<0x4E>(p3); p4 += dpp_f<0x4E>(p4);
    p1 += dpp_f<0x124>(p1); p2 += dpp_f<0x124>(p2); p3 += dpp_f<0x124>(p3); p4 += dpp_f<0x124>(p4);
    p1 += dpp_f<0x128>(p1); p2 += dpp_f<0x128>(p2); p3 += dpp_f<0x128>(p3); p4 += dpp_f<0x128>(p4);
    const float sa1 = p1, sa2 = (p2 + c.v1 * c.s0[1]) + sa1 * c.s0[0];
    S = ((S * c.w12 + c.v1 * c.k1) + c.v2 * c.k2) + sa1 * c.b1 + sa2 * c.b2;
    yb[(2 * j) * 16 + row] = (p3 + c.v1 * c.s0[3]) + sa1 * c.s0[2];
    yb[(2 * j + 1) * 16 + row] = ((p4 + c.v1 * c.s1[1]) + c.v2 * c.s1[3]) + sa1 * c.s1[0] + sa2 * c.s1[2];
}
DEV void wk2_consume(const LAS float* buf, LAS float* yb, f32x4& S, int row, int ks) {
    Wk2Op A, B; wk2_ld(A, buf, row, ks);
#pragma unroll 2
    for (int j = 0; j < W2_NP; j += 2) {
        wk2_ld(B, buf + (j + 1) * W2_PF, row, ks);
        wk2_step(A, yb, S, j, row);
        __builtin_amdgcn_sched_barrier(0);
        if (j + 2 < W2_NP) wk2_ld(A, buf + (j + 2) * W2_PF, row, ks);
        wk2_step(B, yb, S, j + 1, row);
        __builtin_amdgcn_sched_barrier(0);
    }
}
DEV void phase4_wkv2(unsigned char* ws, LAS float* lds, int wg, int nwg, const float* pu, const float* pv, const float* gn) {
    const bf16_t* praw = (const bf16_t*)(ws + WS_PRAW); const bf16_t* dd = (const bf16_t*)(ws + WS_DD); const bf16_t* aa = (const bf16_t*)(ws + WS_AA); bf16_t* yr = (bf16_t*)(ws + WS_YR);
    const float* par = (const float*)(ws + WS_PAR);
    const int tid = threadIdx.x, wid = __builtin_amdgcn_readfirstlane(tid >> 6), lane = tid & 63; const bool producer = wid >= 4;
    LAS float* buf0 = lds; LAS float* buf1 = lds + W2_BF; LAS float* yb0 = lds + 2 * W2_BF; LAS float* yb1 = yb0 + WK_YF;
    const int p = tid & 255, j = p >> 4, q = p & 15, s = p >> 3, kseg = p & 7;
    const int row = (wid & 3) * 4 + (lane >> 4), ks = lane & 15;
    for (int it = wg; it < 256; it += nwg) {
        const int bh = (it & 7) * 8 + ((it >> 3) >> 2), qd = (it >> 3) & 3, b = bh >> 3, h = bh & 7;
        if (producer) {
            const int c = h * 64 + q * 4;
            const f32x4 mur = *(const f32x4*)(par + PAR_MU + c), muk = *(const f32x4*)(par + PAR_MU + 512 + c), kkc = *(const f32x4*)(par + PAR_KK + c), kac = *(const f32x4*)(par + PAR_KA + c);
            const f32x4 muv = *(const f32x4*)(par + PAR_MU + 1024 + h * 64 + qd * 16 + (q & 3) * 4);
            Wk2Load L0, L1;
            wk2_issue(L0, praw, dd, aa, b, h, qd, 0, j, q); wk2_issue(L1, praw, dd, aa, b, h, qd, 1, j, q);
            wk2_produce(L0, buf0, 0, j, q, mur, muk, kkc, kac, muv);
            wk2_issue(L0, praw, dd, aa, b, h, qd, 2, j, q);
#if OPT_PEER == 2
            TabGrp tg; tab_cvt_load(tg, pu, pv, (it * 64) * 256 + p);
#endif
            __syncthreads();
            for (int blk = 0; blk < WK_NBLK; blk += 2) {
                wk2_produce(L1, buf1, blk + 1, j, q, mur, muk, kkc, kac, muv);
                if (blk + 3 < WK_NBLK) wk2_issue(L1, praw, dd, aa, b, h, qd, blk + 3, j, q);
                if (blk > 0) wk_flush(yb1, yr, b, h, qd, blk - 1, s, kseg);
                __syncthreads();
                if (blk + 2 < WK_NBLK) wk2_produce(L0, buf0, blk + 2, j, q, mur, muk, kkc, kac, muv);
                if (blk + 4 < WK_NBLK) wk2_issue(L0, praw, dd, aa, b, h, qd, blk + 4, j, q);
                wk_flush(yb0, yr, b, h, qd, blk, s, kseg);
#if OPT_PEER == 2
                { const int gi = (it * 64 + (blk >> 1)) * 256 + p; tab_cvt_store(tg, gn, ws, gi); if (blk + 2 < WK_NBLK) tab_cvt_load(tg, pu, pv, gi + 256); }
#endif
                __syncthreads();
            }
            wk_flush(yb1, yr, b, h, qd, WK_NBLK - 1, s, kseg);
        } else {
            f32x4 S = (f32x4){0.f, 0.f, 0.f, 0.f};
            __syncthreads();
            for (int blk = 0; blk < WK_NBLK; blk += 2) {
                wk2_consume(buf0, yb0, S, row, ks);
                __syncthreads();
                wk2_consume(buf1, yb1, S, row, ks);
                __syncthreads();
            }
        }
        __syncthreads();
    }
}

constexpr int W3_SIDE0 = 79872, W3_SIDESZ = 15360, W3_BT = 4608, W3_KT = 9216, W3_VT = 13824;
constexpr int W3_SA0 = 110592, W3_SASZ = 2304, W3_H00 = 115200, W3_H0SZ = 4352, W3_GS0 = 123904, W3_GSSZ = 2560;
static_assert(W3_GS0 + 2 * W3_GSSZ <= 131072, "wkv3 LDS map");
template <int CTRL> DEV float dpp_shr_id1(float x) { return __builtin_bit_cast(float, __builtin_amdgcn_update_dpp(0x3f800000, __builtin_bit_cast(int, x), CTRL, 0xf, 0xf, false)); }
DEV bf16x8 f8_to_bf16x8(const f32x4 a, const f32x4 b) { const u32x4 w = pack8(a, b); return __builtin_bit_cast(bf16x8, w); }
struct Wk3Op { f32x4 a1, a2, w12, b1, k1, b2, k2; float v1, v2, be, ka; };
DEV void wk3_ld(Wk3Op& o, const LAS float* P, int row, int ks) {
    o.a1 = *(const LAS f32x4*)(P + ks * 4); o.a2 = *(const LAS f32x4*)(P + 64 + ks * 4); o.w12 = *(const LAS f32x4*)(P + 256 + ks * 4);
    o.b1 = *(const LAS f32x4*)(P + 320 + ks * 4); o.k1 = *(const LAS f32x4*)(P + 384 + ks * 4); o.b2 = *(const LAS f32x4*)(P + 448 + ks * 4); o.k2 = *(const LAS f32x4*)(P + 512 + ks * 4);
    o.v1 = P[576 + row]; o.v2 = P[592 + row]; const f32x2 s = *(const LAS f32x2*)(P + 608); o.be = s[0]; o.ka = s[1];
}
DEV void wk3_step(const Wk3Op& c, LAS float* sa, f32x4& S, int j) {
    float p1 = dot4(S, c.a1), p2 = dot4(S, c.a2);
    p1 += dpp_f<0xB1>(p1); p2 += dpp_f<0xB1>(p2); p1 += dpp_f<0x4E>(p1); p2 += dpp_f<0x4E>(p2); p1 += dpp_f<0x124>(p1); p2 += dpp_f<0x124>(p2); p1 += dpp_f<0x128>(p1); p2 += dpp_f<0x128>(p2);
    const float sa1 = p1, sa2 = (p2 + c.v1 * c.ka) + sa1 * c.be;
    S = ((S * c.w12 + c.v1 * c.k1) + c.v2 * c.k2) + sa1 * c.b1 + sa2 * c.b2;
    *(LAS f32x2*)(sa + 2 * j) = (f32x2){sa1, sa2};
}
DEV void wk3_consume(const LAS float* buf, LAS unsigned char* sab, LAS unsigned char* h0b, f32x4& S, int row, int ks) {
    *(LAS f32x4*)(h0b + row * 272 + ks * 16) = S;
    LAS float* sa = (LAS float*)(sab + row * 144);
    Wk3Op A, B; wk3_ld(A, buf, row, ks);
#pragma unroll 2
    for (int j = 0; j < W2_NP; j += 2) {
        wk3_ld(B, buf + (j + 1) * W2_PF, row, ks);
        wk3_step(A, sa, S, j);
        __builtin_amdgcn_sched_barrier(0);
        if (j + 2 < W2_NP) wk3_ld(A, buf + (j + 2) * W2_PF, row, ks);
        wk3_step(B, sa, S, j + 1);
        __builtin_amdgcn_sched_barrier(0);
    }
}
DEV void wk3_side(const LAS float* buf, LAS unsigned char* side, int pw, int lane) {
    const int qq = lane >> 4, j = lane & 15, kq = 4 * pw + qq; const LAS float* P = buf + j * W2_PF + kq * 4;
    const f32x4 Q1 = *(const LAS f32x4*)(P + 128), Q2 = *(const LAS f32x4*)(P + 192), W12 = *(const LAS f32x4*)(P + 256), B1 = *(const LAS f32x4*)(P + 320), K1 = *(const LAS f32x4*)(P + 384), B2 = *(const LAS f32x4*)(P + 448), K2 = *(const LAS f32x4*)(P + 512);
    f32x4 g2 = W12;
#pragma unroll
    for (int c = 0; c < 4; ++c) { float x = g2[c]; x *= dpp_shr_id1<0x111>(x); x *= dpp_shr_id1<0x112>(x); x *= dpp_shr_id1<0x114>(x); x *= dpp_shr_id1<0x118>(x); g2[c] = x; }
    f32x4 g0, inv;
#pragma unroll
    for (int c = 0; c < 4; ++c) { g0[c] = dpp_shr_id1<0x111>(g2[c]); inv[c] = 1.0f / g2[c]; }
    const f32x4 r1 = g0 * Q1, r2 = g0 * Q2, b1 = B1 * inv, k1 = K1 * inv, b2 = B2 * inv, k2 = K2 * inv;
    LAS unsigned char* o = side + (2 * j) * 144 + kq * 8;
    *(LAS u32x2*)(o) = (u32x2){cvt_pk_bf16(r1[0], r1[1]), cvt_pk_bf16(r1[2], r1[3])}; *(LAS u32x2*)(o + 144) = (u32x2){cvt_pk_bf16(r2[0], r2[1]), cvt_pk_bf16(r2[2], r2[3])};
    *(LAS u32x2*)(o + W3_BT) = (u32x2){cvt_pk_bf16(b1[0], b1[1]), cvt_pk_bf16(b1[2], b1[3])}; *(LAS u32x2*)(o + W3_BT + 144) = (u32x2){cvt_pk_bf16(b2[0], b2[1]), cvt_pk_bf16(b2[2], b2[3])};
    *(LAS u32x2*)(o + W3_KT) = (u32x2){cvt_pk_bf16(k1[0], k1[1]), cvt_pk_bf16(k1[2], k1[3])}; *(LAS u32x2*)(o + W3_KT + 144) = (u32x2){cvt_pk_bf16(k2[0], k2[1]), cvt_pk_bf16(k2[2], k2[3])};
    if (pw == 0) { const f32x4 v1 = *(const LAS f32x4*)(buf + j * W2_PF + 576 + 4 * qq), v2 = *(const LAS f32x4*)(buf + j * W2_PF + 592 + 4 * qq);
#pragma unroll
        for (int rr = 0; rr < 4; ++rr) *(LAS unsigned*)(side + W3_VT + (4 * qq + rr) * 80 + (2 * j) * 2) = cvt_pk_bf16(v1[rr], v2[rr]); }
}
DEV void wk3_ymma(const LAS unsigned char* side, const LAS unsigned char* sab, const LAS unsigned char* h0b, LAS unsigned char* gs, bf16_t* yrow, int mt, int lane) {
    const int tl = lane & 15, lq = lane >> 4; const f32x4 z4 = (f32x4){0.f, 0.f, 0.f, 0.f};
    bf16x8 fR[2];
#pragma unroll
    for (int ks = 0; ks < 2; ++ks) fR[ks] = *(const LAS bf16x8*)(side + (16 * mt + tl) * 144 + (32 * ks + 8 * lq) * 2);
#pragma unroll
    for (int nt = 0; nt < 2; ++nt) { f32x4 g1 = z4, g2 = z4;
        if (nt <= mt) {
#pragma unroll
            for (int ks = 0; ks < 2; ++ks) { const bf16x8 fB = *(const LAS bf16x8*)(side + W3_BT + (16 * nt + tl) * 144 + (32 * ks + 8 * lq) * 2), fK = *(const LAS bf16x8*)(side + W3_KT + (16 * nt + tl) * 144 + (32 * ks + 8 * lq) * 2);
                g1 = __builtin_amdgcn_mfma_f32_16x16x32_bf16(fB, fR[ks], g1, 0, 0, 0); g2 = __builtin_amdgcn_mfma_f32_16x16x32_bf16(fK, fR[ks], g2, 0, 0, 0); } }
#pragma unroll
        for (int i = 0; i < 4; ++i) { const bool keep = (nt <= mt) && (16 * nt + 4 * lq + i <= 16 * mt + tl); g1[i] = keep ? g1[i] : 0.f; g2[i] = keep ? g2[i] : 0.f; }
        *(LAS u32x2*)(gs + tl * 80 + (16 * nt + 4 * lq) * 2) = (u32x2){cvt_pk_bf16(g1[0], g1[1]), cvt_pk_bf16(g1[2], g1[3])};
        *(LAS u32x2*)(gs + 1280 + tl * 80 + (16 * nt + 4 * lq) * 2) = (u32x2){cvt_pk_bf16(g2[0], g2[1]), cvt_pk_bf16(g2[2], g2[3])}; }
    asm volatile("s_waitcnt lgkmcnt(0)" ::: "memory");
    const bf16x8 fG1 = *(const LAS bf16x8*)(gs + tl * 80 + (8 * lq) * 2), fG2 = *(const LAS bf16x8*)(gs + 1280 + tl * 80 + (8 * lq) * 2);
    const LAS float* sp = (const LAS float*)(sab + tl * 144) + 8 * lq; const bf16x8 fS = f8_to_bf16x8(*(const LAS f32x4*)sp, *(const LAS f32x4*)(sp + 4));
    const bf16x8 fV = *(const LAS bf16x8*)(side + W3_VT + tl * 80 + (8 * lq) * 2);
    f32x4 y = __builtin_amdgcn_mfma_f32_16x16x32_bf16(fS, fG1, z4, 0, 0, 0);
    y = __builtin_amdgcn_mfma_f32_16x16x32_bf16(fV, fG2, y, 0, 0, 0);
#pragma unroll
    for (int ks = 0; ks < 2; ++ks) { const LAS float* hp = (const LAS float*)(h0b + tl * 272) + 32 * ks + 8 * lq; const bf16x8 fH = f8_to_bf16x8(*(const LAS f32x4*)hp, *(const LAS f32x4*)(hp + 4));
        y = __builtin_amdgcn_mfma_f32_16x16x32_bf16(fH, fR[ks], y, 0, 0, 0); }
    asm volatile("s_nop 15" : "+v"(y));
    *(u32x2*)(yrow + (size_t)(16 * mt + tl) * 512 + 4 * lq) = (u32x2){cvt_pk_bf16(y[0], y[1]), cvt_pk_bf16(y[2], y[3])};
    asm volatile("s_waitcnt lgkmcnt(0)" ::: "memory");
}
DEV void phase4_wkv3(unsigned char* ws, LAS float* lds, int wg, int nwg, const float* pu, const float* pv, const float* gn) {
    const bf16_t* praw = (const bf16_t*)(ws + WS_PRAW); const bf16_t* dd = (const bf16_t*)(ws + WS_DD); const bf16_t* aa = (const bf16_t*)(ws + WS_AA); bf16_t* yr = (bf16_t*)(ws + WS_YR);
    const float* par = (const float*)(ws + WS_PAR); LAS unsigned char* lb = (LAS unsigned char*)lds;
    const int tid = threadIdx.x, wid = __builtin_amdgcn_readfirstlane(tid >> 6), lane = tid & 63; const bool producer = wid >= 4; const int pw = wid & 3;
    LAS float* buf0 = lds; LAS float* buf1 = lds + W2_BF;
    const int p = tid & 255, j = p >> 4, q = p & 15;
    const int row = (wid & 3) * 4 + (lane >> 4), ks = lane & 15;
    for (int it = wg; it < 256; it += nwg) {
        const int bh = (it & 7) * 8 + ((it >> 3) >> 2), qd = (it >> 3) & 3, b = bh >> 3, h = bh & 7;
        bf16_t* ybase = yr + (size_t)b * SEQ * 512 + h * 64 + qd * 16;
        if (producer) {
            const int c = h * 64 + q * 4;
            const f32x4 mur = *(const f32x4*)(par + PAR_MU + c), muk = *(const f32x4*)(par + PAR_MU + 512 + c), kkc = *(const f32x4*)(par + PAR_KK + c), kac = *(const f32x4*)(par + PAR_KA + c);
            const f32x4 muv = *(const f32x4*)(par + PAR_MU + 1024 + h * 64 + qd * 16 + (q & 3) * 4);
            Wk2Load L0, L1;
            wk2_issue(L0, praw, dd, aa, b, h, qd, 0, j, q); wk2_issue(L1, praw, dd, aa, b, h, qd, 1, j, q);
            wk2_produce(L0, buf0, 0, j, q, mur, muk, kkc, kac, muv);
            wk2_issue(L0, praw, dd, aa, b, h, qd, 2, j, q);
#if OPT_PEER == 2
            TabGrp tg; tab_cvt_load(tg, pu, pv, (it * 64) * 256 + p);
#endif
            __syncthreads();
            for (int blk = 0; blk < WK_NBLK; blk += 2) {
                wk2_produce(L1, buf1, blk + 1, j, q, mur, muk, kkc, kac, muv);
                if (blk + 3 < WK_NBLK) wk2_issue(L1, praw, dd, aa, b, h, qd, blk + 3, j, q);
                wk3_side(buf0, lb + W3_SIDE0, pw, lane);
                if (blk > 0 && pw < 2) wk3_ymma(lb + W3_SIDE0 + W3_SIDESZ, lb + W3_SA0 + W3_SASZ, lb + W3_H00 + W3_H0SZ, lb + W3_GS0 + pw * W3_GSSZ, ybase + (size_t)(blk - 1) * WK_TB * 512, pw, lane);
                __syncthreads();
                if (blk + 2 < WK_NBLK) wk2_produce(L0, buf0, blk + 2, j, q, mur, muk, kkc, kac, muv);
                if (blk + 4 < WK_NBLK) wk2_issue(L0, praw, dd, aa, b, h, qd, blk + 4, j, q);
                wk3_side(buf1, lb + W3_SIDE0 + W3_SIDESZ, pw, lane);
                if (pw < 2) wk3_ymma(lb + W3_SIDE0, lb + W3_SA0, lb + W3_H00, lb + W3_GS0 + pw * W3_GSSZ, ybase + (size_t)blk * WK_TB * 512, pw, lane);
#if OPT_PEER == 2
                { const int gi = (it * 64 + (blk >> 1)) * 256 + p; tab_cvt_store(tg, gn, ws, gi); if (blk + 2 < WK_NBLK) tab_cvt_load(tg, pu, pv, gi + 256); }
#endif
                __syncthreads();
            }
            if (pw < 2) wk3_ymma(lb + W3_SIDE0 + W3_SIDESZ, lb + W3_SA0 + W3_SASZ, lb + W3_H00 + W3_H0SZ, lb + W3_GS0 + pw * W3_GSSZ, ybase + (size_t)(WK_NBLK - 1) * WK_TB * 512, pw, lane);
        } else {
            f32x4 S = (f32x4){0.f, 0.f, 0.f, 0.f};
            __syncthreads();
            for (int blk = 0; blk < WK_NBLK; blk += 2) {
                wk3_consume(buf0, lb + W3_SA0, lb + W3_H00, S, row, ks);
                __syncthreads();
                wk3_consume(buf1, lb + W3_SA0 + W3_SASZ, lb + W3_H00 + W3_H0SZ, S, row, ks);
                __syncthreads();
            }
        }
        __syncthreads();
    }
}

DEV void phase3_invn(unsigned char* ws, int gtid, int gsize) {
    const bf16_t* praw = (const bf16_t*)(ws + WS_PRAW); float* invn = (float*)(ws + WS_INVN); const float* par = (const float*)(ws + WS_PAR);
    const int lane = threadIdx.x & 63, gw = gtid >> 6, ngw = gsize >> 6, c0 = lane * 8;
    f32x4 muk[2], kkc[2];
#pragma unroll
    for (int j = 0; j < 2; ++j) { muk[j] = *(const f32x4*)(par + PAR_MU + 512 + c0 + 4 * j); kkc[j] = *(const f32x4*)(par + PAR_KK + c0 + 4 * j); }
    for (int m = gw; m < T; m += ngw) { const bool first = (m & (SEQ - 1)) == 0; const size_t mp = first ? m : m - 1;
        f32x4 k[2], kp[2]; unpack8(*(const u32x4*)(praw + pr_off((size_t)((size_t)m), 512 + c0)), k[0], k[1]); unpack8(*(const u32x4*)(praw + pr_off((size_t)(mp), 512 + c0)), kp[0], kp[1]);
        float n2 = 0.f;
#pragma unroll
        for (int j = 0; j < 2; ++j) { if (first) kp[j] = (f32x4){0.f, 0.f, 0.f, 0.f}; const f32x4 q = (k[j] + (kp[j] - k[j]) * muk[j]) * kkc[j]; n2 += (q[0] * q[0] + q[1] * q[1]) + (q[2] * q[2] + q[3] * q[3]); }
        n2 += dpp_f<0xB1>(n2); n2 += dpp_f<0x4E>(n2); n2 += dpp_f<0x141>(n2);
        if ((lane & 7) == 0) invn[(size_t)m * 8 + (lane >> 3)] = 1.0f / fmaxf(sqrtf(n2), 1e-12f);
    }
}

constexpr int W4_AT = 0, W4_BT = 2304, W4_KT = 4608, W4_RT = 6912, W4_BTT = 9216, W4_KTT = 12288, W4_VT = 15360, W4_GL = 16128, W4_SLOT = 16384;
constexpr int W4_PO = 3 * W4_SLOT, W4_POSZ = 3072, W4_PT = 0, W4_PM = 768, W4_PG1 = 1536, W4_PG2 = 2304;
constexpr int W4_PS = W4_PO + 2 * W4_POSZ, W4_NR = 0, W4_PR = 768, W4_VB = 1536, W4_SS = W4_PS + 2304, W4_RB = 0, W4_SB = 768, W4_HB = 1536, W4_NBLK = SEQ / 16;
static_assert(W4_SS + W4_HB + 2304 <= 131072, "wkv4 LDS map");
DEV bf16x8 ld16(const LAS unsigned char* base, int tl, int lq) { const bf16x8 v = *(const LAS bf16x8*)(base + tl * 48 + (lq & 1) * 16); const bf16x8 z = {0, 0, 0, 0, 0, 0, 0, 0}; return (lq < 2) ? v : z; }
typedef __bf16 bf16x4n __attribute__((ext_vector_type(4)));
DEV u32x2 cvt4(f32x4 x) { return __builtin_bit_cast(u32x2, __builtin_convertvector(x, bf16x4n)); }
DEV void wr16(LAS unsigned char* base, f32x4 x, int tl, int lq) { *(LAS u32x2*)(base + tl * 48 + lq * 8) = cvt4(x); }
DEV f32x4 mm(const bf16x8 a, const bf16x8 b, const f32x4 c) { return __builtin_amdgcn_mfma_f32_16x16x32_bf16(a, b, c, 0, 0, 0); }
struct W4Load { u32x2 r0, r1, k0, k1, d, a, v0, v1; float inv; };
DEV void wk4_issue(W4Load& L, const bf16_t* praw, const bf16_t* dd, const bf16_t* aa, const float* invn, int b, int h, int qd, int bi, int s, int kq, int qq, int pw) {
    const int t = min(bi, W4_NBLK - 1) * 16 + s; const size_t m = (size_t)b * SEQ + t, mp = (t > 0) ? m - 1 : m; const int c = h * 64 + kq * 4;
    L.r1 = *(const u32x2*)(praw + pr_off((size_t)(m), c)); L.r0 = *(const u32x2*)(praw + pr_off((size_t)(mp), c)); L.k1 = *(const u32x2*)(praw + pr_off((size_t)(m), 512 + c)); L.k0 = *(const u32x2*)(praw + pr_off((size_t)(mp), 512 + c));
    L.d = *(const u32x2*)(dd + da_off(m, c)); L.a = *(const u32x2*)(aa + da_off(m, c)); L.inv = invn[m * 8 + h];
    { const int cv = 1024 + h * 64 + qd * 16 + qq * 4; L.v1 = *(const u32x2*)(praw + pr_off((size_t)(m), cv)); L.v0 = *(const u32x2*)(praw + pr_off((size_t)(mp), cv)); }
}
DEV void wk4_produce(const W4Load& L, LAS unsigned char* slot, int bi, int s, int kq, int qq, int pw, const f32x4 mur, const f32x4 muk, const f32x4 kkc, const f32x4 kac, const f32x4 muv) {
    const bool first = (bi == 0 && s == 0);
    f32x4 r0, r1, k0, k1, d, a; up4(L.r0, r0); up4(L.r1, r1); up4(L.k0, k0); up4(L.k1, k1); up4(L.d, d); up4(L.a, a);
    if (first) { r0 = (f32x4){0.f, 0.f, 0.f, 0.f}; k0 = r0; }
    const f32x4 rl = r1 + (r0 - r1) * mur, kl = k1 + (k0 - k1) * muk, kk = kl * kkc * L.inv;
    const f32x4 bh = kk * a, k2 = kl * (1.0f + (a - 1.0f) * kac), w = 1.0f - d;
    f32x4 g = w, gx, ig;
#pragma unroll
    for (int c = 0; c < 4; ++c) { float x = g[c]; x *= dpp_shr_id1<0x111>(x); x *= dpp_shr_id1<0x112>(x); x *= dpp_shr_id1<0x114>(x); x *= dpp_shr_id1<0x118>(x); g[c] = x; gx[c] = dpp_shr_id1<0x111>(x); ig[c] = 1.0f / x; }
    const f32x4 at = -(kk * gx), bt = bh * ig, kt = k2 * ig, rt = rl * g;
    LAS unsigned char* o = slot + s * 144 + kq * 8;
    *(LAS u32x2*)(o + W4_AT) = (u32x2){cvt_pk_bf16(at[0], at[1]), cvt_pk_bf16(at[2], at[3])}; *(LAS u32x2*)(o + W4_BT) = (u32x2){cvt_pk_bf16(bt[0], bt[1]), cvt_pk_bf16(bt[2], bt[3])};
    *(LAS u32x2*)(o + W4_KT) = (u32x2){cvt_pk_bf16(kt[0], kt[1]), cvt_pk_bf16(kt[2], kt[3])}; *(LAS u32x2*)(o + W4_RT) = (u32x2){cvt_pk_bf16(rt[0], rt[1]), cvt_pk_bf16(rt[2], rt[3])};
#pragma unroll
    for (int c = 0; c < 4; ++c) { *(LAS bf16_t*)(slot + W4_BTT + (4 * kq + c) * 48 + s * 2) = f2bf(bt[c]); *(LAS bf16_t*)(slot + W4_KTT + (4 * kq + c) * 48 + s * 2) = f2bf(kt[c]); }
    if (s == 15) *(LAS f32x4*)(slot + W4_GL + kq * 16) = g;
    if (pw == 0) { f32x4 v0, v1; up4(L.v0, v0); up4(L.v1, v1); if (first) v0 = (f32x4){0.f, 0.f, 0.f, 0.f}; const f32x4 vl = v1 + (v0 - v1) * muv;
#pragma unroll
        for (int c = 0; c < 4; ++c) *(LAS bf16_t*)(slot + W4_VT + (4 * qq + c) * 48 + s * 2) = f2bf(vl[c]); }
}
DEV bf16x8 fa(f32x4 x) { const u32x2 c = cvt4(x); const u32x4 w = (u32x4){c[0], c[1], 0u, 0u}; return __builtin_bit_cast(bf16x8, w); }
DEV bf16x8 ld16p(const LAS unsigned char* base, int tl, int lq) { const u32x2 v = *(const LAS u32x2*)(base + tl * 48 + lq * 8); const u32x4 w = (u32x4){v[0], v[1], 0u, 0u}; return __builtin_bit_cast(bf16x8, w); }
DEV bf16x8 ld64p(const LAS unsigned char* rowbase, int ks, int lq) { const u32x2 a = *(const LAS u32x2*)(rowbase + (32 * ks + 4 * lq) * 2), b = *(const LAS u32x2*)(rowbase + (32 * ks + 16 + 4 * lq) * 2); const u32x4 w = (u32x4){a[0], a[1], b[0], b[1]}; return __builtin_bit_cast(bf16x8, w); }
DEV void wk4_prep(const LAS unsigned char* slot, LAS unsigned char* po, int lane) {
    const int tl = lane & 15, lq = lane >> 4; const f32x4 z4 = (f32x4){0.f, 0.f, 0.f, 0.f};
    f32x4 aN = z4, aP = z4, aM = z4, aG1 = z4, aG2 = z4;
#pragma unroll
    for (int ks = 0; ks < 2; ++ks) { const int off = tl * 144 + (32 * ks + 8 * lq) * 2;
        const bf16x8 fA = *(const LAS bf16x8*)(slot + W4_AT + off), fB = *(const LAS bf16x8*)(slot + W4_BT + off), fK = *(const LAS bf16x8*)(slot + W4_KT + off), fR = *(const LAS bf16x8*)(slot + W4_RT + off);
        aN = mm(fA, fB, aN); aP = mm(fB, fA, aP); aM = mm(fK, fA, aM); aG1 = mm(fB, fR, aG1); aG2 = mm(fK, fR, aG2); }
    f32x4 aV;
#pragma unroll
    for (int i = 0; i < 4; ++i) { const int r = 4 * lq + i;
        aN[i] = (tl < r) ? aN[i] : 0.f;
        aP[i] = (r < tl) ? aP[i] : 0.f;
        aM[i] = (r < tl) ? aM[i] : 0.f;
        aG1[i] = (r <= tl) ? aG1[i] : 0.f; aG2[i] = (r <= tl) ? aG2[i] : 0.f;
        aV[i] = aP[i] + ((r == tl) ? 1.0f : 0.f); }
    wr16(po + W4_PM, aM, tl, lq); wr16(po + W4_PG1, aG1, tl, lq); wr16(po + W4_PG2, aG2, tl, lq);
#pragma unroll
    for (int lv = 1; lv <= 3; ++lv) {
        const bf16x8 fN = fa(aN), fP = fa(aP);
        aN = mm(fP, fN, z4);
        if (lv < 3) aP = mm(fN, fP, z4);
        aV = mm(fa(aN), fa(aV), aV);
    }
    wr16(po + W4_PT, aV, tl, lq);
    asm volatile("s_waitcnt lgkmcnt(0)" ::: "memory");
}
DEV void wk4_solve(const LAS unsigned char* slot, const LAS unsigned char* po, f32x4 (&H)[4], bf16_t* yrow, int lane) {
    const int tl = lane & 15, lq = lane >> 4; const f32x4 z4 = (f32x4){0.f, 0.f, 0.f, 0.f};
    bf16x8 fH[2], fA[2], fR[2];
#pragma unroll
    for (int ks = 0; ks < 2; ++ks) { fA[ks] = ld64p(slot + W4_AT + tl * 144, ks, lq); fR[ks] = ld64p(slot + W4_RT + tl * 144, ks, lq);
        const u32x2 c0 = cvt4(H[2 * ks]), c1 = cvt4(H[2 * ks + 1]); const u32x4 w = (u32x4){c0[0], c0[1], c1[0], c1[1]}; fH[ks] = __builtin_bit_cast(bf16x8, w); }
    const bf16x8 fM = ld16p(po + W4_PM, tl, lq), fT = ld16p(po + W4_PT, tl, lq), fG1 = ld16p(po + W4_PG1, tl, lq), fG2 = ld16p(po + W4_PG2, tl, lq), fV = ld16p(slot + W4_VT, tl, lq);
    f32x4 rhs = mm(fA[0], fH[0], z4); rhs = mm(fA[1], fH[1], rhs); rhs = mm(fM, fV, rhs);
    const f32x4 sa = mm(fT, fa(rhs), z4);
    const bf16x8 fS = fa(sa);
    f32x4 y = mm(fS, fG1, z4); y = mm(fV, fG2, y); y = mm(fH[0], fR[0], y); y = mm(fH[1], fR[1], y);
#pragma unroll
    for (int kt = 0; kt < 4; ++kt) { H[kt] = mm(ld16p(slot + W4_BTT + kt * 768, tl, lq), fS, H[kt]); H[kt] = mm(ld16p(slot + W4_KTT + kt * 768, tl, lq), fV, H[kt]);
        H[kt] = H[kt] * *(const LAS f32x4*)(slot + W4_GL + (16 * kt + 4 * lq) * 4); }
    *(u32x2*)(yrow + (size_t)tl * 512 + 4 * lq) = cvt4(y);
}
DEV void phase4_wkv4(unsigned char* ws, LAS float* lds, int wg, int nwg, const float* pu, const float* pv, const float* gn, const int abl) {
    const bf16_t* praw = (const bf16_t*)(ws + WS_PRAW); const bf16_t* dd = (const bf16_t*)(ws + WS_DD); const bf16_t* aa = (const bf16_t*)(ws + WS_AA); bf16_t* yr = (bf16_t*)(ws + WS_YR);
    const float* par = (const float*)(ws + WS_PAR); const float* invn = (const float*)(ws + WS_INVN); LAS unsigned char* lb = (LAS unsigned char*)lds;
    const int tid = threadIdx.x, wid = __builtin_amdgcn_readfirstlane(tid >> 6), lane = tid & 63; const int pw = wid & 3, qq = lane >> 4, s = lane & 15, kq = 4 * pw + qq;
    const bool producer = wid >= 4;
    for (int it = wg; it < 256; it += nwg) {
        const int bh = (it & 7) * 8 + ((it >> 3) >> 2), qd = (it >> 3) & 3, b = bh >> 3, h = bh & 7;
        bf16_t* ybase = yr + (size_t)b * SEQ * 512 + h * 64 + qd * 16;
        const int c = h * 64 + kq * 4;
        const f32x4 mur = *(const f32x4*)(par + PAR_MU + c), muk = *(const f32x4*)(par + PAR_MU + 512 + c), kkc = *(const f32x4*)(par + PAR_KK + c), kac = *(const f32x4*)(par + PAR_KA + c);
        const f32x4 muv = *(const f32x4*)(par + PAR_MU + 1024 + h * 64 + qd * 16 + qq * 4);
        W4Load La, Lb; f32x4 H[4];
#pragma unroll
        for (int kt = 0; kt < 4; ++kt) H[kt] = (f32x4){0.f, 0.f, 0.f, 0.f};
#if OPT_PEER == 2
        TabGrp tg0, tg1, tg2, tg3; const int p2 = tid & 127;
#endif
        if (producer) {
            wk4_issue(La, praw, dd, aa, invn, b, h, qd, 0, s, kq, qq, pw); wk4_issue(Lb, praw, dd, aa, invn, b, h, qd, 1, s, kq, qq, pw);
            wk4_produce(La, lb, 0, s, kq, qq, pw, mur, muk, kkc, kac, muv); wk4_issue(La, praw, dd, aa, invn, b, h, qd, 2, s, kq, qq, pw);
            __syncthreads();
            wk4_produce(Lb, lb + W4_SLOT, 1, s, kq, qq, pw, mur, muk, kkc, kac, muv); wk4_issue(Lb, praw, dd, aa, invn, b, h, qd, 3, s, kq, qq, pw);
            __syncthreads();
            int s0 = 0, s2 = 2;
            for (int bi = 0; bi < W4_NBLK; bi += 2) {
                if (!(abl & 4)) wk4_produce(La, lb + s2 * W4_SLOT, bi + 2, s, kq, qq, pw, mur, muk, kkc, kac, muv); if (!(abl & 8)) wk4_issue(La, praw, dd, aa, invn, b, h, qd, bi + 4, s, kq, qq, pw);
                __syncthreads();
                if (!(abl & 4)) wk4_produce(Lb, lb + s0 * W4_SLOT, bi + 3, s, kq, qq, pw, mur, muk, kkc, kac, muv); if (!(abl & 8)) wk4_issue(Lb, praw, dd, aa, invn, b, h, qd, bi + 5, s, kq, qq, pw);
                __syncthreads();
                const int s1 = 3 - s0 - s2, t0 = s0; s0 = s2; s2 = s1; (void)t0;
            }
        } else if (wid == 1) {
            __syncthreads();
            wk4_prep(lb, lb + W4_PO, lane);
            __syncthreads();
            int s1 = 1, s2 = 2;
            for (int bi = 0; bi < W4_NBLK; bi += 2) {
                if (!(abl & 2)) wk4_prep(lb + s1 * W4_SLOT, lb + W4_PO + W4_POSZ, lane);
                __syncthreads();
                if (!(abl & 2)) wk4_prep(lb + s2 * W4_SLOT, lb + W4_PO, lane);
                __syncthreads();
                const int s0 = 3 - s1 - s2; s2 = s1; s1 = s0;
            }
        } else if (wid == 0) {
            __syncthreads();
            __syncthreads();
            int s0 = 0, s1 = 1;
            for (int bi = 0; bi < W4_NBLK; bi += 2) {
                if (!(abl & 1)) wk4_solve(lb + s0 * W4_SLOT, lb + W4_PO, H, ybase + (size_t)bi * 16 * 512, lane);
                __syncthreads();
                if (!(abl & 1)) wk4_solve(lb + s1 * W4_SLOT, lb + W4_PO + W4_POSZ, H, ybase + (size_t)(bi + 1) * 16 * 512, lane);
                __syncthreads();
                const int s2 = 3 - s0 - s1; s1 = s0; s0 = s2;
            }
        } else {
#if OPT_PEER == 2
            { const int gi = (it * 128) * 128 + p2; tab_cvt_load(tg0, pu, pv, gi); tab_cvt_load(tg1, pu, pv, gi + 128); tab_cvt_load(tg2, pu, pv, gi + 256); tab_cvt_load(tg3, pu, pv, gi + 384); }
#endif
            __syncthreads();
            __syncthreads();
            for (int bi = 0; bi < W4_NBLK; bi += 2) {
#if OPT_PEER == 2
                if ((bi & 7) == 0 && !(abl & 16)) { const int gi = (it * 128 + (bi >> 1)) * 128 + p2;
                    tab_cvt_store(tg0, gn, ws, gi); tab_cvt_store(tg1, gn, ws, gi + 128); tab_cvt_store(tg2, gn, ws, gi + 256); tab_cvt_store(tg3, gn, ws, gi + 384);
                    if (bi + 8 < W4_NBLK) { tab_cvt_load(tg0, pu, pv, gi + 512); tab_cvt_load(tg1, pu, pv, gi + 640); tab_cvt_load(tg2, pu, pv, gi + 768); tab_cvt_load(tg3, pu, pv, gi + 896); } }
#endif
                __syncthreads();
                __syncthreads();
            }
        }
        __syncthreads();
    }
}

struct XcdBarrier; DEV void xcd_barrier(const XcdBarrier& b);
constexpr int W5_NBH = 128, W5_STEPS = W5_NBH + 8, W5_NCH = 256 / W5_NBH;
constexpr int R_FA = 0, R_FR = 2048, R_FBT = 4096, R_FKT = 6144, R_FM = 8192, R_FT = 8704, R_FG1 = 9216, R_FG2 = 9728, R_GL = 10240, R_FV = 10752, R_SIZE = 10752, W5_SLOT = 11264;
constexpr int P5_AT = 0, P5_BT = 2304, P5_KT = 4608, P5_RT = 6912, P5_BS = 9216, P5_KS = 11520, P5_VT = 13824, P5_GL = 16128, P5_SIZE = 16384;
typedef short bf16x4s __attribute__((ext_vector_type(4)));
DEV f32x4 mm16(const u32x2 a, const u32x2 b, const f32x4 c) { return __builtin_amdgcn_mfma_f32_16x16x16bf16_1k(__builtin_bit_cast(bf16x4s, a), __builtin_bit_cast(bf16x4s, b), c, 0, 0, 0); }
DEV f32x4 mm16p(const u32x2 a, const u32x2 b, const f32x4 c) { const u32x4 a4 = (u32x4){a[0], a[1], 0u, 0u}, b4 = (u32x4){b[0], b[1], 0u, 0u}; return __builtin_amdgcn_mfma_f32_16x16x32_bf16(__builtin_bit_cast(bf16x8, a4), __builtin_bit_cast(bf16x8, b4), c, 0, 0, 0); }
DEV f32x4 mm32(const u32x4 a, const u32x4 b, const f32x4 c) { return __builtin_amdgcn_mfma_f32_16x16x32_bf16(__builtin_bit_cast(bf16x8, a), __builtin_bit_cast(bf16x8, b), c, 0, 0, 0); }
struct W5Load { u32x4 r0, r1, k0, k1, d, a; };
constexpr int P5_CONST = 131072 + 1024;
DEV void wk5_issue(W5Load& L, const bf16_t* praw, const bf16_t* dd, const bf16_t* aa, const float* invn, int b, int h, int blk, int s, int g8) {
    const int t = blk * 16 + s; const size_t m = (size_t)b * SEQ + t, mp = (t > 0) ? m - 1 : m; const int c = h * 64 + g8 * 8;
    L.r1 = *(const u32x4*)(praw + pr_off((size_t)(m), c)); L.k1 = *(const u32x4*)(praw + pr_off((size_t)(m), 512 + c));
    if (s == 0) { L.r0 = *(const u32x4*)(praw + pr_off((size_t)(mp), c)); L.k0 = *(const u32x4*)(praw + pr_off((size_t)(mp), 512 + c)); }
    L.d = *(const u32x4*)(dd + da_off(m, c)); L.a = *(const u32x4*)(aa + da_off(m, c)); (void)invn;
}
struct W5Half { f32x4 g, at, bt, kt, rt; float bsum; };
DEV void wk5_math(W5Half& R, const u32x2 r0w, const u32x2 r1w, const u32x2 k0w, const u32x2 k1w, const u32x2 dw, const u32x2 aw, const float inv, const bool first, const LAS float* cst, const int kq) {
    const f32x4 mur = *(const LAS f32x4*)(cst + kq * 4), muk = *(const LAS f32x4*)(cst + 64 + kq * 4), kkc = *(const LAS f32x4*)(cst + 192 + kq * 4), kac = *(const LAS f32x4*)(cst + 256 + kq * 4);
    f32x4 r0, r1, k0, k1, d, a; up4(r0w, r0); up4(r1w, r1); up4(k0w, k0); up4(k1w, k1); up4(dw, d); up4(aw, a);
    if (first) { r0 = (f32x4){0.f, 0.f, 0.f, 0.f}; k0 = r0; }
    const f32x4 rl = r1 + (r0 - r1) * mur, kl = k1 + (k0 - k1) * muk, kk = kl * kkc * inv;
    const f32x4 bh = kk * a, k2 = kl * (1.0f + (a - 1.0f) * kac), w = 1.0f - d;
    { const f32x4 tb = rl * k2 * *(const LAS f32x4*)(cst + 320 + kq * 4); R.bsum = (tb[0] + tb[1]) + (tb[2] + tb[3]); }
    f32x4 g = w, gx, ig;
#pragma unroll
    for (int c = 0; c < 4; ++c) { float x = g[c]; x *= dpp_shr_id1<0x111>(x); x *= dpp_shr_id1<0x112>(x); x *= dpp_shr_id1<0x114>(x); x *= dpp_shr_id1<0x118>(x); g[c] = x; gx[c] = dpp_shr_id1<0x111>(x); ig[c] = __builtin_amdgcn_rcpf(x); }
    R.g = g; R.at = -(kk * gx); R.bt = bh * ig; R.kt = k2 * ig; R.rt = rl * g;
}
DEV float wk5_knorm2(const W5Load& L, const LAS float* cst, const bool first, const int g8) {
    float n2 = 0.f;
#pragma unroll
    for (int hf = 0; hf < 2; ++hf) { const int kq = 2 * g8 + hf;
        const f32x4 muk = *(const LAS f32x4*)(cst + 64 + kq * 4), kkc = *(const LAS f32x4*)(cst + 192 + kq * 4);
        u32x2 k0w, k1w = (u32x2){L.k1[2 * hf], L.k1[2 * hf + 1]};
        k0w[0] = (unsigned)__builtin_amdgcn_update_dpp((int)L.k0[2 * hf], (int)L.k1[2 * hf], 0x111, 0xf, 0xf, false); k0w[1] = (unsigned)__builtin_amdgcn_update_dpp((int)L.k0[2 * hf + 1], (int)L.k1[2 * hf + 1], 0x111, 0xf, 0xf, false);
        f32x4 k0, k1; up4(k0w, k0); up4(k1w, k1); if (first) k0 = (f32x4){0.f, 0.f, 0.f, 0.f};
        const f32x4 q = (k1 + (k0 - k1) * muk) * kkc; n2 += (q[0] * q[0] + q[1] * q[1]) + (q[2] * q[2] + q[3] * q[3]); }
    return n2;
}
DEV u32x4 pk8(const f32x4 lo, const f32x4 hi) { const u32x2 a = cvt4(lo), b = cvt4(hi); return (u32x4){a[0], a[1], b[0], b[1]}; }
DEV float wk5_produce(const W5Load& L, const float inv, LAS unsigned char* pl, const LAS float* cst, unsigned char* rec, int blk, int s, int g8) {
    const bool first = (blk == 0 && s == 0);
    W5Half A, B; u32x4 r0, k0;
#pragma unroll
    for (int i = 0; i < 4; ++i) { r0[i] = (unsigned)__builtin_amdgcn_update_dpp((int)L.r0[i], (int)L.r1[i], 0x111, 0xf, 0xf, false); k0[i] = (unsigned)__builtin_amdgcn_update_dpp((int)L.k0[i], (int)L.k1[i], 0x111, 0xf, 0xf, false); }
    wk5_math(A, (u32x2){r0[0], r0[1]}, (u32x2){L.r1[0], L.r1[1]}, (u32x2){k0[0], k0[1]}, (u32x2){L.k1[0], L.k1[1]}, (u32x2){L.d[0], L.d[1]}, (u32x2){L.a[0], L.a[1]}, inv, first, cst, 2 * g8);
    wk5_math(B, (u32x2){r0[2], r0[3]}, (u32x2){L.r1[2], L.r1[3]}, (u32x2){k0[2], k0[3]}, (u32x2){L.k1[2], L.k1[3]}, (u32x2){L.d[2], L.d[3]}, (u32x2){L.a[2], L.a[3]}, inv, first, cst, 2 * g8 + 1);
    if (s == 15) { *(LAS f32x4*)(pl + P5_GL + g8 * 32) = A.g; *(LAS f32x4*)(pl + P5_GL + g8 * 32 + 16) = B.g; *(f32x4*)(rec + R_GL + g8 * 32) = A.g; *(f32x4*)(rec + R_GL + g8 * 32 + 16) = B.g; }
    LAS unsigned char* o = pl + s * 144 + g8 * 16;
    *(LAS u32x4*)(o + P5_AT) = pk8(A.at, B.at); *(LAS u32x4*)(o + P5_BT) = pk8(A.bt, B.bt); *(LAS u32x4*)(o + P5_KT) = pk8(A.kt, B.kt); *(LAS u32x4*)(o + P5_RT) = pk8(A.rt, B.rt);
    asm volatile("" ::: "memory");
    const f32x4 gl0 = *(const LAS f32x4*)(pl + P5_GL + g8 * 32), gl1 = *(const LAS f32x4*)(pl + P5_GL + g8 * 32 + 16);
    *(LAS u32x4*)(o + P5_BS) = pk8(A.bt * gl0, B.bt * gl1); *(LAS u32x4*)(o + P5_KS) = pk8(A.kt * gl0, B.kt * gl1);
    float bs = A.bsum + B.bsum; bs += __shfl_xor(bs, 16); bs += __shfl_xor(bs, 32); return bs;
}
DEV u32x2 ld4t(const LAS unsigned char* tab, int lq, int col) {
    const LAS unsigned char* p = tab + (4 * lq) * 144 + col * 2;
    const unsigned x0 = *(const LAS unsigned short*)(p), x1 = *(const LAS unsigned short*)(p + 144), x2 = *(const LAS unsigned short*)(p + 288), x3 = *(const LAS unsigned short*)(p + 432);
    return (u32x2){x0 | (x1 << 16), x2 | (x3 << 16)};
}
DEV u32x4 ld64q(const LAS unsigned char* rowbase, int ks, int lq) { const u32x2 a = *(const LAS u32x2*)(rowbase + (32 * ks + 4 * lq) * 2), b = *(const LAS u32x2*)(rowbase + (32 * ks + 16 + 4 * lq) * 2); return (u32x4){a[0], a[1], b[0], b[1]}; }
DEV void wk5_emit(const LAS unsigned char* pl, unsigned char* rec, int lane) {
    const int tl = lane & 15, lq = lane >> 4; const f32x4 z4 = (f32x4){0.f, 0.f, 0.f, 0.f};
    f32x4 aN = z4, aP = z4, aM = z4, aG1 = z4, aG2 = z4;
#pragma unroll
    for (int ks = 0; ks < 2; ++ks) { const int off = tl * 144 + (32 * ks + 8 * lq) * 2;
        const bf16x8 fA = *(const LAS bf16x8*)(pl + P5_AT + off), fB = *(const LAS bf16x8*)(pl + P5_BT + off), fK = *(const LAS bf16x8*)(pl + P5_KT + off), fR = *(const LAS bf16x8*)(pl + P5_RT + off);
        aN = mm(fA, fB, aN); aP = mm(fB, fA, aP); aM = mm(fK, fA, aM); aG1 = mm(fB, fR, aG1); aG2 = mm(fK, fR, aG2); }
    f32x4 aV;
#pragma unroll
    for (int i = 0; i < 4; ++i) { const int r = 4 * lq + i;
        aN[i] = (tl < r) ? aN[i] : 0.f;
        aP[i] = (r < tl) ? aP[i] : 0.f;
        aM[i] = (r < tl) ? aM[i] : 0.f;
        aG1[i] = (r <= tl) ? aG1[i] : 0.f; aG2[i] = (r <= tl) ? aG2[i] : 0.f;
        aV[i] = aP[i] + ((r == tl) ? 1.0f : 0.f); }
#pragma unroll
    for (int lv = 1; lv <= 3; ++lv) {
        const u32x2 fN = cvt4(aN), fP = cvt4(aP);
        aN = mm16p(fP, fN, z4);
        if (lv < 3) aP = mm16p(fN, fP, z4);
        aV = mm16p(cvt4(aN), cvt4(aV), aV);
    }
    const u32x2 fM = cvt4(aM), fT = cvt4(aV), fG1 = cvt4(aG1), fG2 = cvt4(aG2);
    const unsigned one = 0x3F80u, jsel = (unsigned)(tl & 7), lsel = (unsigned)(tl >> 3);
    u32x4 slo, shi;
#pragma unroll
    for (int p = 0; p < 4; ++p) { const unsigned e0 = (jsel == 2u * p) ? one : 0u, e1 = (jsel == 2u * p + 1u) ? (one << 16) : 0u; slo[p] = ((unsigned)lq == lsel) ? (e0 | e1) : 0u; shi[p] = ((unsigned)lq == lsel + 2u) ? (e0 | e1) : 0u; }
    u32x2 fb[4], fk[4];
#pragma unroll
    for (int ks = 0; ks < 2; ++ks) { const u32x4 xb = *(const LAS u32x4*)(pl + P5_BS + tl * 144 + (32 * ks + 8 * lq) * 2), xk = *(const LAS u32x4*)(pl + P5_KS + tl * 144 + (32 * ks + 8 * lq) * 2);
        fb[2 * ks] = cvt4(mm32(xb, slo, z4)); fb[2 * ks + 1] = cvt4(mm32(xb, shi, z4)); fk[2 * ks] = cvt4(mm32(xk, slo, z4)); fk[2 * ks + 1] = cvt4(mm32(xk, shi, z4)); }
    unsigned char* o = rec + lane * 16;
    *(u32x4*)(o) = ld64q(pl + P5_AT + tl * 144, 0, lq); *(u32x4*)(o + 1024) = ld64q(pl + P5_AT + tl * 144, 1, lq);
    *(u32x4*)(o + 2048) = ld64q(pl + P5_RT + tl * 144, 0, lq); *(u32x4*)(o + 3072) = ld64q(pl + P5_RT + tl * 144, 1, lq);
    *(u32x4*)(o + 4096) = (u32x4){fb[0][0], fb[0][1], fb[1][0], fb[1][1]}; *(u32x4*)(o + 5120) = (u32x4){fb[2][0], fb[2][1], fb[3][0], fb[3][1]};
    *(u32x4*)(o + 6144) = (u32x4){fk[0][0], fk[0][1], fk[1][0], fk[1][1]}; *(u32x4*)(o + 7168) = (u32x4){fk[2][0], fk[2][1], fk[3][0], fk[3][1]};
    *(u32x4*)(o + 8192) = (u32x4){fM[0], fM[1], fT[0], fT[1]}; *(u32x4*)(o + 9216) = (u32x4){fG1[0], fG1[1], fG2[0], fG2[1]};
}
struct W5Ops { u32x4 fA0, fA1; };
DEV void wk5_ld(W5Ops& P, const LAS unsigned char* slot, int lane) { P.fA0 = *(const LAS u32x4*)(slot + R_FA + lane * 16); P.fA1 = *(const LAS u32x4*)(slot + R_FA + 1024 + lane * 16); }
DEV void mm16_guard(f32x4& x) { asm volatile("s_nop 15\n\ts_nop 3" : "+v"(x)); }
DEV void wk5_block(const W5Ops& P, const LAS unsigned char* slot, f32x4 (&H)[4], bf16_t* yrow, int lane) {
    const int tl = lane & 15, lq = lane >> 4; const f32x4 z4 = (f32x4){0.f, 0.f, 0.f, 0.f};
    const u32x2 c0 = cvt4(H[0]), c1 = cvt4(H[1]), c2 = cvt4(H[2]), c3 = cvt4(H[3]);
    const u32x4 fH0 = (u32x4){c0[0], c0[1], c1[0], c1[1]}, fH1 = (u32x4){c2[0], c2[1], c3[0], c3[1]};
    const LAS unsigned char* sl = slot + lane * 16;
    const u32x2 fV = *(const LAS u32x2*)(slot + R_FV + lane * 8);
    const u32x4 mt = *(const LAS u32x4*)(sl + 8192);
    f32x4 rhs = mm32(P.fA0, fH0, z4); rhs = mm32(P.fA1, fH1, rhs); rhs = mm16p((u32x2){mt[0], mt[1]}, fV, rhs);
    const u32x4 k01 = *(const LAS u32x4*)(sl + 6144), k23 = *(const LAS u32x4*)(sl + 7168);
    H[0] = mm16p((u32x2){k01[0], k01[1]}, fV, H[0] * *(const LAS f32x4*)(slot + R_GL + (4 * lq) * 4));
    H[1] = mm16p((u32x2){k01[2], k01[3]}, fV, H[1] * *(const LAS f32x4*)(slot + R_GL + (16 + 4 * lq) * 4));
    H[2] = mm16p((u32x2){k23[0], k23[1]}, fV, H[2] * *(const LAS f32x4*)(slot + R_GL + (32 + 4 * lq) * 4));
    H[3] = mm16p((u32x2){k23[2], k23[3]}, fV, H[3] * *(const LAS f32x4*)(slot + R_GL + (48 + 4 * lq) * 4));
    const u32x4 g12 = *(const LAS u32x4*)(sl + 9216);
    f32x4 y = mm32(fH0, *(const LAS u32x4*)(sl + 2048), z4); y = mm32(fH1, *(const LAS u32x4*)(sl + 3072), y);
    y = mm16p(fV, (u32x2){g12[2], g12[3]}, y);
    const f32x4 sa = mm16p((u32x2){mt[2], mt[3]}, cvt4(rhs), z4);
    const u32x2 fS = cvt4(sa);
    const u32x4 b01 = *(const LAS u32x4*)(sl + 4096), b23 = *(const LAS u32x4*)(sl + 5120);
    H[0] = mm16p((u32x2){b01[0], b01[1]}, fS, H[0]); H[1] = mm16p((u32x2){b01[2], b01[3]}, fS, H[1]); H[2] = mm16p((u32x2){b23[0], b23[1]}, fS, H[2]); H[3] = mm16p((u32x2){b23[2], b23[3]}, fS, H[3]);
    y = mm16p(fS, (u32x2){g12[0], g12[1]}, y);
    *(u32x2*)(yrow + (size_t)tl * 512 + 4 * lq) = cvt4(y);
}
struct W5Rec { u32x4 c0, c1, c2, c3, c4, c5, c6, c7, c8, c9, c10; };
DEV void wk5_rissue(W5Rec& L, const unsigned char* rec0, int B, int lane, int off10) {
    const unsigned char* r = rec0 + (size_t)min(B, W5_NBH - 1) * R_SIZE + lane * 16;
    L.c0 = *(const u32x4*)(r); L.c1 = *(const u32x4*)(r + 1024); L.c2 = *(const u32x4*)(r + 2048); L.c3 = *(const u32x4*)(r + 3072); L.c4 = *(const u32x4*)(r + 4096); L.c5 = *(const u32x4*)(r + 5120);
    L.c6 = *(const u32x4*)(r + 6144); L.c7 = *(const u32x4*)(r + 7168); L.c8 = *(const u32x4*)(r + 8192); L.c9 = *(const u32x4*)(r + 9216); L.c10 = *(const u32x4*)(r + off10);
}
DEV void wk5_rwrite(const W5Rec& L, LAS unsigned char* slot, int lane) {
    LAS unsigned char* o = slot + lane * 16;
    *(LAS u32x4*)(o) = L.c0; *(LAS u32x4*)(o + 1024) = L.c1; *(LAS u32x4*)(o + 2048) = L.c2; *(LAS u32x4*)(o + 3072) = L.c3; *(LAS u32x4*)(o + 4096) = L.c4; *(LAS u32x4*)(o + 5120) = L.c5;
    *(LAS u32x4*)(o + 6144) = L.c6; *(LAS u32x4*)(o + 7168) = L.c7; *(LAS u32x4*)(o + 8192) = L.c8; *(LAS u32x4*)(o + 9216) = L.c9; *(LAS u32x4*)(o + 10240) = L.c10;
}
DEV void phase5_post_b(unsigned char* ws, int gw, int ngw, int t_lo, int t_hi);
constexpr int W6_LOADER = 1;
constexpr int W6_NBH = 64, W6_NCH = 256 / W6_NBH, W6_UNITS = 8 * (W6_NBH / 32), W6_HTAB = 4 * W5_SLOT, W6_CONST = W6_HTAB + 6 * P5_SIZE, W6_FLAGS = W6_CONST + 1536;
static_assert(W6_FLAGS + 32 <= LDSCTL_OFF, "wkv6 LDS map overruns the barrier words");
constexpr size_t W6_BUF = (size_t)64 * W6_NBH * R_SIZE;
constexpr int W6_TPOST = (W6_NCH - 1) * W6_NBH * 16;
DEV void w6_wait_ge(const volatile LAS unsigned* p, int need) { while ((int)*p < need) __builtin_amdgcn_s_sleep(1); asm volatile("" ::: "memory"); }
template <bool TAB> DEV void wk6_units(unsigned char* ws, unsigned char* rbuf, LAS unsigned char* pl, const LAS float* cst, int wg, int c, int q0, int qstep, int lane, const float* pu, const float* pv, const float* gn, int tabbase) {
    const bf16_t* praw = (const bf16_t*)(ws + WS_PRAW); const bf16_t* dd = (const bf16_t*)(ws + WS_DD); const bf16_t* aa = (const bf16_t*)(ws + WS_AA); const float* invn = (const float*)(ws + WS_INVN);
    const int qq = lane >> 4, s = lane & 15, b = wg & 7, lwb = (wg >> 3) * 8, h = lwb >> 5;
    unsigned char* rec0 = rbuf + (size_t)(b * 8 + h) * W6_NBH * R_SIZE;
    int bl = ((lwb + (q0 & 7)) & 31) + 32 * (q0 >> 3);
    W5Load La, Lb;
    wk5_issue(La, praw, dd, aa, invn, b, h, c * W6_NBH + bl, s, qq); wk5_issue(Lb, praw, dd, aa, invn, b, h, c * W6_NBH + bl, s, 4 + qq);
    for (int q = q0; q < W6_UNITS; q += qstep) {
        const int qn = min(q + qstep, W6_UNITS - 1), bn = ((lwb + (qn & 7)) & 31) + 32 * (qn >> 3);
        const int blk = c * W6_NBH + bl, bln = c * W6_NBH + bn;
        unsigned char* rec = rec0 + (size_t)bl * R_SIZE;
        TabGrp tg0, tg1; const int ti = tabbase + q * 256 + lane;
        if (TAB) { tab_cvt_load(tg0, pu, pv, ti); tab_cvt_load(tg1, pu, pv, ti + 64); }
        float n2 = wk5_knorm2(La, cst, blk == 0 && s == 0, qq) + wk5_knorm2(Lb, cst, blk == 0 && s == 0, 4 + qq); n2 += __shfl_xor(n2, 16); n2 += __shfl_xor(n2, 32);
        const float inv = 1.0f / fmaxf(sqrtf(n2), 1e-12f);
        float bonus = wk5_produce(La, inv, pl, cst, rec, blk, s, qq);     wk5_issue(La, praw, dd, aa, invn, b, h, bln, s, qq);
        if (TAB) { tab_cvt_store(tg0, gn, ws, ti); tab_cvt_store(tg1, gn, ws, ti + 64); tab_cvt_load(tg0, pu, pv, ti + 128); tab_cvt_load(tg1, pu, pv, ti + 192); }
        bonus += wk5_produce(Lb, inv, pl, cst, rec, blk, s, 4 + qq); wk5_issue(Lb, praw, dd, aa, invn, b, h, bln, s, 4 + qq);
        if (qq == 0) ((float*)(ws + WS_BONUS))[((size_t)b * SEQ + blk * 16 + s) * 8 + h] = bonus;
        asm volatile("s_waitcnt lgkmcnt(0)" ::: "memory");
        wk5_emit(pl, rec, lane);
        asm volatile("s_waitcnt lgkmcnt(0)" ::: "memory");
        if (TAB) { tab_cvt_store(tg0, gn, ws, ti + 128); tab_cvt_store(tg1, gn, ws, ti + 192); }
        bl = bn;
    }
}
DEV void wk6_rissue(W5Rec& L, const unsigned char* rec0, int B, int lane, int off10) {
    const unsigned char* r = rec0 + (size_t)min(B, W6_NBH - 1) * R_SIZE + lane * 16;
    L.c0 = *(const u32x4*)(r); L.c1 = *(const u32x4*)(r + 1024); L.c2 = *(const u32x4*)(r + 2048); L.c3 = *(const u32x4*)(r + 3072); L.c4 = *(const u32x4*)(r + 4096); L.c5 = *(const u32x4*)(r + 5120);
    L.c6 = *(const u32x4*)(r + 6144); L.c7 = *(const u32x4*)(r + 7168); L.c8 = *(const u32x4*)(r + 8192); L.c9 = *(const u32x4*)(r + 9216); L.c10 = *(const u32x4*)(r + off10);
}
struct W6V { unsigned p, a, b, c, d; };
DEV void wk6_vissue(W6V& V, const bf16_t* vcol, int gB, int lq) {
    const int t0 = gB * 16 + 4 * lq; const bf16_t* q = vcol + (size_t)t0 * PRV;
    V.p = q[(t0 > 0) ? -PRV : 0]; V.a = q[0]; V.b = q[PRV]; V.c = q[2 * PRV]; V.d = q[3 * PRV];
}
DEV void wk6_hand(const W5Rec& L, const W6V& V, float muv, LAS unsigned char* lb, const volatile LAS unsigned* fl, int slot, int gB, int lane) {
    const int lq = lane >> 4;
    const float vp = (gB == 0 && lq == 0) ? 0.f : __uint_as_float(V.p << 16), va = __uint_as_float(V.a << 16), vb = __uint_as_float(V.b << 16), vc = __uint_as_float(V.c << 16), vd = __uint_as_float(V.d << 16);
    const f32x4 vl = (f32x4){va + (vp - va) * muv, vb + (va - vb) * muv, vc + (vb - vc) * muv, vd + (vc - vd) * muv};
    w6_wait_ge(fl + 4, gB - 3);
    wk5_rwrite(L, lb + slot * W5_SLOT, lane); *(LAS u32x2*)(lb + slot * W5_SLOT + R_FV + lane * 8) = cvt4(vl);
    asm volatile("s_waitcnt lgkmcnt(0)" ::: "memory"); *(volatile LAS unsigned*)(fl + slot) = (unsigned)(gB + 1);
}
DEV void phase4_wkv6(unsigned char* ws, unsigned char* recbase, LAS float* lds, const int wg_in, const float* pu, const float* pv, const float* gn, const XcdBarrier& bar) {
    bf16_t* yr = (bf16_t*)(ws + WS_YR); LAS unsigned char* lb = (LAS unsigned char*)lds; const float* par = (const float*)(ws + WS_PAR);
    const int tid = threadIdx.x, wid = __builtin_amdgcn_readfirstlane(tid >> 6), lane_in = tid & 63;
    asm volatile("s_waitcnt vmcnt(0)" ::: "memory");
    __syncthreads();
    { const int h = ((wg_in >> 3) * 8) >> 5;
      if (tid < 384) { const int v = tid >> 6, c = tid & 63; ((LAS float*)(lb + W6_CONST))[tid] = par[(v < 3 ? PAR_MU + 512 * v : (v == 3 ? PAR_KK : (v == 4 ? PAR_KA : PAR_RK))) + h * 64 + c]; }
      if (tid < 8) *(volatile LAS unsigned*)(lb + W6_FLAGS + tid * 4) = 0u; }
    __syncthreads();
    const LAS float* cst = (const LAS float*)(lb + W6_CONST);
    wk6_units<false>(ws, recbase, lb + wid * P5_SIZE, cst, wg_in, 0, wid, 8, lane_in, pu, pv, gn, 0);
    f32x4 H[4];
#pragma unroll
    for (int kt = 0; kt < 4; ++kt) H[kt] = (f32x4){0.f, 0.f, 0.f, 0.f};
    for (int c = 0; c < W6_NCH; ++c) {
        xcd_barrier(bar);
        int lane = lane_in, wg = wg_in; asm volatile("" : "+v"(lane), "+s"(wg));
        const int it = wg, bh = (it & 7) * 8 + ((it >> 3) >> 2), qd = (it >> 3) & 3, b = bh >> 3, h = bh & 7;
        const unsigned char* rec0 = recbase + (size_t)(c & 1) * W6_BUF + (size_t)bh * W6_NBH * R_SIZE;
        const volatile LAS unsigned* fl = (const volatile LAS unsigned*)(lb + W6_FLAGS);
        const int g0 = c * W6_NBH;
        if (wid == W6_LOADER) {
            const int o10 = (lane < 32) ? 10240 : 10240 - 512;
            const int tl = lane & 15, lq = lane >> 4;
            const bf16_t* vcol = (const bf16_t*)(ws + WS_PRAW) + pr_off((size_t)b * SEQ, 1024 + h * 64 + qd * 16 + tl);
            const float muv = par[PAR_MU + 1024 + h * 64 + qd * 16 + tl];
            W5Rec La, Lb, Lc, Ld; W6V Va, Vb, Vc, Vd;
            wk6_rissue(La, rec0, 0, lane, o10); wk6_vissue(Va, vcol, g0, lq); wk6_rissue(Lb, rec0, 1, lane, o10); wk6_vissue(Vb, vcol, g0 + 1, lq);
            wk6_rissue(Lc, rec0, 2, lane, o10); wk6_vissue(Vc, vcol, g0 + 2, lq); wk6_rissue(Ld, rec0, 3, lane, o10); wk6_vissue(Vd, vcol, g0 + 3, lq);
            for (int B = 0; B < W6_NBH; B += 4) {
                wk6_hand(La, Va, muv, lb, fl, 0, g0 + B, lane);     wk6_rissue(La, rec0, B + 4, lane, o10); wk6_vissue(Va, vcol, g0 + min(B + 4, W6_NBH - 1), lq);
                wk6_hand(Lb, Vb, muv, lb, fl, 1, g0 + B + 1, lane); wk6_rissue(Lb, rec0, B + 5, lane, o10); wk6_vissue(Vb, vcol, g0 + min(B + 5, W6_NBH - 1), lq);
                wk6_hand(Lc, Vc, muv, lb, fl, 2, g0 + B + 2, lane); wk6_rissue(Lc, rec0, B + 6, lane, o10); wk6_vissue(Vc, vcol, g0 + min(B + 6, W6_NBH - 1), lq);
                wk6_hand(Ld, Vd, muv, lb, fl, 3, g0 + B + 3, lane); wk6_rissue(Ld, rec0, B + 7, lane, o10); wk6_vissue(Vd, vcol, g0 + min(B + 7, W6_NBH - 1), lq);
            }
        } else if (wid == 0) {
            W5Ops P0, P1; bf16_t* yh = yr + (size_t)b * SEQ * 512 + h * 64 + qd * 16 + (size_t)g0 * 16 * 512;
            volatile LAS unsigned* done = (volatile LAS unsigned*)(lb + W6_FLAGS + 16);
            w6_wait_ge(fl, g0 + 1); wk5_ld(P0, lb, lane);
            for (int B = 0; B < W6_NBH; B += 2) {
                w6_wait_ge(fl + ((B + 1) & 3), g0 + B + 2); wk5_ld(P1, lb + ((B + 1) & 3) * W5_SLOT, lane);
                wk5_block(P0, lb + (B & 3) * W5_SLOT, H, yh + (size_t)B * 16 * 512, lane);
                asm volatile("s_waitcnt lgkmcnt(0)" ::: "memory"); *done = (unsigned)(g0 + B + 1);
                if (B + 2 < W6_NBH) { w6_wait_ge(fl + ((B + 2) & 3), g0 + B + 3); wk5_ld(P0, lb + ((B + 2) & 3) * W5_SLOT, lane); }
                wk5_block(P1, lb + ((B + 1) & 3) * W5_SLOT, H, yh + (size_t)(B + 1) * 16 * 512, lane);
                asm volatile("s_waitcnt lgkmcnt(0)" ::: "memory"); *done = (unsigned)(g0 + B + 2);
            }
        } else {
            const int hw = (wid < W6_LOADER) ? wid - 1 : wid - 2;
            if (c + 1 < W6_NCH) wk6_units<false>(ws, recbase + (size_t)((c + 1) & 1) * W6_BUF, lb + W6_HTAB + hw * P5_SIZE, cst, wg, c + 1, hw, 6, lane, pu, pv, gn, 0);
            else { unsigned char* ws2 = ws; asm volatile("" : "+s"(ws2)); phase5_post_b(ws2, wg * 6 + hw, 256 * 6, 0, W6_TPOST); }
        }
    }
    __syncthreads();
}

DEV void phase5_post(unsigned char* ws, int gtid, int gsize) {
    const bf16_t* praw = (const bf16_t*)(ws + WS_PRAW); const bf16_t* aa = (const bf16_t*)(ws + WS_AA); const bf16_t* gr = (const bf16_t*)(ws + WS_GR); const bf16_t* yr = (const bf16_t*)(ws + WS_YR); bf16_t* yo = (bf16_t*)(ws + WS_YO);
    const float* par = (const float*)(ws + WS_PAR); const float* mu = par + PAR_MU; const int lane = threadIdx.x & 63, gw = gtid >> 6, ngw = gsize >> 6;
    for (int i = gw; i < T * 8; i += ngw) { const int m = i >> 3, h = i & 7, c = h * 64 + lane;
        const float y = bf2f(yr[(size_t)m * 512 + c]); const float mean = wave_sum(y) * (1.0f / 64.0f); const float dy = y - mean; const float var = wave_sum(dy * dy) * (1.0f / 64.0f);
        const float yn = dy * rsqrtf(var + 64e-5f) * par[PAR_LNW + c] + par[PAR_LNB + c];
        const float rl = lerp_prev(praw, m, c, mu[c]), kl = lerp_prev(praw, m, 512 + c, mu[512 + c]), vl = lerp_prev(praw, m, 1024 + c, mu[1024 + c]);
        const float av = bf2f(aa[da_off((size_t)m, c)]); const float k2 = kl * (1.0f + (av - 1.0f) * par[PAR_KA + c]);
        const float bonus = wave_sum(rl * k2 * par[PAR_RK + c]) * vl;
        yo[(size_t)m * 512 + c] = f2bf((yn + bonus) * bf2f(gr[(size_t)m * 512 + c]));
    }
}

DEV void phase8_tables(const float* pu, const float* pv, const float* gn, unsigned char* ws, int gtid, int gsize) {
#if TAB_FP8 && OPT_PEER
    unsigned* u8 = (unsigned*)(ws + WS_U16); unsigned* v8 = (unsigned*)(ws + WS_V16);
    for (int i = gtid; i < 16384 * 1024 / 4; i += gsize) { const f32x4 u = ((const f32x4*)pu)[i], v = ((const f32x4*)pv)[i]; const f32x4 g = ((const f32x4*)gn)[i & 255];
        int pu_ = 0, pv_ = 0;
#if OPT_PEER == 2
        pu_ = (int)q8x4(u[0] * g[0] * U8_SCALE, u[1] * g[1] * U8_SCALE, u[2] * g[2] * U8_SCALE, u[3] * g[3] * U8_SCALE);
#else
        pu_ = __builtin_amdgcn_cvt_pk_fp8_f32(u[0] * g[0] * 256.0f, u[1] * g[1] * 256.0f, pu_, false); pu_ = __builtin_amdgcn_cvt_pk_fp8_f32(u[2] * g[2] * 256.0f, u[3] * g[3] * 256.0f, pu_, true);
#endif
        pv_ = __builtin_amdgcn_cvt_pk_fp8_f32(v[0] * 16.0f, v[1] * 16.0f, pv_, false); pv_ = __builtin_amdgcn_cvt_pk_fp8_f32(v[2] * 16.0f, v[3] * 16.0f, pv_, true);
#if OPT_PEER == 2
        { const size_t o = ((size_t)((i & 255) >> 5) * 16384 + (i >> 8)) * 32 + (i & 31); u8[o] = (unsigned)pu_; v8[o] = (unsigned)pv_; }
    }
#else
        u8[i] = (unsigned)pu_; v8[i] = (unsigned)pv_; }
#endif
#else
    bf16_t* u16 = (bf16_t*)(ws + WS_U16); bf16_t* v16 = (bf16_t*)(ws + WS_V16);
    for (int i = gtid; i < 16384 * 1024 / 4; i += gsize) { const f32x4 u = ((const f32x4*)pu)[i], v = ((const f32x4*)pv)[i]; const f32x4 g = ((const f32x4*)gn)[i & 255];
        u32x2 o; o[0] = (unsigned)f2bf(u[0] * g[0]) | ((unsigned)f2bf(u[1] * g[1]) << 16); o[1] = (unsigned)f2bf(u[2] * g[2]) | ((unsigned)f2bf(u[3] * g[3]) << 16); ((u32x2*)u16)[i] = o;
        u32x2 p; p[0] = (unsigned)f2bf(v[0]) | ((unsigned)f2bf(v[1]) << 16); p[1] = (unsigned)f2bf(v[2]) | ((unsigned)f2bf(v[3]) << 16); ((u32x2*)v16)[i] = p; }
#endif
}

DEV void wave_argmax(float& v, int& idx) {
#pragma unroll
    for (int o = 1; o < 64; o <<= 1) { const float ov = __shfl_xor(v, o); const int oi = __shfl_xor(idx, o); if (ov > v || (ov == v && oi < idx)) { v = ov; idx = oi; } }
}

DEV void phase9_topk(unsigned char* ws, float* lds, int gtid, int gsize) {
    const bf16_t* q = (const bf16_t*)(ws + WS_Q); const bf16_t* sk = (const bf16_t*)(ws + WS_SK); int* ids = (int*)(ws + WS_IDS); float* gwt = (float*)(ws + WS_GW);
    const int lane = threadIdx.x & 63, wv = threadIdx.x >> 6, gw = gtid >> 6, ngw = gsize >> 6;
    float* svl = lds + wv * 64; int* sil = (int*)(lds + 512) + wv * 64;
    for (int i = gw; i < T * 8; i += ngw) { const int m = i >> 3, hh = i & 7;
        float sc[2][2];
#pragma unroll
        for (int c = 0; c < 2; ++c)
#pragma unroll
            for (int w2 = 0; w2 < 2; ++w2) { const int n = lane + 64 * w2; const bf16_t* qp = q + (size_t)m * DM + hh * 128 + c * 64; const bf16_t* kp = sk + ((size_t)(hh * 2 + c) * 128 + n) * 64; float s = 0.f;
                for (int d = 0; d < 64; ++d) s += bf2f(qp[d]) * bf2f(kp[d]);
                sc[c][w2] = s; }
#pragma unroll
        for (int c = 0; c < 2; ++c) { float c0 = sc[c][0], c1 = sc[c][1];
            for (int r = 0; r < 16; ++r) { float bv; int bi; if (c0 >= c1) { bv = c0; bi = lane; } else { bv = c1; bi = lane + 64; }
                wave_argmax(bv, bi);
                if (bi == lane) c0 = -INFINITY; if (bi == lane + 64) c1 = -INFINITY;
                if (lane == 0) { svl[c * 16 + r] = bv; sil[c * 16 + r] = bi; } } }
        __builtin_amdgcn_wave_barrier(); asm volatile("s_waitcnt lgkmcnt(0)" ::: "memory");
        float cd[4];
#pragma unroll
        for (int w4 = 0; w4 < 4; ++w4) { const int ci = lane + 64 * w4; cd[w4] = svl[ci >> 4] + svl[16 + (ci & 15)]; }
        float myv = 0.f; int mye = 0;
        for (int r = 0; r < 16; ++r) { float bv = cd[0]; int bi = lane;
#pragma unroll
            for (int w4 = 1; w4 < 4; ++w4) if (cd[w4] > bv) { bv = cd[w4]; bi = lane + 64 * w4; }
            wave_argmax(bv, bi);
#pragma unroll
            for (int w4 = 0; w4 < 4; ++w4) if (bi == lane + 64 * w4) cd[w4] = -INFINITY;
            if (lane == r) { myv = bv; mye = sil[bi >> 4] * 128 + sil[16 + (bi & 15)]; } }
        float mx = (lane < 16) ? myv : -INFINITY;
#pragma unroll
        for (int o = 1; o < 16; o <<= 1) mx = fmaxf(mx, __shfl_xor(mx, o));
        float ex = (lane < 16) ? __expf(myv - mx) : 0.f; float sm = ex;
#pragma unroll
        for (int o = 1; o < 16; o <<= 1) sm += __shfl_xor(sm, o);
        if (lane < 16) { ids[(size_t)m * 128 + hh * 16 + lane] = mye; gwt[(size_t)m * 128 + hh * 16 + lane] = ex / sm; }
        __builtin_amdgcn_wave_barrier(); asm volatile("s_waitcnt lgkmcnt(0)" ::: "memory");
    }
}

DEV void phase10_peer(float* out, unsigned char* ws, int gtid, int gsize) {
    const bf16_t* h1b = (const bf16_t*)(ws + WS_H1B); const bf16_t* u16 = (const bf16_t*)(ws + WS_U16); const bf16_t* v16 = (const bf16_t*)(ws + WS_V16);
    const int* ids = (const int*)(ws + WS_IDS); const float* gwt = (const float*)(ws + WS_GW); const float* rss = (const float*)(ws + WS_RSS); const float* nf = (const float*)(ws + WS_PAR) + PAR_NF;
    const int lane = threadIdx.x & 63, gw = gtid >> 6, ngw = gsize >> 6, d0 = lane * 16;
    for (int m = gw; m < T; m += ngw) {
        float hb[16], acc[16];
        { const u32x4 x0 = *(const u32x4*)(h1b + (size_t)m * DM + d0), x1 = *(const u32x4*)(h1b + (size_t)m * DM + d0 + 8);
#pragma unroll
          for (int j = 0; j < 4; ++j) { hb[2 * j] = __uint_as_float(x0[j] << 16); hb[2 * j + 1] = __uint_as_float(x0[j] & 0xffff0000u); hb[8 + 2 * j] = __uint_as_float(x1[j] << 16); hb[8 + 2 * j + 1] = __uint_as_float(x1[j] & 0xffff0000u); } }
#pragma unroll
        for (int j = 0; j < 16; ++j) acc[j] = 0.f;
        const float rstd = rsqrtf(rss[m] * (1.0f / DM) + EPS);
        for (int i = 0; i < 128; ++i) { const int e = ids[(size_t)m * 128 + i]; const float gt = gwt[(size_t)m * 128 + i];
            const u32x4 u0 = *(const u32x4*)(u16 + (size_t)e * DM + d0), u1 = *(const u32x4*)(u16 + (size_t)e * DM + d0 + 8);
            float s = 0.f;
#pragma unroll
            for (int j = 0; j < 4; ++j) { s += hb[2 * j] * __uint_as_float(u0[j] << 16) + hb[2 * j + 1] * __uint_as_float(u0[j] & 0xffff0000u) + hb[8 + 2 * j] * __uint_as_float(u1[j] << 16) + hb[8 + 2 * j + 1] * __uint_as_float(u1[j] & 0xffff0000u); }
            const float hid = wave_sum(s) * rstd; const float w = gt * gelu_tanh(hid);
            const u32x4 v0 = *(const u32x4*)(v16 + (size_t)e * DM + d0), v1 = *(const u32x4*)(v16 + (size_t)e * DM + d0 + 8);
#pragma unroll
            for (int j = 0; j < 4; ++j) { acc[2 * j] += w * __uint_as_float(v0[j] << 16); acc[2 * j + 1] += w * __uint_as_float(v0[j] & 0xffff0000u); acc[8 + 2 * j] += w * __uint_as_float(v1[j] << 16); acc[8 + 2 * j + 1] += w * __uint_as_float(v1[j] & 0xffff0000u); }
        }
        float ss = 0.f;
#pragma unroll
        for (int j = 0; j < 16; ++j) { acc[j] += hb[j]; ss += acc[j] * acc[j]; }
        const float r2 = rsqrtf(wave_sum(ss) * (1.0f / DM) + EPS);
#pragma unroll
        for (int j = 0; j < 4; ++j) { const f32x4 g = *(const f32x4*)(nf + d0 + 4 * j); f32x4 o; o[0] = acc[4 * j] * r2 * g[0]; o[1] = acc[4 * j + 1] * r2 * g[1]; o[2] = acc[4 * j + 2] * r2 * g[2]; o[3] = acc[4 * j + 3] * r2 * g[3];
            *(f32x4*)(out + (size_t)m * DM + d0 + 4 * j) = o; }
    }
}


constexpr size_t WS_KT = 30 * MiB;
struct RowId { DEV int operator()(int n0) const { return n0; } };
struct RowGlu { DEV int operator()(int n0) const { return (n0 < 1024) ? (256 * (n0 >> 7) + (n0 & 127)) : (256 * ((n0 - 1024) >> 7) + 128 + ((n0 - 1024) & 127)); } };
template <class RowMap> DEV void p0_transpose_item(const float* W, int K, int N, bf16_t* WT, LAS float* scr, int item, int lane, const float* kscale, RowMap rm) {
    const int nblk = N / 32, kb = item / nblk, nb = item % nblk, k0 = 64 * kb, n0 = 32 * nb;
#pragma unroll 8
    for (int i = 0; i < 32; ++i) { const int kk = 2 * i + (lane >> 5); float v = W[(size_t)(k0 + kk) * N + n0 + (lane & 31)]; if (kscale) v *= kscale[k0 + kk]; scr[kk * 33 + (lane & 31)] = v; }
    asm volatile("s_waitcnt lgkmcnt(0)" ::: "memory");
    const int c = lane & 7; const int r0 = rm(n0);
#pragma unroll
    for (int j = 0; j < 4; ++j) { const int n = (lane >> 3) + 8 * j; const LAS float* s = scr + (8 * c) * 33 + n;
        u32x4 o; o[0] = cvt_pk_bf16(s[0], s[33]); o[1] = cvt_pk_bf16(s[2 * 33], s[3 * 33]); o[2] = cvt_pk_bf16(s[4 * 33], s[5 * 33]); o[3] = cvt_pk_bf16(s[6 * 33], s[7 * 33]);
        *(u32x4*)(WT + (size_t)(r0 + n) * K + k0 + 8 * c) = o; }
    asm volatile("s_waitcnt lgkmcnt(0)" ::: "memory");
}
DEV void phase0_opt(const Args& a, unsigned char* ws, LAS float* lds, int gtid, int gsize) {
    const int lane = threadIdx.x & 63, wv = threadIdx.x >> 6, gw = gtid >> 6, ngw = gsize >> 6;
    {
        LAS float* scr = lds + wv * (64 * 33);
        constexpr int I_IN = 16 * 136, I_O = 8 * 32, I_GLU = 8 * 64, I_OUT = 16 * 32, I_Q = 16 * 32, NIT = I_IN + I_O + I_GLU + I_OUT + I_Q;
        for (int it = gw; it < NIT; it += ngw) { int r = it;
            if (r < I_IN) { p0_transpose_item(a.in[I_W_IN], 1024, NIN, (bf16_t*)(ws + WS_WIN), scr, r, lane, nullptr, RowId()); continue; } r -= I_IN;
            if (r < I_O) { p0_transpose_item(a.in[I_WO], 512, 1024, (bf16_t*)(ws + WS_WO), scr, r, lane, nullptr, RowId()); continue; } r -= I_O;
            if (r < I_GLU) { p0_transpose_item(a.in[I_WGLU], 512, 2048, (bf16_t*)(ws + WS_WGLU), scr, r, lane, nullptr, RowGlu()); continue; } r -= I_GLU;
            if (r < I_OUT) { p0_transpose_item(a.in[I_WOUT], 1024, 1024, (bf16_t*)(ws + WS_WOUT), scr, r, lane, nullptr, RowId()); continue; } r -= I_OUT;
            p0_transpose_item(a.in[I_WQ], 1024, 1024, (bf16_t*)(ws + WS_WQ), scr, r, lane, a.in[I_NORM_FFN], RowId()); }
    }
    {
        bf16_t* xn = (bf16_t*)(ws + WS_XN); const float* x = a.in[I_X]; const float* gain = a.in[I_NORM_MIX];
        f32x4 gn[4];
#pragma unroll
        for (int j = 0; j < 4; ++j) gn[j] = ((const f32x4*)gain)[lane + 64 * j];
        for (int m = gw; m < T; m += ngw) {
            const f32x4* xr = (const f32x4*)(x + (size_t)m * DM) + lane; f32x4 v[4]; float s = 0.f;
#pragma unroll
            for (int j = 0; j < 4; ++j) { v[j] = xr[64 * j]; s += v[j][0] * v[j][0] + v[j][1] * v[j][1] + v[j][2] * v[j][2] + v[j][3] * v[j][3]; }
            const float rstd = rsqrtf(wave_sum(s) * (1.0f / DM) + EPS);
#pragma unroll
            for (int j = 0; j < 4; ++j) { u32x2 o; o[0] = cvt_pk_bf16(v[j][0] * rstd * gn[j][0], v[j][1] * rstd * gn[j][1]); o[1] = cvt_pk_bf16(v[j][2] * rstd * gn[j][2], v[j][3] * rstd * gn[j][3]);
                ((u32x2*)(xn + (size_t)m * DM))[lane + 64 * j] = o; }
        }
    }
    { bf16_t* w = (bf16_t*)(ws + WS_BLK); for (int i = gtid; i < 1536 * 256; i += gsize) { const int n = i >> 8, k = i & 255; float v = 0.f;
            if (n < 512) { if (k < 64) v = a.in[I_W_LORA][k * 512 + n]; }
            else if (n < 1024) { if (k >= 64 && k < 128) v = a.in[I_A_LORA][(k - 64) * 512 + n - 512]; }
            else { if (k >= 128) v = a.in[I_G_LORA][(k - 128) * 512 + n - 1024]; }
            w[i] = f2bf(v); } }
    { bf16_t* w = (bf16_t*)(ws + WS_SK); const float* s = a.in[I_SUBK]; for (int i = gtid; i < 8 * 2 * 128 * 64; i += gsize) w[i] = f2bf(s[i]); }
    { float* par = (float*)(ws + WS_PAR);
      for (int i = gtid; i < PAR_END; i += gsize) { float v;
        if (i < PAR_W0) v = a.in[I_MU][i]; else if (i < PAR_A0) v = a.in[I_W0][i - PAR_W0]; else if (i < PAR_KK) v = a.in[I_A0][i - PAR_A0]; else if (i < PAR_KA) v = a.in[I_KK][i - PAR_KK];
        else if (i < PAR_RK) v = a.in[I_KA][i - PAR_KA]; else if (i < PAR_LNW) v = a.in[I_RK][i - PAR_RK]; else if (i < PAR_LNB) v = a.in[I_LNW][i - PAR_LNW]; else if (i < PAR_BG) v = a.in[I_LNB][i - PAR_LNB];
        else if (i < PAR_NF) v = a.in[I_B_GATE][i - PAR_BG]; else if (i < PAR_LAM16) v = a.in[I_NORM_FINAL][i - PAR_NF];
        else { const int j = i - PAR_LAM16, gp = j >> 1; const S5p q = s5_param(a, gp >> 6, gp & 63); float pr, pi; s5_pow(q, 16, pr, pi); v = (j & 1) ? pi : pr; }
        par[i] = v; } }
    {
        bf16_t* w = (bf16_t*)(ws + WS_EBT);
        for (int i = gtid; i < 32 * 256 * 256; i += gsize) { const int g = i >> 16, n = (i >> 8) & 255, k = i & 255; float v = 0.f;
            if (n < 128) { const int p = n & 63, sp = k >> 4, j = k & 15; const S5p q = s5_param(a, g, p);
                const float br = a.in[I_BRE][(g * 64 + p) * 16 + j], bi = a.in[I_BIM][(g * 64 + p) * 16 + j];
                const float bbr = q.fr * br - q.fi * bi, bbi = q.fr * bi + q.fi * br; float pr, pi; s5_pow(q, 15 - sp, pr, pi);
                v = (n < 64) ? (pr * bbr - pi * bbi) : (pr * bbi + pi * bbr); }
            w[i] = f2bf(v); }
    }
    {
        float* kt = (float*)(ws + WS_KT);
        for (int i4 = gtid; i4 < 32 * 256 * 4; i4 += gsize) { const int i = i4 >> 2, pc = i4 & 3; const int g = i >> 8, h = (i >> 4) & 15, j = i & 15; float acc[16];
#pragma unroll
            for (int n = 0; n < 16; ++n) acc[n] = 0.f;
            for (int pi = 0; pi < 16; ++pi) { const int p = pc * 16 + pi; const S5p q = s5_param(a, g, p);
                const float br = a.in[I_BRE][(g * 64 + p) * 16 + j], bi = a.in[I_BIM][(g * 64 + p) * 16 + j];
                const float bbr = q.fr * br - q.fi * bi, bbi = q.fr * bi + q.fi * br;
                const float cr = a.in[I_CRE][(g * 16 + h) * 64 + p], ci = a.in[I_CIM][(g * 16 + h) * 64 + p];
                float zr = cr * bbr - ci * bbi, zi = cr * bbi + ci * bbr;
#pragma unroll
                for (int n = 0; n < 16; ++n) { acc[n] += zr; const float t = zr * q.lr - zi * q.li; zi = zr * q.li + zi * q.lr; zr = t; } }
#pragma unroll
            for (int n = 0; n < 16; ++n) { acc[n] += dpp_f<0xB1>(acc[n]); acc[n] += dpp_f<0x4E>(acc[n]); }
            if (pc == 0) { if (h == j) acc[0] += a.in[I_SD][g * 16 + h];
#pragma unroll
                for (int n = 0; n < 16; ++n) kt[(((size_t)g * 16 + n) * 16 + h) * 16 + j] = acc[n]; } }
    }
    {
        bf16_t* w = (bf16_t*)(ws + WS_YBT);
        for (int i = gtid; i < 32 * 256 * 64; i += gsize) { const int g = i >> 14, n = (i >> 6) & 255, p = i & 63; const int s = n >> 4, h = n & 15;
            const S5p q = s5_param(a, g, p); float pr, pi; s5_pow(q, s + 1, pr, pi);
            const float cr = a.in[I_CRE][(g * 16 + h) * 64 + p], ci = a.in[I_CIM][(g * 16 + h) * 64 + p];
            w[((size_t)g * 256 + n) * 384 + 256 + p] = f2bf(cr * pr - ci * pi); w[((size_t)g * 256 + n) * 384 + 320 + p] = f2bf(-(cr * pi + ci * pr)); }
    }
}
DEV void phase2_ybt(unsigned char* ws, int gtid, int gsize) {
    const float* kt = (const float*)(ws + WS_KT); bf16_t* w = (bf16_t*)(ws + WS_YBT);
    for (int i = gtid; i < 32 * 256 * 32; i += gsize) { const int g = i >> 13, n = (i >> 5) & 255, k8 = (i & 31) * 8; const int s = n >> 4, h = n & 15, sp = k8 >> 4, j0 = k8 & 15;
        u32x4 o = (u32x4){0u, 0u, 0u, 0u};
        if (sp <= s) { const float* src = kt + (((size_t)g * 16 + (s - sp)) * 16 + h) * 16 + j0; const f32x4 v0 = *(const f32x4*)src, v1 = *(const f32x4*)(src + 4); o = pack8(v0, v1); }
        *(u32x4*)(w + ((size_t)g * 256 + n) * 384 + k8) = o; }
}
DEV void phase3_scan_opt(unsigned char* ws, int gtid, int gsize) {
    const float* e = (const float*)(ws + WS_E); bf16_t* uc = (bf16_t*)(ws + WS_UC); const float* lam16 = (const float*)(ws + WS_PAR) + PAR_LAM16;
    for (int i = gtid; i < NB * 32 * 64; i += gsize) { const int b = i >> 11, g = (i >> 6) & 31, p = i & 63; const float lr = lam16[(g * 64 + p) * 2], li = lam16[(g * 64 + p) * 2 + 1];
        float xr = 0.f, xi = 0.f;
        for (int c0 = 0; c0 < 256; c0 += 16) { float er[16], ei[16];
#pragma unroll
            for (int c = 0; c < 16; ++c) { const size_t crow = (size_t)g * 2048 + b * 256 + c0 + c; er[c] = e[crow * 128 + p]; ei[c] = e[crow * 128 + 64 + p]; }
#pragma unroll
            for (int c = 0; c < 16; ++c) { const size_t crow = (size_t)g * 2048 + b * 256 + c0 + c;
                uc[crow * 384 + 256 + p] = f2bf(xr); uc[crow * 384 + 320 + p] = f2bf(xi);
                const float nr = lr * xr - li * xi + er[c], ni = lr * xi + li * xr + ei[c]; xr = nr; xi = ni; } }
    }
}
DEV void phase3_scan_seg(unsigned char* ws, LAS float* lds, int wg, int nwg) {
    const float* e = (const float*)(ws + WS_E); bf16_t* uc = (bf16_t*)(ws + WS_UC); const float* lam16 = (const float*)(ws + WS_PAR) + PAR_LAM16;
    const int w = threadIdx.x >> 6, p = threadIdx.x & 63;
    for (int pair = wg; pair < NB * 32; pair += nwg) { const int b = pair >> 5, g = pair & 31; const float lr = lam16[(g * 64 + p) * 2], li = lam16[(g * 64 + p) * 2 + 1];
        const size_t crow0 = (size_t)g * 2048 + b * 256 + w * 32;
        float er[32], ei[32];
#pragma unroll
        for (int c = 0; c < 32; ++c) { er[c] = e[(crow0 + c) * 128 + p]; ei[c] = e[(crow0 + c) * 128 + 64 + p]; }
        float xr = 0.f, xi = 0.f;
#pragma unroll
        for (int c = 0; c < 32; ++c) { const float nr = lr * xr - li * xi + er[c], ni = lr * xi + li * xr + ei[c]; xr = nr; xi = ni; }
        __syncthreads();
        lds[(w * 64 + p) * 2] = xr; lds[(w * 64 + p) * 2 + 1] = xi;
        __syncthreads();
        float ar = lr, ai = li;
#pragma unroll
        for (int q = 0; q < 5; ++q) { const float nr = ar * ar - ai * ai, ni = 2.0f * ar * ai; ar = nr; ai = ni; }
        xr = 0.f; xi = 0.f;
        for (int j = 0; j < w; ++j) { const float pr = lds[(j * 64 + p) * 2], pi = lds[(j * 64 + p) * 2 + 1]; const float nr = ar * xr - ai * xi + pr, ni = ar * xi + ai * xr + pi; xr = nr; xi = ni; }
#pragma unroll
        for (int c = 0; c < 32; ++c) { uc[(crow0 + c) * 384 + 256 + p] = f2bf(xr); uc[(crow0 + c) * 384 + 320 + p] = f2bf(xi);
            const float nr = lr * xr - li * xi + er[c], ni = lr * xi + li * xr + ei[c]; xr = nr; xi = ni; }
    }
}
DEV void phase5_post_b(unsigned char* ws, int gw, int ngw, int t_lo, int t_hi) {
    const bf16_t* praw = (const bf16_t*)(ws + WS_PRAW); const bf16_t* gr = (const bf16_t*)(ws + WS_GR); const bf16_t* yr = (const bf16_t*)(ws + WS_YR); bf16_t* yo = (bf16_t*)(ws + WS_YO);
    const float* par = (const float*)(ws + WS_PAR); const float* bonus = (const float*)(ws + WS_BONUS); const int lane = threadIdx.x & 63, c0 = lane * 8, nt = t_hi - t_lo;
    f32x4 muv[2], lw[2], lb[2];
#pragma unroll
    for (int j = 0; j < 2; ++j) { muv[j] = *(const f32x4*)(par + PAR_MU + 1024 + c0 + 4 * j); lw[j] = *(const f32x4*)(par + PAR_LNW + c0 + 4 * j); lb[j] = *(const f32x4*)(par + PAR_LNB + c0 + 4 * j); }
    for (int idx = gw; idx < NB * nt; idx += ngw) { const int m = (idx / nt) * SEQ + t_lo + idx % nt; const bool first = (m & (SEQ - 1)) == 0; const size_t mp = first ? m : m - 1;
        f32x4 y[2], v[2], vp[2], gg[2];
        unpack8(*(const u32x4*)(yr + (size_t)m * 512 + c0), y[0], y[1]); unpack8(*(const u32x4*)(gr + (size_t)m * 512 + c0), gg[0], gg[1]);
        unpack8(*(const u32x4*)(praw + pr_off((size_t)((size_t)m), 1024 + c0)), v[0], v[1]); unpack8(*(const u32x4*)(praw + pr_off((size_t)(mp), 1024 + c0)), vp[0], vp[1]);
        const float bs = bonus[(size_t)m * 8 + (lane >> 3)];
        float sy = 0.f; f32x4 vl[2];
#pragma unroll
        for (int j = 0; j < 2; ++j) { if (first) vp[j] = (f32x4){0.f, 0.f, 0.f, 0.f};
            vl[j] = v[j] + (vp[j] - v[j]) * muv[j]; sy += (y[j][0] + y[j][1]) + (y[j][2] + y[j][3]); }
        sy += dpp_f<0xB1>(sy); sy += dpp_f<0x4E>(sy); sy += dpp_f<0x141>(sy);
        const float mean = sy * (1.0f / 64.0f); float q = 0.f;
#pragma unroll
        for (int j = 0; j < 2; ++j) { const f32x4 d = y[j] - mean; y[j] = d; q += (d[0] * d[0] + d[1] * d[1]) + (d[2] * d[2] + d[3] * d[3]); }
        q += dpp_f<0xB1>(q); q += dpp_f<0x4E>(q); q += dpp_f<0x141>(q);
        const float rs = rsqrtf(q * (1.0f / 64.0f) + 64e-5f);
        const f32x4 o0 = (y[0] * rs * lw[0] + lb[0] + bs * vl[0]) * gg[0], o1 = (y[1] * rs * lw[1] + lb[1] + bs * vl[1]) * gg[1];
        *(u32x4*)(yo + (size_t)m * 512 + c0) = pack8(o0, o1);
    }
}
DEV void phase5_post_opt(unsigned char* ws, int gtid, int gsize) {
    const bf16_t* praw = (const bf16_t*)(ws + WS_PRAW); const bf16_t* aa = (const bf16_t*)(ws + WS_AA); const bf16_t* gr = (const bf16_t*)(ws + WS_GR); const bf16_t* yr = (const bf16_t*)(ws + WS_YR); bf16_t* yo = (bf16_t*)(ws + WS_YO);
    const float* par = (const float*)(ws + WS_PAR); const int lane = threadIdx.x & 63, gw = gtid >> 6, ngw = gsize >> 6, c0 = lane * 8;
    f32x4 mur[2], muk[2], muv[2], ka[2], rk[2], lw[2], lb[2];
#pragma unroll
    for (int j = 0; j < 2; ++j) { mur[j] = *(const f32x4*)(par + PAR_MU + c0 + 4 * j); muk[j] = *(const f32x4*)(par + PAR_MU + 512 + c0 + 4 * j); muv[j] = *(const f32x4*)(par + PAR_MU + 1024 + c0 + 4 * j);
        ka[j] = *(const f32x4*)(par + PAR_KA + c0 + 4 * j); rk[j] = *(const f32x4*)(par + PAR_RK + c0 + 4 * j); lw[j] = *(const f32x4*)(par + PAR_LNW + c0 + 4 * j); lb[j] = *(const f32x4*)(par + PAR_LNB + c0 + 4 * j); }
    for (int m = gw; m < T; m += ngw) { const bool first = (m & (SEQ - 1)) == 0; const size_t mp = first ? m : m - 1;
        f32x4 y[2], r[2], rp[2], k[2], kp[2], v[2], vp[2], av[2], gg[2];
        unpack8(*(const u32x4*)(yr + (size_t)m * 512 + c0), y[0], y[1]); unpack8(*(const u32x4*)(aa + da_off((size_t)m, c0)), av[0], av[1]); unpack8(*(const u32x4*)(gr + (size_t)m * 512 + c0), gg[0], gg[1]);
        unpack8(*(const u32x4*)(praw + pr_off((size_t)((size_t)m), c0)), r[0], r[1]); unpack8(*(const u32x4*)(praw + pr_off((size_t)(mp), c0)), rp[0], rp[1]);
        unpack8(*(const u32x4*)(praw + pr_off((size_t)((size_t)m), 512 + c0)), k[0], k[1]); unpack8(*(const u32x4*)(praw + pr_off((size_t)(mp), 512 + c0)), kp[0], kp[1]);
        unpack8(*(const u32x4*)(praw + pr_off((size_t)((size_t)m), 1024 + c0)), v[0], v[1]); unpack8(*(const u32x4*)(praw + pr_off((size_t)(mp), 1024 + c0)), vp[0], vp[1]);
        float sy = 0.f, bs = 0.f; f32x4 vl[2];
#pragma unroll
        for (int j = 0; j < 2; ++j) { if (first) { rp[j] = (f32x4){0.f, 0.f, 0.f, 0.f}; kp[j] = rp[j]; vp[j] = rp[j]; }
            const f32x4 rl = r[j] + (rp[j] - r[j]) * mur[j], kl = k[j] + (kp[j] - k[j]) * muk[j]; vl[j] = v[j] + (vp[j] - v[j]) * muv[j];
            const f32x4 k2 = kl * (1.0f + (av[j] - 1.0f) * ka[j]), t = rl * k2 * rk[j];
            sy += (y[j][0] + y[j][1]) + (y[j][2] + y[j][3]); bs += (t[0] + t[1]) + (t[2] + t[3]); }
        sy += dpp_f<0xB1>(sy); bs += dpp_f<0xB1>(bs); sy += dpp_f<0x4E>(sy); bs += dpp_f<0x4E>(bs); sy += dpp_f<0x141>(sy); bs += dpp_f<0x141>(bs);
        const float mean = sy * (1.0f / 64.0f); float q = 0.f;
#pragma unroll
        for (int j = 0; j < 2; ++j) { const f32x4 d = y[j] - mean; y[j] = d; q += (d[0] * d[0] + d[1] * d[1]) + (d[2] * d[2] + d[3] * d[3]); }
        q += dpp_f<0xB1>(q); q += dpp_f<0x4E>(q); q += dpp_f<0x141>(q);
        const float rs = rsqrtf(q * (1.0f / 64.0f) + 64e-5f);
        const f32x4 o0 = (y[0] * rs * lw[0] + lb[0] + bs * vl[0]) * gg[0], o1 = (y[1] * rs * lw[1] + lb[1] + bs * vl[1]) * gg[1];
        *(u32x4*)(yo + (size_t)m * 512 + c0) = pack8(o0, o1);
    }
}

template <int CTRL> DEV unsigned dpp_u(unsigned x) { return (unsigned)__builtin_amdgcn_update_dpp(0, (int)x, CTRL, 0xf, 0xf, true); }
DEV unsigned umax_(unsigned a, unsigned b) { return a > b ? a : b; }
DEV unsigned umin_(unsigned a, unsigned b) { return a < b ? a : b; }
DEV unsigned red16max(unsigned x) { x = umax_(x, dpp_u<0xB1>(x)); x = umax_(x, dpp_u<0x4E>(x)); x = umax_(x, dpp_u<0x124>(x)); x = umax_(x, dpp_u<0x128>(x)); return x; }
DEV unsigned f2key(float s) { const unsigned u = __float_as_uint(s); return u ^ ((unsigned)((int)u >> 31) | 0x80000000u); }
DEV float key2f(unsigned k) { return __uint_as_float((k & 0x80000000u) ? (k ^ 0x80000000u) : ~k); }
#define CE_(a, b) { const unsigned hi_ = umax_(a, b), lo_ = umin_(a, b); a = hi_; b = lo_; }
DEV unsigned top16_of_128(unsigned (&k)[8], int l15) {
    CE_(k[0], k[1]) CE_(k[2], k[3]) CE_(k[4], k[5]) CE_(k[6], k[7]) CE_(k[0], k[2]) CE_(k[1], k[3]) CE_(k[4], k[6]) CE_(k[5], k[7]) CE_(k[1], k[2]) CE_(k[5], k[6])
    CE_(k[0], k[4]) CE_(k[1], k[5]) CE_(k[2], k[6]) CE_(k[3], k[7]) CE_(k[2], k[4]) CE_(k[3], k[5]) CE_(k[1], k[2]) CE_(k[3], k[4]) CE_(k[5], k[6])
    unsigned mine = 0u;
#pragma unroll
    for (int r = 0; r < 16; ++r) { const unsigned w = red16max(k[0]); mine = (l15 == r) ? w : mine; const bool pop = (k[0] == w);
#pragma unroll
        for (int i = 0; i < 7; ++i) k[i] = pop ? k[i + 1] : k[i];
        k[7] = pop ? 0u : k[7]; }
    return mine;
}
DEV unsigned top16_of_64(unsigned (&k)[4], int l15) {
    CE_(k[0], k[1]) CE_(k[2], k[3]) CE_(k[0], k[2]) CE_(k[1], k[3]) CE_(k[1], k[2])
    unsigned mine = 0u;
#pragma unroll
    for (int r = 0; r < 16; ++r) { const unsigned w = red16max(k[0]); mine = (l15 == r) ? w : mine; const bool pop = (k[0] == w);
        k[0] = pop ? k[1] : k[0]; k[1] = pop ? k[2] : k[1]; k[2] = pop ? k[3] : k[2]; k[3] = pop ? 0u : k[3]; }
    return mine;
}
DEV void top16x4_of_128(unsigned (&k)[4][8], int l15, unsigned (&mine)[4]) {
#pragma unroll
    for (int t = 0; t < 4; ++t) {
        CE_(k[t][0], k[t][1]) CE_(k[t][2], k[t][3]) CE_(k[t][4], k[t][5]) CE_(k[t][6], k[t][7]) CE_(k[t][0], k[t][2]) CE_(k[t][1], k[t][3]) CE_(k[t][4], k[t][6]) CE_(k[t][5], k[t][7]) CE_(k[t][1], k[t][2]) CE_(k[t][5], k[t][6])
        CE_(k[t][0], k[t][4]) CE_(k[t][1], k[t][5]) CE_(k[t][2], k[t][6]) CE_(k[t][3], k[t][7]) CE_(k[t][2], k[t][4]) CE_(k[t][3], k[t][5]) CE_(k[t][1], k[t][2]) CE_(k[t][3], k[t][4]) CE_(k[t][5], k[t][6])
        mine[t] = 0u; }
#pragma unroll
    for (int r = 0; r < 16; ++r) { unsigned w[4];
#pragma unroll
        for (int t = 0; t < 4; ++t) w[t] = umax_(k[t][0], dpp_u<0xB1>(k[t][0]));
#pragma unroll
        for (int t = 0; t < 4; ++t) w[t] = umax_(w[t], dpp_u<0x4E>(w[t]));
#pragma unroll
        for (int t = 0; t < 4; ++t) w[t] = umax_(w[t], dpp_u<0x124>(w[t]));
#pragma unroll
        for (int t = 0; t < 4; ++t) w[t] = umax_(w[t], dpp_u<0x128>(w[t]));
#pragma unroll
        for (int t = 0; t < 4; ++t) { mine[t] = (l15 == r) ? w[t] : mine[t]; const bool pop = (k[t][0] == w[t]);
#pragma unroll
            for (int i = 0; i < 7; ++i) k[t][i] = pop ? k[t][i + 1] : k[t][i];
            k[t][7] = pop ? 0u : k[t][7]; } }
}
DEV void top16x4_of_64(unsigned (&k)[4][4], int l15, unsigned (&mine)[4]) {
#pragma unroll
    for (int t = 0; t < 4; ++t) { CE_(k[t][0], k[t][1]) CE_(k[t][2], k[t][3]) CE_(k[t][0], k[t][2]) CE_(k[t][1], k[t][3]) CE_(k[t][1], k[t][2]) mine[t] = 0u; }
#pragma unroll
    for (int r = 0; r < 16; ++r) { unsigned w[4];
#pragma unroll
        for (int t = 0; t < 4; ++t) w[t] = umax_(k[t][0], dpp_u<0xB1>(k[t][0]));
#pragma unroll
        for (int t = 0; t < 4; ++t) w[t] = umax_(w[t], dpp_u<0x4E>(w[t]));
#pragma unroll
        for (int t = 0; t < 4; ++t) w[t] = umax_(w[t], dpp_u<0x124>(w[t]));
#pragma unroll
        for (int t = 0; t < 4; ++t) w[t] = umax_(w[t], dpp_u<0x128>(w[t]));
#pragma unroll
        for (int t = 0; t < 4; ++t) { mine[t] = (l15 == r) ? w[t] : mine[t]; const bool pop = (k[t][0] == w[t]);
            k[t][0] = pop ? k[t][1] : k[t][0]; k[t][1] = pop ? k[t][2] : k[t][1]; k[t][2] = pop ? k[t][3] : k[t][2]; k[t][3] = pop ? 0u : k[t][3]; } }
}
#define T9_TAB (OPT_PEER == 2 && OPT_WKV == 6)
DEV void phase9_topk_opt(unsigned char* ws, LAS unsigned char* lds, int wg, int nwg, const float* pu, const float* pv, const float* gn) {
#if T9_TAB
    constexpr int NTG = 16384 * 256; const int tstride = nwg * NTHR; int te = wg * NTHR + (int)threadIdx.x; TabGrp tg;
    if (te < NTG) tab_cvt_load(tg, pu, pv, te);
#define T9_STEP { if (te < NTG) { tab_cvt_store(tg, gn, ws, te); te += tstride; if (te < NTG) tab_cvt_load(tg, pu, pv, te); } }
#else
#define T9_STEP
#endif
    const bf16_t* q = (const bf16_t*)(ws + WS_Q); const bf16_t* sk = (const bf16_t*)(ws + WS_SK); int* ids = (int*)(ws + WS_IDS); float* gwt = (float*)(ws + WS_GW);
    const int tid = threadIdx.x, lane = tid & 63, wv = tid >> 6, l15 = lane & 15, quad = lane >> 4;
    const int i3 = (l15 < 5) ? 2 : (l15 < 9) ? 3 : (l15 < 12) ? 4 : (l15 < 14) ? 5 : 6;
    const int j3 = (l15 < 5) ? l15 : (l15 < 9) ? l15 - 5 : (l15 < 12) ? l15 - 9 : (l15 < 14) ? l15 - 12 : l15 - 14;
    const bool grp = (nwg & 7) == 0; const int nh = grp ? 1 : 8, wix = grp ? ((wg >> 3) * 8 + wv) : (wg * 8 + wv), nwx = grp ? ((nwg >> 3) * 8) : (nwg * 8);
    for (int hi = 0; hi < nh; ++hi) { const int hh = grp ? (wg & 7) : hi;
        __syncthreads();
        for (int i = tid; i < 256 * 8; i += NTHR) { const int key = i >> 3, ch = i & 7; *(LAS u32x4*)(lds + key * 144 + ch * 16) = *(const u32x4*)(sk + ((size_t)hh * 256 + key) * 64 + ch * 8); }
        __syncthreads();
        for (int tile = wix; tile < T / 16; tile += nwx) { const int m0 = tile * 16;
            bf16x8 aq[2][2];
#pragma unroll
            for (int c = 0; c < 2; ++c)
#pragma unroll
                for (int ks = 0; ks < 2; ++ks) aq[c][ks] = *(const bf16x8*)(q + (size_t)(m0 + l15) * DM + hh * 128 + c * 64 + ks * 32 + quad * 8);
            unsigned win[2][4];
#pragma unroll
            for (int c = 0; c < 2; ++c) {
                f32x4 acc[8];
#pragma unroll
                for (int nt = 0; nt < 8; ++nt) acc[nt] = (f32x4){0.f, 0.f, 0.f, 0.f};
#pragma unroll
                for (int ks = 0; ks < 2; ++ks) {
#pragma unroll
                    for (int nt = 0; nt < 8; ++nt) { const bf16x8 bfr = *(const LAS bf16x8*)(lds + (c * 128 + nt * 16 + l15) * 144 + ks * 64 + quad * 16);
                        acc[nt] = __builtin_amdgcn_mfma_f32_16x16x32_bf16(aq[c][ks], bfr, acc[nt], 0, 0, 0); } }
                __builtin_amdgcn_sched_barrier(0);
                { unsigned k[4][8];
#pragma unroll
                  for (int i = 0; i < 4; ++i)
#pragma unroll
                    for (int nt = 0; nt < 8; ++nt) k[i][nt] = (f2key(acc[nt][i]) & 0xFFFFFF80u) | (unsigned)(127 - (nt * 16 + l15));
                  top16x4_of_128(k, l15, win[c]); }
                __builtin_amdgcn_sched_barrier(0);
                T9_STEP
            }
            const int base = lane & 48; unsigned k2[4][4], wk[4];
#pragma unroll
            for (int i = 0; i < 4; ++i) {
                const float sv0 = key2f(win[0][i] & 0xFFFFFF80u), sv1 = key2f(win[1][i] & 0xFFFFFF80u);
                const float s00 = __shfl(sv0, base), s01 = __shfl(sv0, base + 1), s10 = __shfl(sv1, base), s07 = __shfl(sv0, base + 7);
                const float s0i3 = __shfl(sv0, base + i3), s1j3 = __shfl(sv1, base + j3);
                k2[i][0] = (f2key(s00 + sv1) & 0xFFFFFF00u) | (unsigned)(255 - l15);
                k2[i][1] = (l15 < 8) ? ((f2key(s01 + sv1) & 0xFFFFFF00u) | (unsigned)(255 - (16 + l15))) : ((f2key(sv0 + s10) & 0xFFFFFF00u) | (unsigned)(255 - l15 * 16));
                k2[i][2] = (f2key(s0i3 + s1j3) & 0xFFFFFF00u) | (unsigned)(255 - (i3 * 16 + j3));
                k2[i][3] = (l15 < 2) ? ((f2key(s07 + sv1) & 0xFFFFFF00u) | (unsigned)(255 - (7 * 16 + l15))) : 0u; }
            top16x4_of_64(k2, l15, wk);
            T9_STEP
#pragma unroll
            for (int i = 0; i < 4; ++i) {
                const float cv = key2f(wk[i] & 0xFFFFFF00u); const int ci = 255 - (int)(wk[i] & 255u);
                const unsigned k0 = (unsigned)__shfl((int)win[0][i], base + (ci >> 4)), k1 = (unsigned)__shfl((int)win[1][i], base + (ci & 15));
                const int e = (127 - (int)(k0 & 127u)) * 128 + (127 - (int)(k1 & 127u));
                const float mx = __shfl(cv, base); float ex = __expf(cv - mx); float sm = ex;
                sm += dpp_f<0xB1>(sm); sm += dpp_f<0x4E>(sm); sm += dpp_f<0x124>(sm); sm += dpp_f<0x128>(sm);
                const size_t o = (size_t)(m0 + quad * 4 + i) * 128 + hh * 16 + l15;
                ids[o] = e; gwt[o] = ex / sm;
            }
            T9_STEP
        }
    }
#if T9_TAB
    while (te < NTG) T9_STEP
#endif
}

#if TAB_FP8
constexpr float TAB_USCALE = 256.0f, TAB_VSCALE = 16.0f;
typedef u32x4 tabrow_t;
DEV tabrow_t tab_ld(const unsigned char* tab, int e, int lane) { return *(const u32x4*)(tab + (size_t)e * 1024 + lane * 16); }
DEV void tab_dec(const tabrow_t& r, float (&f)[16]) {
#pragma unroll
    for (int i = 0; i < 4; ++i) { const auto lo = __builtin_amdgcn_cvt_pk_f32_fp8((int)r[i], false), hi = __builtin_amdgcn_cvt_pk_f32_fp8((int)r[i], true); f[4 * i] = lo[0]; f[4 * i + 1] = lo[1]; f[4 * i + 2] = hi[0]; f[4 * i + 3] = hi[1]; }
}
#else
constexpr float TAB_USCALE = 1.0f, TAB_VSCALE = 1.0f;
struct tabrow_t { u32x4 a, b; };
DEV tabrow_t tab_ld(const unsigned char* tab, int e, int lane) { tabrow_t r; const u32x4* p = (const u32x4*)(tab + (size_t)e * 2048 + lane * 32); r.a = p[0]; r.b = p[1]; return r; }
DEV void tab_dec(const tabrow_t& r, float (&f)[16]) {
#pragma unroll
    for (int i = 0; i < 4; ++i) { f[2 * i] = __uint_as_float(r.a[i] << 16); f[2 * i + 1] = __uint_as_float(r.a[i] & 0xffff0000u); f[8 + 2 * i] = __uint_as_float(r.b[i] << 16); f[8 + 2 * i + 1] = __uint_as_float(r.b[i] & 0xffff0000u); }
}
#endif
DEV float wave_total(float x) { x = red16(x); x += __shfl_xor(x, 16); x += __shfl_xor(x, 32); return x; }
DEV void phase10_peer_opt(float* out, unsigned char* ws, int gtid, int gsize) {
    const bf16_t* h1b = (const bf16_t*)(ws + WS_H1B); const unsigned char* utab = ws + WS_U16; const unsigned char* vtab = ws + WS_V16;
    const int* ids = (const int*)(ws + WS_IDS); const float* gwt = (const float*)(ws + WS_GW); const float* rss = (const float*)(ws + WS_RSS); const float* nf = (const float*)(ws + WS_PAR) + PAR_NF;
    const int lane = threadIdx.x & 63, gw = gtid >> 6, ngw = gsize >> 6, d0 = lane * 16;
    for (int m = gw; m < T; m += ngw) {
        float xf[16];
        { const u32x4 x0 = *(const u32x4*)(h1b + (size_t)m * DM + d0), x1 = *(const u32x4*)(h1b + (size_t)m * DM + d0 + 8); f32x4 a, b, c, d; unpack8(x0, a, b); unpack8(x1, c, d);
#pragma unroll
          for (int j = 0; j < 4; ++j) { xf[j] = a[j]; xf[4 + j] = b[j]; xf[8 + j] = c[j]; xf[12 + j] = d[j]; } }
        const int id0 = ids[(size_t)m * 128 + lane], id1 = ids[(size_t)m * 128 + 64 + lane];
        const float g0 = gwt[(size_t)m * 128 + lane], g1 = gwt[(size_t)m * 128 + 64 + lane];
        const float rstd = rsqrtf(rss[m] * (1.0f / DM) + EPS);
        float hid0 = 0.f, hid1 = 0.f;
        for (int c = 0; c < 128 / PEER_CH; ++c) {
            const int idv = (c * PEER_CH < 64) ? id0 : id1; tabrow_t rows[PEER_CH];
#pragma unroll
            for (int j = 0; j < PEER_CH; ++j) { const int e = __builtin_amdgcn_readlane(idv, (c * PEER_CH + j) & 63); rows[j] = tab_ld(utab, e, lane); }
            float hv = 0.f;
#pragma unroll
            for (int j = 0; j < PEER_CH; ++j) { float f[16]; tab_dec(rows[j], f); float s = 0.f;
#pragma unroll
                for (int i = 0; i < 16; ++i) s += xf[i] * f[i];
                s = wave_total(s); hv = (lane == ((c * PEER_CH + j) & 63)) ? s : hv; }
            if (c * PEER_CH < 64) hid0 += hv; else hid1 += hv;
        }
        const float w0 = g0 * gelu_tanh(hid0 * (rstd / TAB_USCALE)) * (1.0f / TAB_VSCALE), w1 = g1 * gelu_tanh(hid1 * (rstd / TAB_USCALE)) * (1.0f / TAB_VSCALE);
        float acc[16];
#pragma unroll
        for (int i = 0; i < 16; ++i) acc[i] = 0.f;
        for (int c = 0; c < 128 / PEER_CH; ++c) {
            const int idv = (c * PEER_CH < 64) ? id0 : id1; const float wv = (c * PEER_CH < 64) ? w0 : w1; tabrow_t rows[PEER_CH];
#pragma unroll
            for (int j = 0; j < PEER_CH; ++j) { const int e = __builtin_amdgcn_readlane(idv, (c * PEER_CH + j) & 63); rows[j] = tab_ld(vtab, e, lane); }
#pragma unroll
            for (int j = 0; j < PEER_CH; ++j) { const float w = __builtin_bit_cast(float, __builtin_amdgcn_readlane(__builtin_bit_cast(int, wv), (c * PEER_CH + j) & 63)); float f[16]; tab_dec(rows[j], f);
#pragma unroll
                for (int i = 0; i < 16; ++i) acc[i] += w * f[i]; }
        }
        float ss = 0.f;
#pragma unroll
        for (int i = 0; i < 16; ++i) { acc[i] += xf[i]; ss += acc[i] * acc[i]; }
        const float r2 = rsqrtf(wave_total(ss) * (1.0f / DM) + EPS);
#pragma unroll
        for (int j = 0; j < 4; ++j) { const f32x4 g = *(const f32x4*)(nf + d0 + 4 * j); f32x4 o; o[0] = acc[4 * j] * r2 * g[0]; o[1] = acc[4 * j + 1] * r2 * g[1]; o[2] = acc[4 * j + 2] * r2 * g[2]; o[3] = acc[4 * j + 3] * r2 * g[3];
            *(f32x4*)(out + (size_t)m * DM + d0 + 4 * j) = o; }
    }
}

#if TAB_FP8
DEV void peer_dec16(const u32x4& r, float (&f)[16]) {
#pragma unroll
    for (int i = 0; i < 4; ++i) { const auto lo = __builtin_amdgcn_cvt_pk_f32_fp8((int)r[i], false), hi = __builtin_amdgcn_cvt_pk_f32_fp8((int)r[i], true); f[4 * i] = lo[0]; f[4 * i + 1] = lo[1]; f[4 * i + 2] = hi[0]; f[4 * i + 3] = hi[1]; }
}
constexpr size_t WS_PART = 256 * MiB;
DEV void phase10a_part(unsigned char* ws, LAS float* lds, int wg, int nwg) {
    const unsigned char* x8 = ws + WS_X8; const unsigned char* utab = ws + WS_U16;
    const int* ids = (const int*)(ws + WS_IDS); float* part = (float*)(ws + WS_PART);
    const int lane = threadIdx.x & 63, wv = threadIdx.x >> 6, g = lane >> 3, p = lane & 7; const bool grp = (nwg & 7) == 0;
    const int nsl = grp ? 1 : 8, wix = grp ? ((wg >> 3) * 8 + wv) : (wg * 8 + wv), nwx = grp ? ((nwg >> 3) * 8) : (nwg * 8);
    LAS int* il = (LAS int*)(lds + wv * 1024);
    for (int sl = 0; sl < nsl; ++sl) { const int x = grp ? (wg & 7) : sl; const unsigned char* us = utab + (size_t)x * 16384 * 128 + p * 16;
        for (int tile = wix; tile < T / 8; tile += nwx) { const int m0 = tile * 8;
            { const u32x4* si = (const u32x4*)(ids + (size_t)m0 * 128);
#pragma unroll
              for (int i = 0; i < 4; ++i) *(LAS u32x4*)(il + (i * 64 + lane) * 4) = si[i * 64 + lane]; }
            const int m = m0 + g; const u32x4 xq = *(const u32x4*)(x8 + (size_t)m * DM + x * 128 + p * 16);
            int pt[16];
#pragma unroll
            for (int i = 0; i < 16; ++i) pt[i] = 0;
            asm volatile("s_waitcnt lgkmcnt(0)" ::: "memory");
            for (int pp = 0; pp < 8; ++pp) {
#pragma unroll
                for (int cc = 0; cc < 2; ++cc) { u32x4 rows[8];
#pragma unroll
                    for (int h = 0; h < 2; ++h) { const u32x4 e4 = *(const LAS u32x4*)(il + g * 128 + pp * 16 + cc * 8 + h * 4);
#pragma unroll
                        for (int r = 0; r < 4; ++r) rows[h * 4 + r] = *(const u32x4*)(us + (size_t)e4[r] * 128); }
#pragma unroll
                    for (int r = 0; r < 8; ++r) { int s = __builtin_amdgcn_sdot4((int)rows[r][0], (int)xq[0], 0, false); s = __builtin_amdgcn_sdot4((int)rows[r][1], (int)xq[1], s, false);
                        s = __builtin_amdgcn_sdot4((int)rows[r][2], (int)xq[2], s, false); s = __builtin_amdgcn_sdot4((int)rows[r][3], (int)xq[3], s, false);
                        s += (int)dpp_u<0xB1>((unsigned)s); s += (int)dpp_u<0x4E>((unsigned)s); s += (int)dpp_u<0x141>((unsigned)s);
                        pt[cc * 8 + r] = (p == pp) ? s : pt[cc * 8 + r]; } }
            }
            { bf16_t* d16 = (bf16_t*)part + ((size_t)x * T + m) * 128 + p * 16;
              *(u32x4*)(d16) = pack8((f32x4){(float)pt[0], (float)pt[1], (float)pt[2], (float)pt[3]}, (f32x4){(float)pt[4], (float)pt[5], (float)pt[6], (float)pt[7]});
              *(u32x4*)(d16 + 8) = pack8((f32x4){(float)pt[8], (float)pt[9], (float)pt[10], (float)pt[11]}, (f32x4){(float)pt[12], (float)pt[13], (float)pt[14], (float)pt[15]}); }
        }
    }
}
DEV void phase10r_reduce(unsigned char* ws, int gtid, int gsize) {
    const bf16_t* part = (const bf16_t*)(ws + WS_PART); const float* gwt = (const float*)(ws + WS_GW); const float* rss = (const float*)(ws + WS_RSS); float* w2 = (float*)(ws + WS_W2);
    for (int i8 = gtid; i8 < T * 16; i8 += gsize) { const int m = i8 >> 4; f32x4 s0 = (f32x4){0.f, 0.f, 0.f, 0.f}, s1 = s0;
#pragma unroll
        for (int x = 0; x < 8; ++x) { f32x4 a, b; unpack8(*(const u32x4*)(part + (size_t)x * T * 128 + (size_t)i8 * 8), a, b); s0 += a; s1 += b; }
        const float sc = rsqrtf(rss[m] * (1.0f / DM) + EPS) / (U8_SCALE * X8_SCALE); const f32x4 g0 = *(const f32x4*)(gwt + (size_t)i8 * 8), g1 = *(const f32x4*)(gwt + (size_t)i8 * 8 + 4); f32x4 o0, o1;
#pragma unroll
        for (int i = 0; i < 4; ++i) { o0[i] = g0[i] * gelu_tanh(s0[i] * sc) * (1.0f / TAB_VSCALE); o1[i] = g1[i] * gelu_tanh(s1[i] * sc) * (1.0f / TAB_VSCALE); }
        *(f32x4*)(w2 + (size_t)i8 * 8) = o0; *(f32x4*)(w2 + (size_t)i8 * 8 + 4) = o1; }
}
DEV void phase10b_out(float* out, unsigned char* ws, LAS float* lds, int wg, int nwg) {
    const bf16_t* h1b = (const bf16_t*)(ws + WS_H1B); const unsigned char* vtab = ws + WS_V16;
    const int* ids = (const int*)(ws + WS_IDS); const float* w2 = (const float*)(ws + WS_W2); float* rss2 = (float*)(ws + WS_RSS2);
    const int lane = threadIdx.x & 63, wv = threadIdx.x >> 6, g = lane >> 3, p = lane & 7; const bool grp = (nwg & 7) == 0;
    const int nsl = grp ? 1 : 8, wix = grp ? ((wg >> 3) * 8 + wv) : (wg * 8 + wv), nwx = grp ? ((nwg >> 3) * 8) : (nwg * 8);
    LAS float* wl = lds + wv * 2048; LAS int* il = (LAS int*)(lds + wv * 2048 + 1024);
    for (int sl = 0; sl < nsl; ++sl) { const int x = grp ? (wg & 7) : sl; const unsigned char* vs = vtab + (size_t)x * 16384 * 128 + p * 16;
        for (int tile = wix; tile < T / 8; tile += nwx) { const int m0 = tile * 8;
            {
                const f32x4* sw = (const f32x4*)(w2 + (size_t)m0 * 128); const u32x4* si = (const u32x4*)(ids + (size_t)m0 * 128);
#pragma unroll
                for (int i = 0; i < 4; ++i) { *(LAS f32x4*)(wl + (i * 64 + lane) * 4) = sw[i * 64 + lane]; *(LAS u32x4*)(il + (i * 64 + lane) * 4) = si[i * 64 + lane]; }
            }
            const int m = m0 + g;
            const u32x4 hx0 = *(const u32x4*)(h1b + (size_t)m * DM + x * 128 + p * 16), hx1 = *(const u32x4*)(h1b + (size_t)m * DM + x * 128 + p * 16 + 8);
            float acc[16];
#pragma unroll
            for (int i = 0; i < 16; ++i) acc[i] = 0.f;
            asm volatile("s_waitcnt lgkmcnt(0)" ::: "memory");
            for (int c = 0; c < 16; ++c) { u32x4 rows[8]; f32x4 wq[2];
#pragma unroll
                for (int h = 0; h < 2; ++h) { const u32x4 e4 = *(const LAS u32x4*)(il + g * 128 + c * 8 + h * 4); wq[h] = *(const LAS f32x4*)(wl + g * 128 + c * 8 + h * 4);
#pragma unroll
                    for (int r = 0; r < 4; ++r) rows[h * 4 + r] = *(const u32x4*)(vs + (size_t)e4[r] * 128); }
#pragma unroll
                for (int r = 0; r < 8; ++r) { float f[16]; peer_dec16(rows[r], f); const float w = wq[r >> 2][r & 3];
#pragma unroll
                    for (int i = 0; i < 16; ++i) acc[i] += w * f[i]; }
            }
            f32x4 a0, a1, a2, a3; unpack8(hx0, a0, a1); unpack8(hx1, a2, a3);
            f32x4 o0, o1, o2, o3; float ss = 0.f;
#pragma unroll
            for (int i = 0; i < 4; ++i) { o0[i] = a0[i] + acc[i]; o1[i] = a1[i] + acc[4 + i]; o2[i] = a2[i] + acc[8 + i]; o3[i] = a3[i] + acc[12 + i]; ss += o0[i] * o0[i] + o1[i] * o1[i] + o2[i] * o2[i] + o3[i] * o3[i]; }
            bf16_t* op = (bf16_t*)(ws + WS_H2B) + (size_t)m * DM + x * 128 + p * 16;
            *(u32x4*)(op) = pack8(o0, o1); *(u32x4*)(op + 8) = pack8(o2, o3);
            ss += dpp_f<0xB1>(ss); ss += dpp_f<0x4E>(ss); ss += dpp_f<0x141>(ss);
            if (p == 0) atomicAdd(rss2 + m, ss);
        }
    }
}
DEV void phase10c_norm(float* out, unsigned char* ws, int gtid, int gsize) {
    const float* rss2 = (const float*)(ws + WS_RSS2); const float* nf = (const float*)(ws + WS_PAR) + PAR_NF; const bf16_t* h2 = (const bf16_t*)(ws + WS_H2B);
    for (int i = gtid; i < T * DM / 8; i += gsize) { const int m = i >> 7, c8 = i & 127; const float r2 = rsqrtf(rss2[m] * (1.0f / DM) + EPS); const f32x4 g0 = ((const f32x4*)nf)[2 * c8], g1 = ((const f32x4*)nf)[2 * c8 + 1];
        f32x4 a, b; unpack8(((const u32x4*)h2)[i], a, b); ((f32x4*)out)[2 * i] = a * r2 * g0; ((f32x4*)out)[2 * i + 1] = b * r2 * g1; }
}
#endif

#define XB_TMO      128
#define XB_XCNT(j)  (256  + 64 * (j))
#define XB_XSUB(j)  (1280 + 64 * (j))
#define XB_XGEN(j)  (2304 + 64 * (j))
#define XB_TOP      3328
#define XB_TOPGEN   3392
#define XCD_BAR_WORDS 3456
#define XB_SPIN_CAP (1u << 20)
DEV unsigned xb_ld(unsigned* p)              { return __hip_atomic_load(p, __ATOMIC_RELAXED, __HIP_MEMORY_SCOPE_AGENT); }
DEV unsigned xb_add(unsigned* p, unsigned v) { return __hip_atomic_fetch_add(p, v, __ATOMIC_RELAXED, __HIP_MEMORY_SCOPE_AGENT); }
DEV unsigned xb_xcc_id() { return (unsigned)__builtin_amdgcn_s_getreg((3 << 11) | 20) & 0xFu; }
#define XB_SPIN(cond, bar) do { unsigned _sp = 0; while (cond) { __builtin_amdgcn_s_sleep(1); \
    if ((++_sp & 255u) == 0u) { if (xb_ld(&(bar)[XB_TMO])) break; if (_sp > XB_SPIN_CAP) { atomicAdd(&(bar)[XB_TMO], 1u); break; } } } } while (0)
struct XcdBarrier { unsigned* bar; unsigned x; volatile LAS unsigned* st; };
DEV XcdBarrier xcd_barrier_post(unsigned* bar, volatile LAS unsigned* st) {
    XcdBarrier b; b.bar = bar; b.x = xb_xcc_id(); b.st = st;
    if (threadIdx.x == 0) (void)xb_add(&bar[XB_XCNT(b.x)], 1u);
    return b;
}
DEV void xcd_barrier_complete(unsigned* bar, unsigned x, unsigned& nloc, unsigned& nx) {
    const unsigned G = gridDim.x * gridDim.y * gridDim.z;
    unsigned sum, cnt, mine, sp = 0u;
    for (;;) {
        sum = 0u; cnt = 0u; mine = 0u;
#pragma unroll
        for (unsigned j = 0; j < 16; ++j) { const unsigned c = xb_ld(&bar[XB_XCNT(j)]); sum += c; cnt += (c > 0u) ? 1u : 0u; mine = (j == x) ? c : mine; }
        if (sum == G) break;
        __builtin_amdgcn_s_sleep(1);
        if ((++sp & 255u) == 0u) { if (xb_ld(&bar[XB_TMO])) break; if (sp > XB_SPIN_CAP) { atomicAdd(&bar[XB_TMO], 1u); break; } }
    }
    nloc = mine > 0u ? mine : 1u; nx = cnt > 0u ? cnt : 1u;
}
DEV void xcd_barrier(const XcdBarrier& b) {
    asm volatile("s_waitcnt vmcnt(0)" ::: "memory");
    __syncthreads();
    if (threadIdx.x == 0) {
        unsigned* bar = b.bar;
        __builtin_amdgcn_s_waitcnt(0);
        unsigned nloc = b.st[0], nx = b.st[1];
        if (nloc == 0u) { xcd_barrier_complete(bar, b.x, nloc, nx); b.st[0] = nloc; b.st[1] = nx; }
        const unsigned old = xb_add(&bar[XB_XSUB(b.x)], 1u);
        const unsigned gen = old / nloc;
        if (old + 1u == (gen + 1u) * nloc) {
            __builtin_amdgcn_fence(__ATOMIC_RELEASE, "agent");
            asm volatile("s_waitcnt vmcnt(0)" ::: "memory");
            const unsigned og = xb_add(&bar[XB_TOP], 1u);
            const unsigned tg = og / nx;
            if (og + 1u == (tg + 1u) * nx) xb_add(&bar[XB_TOPGEN], 1u);
            else XB_SPIN(xb_ld(&bar[XB_TOPGEN]) == tg, bar);
            __builtin_amdgcn_fence(__ATOMIC_ACQUIRE, "agent");
            xb_add(&bar[XB_XGEN(b.x)], 1u);
            asm volatile("s_waitcnt vmcnt(0)" ::: "memory");
        } else {
            XB_SPIN(xb_ld(&bar[XB_XGEN(b.x)]) == gen, bar);
            __builtin_amdgcn_fence(__ATOMIC_ACQUIRE, "agent");
            asm volatile("s_waitcnt vmcnt(0)" ::: "memory");
        }
    }
    __syncthreads();
}
constexpr int LDS_BYTES = 147456;
constexpr int CW_BAR = 4096;

__global__ void __launch_bounds__(NTHR, 2) fwd_kernel(Args a) {
    extern __shared__ __attribute__((aligned(16))) unsigned char lds_raw[];
    float* lds = (float*)lds_raw;
    PG8_LAS unsigned char* ldsl = (PG8_LAS unsigned char*)lds_raw;
    unsigned char* ws = a.ws;
    const int wg = blockIdx.x, nwg = gridDim.x, gtid = wg * NTHR + threadIdx.x, gsize = nwg * NTHR;
    volatile LAS unsigned* misc = (volatile LAS unsigned*)((LAS unsigned char*)lds_raw + LDSCTL_OFF);
    if (threadIdx.x < 64) misc[threadIdx.x] = 0u;
    __syncthreads();
    XcdBarrier bar = xcd_barrier_post((unsigned*)(ws + WS_CTL) + CW_BAR, misc + 8);
#if PROBE_PH >= 0
    const int abl = a.ph_lo >> 8, phlo = a.ph_lo & 255;
#else
    constexpr int abl = 0; const int phlo = a.ph_lo;
#endif
#define PH(k) if (phlo <= (k) && (k) < a.ph_hi)
#define SEAM(k) if (phlo <= (k) && (k) + 1 < a.ph_hi) xcd_barrier(bar)
    const float* par = (const float*)(ws + WS_PAR);
#if OPT_P0
    PH(0) { phase0_opt(a, ws, (LAS float*)lds_raw, gtid, gsize); }
#else
    PH(0) { phase0(a, ws, gtid, gsize); }
#endif
    SEAM(0);
    PH(1) {
#if (OPT_GEMM >> 1) & 1
            SchedStd S; S.init(T, NIN, nwg, wg, 1024, 1024); Epi1V E{(bf16_t*)(ws + WS_PRAW), (bf16_t*)(ws + WS_UC), (bf16_t*)(ws + WS_GATES), par + PAR_BG};
            gemm_phase<Epi1V, SchedStd, true, true>(ldsl, Gemm{(const bf16_t*)(ws + WS_XN), (const bf16_t*)(ws + WS_WIN), 1024, 1024, 1024}, S, E);
#else
            Epi1 E{(bf16_t*)(ws + WS_PRAW), (bf16_t*)(ws + WS_UC), (bf16_t*)(ws + WS_GATES), par + PAR_BG};
            gemm_naive<Epi1, false>(lds, (const bf16_t*)(ws + WS_XN), 1024, (const bf16_t*)(ws + WS_WIN), 1024, T, NIN, 1024, E, wg, nwg);
#endif
            }
    SEAM(1);
    PH(2) { phase2_prep(ws, gtid, gsize);
#if OPT_P0
            phase2_ybt(ws, gtid, gsize);
#endif
#if (OPT_GEMM >> 2) & 1
            __syncthreads();
            SchedGrp S{nwg, wg, 384, (size_t)2048 * 384, (size_t)256 * 256}; EpiEV E{(float*)(ws + WS_E)};
            gemm_phase<EpiEV, SchedGrp, true, true>(ldsl, Gemm{(const bf16_t*)(ws + WS_UC), (const bf16_t*)(ws + WS_EBT), 384, 256, 256}, S, E);
#else
            for (int g = 0; g < 32; ++g) { EpiE E{(float*)(ws + WS_E) + (size_t)g * 2048 * 128};
                gemm_naive<EpiE, false>(lds, (const bf16_t*)(ws + WS_UC) + (size_t)g * 2048 * 384, 384, (const bf16_t*)(ws + WS_EBT) + (size_t)g * 256 * 256, 256, 2048, 128, 256, E, wg, nwg); }
#endif
            }
    SEAM(2);
    PH(3) { phase3_scan_seg(ws, (LAS float*)lds_raw, wg, nwg);
#if OPT_WKV >= 4
            if (OPT_WKV != 6 || nwg != 256) phase3_invn(ws, gtid, gsize);
#endif
#if (OPT_GEMM >> 3) & 1
            __syncthreads();
            SchedStd S; S.init(T, 1536, nwg, wg, 256, 256); EpiLoraV E{(bf16_t*)(ws + WS_DD), (bf16_t*)(ws + WS_AA), (bf16_t*)(ws + WS_GR), par + PAR_W0, par + PAR_A0};
            gemm_phase<EpiLoraV, SchedStd, true, true>(ldsl, Gemm{(const bf16_t*)(ws + WS_A2), (const bf16_t*)(ws + WS_BLK), 256, 256, 256}, S, E);
#else
            EpiLora E{(bf16_t*)(ws + WS_DD), (bf16_t*)(ws + WS_AA), (bf16_t*)(ws + WS_GR), par + PAR_W0, par + PAR_A0};
            gemm_naive<EpiLora, false>(lds, (const bf16_t*)(ws + WS_A2), 256, (const bf16_t*)(ws + WS_BLK), 256, T, 1536, 256, E, wg, nwg);
#endif
            }
    SEAM(3);
    PH(4) {
#if (OPT_GEMM >> 4) & 1
            if (!(abl & 32)) { SchedGrp S{nwg, wg, 384, (size_t)2048 * 384, (size_t)256 * 384}; EpiYV E{(bf16_t*)(ws + WS_YS)};
              gemm_phase<EpiYV, SchedGrp, true, true>(ldsl, Gemm{(const bf16_t*)(ws + WS_UC), (const bf16_t*)(ws + WS_YBT), 384, 384, 384}, S, E); }
            __syncthreads();
#else
            for (int g = 0; g < 32; ++g) { EpiY E{(bf16_t*)(ws + WS_YS), g};
                gemm_naive<EpiY, false>(lds, (const bf16_t*)(ws + WS_UC) + (size_t)g * 2048 * 384, 384, (const bf16_t*)(ws + WS_YBT) + (size_t)g * 256 * 384, 384, 2048, 256, 384, E, wg, nwg); }
#endif
#if OPT_WKV == 6
#if W6_ABL
            if (nwg == 256) { phase4_wkv6(ws, (unsigned char*)a.out, (LAS float*)lds_raw, wg, a.in[I_PU], a.in[I_PV], a.in[I_NORM_FFN], bar); xcd_barrier(bar); phase4_wkv4(ws, (LAS float*)lds_raw, wg, nwg, a.in[I_PU], a.in[I_PV], a.in[I_NORM_FFN], 0); }
#else
            if (nwg == 256) phase4_wkv6(ws, (unsigned char*)a.out, (LAS float*)lds_raw, wg, a.in[I_PU], a.in[I_PV], a.in[I_NORM_FFN], bar);
#endif
            else phase4_wkv4(ws, (LAS float*)lds_raw, wg, nwg, a.in[I_PU], a.in[I_PV], a.in[I_NORM_FFN], 0); }
#elif OPT_WKV == 4
            phase4_wkv4(ws, (LAS float*)lds_raw, wg, nwg, a.in[I_PU], a.in[I_PV], a.in[I_NORM_FFN], abl); }
#elif OPT_WKV == 3
            phase4_wkv3(ws, (LAS float*)lds_raw, wg, nwg, a.in[I_PU], a.in[I_PV], a.in[I_NORM_FFN]); }
#elif OPT_WKV == 2
            phase4_wkv2(ws, (LAS float*)lds_raw, wg, nwg, a.in[I_PU], a.in[I_PV], a.in[I_NORM_FFN]); }
#elif OPT_WKV
            phase4_wkv_opt(ws, (LAS float*)lds_raw, wg, nwg, a.in[I_PU], a.in[I_PV], a.in[I_NORM_FFN]); }
#else
            phase4_wkv(ws, wg, nwg); }
#endif
    SEAM(4);
    PH(5) {
#if OPT_WKV == 6
            if (nwg == 256) phase5_post_b(ws, gtid >> 6, gsize >> 6, W6_TPOST, SEQ);
            else
#endif
            phase5_post_opt(ws, gtid, gsize);
#if (OPT_GEMM >> 5) & 1
            __syncthreads();
            SchedStd S; S.init(T, 2048, nwg, wg, 512, 512); EpiGluV E{(bf16_t*)(ws + WS_GATES)};
            gemm_phase<EpiGluV, SchedStd, true, true>(ldsl, Gemm{(const bf16_t*)(ws + WS_YS), (const bf16_t*)(ws + WS_WGLU), 512, 512, 512}, S, E);
#else
            EpiGlu E{(bf16_t*)(ws + WS_GATES)};
            gemm_naive<EpiGlu, true>(lds, (const bf16_t*)(ws + WS_YS), 512, (const bf16_t*)(ws + WS_WGLU), 512, T, 1024, 512, E, wg, nwg);
#endif
            }
    SEAM(5);
    PH(6) {
#if (OPT_GEMM >> 6) & 1
            SchedStd S; S.init(T, 1024, nwg, wg, 512, 512); EpiYaV E{(bf16_t*)(ws + WS_GATES)};
            gemm_phase<EpiYaV, SchedStd, true, true>(ldsl, Gemm{(const bf16_t*)(ws + WS_YO), (const bf16_t*)(ws + WS_WO), 512, 512, 512}, S, E);
#else
            EpiYa E{(bf16_t*)(ws + WS_GATES)};
            gemm_naive<EpiYa, false>(lds, (const bf16_t*)(ws + WS_YO), 512, (const bf16_t*)(ws + WS_WO), 512, T, 1024, 512, E, wg, nwg);
#endif
            }
    SEAM(6);
    PH(7) {
#if (OPT_GEMM >> 7) & 1
            SchedStd S; S.init(T, 1024, nwg, wg, 2048, 1024); EpiOutV E{a.in[I_X], (bf16_t*)(ws + WS_H1B), (float*)(ws + WS_RSS), ws + WS_X8};
            gemm_phase<EpiOutV, SchedStd, true, true>(ldsl, Gemm{(const bf16_t*)(ws + WS_GATES), (const bf16_t*)(ws + WS_WOUT), 2048, 1024, 1024}, S, E);
#else
            EpiOut E{a.in[I_X], (bf16_t*)(ws + WS_H1B), (float*)(ws + WS_RSS)};
            gemm_naive<EpiOut, false>(lds, (const bf16_t*)(ws + WS_GATES), 2048, (const bf16_t*)(ws + WS_WOUT), 1024, T, 1024, 1024, E, wg, nwg);
#endif
            }
    SEAM(7);
    PH(8) {
#if !(OPT_PEER == 2 && OPT_WKV)
            phase8_tables(a.in[I_PU], a.in[I_PV], a.in[I_NORM_FFN], ws, gtid, gsize);
#endif
#if (OPT_GEMM >> 8) & 1
            __syncthreads();
            SchedStd S; S.init(T, 1024, nwg, wg, 1024, 1024); EpiQV E{(bf16_t*)(ws + WS_Q), (const float*)(ws + WS_RSS)};
            gemm_phase<EpiQV, SchedStd, true, true>(ldsl, Gemm{(const bf16_t*)(ws + WS_H1B), (const bf16_t*)(ws + WS_WQ), 1024, 1024, 1024}, S, E);
#else
            EpiQ E{(bf16_t*)(ws + WS_Q), (const float*)(ws + WS_RSS)};
            gemm_naive<EpiQ, false>(lds, (const bf16_t*)(ws + WS_H1B), 1024, (const bf16_t*)(ws + WS_WQ), 1024, T, 1024, 1024, E, wg, nwg);
#endif
            }
    SEAM(8);
#if OPT_TOPK
    PH(9) { phase9_topk_opt(ws, (LAS unsigned char*)lds_raw, wg, nwg, a.in[I_PU], a.in[I_PV], a.in[I_NORM_FFN]); }
#else
    PH(9) { phase9_topk(ws, lds, gtid, gsize); }
#endif
    SEAM(9);
#if OPT_PEER == 2
    PH(10) { phase10a_part(ws, (LAS float*)lds_raw, wg, nwg); }
    SEAM(10);
    PH(11) { phase10r_reduce(ws, gtid, gsize); }
    SEAM(11);
    PH(12) { phase10b_out(a.out, ws, (LAS float*)lds_raw, wg, nwg); }
    SEAM(12);
    PH(13) { phase10c_norm(a.out, ws, gtid, gsize); }
#elif OPT_PEER
    PH(10) { phase10_peer_opt(a.out, ws, gtid, gsize); }
#else
    PH(10) { phase10_peer(a.out, ws, gtid, gsize); }
#endif
#undef PH
#undef SEAM
}

extern "C" void kernel_launch(void* const* d_in, const int* in_sizes, int n_in, void* d_out, int out_size, void* d_ws, size_t ws_size, hipStream_t stream) {
    if (n_in != N_INPUTS || out_size != T * DM || ws_size < WS_END) { fprintf(stderr, "kernel_launch: unexpected shapes (n_in %d, out %d, ws %zu)\n", n_in, out_size, ws_size); return; }
    (void)in_sizes;
    static int grid = 0;
    if (grid == 0) {
        int dev = 0, cus = 0, per_cu = 0;
        if (hipGetDevice(&dev) != hipSuccess || hipDeviceGetAttribute(&cus, hipDeviceAttributeMultiprocessorCount, dev) != hipSuccess) { fprintf(stderr, "kernel_launch: device query failed\n"); grid = -1; return; }
        if (hipFuncSetAttribute((const void*)fwd_kernel, hipFuncAttributeMaxDynamicSharedMemorySize, LDS_BYTES) != hipSuccess) { fprintf(stderr, "kernel_launch: hipFuncSetAttribute failed\n"); grid = -1; return; }
        if (hipOccupancyMaxActiveBlocksPerMultiprocessor(&per_cu, (const void*)fwd_kernel, NTHR, LDS_BYTES) != hipSuccess || per_cu < 1) { fprintf(stderr, "kernel_launch: occupancy query says %d blocks per CU\n", per_cu); (void)hipGetLastError(); }
        grid = cus;
    }
    if (grid < 0) return;
    if (hipMemsetAsync((char*)d_ws + WS_CTL, 0, CTL_BYTES, stream) != hipSuccess) { fprintf(stderr, "kernel_launch: memset failed\n"); return; }
    Args a{};
    for (int i = 0; i < N_INPUTS; ++i) a.in[i] = (const float*)d_in[i];
    a.out = (float*)d_out; a.ws = (unsigned char*)d_ws; a.ph_lo = 0; a.ph_hi = 14;
    void* kargs[] = {&a};
    hipError_t e = hipLaunchCooperativeKernel((const void*)fwd_kernel, dim3(grid), dim3(NTHR), kargs, LDS_BYTES, stream);
    if (e != hipSuccess) { fprintf(stderr, "kernel_launch: cooperative launch failed: %s (grid %d)\n", hipGetErrorString(e), grid); }
#if PROBE_PH >= 0
    a.ph_lo = PROBE_PH | (PROBE_ABL << 8); a.ph_hi = PROBE_PH + 1; (void)hipLaunchCooperativeKernel((const void*)fwd_kernel, dim3(grid), dim3(NTHR), kargs, LDS_BYTES, stream);
#endif
}
```

```cpp
#include <hip/hip_runtime.h>
#include <cstdio>
#include <cstdint>

#define DEV __device__ __forceinline__
#define LAS __attribute__((address_space(3)))
typedef unsigned short bf16_t;
typedef float f32x4 __attribute__((ext_vector_type(4)));
typedef float f32x2 __attribute__((ext_vector_type(2)));
typedef unsigned u32x4 __attribute__((ext_vector_type(4)));
typedef unsigned u32x2 __attribute__((ext_vector_type(2)));

#ifndef PROBE_ABL
#define PROBE_ABL 0
#endif
#ifndef PROBE_PH
#define PROBE_PH -1
#endif
#ifndef PEER_CH
#define PEER_CH 8
#endif
#ifndef OPT_P0
#define OPT_P0 1
#endif
#ifndef OPT_TOPK
#define OPT_TOPK 1
#endif
#ifndef OPT_PEER
#define OPT_PEER 2
#endif
#ifndef TAB_FP8
#define TAB_FP8 1
#endif
#ifndef W6_ABL
#define W6_ABL 0
#endif
#ifndef OPT_WKV
#define OPT_WKV 6
#endif
#ifndef OPT_GEMM
#define OPT_GEMM 0x1FE
#endif
constexpr int T = 32768, SEQ = 4096, NB = 8, DM = 1024;
constexpr int NIN = 4352, NRW = 1792;
constexpr int NTHR = 512;
constexpr float EPS = 1e-6f;

constexpr int LDSCTL_OFF = 147456 - 256;
constexpr size_t MiB = 1u << 20;
constexpr size_t WS_CTL = 0, CTL_BYTES = 1 * MiB;
constexpr size_t WS_RSS = 512 * 1024;
constexpr size_t WS_WIN = 1 * MiB;
constexpr size_t WS_BLK = 10 * MiB;
constexpr size_t WS_EBT = 11 * MiB;
constexpr size_t WS_YBT = 15 * MiB;
constexpr size_t WS_WGLU = 21 * MiB;
constexpr size_t WS_WO = 23 * MiB;
constexpr size_t WS_WOUT = 24 * MiB;
constexpr size_t WS_WQ = 26 * MiB;
constexpr size_t WS_SK = 28 * MiB;
constexpr size_t WS_PAR = 29 * MiB;
constexpr int PAR_MU = 0, PAR_W0 = 1792, PAR_A0 = 2304, PAR_KK = 2816, PAR_KA = 3328, PAR_RK = 3840, PAR_LNW = 4352, PAR_LNB = 4864, PAR_BG = 5376, PAR_NF = 7424, PAR_LAM16 = 8448, PAR_END = 12544;
constexpr size_t WS_INVN = 31 * MiB;
constexpr size_t WS_XN = 32 * MiB;
constexpr size_t WS_E = 32 * MiB;
constexpr size_t WS_A2 = 64 * MiB;
constexpr size_t WS_YS = 32 * MiB;
constexpr size_t WS_YO = 208 * MiB;
constexpr size_t WS_H1B = 96 * MiB;
constexpr size_t WS_PRAW = 96 * MiB;
constexpr size_t WS_UC = 208 * MiB;
constexpr size_t WS_GATES = 256 * MiB;
constexpr size_t WS_DD = 384 * MiB;
constexpr size_t WS_AA = 416 * MiB;
constexpr size_t WS_GR = 448 * MiB;
constexpr size_t WS_YR = 480 * MiB;
constexpr size_t WS_Q = 384 * MiB;
constexpr size_t WS_IDS = 448 * MiB;
constexpr size_t WS_GW = 464 * MiB;
#if OPT_PEER == 2
constexpr size_t WS_U16 = 64 * MiB;
constexpr size_t WS_V16 = 80 * MiB;
#else
constexpr size_t WS_U16 = 256 * MiB;
constexpr size_t WS_V16 = 288 * MiB;
#endif
constexpr size_t WS_X8 = 160 * MiB;
constexpr float X8_SCALE = 16.0f, U8_SCALE = 768.0f;
constexpr size_t WS_H2B = 192 * MiB;
constexpr size_t WS_RSS2 = 640 * 1024;
constexpr size_t WS_TCNT = 768 * 1024;
constexpr size_t WS_W2 = 480 * MiB;
constexpr size_t WS_BONUS = 1 * MiB;
constexpr size_t WS_END = 512 * MiB;
__device__ __forceinline__ size_t da_off(size_t m, int c) { const int b = (int)(m >> 12), t = (int)(m & 4095), h = c >> 6, g8 = (c >> 3) & 7;
    return ((((size_t)(b * 8 + h) * 256 + (t >> 4)) * 2 + (g8 >> 2)) * 1024 + (size_t)(((t & 15) * 4 + (g8 & 3)) * 16)) / 2 + (c & 7); }
static_assert(SEQ == 4096, "da_off assumes 4096 tokens per batch row");
constexpr int PRV = 768;
__device__ __forceinline__ size_t pr_off(size_t m, int col) { return col < 1024 ? (size_t)(col >> 9) * ((size_t)32768 * 512) + da_off(m, col & 511) : (size_t)32768 * 1024 + m * PRV + (size_t)(col - 1024); }

enum { I_X = 0, I_NORM_MIX, I_W_IN, I_B_GATE, I_MU, I_W_LORA, I_W0, I_A_LORA, I_A0, I_G_LORA, I_KK, I_KA, I_RK, I_LNW, I_LNB, I_WO,
       I_LOGDT, I_ARE, I_AIM, I_BRE, I_BIM, I_CRE, I_CIM, I_SD, I_WGLU, I_WOUT, I_NORM_FFN, I_WQ, I_SUBK, I_PU, I_PV, I_NORM_FINAL, N_INPUTS };

struct Args { const float* in[N_INPUTS]; float* out; unsigned char* ws; int ph_lo, ph_hi; };

DEV float bf2f(bf16_t h) { return __uint_as_float(((unsigned)h) << 16); }
DEV bf16_t f2bf(float f) { unsigned u = __float_as_uint(f); return (bf16_t)((u + 0x7fffu + ((u >> 16) & 1u)) >> 16); }
DEV float sigmoidf_(float x) { return 1.0f / (1.0f + __expf(-x)); }
DEV float gelu_tanh(float x) { const float u = 1.5957691216057308f * (x + 0.044715f * x * x * x); return x / (1.0f + __expf(-u)); }
DEV float wave_sum(float v) {
#pragma unroll
    for (int o = 1; o < 64; o <<= 1) v += __shfl_xor(v, o);
    return v;
}
DEV float lerp_prev(const bf16_t* praw, int m, int col, float mu) {
    const float p = bf2f(praw[pr_off((size_t)((size_t)m), col)]);
    const float pv = ((m & (SEQ - 1)) == 0) ? 0.f : bf2f(praw[pr_off((size_t)((size_t)(m - 1)), col)]);
    return p + (pv - p) * mu;
}

DEV unsigned q8(float v) { return (unsigned)__float2int_rn(fminf(fmaxf(v, -127.0f), 127.0f)) & 0xffu; }
DEV unsigned q8x4(float a, float b, float c, float d) { return q8(a) | (q8(b) << 8) | (q8(c) << 16) | (q8(d) << 24); }
template <class Epi, bool DUAL>
DEV void gemm_naive(float* lds, const bf16_t* A, int lda, const bf16_t* Bt, int ldb, int M, int N, int K, const Epi& E, int wg, int nwg) {
    float* As = lds;
    float* Bs = lds + 32 * 132;
    float* Bs2 = Bs + 32 * 68;
    const int tid = threadIdx.x, ty = tid >> 4, tx = tid & 15;
    const int ntm = M / 128, ntn = N / 64;
    for (int tile = wg; tile < ntm * ntn; tile += nwg) {
        const int m0 = (tile / ntn) * 128, n0 = (tile % ntn) * 64;
        float acc[4][4], acc2[4][4];
#pragma unroll
        for (int i = 0; i < 4; ++i)
#pragma unroll
            for (int j = 0; j < 4; ++j) { acc[i][j] = 0.f; acc2[i][j] = 0.f; }
        for (int k0 = 0; k0 < K; k0 += 32) {
            {
                const int r = tid >> 2, kc = (tid & 3) * 8;
                const u32x4 v = *(const u32x4*)(A + (size_t)(m0 + r) * lda + k0 + kc);
#pragma unroll
                for (int i = 0; i < 4; ++i) { As[(kc + 2 * i) * 132 + r] = __uint_as_float(v[i] << 16); As[(kc + 2 * i + 1) * 132 + r] = __uint_as_float(v[i] & 0xffff0000u); }
            }
            {
                const int t2 = tid & 255, r = t2 >> 2, kc = (t2 & 3) * 8;
                const int cabs = n0 + r;
                const int brow = DUAL ? ((cabs >> 7) * 256 + (cabs & 127) + ((tid >= 256) ? 128 : 0)) : cabs;
                if (DUAL || tid < 256) {
                    const u32x4 v = *(const u32x4*)(Bt + (size_t)brow * ldb + k0 + kc);
                    float* dst = (DUAL && tid >= 256) ? Bs2 : Bs;
#pragma unroll
                    for (int i = 0; i < 4; ++i) { dst[(kc + 2 * i) * 68 + r] = __uint_as_float(v[i] << 16); dst[(kc + 2 * i + 1) * 68 + r] = __uint_as_float(v[i] & 0xffff0000u); }
                }
            }
            __syncthreads();
#pragma unroll 8
            for (int kk = 0; kk < 32; ++kk) {
                const f32x4 a = *(const f32x4*)(As + kk * 132 + ty * 4);
                const f32x4 b = *(const f32x4*)(Bs + kk * 68 + tx * 4);
#pragma unroll
                for (int i = 0; i < 4; ++i)
#pragma unroll
                    for (int j = 0; j < 4; ++j) acc[i][j] += a[i] * b[j];
                if (DUAL) {
                    const f32x4 b2 = *(const f32x4*)(Bs2 + kk * 68 + tx * 4);
#pragma unroll
                    for (int i = 0; i < 4; ++i)
#pragma unroll
                        for (int j = 0; j < 4; ++j) acc2[i][j] += a[i] * b2[j];
                }
            }
            __syncthreads();
        }
#pragma unroll
        for (int i = 0; i < 4; ++i)
#pragma unroll
            for (int j = 0; j < 4; ++j) E.elem(m0 + ty * 4 + i, n0 + tx * 4 + j, acc[i][j], acc2[i][j]);
    }
}

struct Epi1 {
    bf16_t* praw; bf16_t* uc; bf16_t* gates; const float* b_gate;
    DEV void elem(int m, int n, float v, float) const {
        if (n < NRW) praw[pr_off((size_t)((size_t)m), n)] = f2bf(v);
        else if (n < NRW + 512) { const int c = n - NRW, g = c >> 4, h = c & 15; uc[((size_t)g * 2048 + (m >> 4)) * 384 + (m & 15) * 16 + h] = f2bf(v); }
        else { const int c = n - NRW - 512; gates[(size_t)m * 2048 + c] = f2bf(sigmoidf_(v + b_gate[c])); }
    }
};
struct EpiE {
    float* e;
    DEV void elem(int m, int n, float v, float) const { e[(size_t)m * 128 + n] = v; }
};
struct EpiLora {
    bf16_t* dd; bf16_t* aa; bf16_t* gr; const float* w0; const float* a0;
    DEV void elem(int m, int n, float v, float) const {
        if (n < 512) {
            const float wl = w0[n] + v, z = -wl;
            const float sp = (z > 20.f) ? z : log1pf(__expf(z));
            const float e = __expf(-sp - 0.5f);
            dd[da_off((size_t)m, n)] = f2bf(-expm1f(-e));
        } else if (n < 1024) aa[da_off((size_t)m, n - 512)] = f2bf(sigmoidf_(a0[n - 512] + v));
        else gr[(size_t)m * 512 + n - 1024] = f2bf(v);
    }
};
struct EpiY {
    bf16_t* ys; int g;
    DEV void elem(int m, int n, float v, float) const { ys[(size_t)(m * 16 + (n >> 4)) * 512 + g * 16 + (n & 15)] = f2bf(gelu_tanh(v)); }
};
struct EpiGlu {
    bf16_t* gates;
    DEV void elem(int m, int n, float v, float gt) const { bf16_t* p = gates + (size_t)m * 2048 + 1024 + n; *p = f2bf(bf2f(*p) * v * sigmoidf_(gt)); }
};
struct EpiYa {
    bf16_t* gates;
    DEV void elem(int m, int n, float v, float) const { bf16_t* p = gates + (size_t)m * 2048 + n; *p = f2bf(bf2f(*p) * v + bf2f(p[1024])); }
};
struct EpiOut {
    const float* x; bf16_t* h1b; float* rss;
    DEV void elem(int m, int n, float v, float) const { const float h = x[(size_t)m * DM + n] + v; h1b[(size_t)m * DM + n] = f2bf(h); atomicAdd(rss + m, h * h); }
};
struct EpiQ {
    bf16_t* q; const float* rss;
    DEV void elem(int m, int n, float v, float) const { q[(size_t)m * DM + n] = f2bf(v * rsqrtf(rss[m] * (1.0f / DM) + EPS)); }
};


#define PG8_LAS __attribute__((address_space(3)))
typedef short bf16x8 __attribute__((ext_vector_type(8)));
constexpr int BM = 256, BK = 64, HALF = 128, HTB = HALF * BK * 2, STAGE_BYTES = 8 * HTB, NXCD = 8, WGM = 8;
__host__ __device__ __forceinline__ int lds_byte(int r, int c) { const int st = (r >> 4) * 2 + (c >> 5), rr = r & 15, cc = c & 31, ob = rr * 64 + cc * 2; return st * 1024 + (ob ^ (((ob >> 9) & 1) << 5)); }
__host__ __device__ __forceinline__ void stage_rc(int b, int& R, int& C) { const int st = b / 1024, sb = b % 1024, swz = sb ^ (((sb >> 9) & 1) << 5); R = (st >> 1) * 16 + swz / 64; C = (st & 1) * 32 + (swz % 64) / 2; }
__host__ __device__ __forceinline__ int perm32(int rho) { const int n = rho >> 4, i = rho & 15; return 8 * (i >> 2) + 4 * n + (i & 3); }
struct Unit { int pm, pn, g; };
struct Gemm { const bf16_t* A; const bf16_t* Bt; int lda, ldb, K; };
struct SchedStd {
    int nM, nN, nwg, G, c, lda, ldb;
    DEV void init(int M, int N, int G_, int c_, int lda_, int ldb_) { nM = M / BM; nN = N / BM; nwg = nM * nN; G = G_; c = c_; lda = lda_; ldb = ldb_; }
    DEV bool next(int i, Unit& u) const {
        const long L = (long)i * G + c; if (L >= nwg) return false;
        int wgid = (int)L; { const int q = nwg / NXCD, r = nwg % NXCD, xcd = wgid % NXCD, off = wgid / NXCD; wgid = (xcd < r ? xcd * (q + 1) : r * (q + 1) + (xcd - r) * q) + off; }
        const int nig = WGM * nN, gid = wgid / nig, fm = gid * WGM, gsz = (nM - fm) < WGM ? (nM - fm) : WGM;
        u.pm = fm + ((wgid % nig) % gsz); u.pn = (wgid % nig) / gsz; u.g = 0; return true;
    }
    DEV size_t aoff(const Unit& u) const { return (size_t)u.pm * BM * lda * 2; }
    DEV size_t boff(const Unit& u) const { return (size_t)u.pn * BM * ldb * 2; }
    DEV void a_ready(const Unit&) const {}
    DEV void done(const Unit&) const {}
};
struct SchedGrp {
    int G, c, lda; size_t ags, bgs;
    DEV bool next(int i, Unit& u) const { const int L = i * G + c; if (L >= 256) return false; u.g = L >> 3; u.pm = L & 7; u.pn = 0; return true; }
    DEV size_t aoff(const Unit& u) const { return ((size_t)u.g * ags + (size_t)u.pm * BM * lda) * 2; }
    DEV size_t boff(const Unit& u) const { return (size_t)u.g * bgs * 2; }
    DEV void a_ready(const Unit&) const {}
    DEV void done(const Unit&) const {}
};
DEV unsigned cvt_pk_bf16(float lo, float hi) { unsigned r; asm volatile("v_cvt_pk_bf16_f32 %0, %1, %2" : "=v"(r) : "v"(lo), "v"(hi)); return r; }
DEV u32x4 pack8(const f32x4 a, const f32x4 b) { u32x4 w; w[0] = cvt_pk_bf16(a[0], a[1]); w[1] = cvt_pk_bf16(a[2], a[3]); w[2] = cvt_pk_bf16(b[0], b[1]); w[3] = cvt_pk_bf16(b[2], b[3]); return w; }
DEV void unpack8(const u32x4 w, f32x4& a, f32x4& b) { a[0] = __uint_as_float(w[0] << 16); a[1] = __uint_as_float(w[0] & 0xffff0000u); a[2] = __uint_as_float(w[1] << 16); a[3] = __uint_as_float(w[1] & 0xffff0000u);
    b[0] = __uint_as_float(w[2] << 16); b[1] = __uint_as_float(w[2] & 0xffff0000u); b[2] = __uint_as_float(w[3] << 16); b[3] = __uint_as_float(w[3] & 0xffff0000u); }
DEV float decay_d(float wl) {
    const float e = 0.6065306597126334f / (1.0f + __expf(-wl)); return -expm1f(-e); }

#define EPI_LOOP_AM for (int ai = 0; ai < 2; ++ai) _Pragma("unroll") for (int m = 0; m < 4; ++m)
struct Epi1V { static constexpr bool PERM = true, AFTER_DRAIN = false; bf16_t* praw; bf16_t* uc; bf16_t* gates; const float* b_gate;
    DEV void operator()(const f32x4 (&acc)[2][2][4][2], const Unit& u, int wr, int wc, int fr, int fq) const {
        const int row0 = u.pm * BM + wr * 64 + fr;
        if (u.pn < 7) {
#pragma unroll
            EPI_LOOP_AM { const int row = row0 + ai * HALF + m * 16;
#pragma unroll
                for (int bj = 0; bj < 2; ++bj) *(u32x4*)(praw + pr_off((size_t)((size_t)row), u.pn * BM + bj * HALF + wc * 32 + 8 * fq)) = pack8(acc[ai][bj][m][0], acc[ai][bj][m][1]); }
        } else if (u.pn < 9) {
#pragma unroll
            for (int bj = 0; bj < 2; ++bj) { const int c = (u.pn - 7) * BM + bj * HALF + wc * 32 + 8 * fq, g = c >> 4, h0 = c & 15;
#pragma unroll
                EPI_LOOP_AM { const int row = row0 + ai * HALF + m * 16;
                    *(u32x4*)(uc + ((size_t)g * 2048 + (row >> 4)) * 384 + (row & 15) * 16 + h0) = pack8(acc[ai][bj][m][0], acc[ai][bj][m][1]); } }
        } else {
#pragma unroll
            for (int bj = 0; bj < 2; ++bj) { const int c = (u.pn - 9) * BM + bj * HALF + wc * 32 + 8 * fq; const f32x4 b0 = *(const f32x4*)(b_gate + c), b1 = *(const f32x4*)(b_gate + c + 4);
#pragma unroll
                EPI_LOOP_AM { const int row = row0 + ai * HALF + m * 16; f32x4 v0 = acc[ai][bj][m][0] + b0, v1 = acc[ai][bj][m][1] + b1;
#pragma unroll
                    for (int i = 0; i < 4; ++i) { v0[i] = sigmoidf_(v0[i]); v1[i] = sigmoidf_(v1[i]); }
                    *(u32x4*)(gates + (size_t)row * 2048 + c) = pack8(v0, v1); } }
        }
    }
};
struct EpiLoraV { static constexpr bool PERM = true, AFTER_DRAIN = false; bf16_t* dd; bf16_t* aa; bf16_t* gr; const float* w0; const float* a0;
    DEV void operator()(const f32x4 (&acc)[2][2][4][2], const Unit& u, int wr, int wc, int fr, int fq) const {
        const int row0 = u.pm * BM + wr * 64 + fr; const int kind = u.pn >> 1;
        if (kind == 0) {
#pragma unroll
            for (int bj = 0; bj < 2; ++bj) { const int c = (u.pn & 1) * BM + bj * HALF + wc * 32 + 8 * fq; const f32x4 b0 = *(const f32x4*)(w0 + c), b1 = *(const f32x4*)(w0 + c + 4);
#pragma unroll
                EPI_LOOP_AM { const int row = row0 + ai * HALF + m * 16; f32x4 v0 = acc[ai][bj][m][0] + b0, v1 = acc[ai][bj][m][1] + b1;
#pragma unroll
                    for (int i = 0; i < 4; ++i) { v0[i] = decay_d(v0[i]); v1[i] = decay_d(v1[i]); }
                    *(u32x4*)(dd + da_off((size_t)row, c)) = pack8(v0, v1); } }
        } else if (kind == 1) {
#pragma unroll
            for (int bj = 0; bj < 2; ++bj) { const int c = (u.pn & 1) * BM + bj * HALF + wc * 32 + 8 * fq; const f32x4 b0 = *(const f32x4*)(a0 + c), b1 = *(const f32x4*)(a0 + c + 4);
#pragma unroll
                EPI_LOOP_AM { const int row = row0 + ai * HALF + m * 16; f32x4 v0 = acc[ai][bj][m][0] + b0, v1 = acc[ai][bj][m][1] + b1;
#pragma unroll
                    for (int i = 0; i < 4; ++i) { v0[i] = sigmoidf_(v0[i]); v1[i] = sigmoidf_(v1[i]); }
                    *(u32x4*)(aa + da_off((size_t)row, c)) = pack8(v0, v1); } }
        } else {
#pragma unroll
            for (int bj = 0; bj < 2; ++bj) { const int c = (u.pn & 1) * BM + bj * HALF + wc * 32 + 8 * fq;
#pragma unroll
                EPI_LOOP_AM { const int row = row0 + ai * HALF + m * 16; *(u32x4*)(gr + (size_t)row * 512 + c) = pack8(acc[ai][bj][m][0], acc[ai][bj][m][1]); } }
        }
    }
};
struct EpiEV { static constexpr bool PERM = false, AFTER_DRAIN = false; float* e;
    DEV void operator()(const f32x4 (&acc)[2][2][4][2], const Unit& u, int wr, int wc, int fr, int fq) const {
        const int row0 = u.pm * BM + wr * 64 + fr;
#pragma unroll
        EPI_LOOP_AM { float* rowp = e + ((size_t)u.g * 2048 + row0 + ai * HALF + m * 16) * 128 + wc * 32 + 4 * fq;
#pragma unroll
            for (int n = 0; n < 2; ++n) *(f32x4*)(rowp + n * 16) = acc[ai][0][m][n]; }
    }
};
struct EpiYV { static constexpr bool PERM = true, AFTER_DRAIN = false; bf16_t* ys;
    DEV void operator()(const f32x4 (&acc)[2][2][4][2], const Unit& u, int wr, int wc, int fr, int fq) const {
        const int row0 = u.pm * BM + wr * 64 + fr;
#pragma unroll
        for (int bj = 0; bj < 2; ++bj) { const int c = bj * HALF + wc * 32 + 8 * fq, s = c >> 4, h0 = c & 15;
#pragma unroll
            EPI_LOOP_AM { const int crow = row0 + ai * HALF + m * 16; f32x4 v0 = acc[ai][bj][m][0], v1 = acc[ai][bj][m][1];
#pragma unroll
                for (int i = 0; i < 4; ++i) { v0[i] = gelu_tanh(v0[i]); v1[i] = gelu_tanh(v1[i]); }
                *(u32x4*)(ys + ((size_t)crow * 16 + s) * 512 + u.g * 16 + h0) = pack8(v0, v1); } }
    }
};
struct EpiGluV { static constexpr bool PERM = true, AFTER_DRAIN = false; bf16_t* gates;
    DEV void operator()(const f32x4 (&acc)[2][2][4][2], const Unit& u, int wr, int wc, int fr, int fq) const {
        const int row0 = u.pm * BM + wr * 64 + fr; const int c = u.pn * HALF + wc * 32 + 8 * fq;
#pragma unroll
        EPI_LOOP_AM { const int row = row0 + ai * HALF + m * 16; u32x4* p = (u32x4*)(gates + (size_t)row * 2048 + 1024 + c); f32x4 g0, g1; unpack8(*p, g0, g1);
            f32x4 v0 = acc[ai][0][m][0], v1 = acc[ai][0][m][1]; const f32x4 t0 = acc[ai][1][m][0], t1 = acc[ai][1][m][1];
#pragma unroll
            for (int i = 0; i < 4; ++i) { v0[i] = g0[i] * v0[i] * sigmoidf_(t0[i]); v1[i] = g1[i] * v1[i] * sigmoidf_(t1[i]); }
            *p = pack8(v0, v1); }
    }
};
struct EpiYaV { static constexpr bool PERM = true, AFTER_DRAIN = false; bf16_t* gates;
    DEV void operator()(const f32x4 (&acc)[2][2][4][2], const Unit& u, int wr, int wc, int fr, int fq) const {
        const int row0 = u.pm * BM + wr * 64 + fr;
#pragma unroll
        for (int bj = 0; bj < 2; ++bj) { const int c = u.pn * BM + bj * HALF + wc * 32 + 8 * fq;
#pragma unroll
            EPI_LOOP_AM { const int row = row0 + ai * HALF + m * 16; u32x4* p = (u32x4*)(gates + (size_t)row * 2048 + c); f32x4 g0, g1, y0, y1; unpack8(*p, g0, g1); unpack8(*(const u32x4*)((const bf16_t*)p + 1024), y0, y1);
                *p = pack8(g0 * acc[ai][bj][m][0] + y0, g1 * acc[ai][bj][m][1] + y1); } }
    }
};
struct EpiOutV { static constexpr bool PERM = true, AFTER_DRAIN = false; const float* x; bf16_t* h1b; float* rss; unsigned char* x8;
    DEV void operator()(const f32x4 (&acc)[2][2][4][2], const Unit& u, int wr, int wc, int fr, int fq) const {
        const int row0 = u.pm * BM + wr * 64 + fr;
#pragma unroll
        EPI_LOOP_AM { const int row = row0 + ai * HALF + m * 16; float s = 0.f;
#pragma unroll
            for (int bj = 0; bj < 2; ++bj) { const int c = u.pn * BM + bj * HALF + wc * 32 + 8 * fq; const f32x4 h0 = *(const f32x4*)(x + (size_t)row * DM + c) + acc[ai][bj][m][0], h1 = *(const f32x4*)(x + (size_t)row * DM + c + 4) + acc[ai][bj][m][1];
                *(u32x4*)(h1b + (size_t)row * DM + c) = pack8(h0, h1);
                *(u32x2*)(x8 + (size_t)row * DM + c) = (u32x2){q8x4(h0[0] * X8_SCALE, h0[1] * X8_SCALE, h0[2] * X8_SCALE, h0[3] * X8_SCALE), q8x4(h1[0] * X8_SCALE, h1[1] * X8_SCALE, h1[2] * X8_SCALE, h1[3] * X8_SCALE)};
                s += h0[0] * h0[0] + h0[1] * h0[1] + h0[2] * h0[2] + h0[3] * h0[3] + h1[0] * h1[0] + h1[1] * h1[1] + h1[2] * h1[2] + h1[3] * h1[3]; }
            s += __shfl_xor(s, 16); s += __shfl_xor(s, 32);
            if (fq == 0) atomicAdd(rss + row, s); }
    }
};
struct EpiQV { static constexpr bool PERM = true, AFTER_DRAIN = false; bf16_t* q; const float* rss;
    DEV void operator()(const f32x4 (&acc)[2][2][4][2], const Unit& u, int wr, int wc, int fr, int fq) const {
        const int row0 = u.pm * BM + wr * 64 + fr;
#pragma unroll
        EPI_LOOP_AM { const int row = row0 + ai * HALF + m * 16; const float rstd = rsqrtf(rss[row] * (1.0f / DM) + EPS);
#pragma unroll
            for (int bj = 0; bj < 2; ++bj) *(u32x4*)(q + (size_t)row * DM + u.pn * BM + bj * HALF + wc * 32 + 8 * fq) = pack8(acc[ai][bj][m][0] * rstd, acc[ai][bj][m][1] * rstd); }
    }
};

template <class Epi, class Sched, bool ALIGN_EPI = false, bool SP2 = false>
__device__ __forceinline__ void gemm_phase(PG8_LAS unsigned char* lds, const Gemm g, const Sched& S, const Epi& E) {
    const int tid = threadIdx.x, wid = __builtin_amdgcn_readfirstlane(tid >> 6), lane = tid & 63, wr = wid >> 2, wc = wid & 3, fr = lane & 15, fq = lane >> 4;
    const int K = g.K, nt = K / BK;
    unsigned voffA[2], voffB[2];
#pragma unroll
    for (int i = 0; i < 2; ++i) { int R, C; stage_rc(tid * 16 + i * 8192, R, C); const int Rb = Epi::PERM ? ((R & ~31) + perm32(R & 31)) : R;
        voffA[i] = (unsigned)(R * g.lda + C) * 2u; voffB[i] = (unsigned)(Rb * g.ldb + C) * 2u; }
    const size_t kstep = (size_t)(BK * 2);
    const size_t hstepA = (size_t)HALF * g.lda * 2, hstepB = (size_t)HALF * g.ldb * 2;
    const unsigned ldsw = (unsigned)wid * 1024u;
    const int aoff = lds_byte(wr * 64 + fr, fq * 8), boff = lds_byte(wc * 32 + fr, fq * 8);
#define PG8_SA(b, h) (((b) * 2 + (h)) * HTB)
#define PG8_SB(b, h) ((4 + (b) * 2 + (h)) * HTB)
#define PG8_STAGE(bufoff, gbase, voff) do { _Pragma("unroll") for (int _i = 0; _i < 2; ++_i) \
        __builtin_amdgcn_global_load_lds((const unsigned*)((const char*)(gbase) + (voff)[_i]), (PG8_LAS unsigned*)(lds + (bufoff) + ldsw + _i * 8192), 16, 0, 0); } while (0)
#define PG8_LDA(dst, b, h) do { _Pragma("unroll") for (int m = 0; m < 4; ++m) _Pragma("unroll") for (int k = 0; k < 2; ++k) dst[m][k] = *(const PG8_LAS bf16x8*)(lds + PG8_SA(b, h) + aoff + m * 2048 + k * 1024); } while (0)
#define PG8_LDB(dst, b, h) do { _Pragma("unroll") for (int n = 0; n < 2; ++n) _Pragma("unroll") for (int k = 0; k < 2; ++k) dst[n][k] = *(const PG8_LAS bf16x8*)(lds + PG8_SB(b, h) + boff + n * 2048 + k * 1024); } while (0)
#define PG8_MMA(ai, bj, At, Bt) do { __builtin_amdgcn_s_setprio(1); _Pragma("unroll") for (int m = 0; m < 4; ++m) _Pragma("unroll") for (int n = 0; n < 2; ++n) _Pragma("unroll") for (int k = 0; k < 2; ++k) \
        acc[ai][bj][m][n] = __builtin_amdgcn_mfma_f32_16x16x32_bf16(Bt[n][k], At[m][k], acc[ai][bj][m][n], 0, 0, 0); __builtin_amdgcn_s_setprio(0); } while (0)
#define PG8_WAIT_V(n) asm volatile("s_waitcnt vmcnt(" #n ")" ::: "memory")
#define PG8_WAIT_L(n) asm volatile("s_waitcnt lgkmcnt(" #n ")" ::: "memory")
#define PG8_BAR __builtin_amdgcn_s_barrier()
#define PG8_SCHED __builtin_amdgcn_sched_barrier(0)
    Unit cur, nxt; int ui = 0;
    if (!S.next(0, cur)) return;
    f32x4 acc[2][2][4][2];
#pragma unroll
    for (int a = 0; a < 2; ++a)
#pragma unroll
        for (int b = 0; b < 2; ++b)
#pragma unroll
            for (int m = 0; m < 4; ++m)
#pragma unroll
                for (int n = 0; n < 2; ++n) acc[a][b][m][n] = (f32x4){0.f, 0.f, 0.f, 0.f};
    bf16x8 At[4][2], B0[2][2], B1[2][2];
    const char* cA = (const char*)g.A + S.aoff(cur); const char* cB = (const char*)g.Bt + S.boff(cur);
    S.a_ready(cur);
    if constexpr (SP2) {
        PG8_STAGE(PG8_SB(0, 0), cB, voffB); PG8_STAGE(PG8_SB(0, 1), cB + hstepB, voffB); PG8_STAGE(PG8_SA(0, 0), cA, voffA); PG8_STAGE(PG8_SA(0, 1), cA + hstepA, voffA);
        if (wr == 1) PG8_BAR;
        PG8_WAIT_V(2); PG8_BAR;
        PG8_STAGE(PG8_SB(1, 0), cB + kstep, voffB); PG8_STAGE(PG8_SA(1, 0), cA + kstep, voffA); PG8_STAGE(PG8_SB(1, 1), cB + hstepB + kstep, voffB);
        PG8_WAIT_V(6); PG8_BAR;
    } else {
        PG8_STAGE(PG8_SB(0, 0), cB, voffB); PG8_STAGE(PG8_SA(0, 0), cA, voffA); PG8_STAGE(PG8_SB(0, 1), cB + hstepB, voffB); PG8_STAGE(PG8_SA(0, 1), cA + hstepA, voffA);
        if (wr == 1) PG8_BAR;
        PG8_WAIT_V(4); PG8_BAR;
        PG8_STAGE(PG8_SB(1, 0), cB + kstep, voffB); PG8_STAGE(PG8_SA(1, 0), cA + kstep, voffA); PG8_STAGE(PG8_SB(1, 1), cB + hstepB + kstep, voffB);
        PG8_WAIT_V(6); PG8_BAR;
    }
    for (;;) {
        const bool has_next = S.next(ui + 1, nxt);
        const char* nA = has_next ? (const char*)g.A + S.aoff(nxt) : cA; const char* nB = has_next ? (const char*)g.Bt + S.boff(nxt) : cB;
#pragma unroll 1
        for (int t = 0; t < nt; t += 2) {
            const bool last = (t == nt - 2);
            const char* a1 = cA + (size_t)(t + 1) * kstep;
            const char* a2 = last ? nA : cA + (size_t)(t + 2) * kstep; const char* b2 = last ? nB : cB + (size_t)(t + 2) * kstep;
            const char* a3 = a2 + kstep; const char* b3 = b2 + kstep;
            if (last && has_next) S.a_ready(nxt);
            if constexpr (SP2) {
            PG8_LDB(B0, 0, 0); PG8_LDB(B1, 0, 1); PG8_SCHED; PG8_LDA(At, 0, 0); PG8_STAGE(PG8_SA(1, 1), a1 + hstepA, voffA);
            PG8_WAIT_V(8); PG8_WAIT_L(0); PG8_BAR; PG8_MMA(0, 0, At, B0); PG8_MMA(0, 1, At, B1); PG8_BAR; PG8_SCHED;
            PG8_LDA(At, 0, 1); PG8_STAGE(PG8_SB(0, 0), b2, voffB); PG8_STAGE(PG8_SB(0, 1), b2 + hstepB, voffB); PG8_STAGE(PG8_SA(0, 0), a2, voffA);
            PG8_WAIT_V(8); PG8_WAIT_L(0); PG8_BAR; PG8_MMA(1, 0, At, B0); PG8_MMA(1, 1, At, B1); PG8_BAR; PG8_SCHED;
            PG8_LDB(B0, 1, 0); PG8_LDB(B1, 1, 1); PG8_SCHED; PG8_LDA(At, 1, 0); PG8_STAGE(PG8_SA(0, 1), a2 + hstepA, voffA);
            PG8_WAIT_V(8); PG8_WAIT_L(0); PG8_BAR; PG8_MMA(0, 0, At, B0); PG8_MMA(0, 1, At, B1); PG8_BAR; PG8_SCHED;
            PG8_LDA(At, 1, 1); PG8_STAGE(PG8_SB(1, 0), b3, voffB); PG8_STAGE(PG8_SB(1, 1), b3 + hstepB, voffB); PG8_STAGE(PG8_SA(1, 0), a3, voffA);
            PG8_WAIT_V(8); PG8_WAIT_L(0); PG8_BAR; PG8_MMA(1, 0, At, B0); PG8_MMA(1, 1, At, B1); PG8_BAR; PG8_SCHED;
            } else {
            PG8_LDB(B0, 0, 0); PG8_SCHED; PG8_LDA(At, 0, 0); PG8_STAGE(PG8_SA(1, 1), a1 + hstepA, voffA);
            PG8_WAIT_L(8); PG8_BAR; PG8_WAIT_L(0); PG8_MMA(0, 0, At, B0); PG8_BAR; PG8_SCHED;
            PG8_LDB(B1, 0, 1); PG8_STAGE(PG8_SB(0, 0), b2, voffB);
            PG8_BAR; PG8_WAIT_L(0); PG8_MMA(0, 1, At, B1); PG8_BAR;
            PG8_LDA(At, 0, 1); PG8_STAGE(PG8_SA(0, 0), a2, voffA);
            PG8_BAR; PG8_WAIT_L(0); PG8_MMA(1, 0, At, B0); PG8_BAR; PG8_SCHED;
            PG8_STAGE(PG8_SB(0, 1), b2 + hstepB, voffB);
            PG8_WAIT_V(6); PG8_BAR; PG8_MMA(1, 1, At, B1); PG8_BAR;
            PG8_LDB(B0, 1, 0); PG8_SCHED; PG8_LDA(At, 1, 0); PG8_STAGE(PG8_SA(0, 1), a2 + hstepA, voffA);
            PG8_WAIT_L(8); PG8_BAR; PG8_WAIT_L(0); PG8_MMA(0, 0, At, B0); PG8_BAR; PG8_SCHED;
            PG8_LDB(B1, 1, 1); PG8_STAGE(PG8_SB(1, 0), b3, voffB);
            PG8_BAR; PG8_WAIT_L(0); PG8_MMA(0, 1, At, B1); PG8_BAR;
            PG8_LDA(At, 1, 1); PG8_STAGE(PG8_SA(1, 0), a3, voffA);
            PG8_BAR; PG8_WAIT_L(0); PG8_MMA(1, 0, At, B0); PG8_BAR; PG8_SCHED;
            PG8_STAGE(PG8_SB(1, 1), b3 + hstepB, voffB);
            PG8_WAIT_V(6); PG8_BAR; PG8_MMA(1, 1, At, B1); PG8_BAR;
            }
        }
        if constexpr (ALIGN_EPI) { if (wr == 0) PG8_BAR; }
        if constexpr (!Epi::AFTER_DRAIN) { E(acc, cur, wr, wc, fr, fq); S.done(cur); }
        if (!has_next) break;
#pragma unroll
        for (int a = 0; a < 2; ++a)
#pragma unroll
            for (int b = 0; b < 2; ++b)
#pragma unroll
                for (int m = 0; m < 4; ++m)
#pragma unroll
                    for (int n = 0; n < 2; ++n) acc[a][b][m][n] = (f32x4){0.f, 0.f, 0.f, 0.f};
        cur = nxt; cA = nA; cB = nB; ++ui;
        if constexpr (ALIGN_EPI) { if (wr == 1) PG8_BAR; }
    }
    PG8_WAIT_V(0);
    if constexpr (!ALIGN_EPI) { if (wr == 0) PG8_BAR; }
    PG8_BAR;
    if constexpr (Epi::AFTER_DRAIN) { E.fused(acc, cur, wr, wc, fr, fq, lds, wid, lane); S.done(cur); }
#undef PG8_SA
#undef PG8_SB
#undef PG8_STAGE
#undef PG8_LDA
#undef PG8_LDB
#undef PG8_MMA
#undef PG8_WAIT_V
#undef PG8_WAIT_L
#undef PG8_BAR
#undef PG8_SCHED
}

struct S5p { float lr, li, fr, fi, adt, idt; };
DEV S5p s5_param(const Args& a, int g, int p) {
    S5p o; const float dt = __expf(a.in[I_LOGDT][g]); const float are = a.in[I_ARE][g * 64 + p], aim = a.in[I_AIM][g * 64 + p];
    o.adt = are * dt; o.idt = aim * dt;
    const float mag = __expf(o.adt); float s, c; sincosf(o.idt, &s, &c);
    o.lr = mag * c; o.li = mag * s;
    const float den = are * are + aim * aim, nr = o.lr - 1.0f;
    o.fr = (nr * are + o.li * aim) / den; o.fi = (o.li * are - nr * aim) / den;
    return o;
}
DEV void s5_pow(const S5p& q, int n, float& pr, float& pi) { const float mag = __expf(q.adt * (float)n); float s, c; sincosf(q.idt * (float)n, &s, &c); pr = mag * c; pi = mag * s; }

DEV void phase0(const Args& a, unsigned char* ws, int gtid, int gsize) {
    const int lane = threadIdx.x & 63, gw = gtid >> 6, ngw = gsize >> 6;
    {
        bf16_t* xn = (bf16_t*)(ws + WS_XN); const float* x = a.in[I_X]; const float* gain = a.in[I_NORM_MIX];
        for (int m = gw; m < T; m += ngw) {
            const f32x4* xr = (const f32x4*)(x + (size_t)m * DM) + lane; f32x4 v[4]; float s = 0.f;
#pragma unroll
            for (int j = 0; j < 4; ++j) { v[j] = xr[64 * j]; s += v[j][0] * v[j][0] + v[j][1] * v[j][1] + v[j][2] * v[j][2] + v[j][3] * v[j][3]; }
            const float rstd = rsqrtf(wave_sum(s) * (1.0f / DM) + EPS);
#pragma unroll
            for (int j = 0; j < 4; ++j) { const f32x4 gn = ((const f32x4*)gain)[lane + 64 * j];
                u32x2 o; o[0] = (unsigned)f2bf(v[j][0] * rstd * gn[0]) | ((unsigned)f2bf(v[j][1] * rstd * gn[1]) << 16); o[1] = (unsigned)f2bf(v[j][2] * rstd * gn[2]) | ((unsigned)f2bf(v[j][3] * rstd * gn[3]) << 16);
                ((u32x2*)(xn + (size_t)m * DM))[lane + 64 * j] = o; }
        }
    }
    { bf16_t* w = (bf16_t*)(ws + WS_WIN); const float* s = a.in[I_W_IN]; for (int i = gtid; i < NIN * 1024; i += gsize) { const int n = i >> 10, k = i & 1023; w[i] = f2bf(s[(size_t)k * NIN + n]); } }
    { bf16_t* w = (bf16_t*)(ws + WS_BLK); for (int i = gtid; i < 1536 * 256; i += gsize) { const int n = i >> 8, k = i & 255; float v = 0.f;
            if (n < 512) { if (k < 64) v = a.in[I_W_LORA][k * 512 + n]; }
            else if (n < 1024) { if (k >= 64 && k < 128) v = a.in[I_A_LORA][(k - 64) * 512 + n - 512]; }
            else { if (k >= 128) v = a.in[I_G_LORA][(k - 128) * 512 + n - 1024]; }
            w[i] = f2bf(v); } }
    { bf16_t* w = (bf16_t*)(ws + WS_WGLU); const float* s = a.in[I_WGLU]; for (int i = gtid; i < 2048 * 512; i += gsize) { const int n = i >> 9, k = i & 511; const int pn = n >> 8, j = n & 255;
            const int col = (j < 128) ? (128 * pn + j) : (1024 + 128 * pn + (j - 128)); w[i] = f2bf(s[(size_t)k * 2048 + col]); } }
    { bf16_t* w = (bf16_t*)(ws + WS_WO); const float* s = a.in[I_WO]; for (int i = gtid; i < 1024 * 512; i += gsize) { const int n = i >> 9, k = i & 511; w[i] = f2bf(s[(size_t)k * 1024 + n]); } }
    { bf16_t* w = (bf16_t*)(ws + WS_WOUT); const float* s = a.in[I_WOUT]; for (int i = gtid; i < 1024 * 1024; i += gsize) { const int n = i >> 10, k = i & 1023; w[i] = f2bf(s[(size_t)k * 1024 + n]); } }
    { bf16_t* w = (bf16_t*)(ws + WS_WQ); const float* s = a.in[I_WQ]; const float* gn = a.in[I_NORM_FFN]; for (int i = gtid; i < 1024 * 1024; i += gsize) { const int n = i >> 10, k = i & 1023; w[i] = f2bf(s[(size_t)k * 1024 + n] * gn[k]); } }
    { bf16_t* w = (bf16_t*)(ws + WS_SK); const float* s = a.in[I_SUBK]; for (int i = gtid; i < 8 * 2 * 128 * 64; i += gsize) w[i] = f2bf(s[i]); }
    { float* par = (float*)(ws + WS_PAR);
      for (int i = gtid; i < PAR_END; i += gsize) { float v;
        if (i < PAR_W0) v = a.in[I_MU][i]; else if (i < PAR_A0) v = a.in[I_W0][i - PAR_W0]; else if (i < PAR_KK) v = a.in[I_A0][i - PAR_A0]; else if (i < PAR_KA) v = a.in[I_KK][i - PAR_KK];
        else if (i < PAR_RK) v = a.in[I_KA][i - PAR_KA]; else if (i < PAR_LNW) v = a.in[I_RK][i - PAR_RK]; else if (i < PAR_LNB) v = a.in[I_LNW][i - PAR_LNW]; else if (i < PAR_BG) v = a.in[I_LNB][i - PAR_LNB];
        else if (i < PAR_NF) v = a.in[I_B_GATE][i - PAR_BG]; else if (i < PAR_LAM16) v = a.in[I_NORM_FINAL][i - PAR_NF];
        else { const int j = i - PAR_LAM16, gp = j >> 1; const S5p q = s5_param(a, gp >> 6, gp & 63); float pr, pi; s5_pow(q, 16, pr, pi); v = (j & 1) ? pi : pr; }
        par[i] = v; } }
    {
        bf16_t* w = (bf16_t*)(ws + WS_EBT);
        for (int i = gtid; i < 32 * 256 * 256; i += gsize) { const int g = i >> 16, n = (i >> 8) & 255, k = i & 255; float v = 0.f;
            if (n < 128) { const int p = n & 63, sp = k >> 4, j = k & 15; const S5p q = s5_param(a, g, p);
                const float br = a.in[I_BRE][(g * 64 + p) * 16 + j], bi = a.in[I_BIM][(g * 64 + p) * 16 + j];
                const float bbr = q.fr * br - q.fi * bi, bbi = q.fr * bi + q.fi * br; float pr, pi; s5_pow(q, 15 - sp, pr, pi);
                v = (n < 64) ? (pr * bbr - pi * bbi) : (pr * bbi + pi * bbr); }
            w[i] = f2bf(v); }
    }
    {
        bf16_t* w = (bf16_t*)(ws + WS_YBT);
        for (int i = gtid; i < 32 * 256 * 384; i += gsize) { const int g = i / (256 * 384), r = i % (256 * 384), n = r / 384, k = r % 384; const int s = n >> 4, h = n & 15; float v = 0.f;
            if (k < 256) { const int sp = k >> 4, j = k & 15;
                if (sp <= s) { const int nn = s - sp; float acc = 0.f;
                    for (int p = 0; p < 64; ++p) { const S5p q = s5_param(a, g, p);
                        const float br = a.in[I_BRE][(g * 64 + p) * 16 + j], bi = a.in[I_BIM][(g * 64 + p) * 16 + j];
                        const float bbr = q.fr * br - q.fi * bi, bbi = q.fr * bi + q.fi * br; float pr, pi; s5_pow(q, nn, pr, pi);
                        const float zr = pr * bbr - pi * bbi, zi = pr * bbi + pi * bbr;
                        acc += a.in[I_CRE][(g * 16 + h) * 64 + p] * zr - a.in[I_CIM][(g * 16 + h) * 64 + p] * zi; }
                    if (nn == 0 && h == j) acc += a.in[I_SD][g * 16 + h];
                    v = acc; } }
            else { const int p = (k - 256) & 63; const S5p q = s5_param(a, g, p); float pr, pi; s5_pow(q, s + 1, pr, pi);
                const float cr = a.in[I_CRE][(g * 16 + h) * 64 + p], ci = a.in[I_CIM][(g * 16 + h) * 64 + p];
                v = (k < 320) ? (cr * pr - ci * pi) : -(cr * pi + ci * pr); }
            w[i] = f2bf(v); }
    }
}

DEV void phase2_prep(unsigned char* ws, int gtid, int gsize) {
    const bf16_t* praw = (const bf16_t*)(ws + WS_PRAW); bf16_t* a2 = (bf16_t*)(ws + WS_A2); const float* mu = (const float*)(ws + WS_PAR) + PAR_MU;
    for (int i = gtid; i < T * 32; i += gsize) { const int m = i >> 5, c = (i & 31) * 8;
        f32x4 p0, p1, q0, q1; unpack8(*(const u32x4*)(praw + pr_off((size_t)m, 1536 + c)), p0, p1);
        if ((m & (SEQ - 1)) == 0) { q0 = (f32x4){0.f, 0.f, 0.f, 0.f}; q1 = q0; } else unpack8(*(const u32x4*)(praw + pr_off((size_t)(m - 1), 1536 + c)), q0, q1);
        f32x4 v0 = p0 + (q0 - p0) * *(const f32x4*)(mu + 1536 + c), v1 = p1 + (q1 - p1) * *(const f32x4*)(mu + 1536 + c + 4);
        if (c < 64) {
#pragma unroll
            for (int j = 0; j < 4; ++j) { v0[j] = tanhf(v0[j]); v1[j] = tanhf(v1[j]); }
        } else if (c >= 128) {
#pragma unroll
            for (int j = 0; j < 4; ++j) { v0[j] = sigmoidf_(v0[j]); v1[j] = sigmoidf_(v1[j]); }
        }
        *(u32x4*)(a2 + (size_t)m * 256 + c) = pack8(v0, v1); }
}

DEV void phase3_scan(unsigned char* ws, int gtid, int gsize) {
    const float* e = (const float*)(ws + WS_E); bf16_t* uc = (bf16_t*)(ws + WS_UC); const float* lam16 = (const float*)(ws + WS_PAR) + PAR_LAM16;
    for (int i = gtid; i < NB * 32 * 64; i += gsize) { const int b = i >> 11, g = (i >> 6) & 31, p = i & 63; const float lr = lam16[(g * 64 + p) * 2], li = lam16[(g * 64 + p) * 2 + 1];
        float xr = 0.f, xi = 0.f;
        for (int c = 0; c < 256; ++c) { const size_t crow = (size_t)g * 2048 + b * 256 + c;
            uc[crow * 384 + 256 + p] = f2bf(xr); uc[crow * 384 + 320 + p] = f2bf(xi);
            const float er = e[crow * 128 + p], ei = e[crow * 128 + 64 + p];
            const float nr = lr * xr - li * xi + er, ni = lr * xi + li * xr + ei; xr = nr; xi = ni; }
    }
}

DEV void phase4_wkv(unsigned char* ws, int wg, int nwg) {
    const bf16_t* praw = (const bf16_t*)(ws + WS_PRAW); const bf16_t* dd = (const bf16_t*)(ws + WS_DD); const bf16_t* aa = (const bf16_t*)(ws + WS_AA); bf16_t* yr = (bf16_t*)(ws + WS_YR);
    const float* par = (const float*)(ws + WS_PAR); const float* mu = par + PAR_MU;
    const int tid = threadIdx.x, row = tid >> 5, ks = tid & 31;
    for (int item = wg; item < 256; item += nwg) {
        const int b = item >> 5, h = (item >> 2) & 7, qd = item & 3; const int v = qd * 16 + row;
        const int c0 = h * 64 + ks * 2;
        const float mur0 = mu[c0], mur1 = mu[c0 + 1], muk0 = mu[512 + c0], muk1 = mu[512 + c0 + 1], muv = mu[1024 + h * 64 + v];
        const float kk0 = par[PAR_KK + c0], kk1 = par[PAR_KK + c0 + 1], ka0 = par[PAR_KA + c0], ka1 = par[PAR_KA + c0 + 1];
        float s0 = 0.f, s1 = 0.f;
        float pr0 = 0.f, pr1 = 0.f, pk0 = 0.f, pk1 = 0.f, pv = 0.f;
        for (int t = 0; t < SEQ; ++t) { const size_t m = (size_t)b * SEQ + t;
            const unsigned rr = *(const unsigned*)(praw + pr_off((size_t)(m), c0)), kr = *(const unsigned*)(praw + pr_off((size_t)(m), 512 + c0));
            const float vr = bf2f(praw[pr_off((size_t)(m), 1024 + h * 64 + v)]);
            const unsigned dr = *(const unsigned*)(dd + da_off(m, c0)), ar = *(const unsigned*)(aa + da_off(m, c0));
            const float r0 = __uint_as_float(rr << 16), r1 = __uint_as_float(rr & 0xffff0000u), k0 = __uint_as_float(kr << 16), k1 = __uint_as_float(kr & 0xffff0000u);
            const float d0 = __uint_as_float(dr << 16), d1 = __uint_as_float(dr & 0xffff0000u), a0_ = __uint_as_float(ar << 16), a1_ = __uint_as_float(ar & 0xffff0000u);
            const float rl0 = r0 + (pr0 - r0) * mur0, rl1 = r1 + (pr1 - r1) * mur1, kl0 = k0 + (pk0 - k0) * muk0, kl1 = k1 + (pk1 - k1) * muk1, vl = vr + (pv - vr) * muv;
            pr0 = r0; pr1 = r1; pk0 = k0; pk1 = k1; pv = vr;
            const float q0 = kl0 * kk0, q1 = kl1 * kk1; float n2 = q0 * q0 + q1 * q1;
#pragma unroll
            for (int o = 1; o < 32; o <<= 1) n2 += __shfl_xor(n2, o);
            const float inv = 1.0f / fmaxf(sqrtf(n2), 1e-12f); const float kn0 = q0 * inv, kn1 = q1 * inv;
            const float k20 = kl0 * (1.0f + (a0_ - 1.0f) * ka0), k21 = kl1 * (1.0f + (a1_ - 1.0f) * ka1);
            float sa = -(s0 * kn0 + s1 * kn1);
#pragma unroll
            for (int o = 1; o < 32; o <<= 1) sa += __shfl_xor(sa, o);
            s0 = s0 * (1.0f - d0) + sa * (kn0 * a0_) + vl * k20; s1 = s1 * (1.0f - d1) + sa * (kn1 * a1_) + vl * k21;
            float y = s0 * rl0 + s1 * rl1;
#pragma unroll
            for (int o = 1; o < 32; o <<= 1) y += __shfl_xor(y, o);
            if (ks == 0) yr[m * 512 + h * 64 + v] = f2bf(y);
        }
    }
}

struct TabGrp { f32x4 u, v; };
DEV void tab_cvt_load(TabGrp& t, const float* pu, const float* pv, int i) { t.u = ((const f32x4*)pu)[i]; t.v = ((const f32x4*)pv)[i]; }
DEV void tab_cvt_store(const TabGrp& t, const float* gn, unsigned char* ws, int i) {
    const f32x4 u = t.u, v = t.v; const f32x4 g = ((const f32x4*)gn)[i & 255];
    int pu_ = 0, pv_ = 0;
    pu_ = (int)q8x4(u[0] * g[0] * U8_SCALE, u[1] * g[1] * U8_SCALE, u[2] * g[2] * U8_SCALE, u[3] * g[3] * U8_SCALE);
    pv_ = __builtin_amdgcn_cvt_pk_fp8_f32(v[0] * 16.0f, v[1] * 16.0f, pv_, false); pv_ = __builtin_amdgcn_cvt_pk_fp8_f32(v[2] * 16.0f, v[3] * 16.0f, pv_, true);
    const size_t o = ((size_t)((i & 255) >> 5) * 16384 + (i >> 8)) * 32 + (i & 31);
    const int d = i & 31, dv = ((d & 15) >> 1) * 4 + ((d >> 4) << 1) + (d & 1);
    ((unsigned*)(ws + WS_U16))[o] = (unsigned)pu_; ((unsigned*)(ws + WS_V16))[o - d + dv] = (unsigned)pv_;
}

constexpr int WK_TB = 32, WK_SF = 340, WK_BF = WK_TB * WK_SF, WK_YF = WK_TB * 16, WK_NBLK = SEQ / WK_TB;
template <int CTRL> DEV float dpp_f(float x) { return __builtin_bit_cast(float, __builtin_amdgcn_update_dpp(0, __builtin_bit_cast(int, x), CTRL, 0xf, 0xf, true)); }
DEV float red16(float x) { x += dpp_f<0xB1>(x); x += dpp_f<0x4E>(x); x += dpp_f<0x124>(x); x += dpp_f<0x128>(x); return x; }
struct WkLoad { u32x4 r, rp, k, kp, d, a, v, vp; };
DEV void wk_issue(WkLoad& L, const bf16_t* praw, const bf16_t* dd, const bf16_t* aa, int b, int h, int qd, int blk, int s, int kseg) {
    const int t = blk * WK_TB + s; const size_t m = (size_t)b * SEQ + t; const size_t mp = (t > 0) ? m - 1 : m; const int c = h * 64 + kseg * 8;
    L.r = *(const u32x4*)(praw + pr_off((size_t)(m), c)); L.rp = *(const u32x4*)(praw + pr_off((size_t)(mp), c));
    L.k = *(const u32x4*)(praw + pr_off((size_t)(m), 512 + c)); L.kp = *(const u32x4*)(praw + pr_off((size_t)(mp), 512 + c));
    L.d = *(const u32x4*)(dd + da_off(m, c)); L.a = *(const u32x4*)(aa + da_off(m, c));
    if (kseg < 2) { const int cv = 1024 + h * 64 + qd * 16 + kseg * 8; L.v = *(const u32x4*)(praw + pr_off((size_t)(m), cv)); L.vp = *(const u32x4*)(praw + pr_off((size_t)(mp), cv)); }
}
DEV void wk_produce(const WkLoad& L, LAS float* buf, int blk, int s, int kseg, const float (&mur)[8], const float (&muk)[8], const float (&kkc)[8], const float (&kac)[8], const float (&muv)[8]) {
    const bool first = (blk == 0 && s == 0);
    f32x4 r0, r1, p0, p1, k0, k1, q0, q1, d0, d1, a0, a1;
    unpack8(L.r, r0, r1); unpack8(L.rp, p0, p1); unpack8(L.k, k0, k1); unpack8(L.kp, q0, q1); unpack8(L.d, d0, d1); unpack8(L.a, a0, a1);
    float rl[8], kl[8], av[8], dv[8], qq[8]; float n2 = 0.f;
#pragma unroll
    for (int i = 0; i < 8; ++i) { const float r = (i < 4) ? r0[i & 3] : r1[i & 3], rp = first ? 0.f : ((i < 4) ? p0[i & 3] : p1[i & 3]); const float k = (i < 4) ? k0[i & 3] : k1[i & 3], kp = first ? 0.f : ((i < 4) ? q0[i & 3] : q1[i & 3]);
        rl[i] = r + (rp - r) * mur[i]; kl[i] = k + (kp - k) * muk[i]; av[i] = (i < 4) ? a0[i & 3] : a1[i & 3]; dv[i] = (i < 4) ? d0[i & 3] : d1[i & 3]; qq[i] = kl[i] * kkc[i]; n2 += qq[i] * qq[i]; }
    n2 += __shfl_xor(n2, 1); n2 += __shfl_xor(n2, 2); n2 += __shfl_xor(n2, 4);
    const float inv = 1.0f / fmaxf(sqrtf(n2), 1e-12f);
    LAS float* P = buf + s * WK_SF + kseg * 8;
    f32x4 o0, o1;
#pragma unroll
    for (int i = 0; i < 4; ++i) { o0[i] = 1.0f - dv[i]; o1[i] = 1.0f - dv[4 + i]; }
    *(LAS f32x4*)(P) = o0; *(LAS f32x4*)(P + 4) = o1;
#pragma unroll
    for (int i = 0; i < 4; ++i) { o0[i] = -qq[i] * inv; o1[i] = -qq[4 + i] * inv; }
    *(LAS f32x4*)(P + 64) = o0; *(LAS f32x4*)(P + 68) = o1;
#pragma unroll
    for (int i = 0; i < 4; ++i) { o0[i] = qq[i] * inv * av[i]; o1[i] = qq[4 + i] * inv * av[4 + i]; }
    *(LAS f32x4*)(P + 128) = o0; *(LAS f32x4*)(P + 132) = o1;
#pragma unroll
    for (int i = 0; i < 4; ++i) { o0[i] = kl[i] * (1.0f + (av[i] - 1.0f) * kac[i]); o1[i] = kl[4 + i] * (1.0f + (av[4 + i] - 1.0f) * kac[4 + i]); }
    *(LAS f32x4*)(P + 192) = o0; *(LAS f32x4*)(P + 196) = o1;
    float c1 = 0.f, c2 = 0.f;
#pragma unroll
    for (int i = 0; i < 8; ++i) { c1 += qq[i] * inv * av[i] * rl[i]; c2 += kl[i] * (1.0f + (av[i] - 1.0f) * kac[i]) * rl[i]; }
    c1 += __shfl_xor(c1, 1); c1 += __shfl_xor(c1, 2); c1 += __shfl_xor(c1, 4); c2 += __shfl_xor(c2, 1); c2 += __shfl_xor(c2, 2); c2 += __shfl_xor(c2, 4);
#pragma unroll
    for (int i = 0; i < 4; ++i) { o0[i] = rl[i] * (1.0f - dv[i]); o1[i] = rl[4 + i] * (1.0f - dv[4 + i]); }
    *(LAS f32x4*)(P + 256) = o0; *(LAS f32x4*)(P + 260) = o1;
    if (kseg == 0) { buf[s * WK_SF + 336] = c1; buf[s * WK_SF + 337] = c2; }
    if (kseg < 2) { f32x4 v0, v1, w0, w1; unpack8(L.v, v0, v1); unpack8(L.vp, w0, w1);
#pragma unroll
        for (int i = 0; i < 4; ++i) { const float vp0 = first ? 0.f : w0[i], vp1 = first ? 0.f : w1[i]; o0[i] = v0[i] + (vp0 - v0[i]) * muv[i]; o1[i] = v1[i] + (vp1 - v1[i]) * muv[4 + i]; }
        *(LAS f32x4*)(buf + s * WK_SF + 320 + kseg * 8) = o0; *(LAS f32x4*)(buf + s * WK_SF + 324 + kseg * 8) = o1; }
}
DEV void wk_flush(const LAS float* yb, bf16_t* yr, int b, int h, int qd, int blk, int s, int kseg) {
    const float y0 = yb[s * 16 + 2 * kseg], y1 = yb[s * 16 + 2 * kseg + 1];
    *(unsigned*)(yr + ((size_t)b * SEQ + blk * WK_TB + s) * 512 + h * 64 + qd * 16 + 2 * kseg) = cvt_pk_bf16(y0, y1);
}
struct WkOp { f32x4 w4, a4, b4, k4, q4; float vv, c1, c2; };
DEV void wk_ld(WkOp& o, const LAS float* P, int row, int ks) {
    o.w4 = *(const LAS f32x4*)(P + ks * 4); o.a4 = *(const LAS f32x4*)(P + 64 + ks * 4); o.b4 = *(const LAS f32x4*)(P + 128 + ks * 4); o.k4 = *(const LAS f32x4*)(P + 192 + ks * 4); o.q4 = *(const LAS f32x4*)(P + 256 + ks * 4);
    o.vv = P[320 + row]; o.c1 = P[336]; o.c2 = P[337];
}
DEV void wk_step(const WkOp& c, LAS float* yb, f32x4& S, int s, int row) {
    float sa = S[0] * c.a4[0] + S[1] * c.a4[1] + S[2] * c.a4[2] + S[3] * c.a4[3];
    float yy = S[0] * c.q4[0] + S[1] * c.q4[1] + S[2] * c.q4[2] + S[3] * c.q4[3];
    sa += dpp_f<0xB1>(sa); yy += dpp_f<0xB1>(yy); sa += dpp_f<0x4E>(sa); yy += dpp_f<0x4E>(yy); sa += dpp_f<0x124>(sa); yy += dpp_f<0x124>(yy); sa += dpp_f<0x128>(sa); yy += dpp_f<0x128>(yy);
    S = S * c.w4 + sa * c.b4 + c.vv * c.k4;
    yb[s * 16 + row] = yy + sa * c.c1 + c.vv * c.c2;
}
DEV void wk_consume(const LAS float* buf, LAS float* yb, f32x4& S, int row, int ks) {
    WkOp A, B; wk_ld(A, buf, row, ks);
#pragma unroll 2
    for (int s = 0; s < WK_TB; s += 2) {
        wk_ld(B, buf + (s + 1) * WK_SF, row, ks);
        wk_step(A, yb, S, s, row);
        __builtin_amdgcn_sched_barrier(0);
        if (s + 2 < WK_TB) wk_ld(A, buf + (s + 2) * WK_SF, row, ks);
        wk_step(B, yb, S, s + 1, row);
        __builtin_amdgcn_sched_barrier(0);
    }
}
DEV void phase4_wkv_opt(unsigned char* ws, LAS float* lds, int wg, int nwg, const float* pu, const float* pv, const float* gn) {
    const bf16_t* praw = (const bf16_t*)(ws + WS_PRAW); const bf16_t* dd = (const bf16_t*)(ws + WS_DD); const bf16_t* aa = (const bf16_t*)(ws + WS_AA); bf16_t* yr = (bf16_t*)(ws + WS_YR);
    const float* par = (const float*)(ws + WS_PAR);
    const int tid = threadIdx.x, wid = __builtin_amdgcn_readfirstlane(tid >> 6), lane = tid & 63; const bool producer = wid >= 4;
    LAS float* buf0 = lds; LAS float* buf1 = lds + WK_BF; LAS float* yb0 = lds + 2 * WK_BF; LAS float* yb1 = yb0 + WK_YF;
    const int p = tid & 255, s = p >> 3, kseg = p & 7;
    const int row = (wid & 3) * 4 + (lane >> 4), ks = lane & 15;
    for (int it = wg; it < 256; it += nwg) {
        const int bh = (it & 7) * 8 + ((it >> 3) >> 2), qd = (it >> 3) & 3, b = bh >> 3, h = bh & 7;
        if (producer) {
            __builtin_amdgcn_s_setprio(0);
            float mur[8], muk[8], kkc[8], kac[8], muv[8];
#pragma unroll
            for (int i = 0; i < 8; ++i) { const int c = h * 64 + kseg * 8 + i; mur[i] = par[PAR_MU + c]; muk[i] = par[PAR_MU + 512 + c]; kkc[i] = par[PAR_KK + c]; kac[i] = par[PAR_KA + c]; muv[i] = par[PAR_MU + 1024 + h * 64 + qd * 16 + (kseg & 1) * 8 + i]; }
            WkLoad L0, L1;
            wk_issue(L0, praw, dd, aa, b, h, qd, 0, s, kseg); wk_issue(L1, praw, dd, aa, b, h, qd, 1, s, kseg);
            wk_produce(L0, buf0, 0, s, kseg, mur, muk, kkc, kac, muv);
            wk_issue(L0, praw, dd, aa, b, h, qd, 2, s, kseg);
#if OPT_PEER == 2
            TabGrp tg; tab_cvt_load(tg, pu, pv, (it * 64) * 256 + p);
#endif
            __syncthreads();
            for (int blk = 0; blk < WK_NBLK; blk += 2) {
                wk_produce(L1, buf1, blk + 1, s, kseg, mur, muk, kkc, kac, muv);
                if (blk + 3 < WK_NBLK) wk_issue(L1, praw, dd, aa, b, h, qd, blk + 3, s, kseg);
                if (blk > 0) wk_flush(yb1, yr, b, h, qd, blk - 1, s, kseg);
                __syncthreads();
                if (blk + 2 < WK_NBLK) wk_produce(L0, buf0, blk + 2, s, kseg, mur, muk, kkc, kac, muv);
                if (blk + 4 < WK_NBLK) wk_issue(L0, praw, dd, aa, b, h, qd, blk + 4, s, kseg);
                wk_flush(yb0, yr, b, h, qd, blk, s, kseg);
#if OPT_PEER == 2
                { const int gi = (it * 64 + (blk >> 1)) * 256 + p; tab_cvt_store(tg, gn, ws, gi); if (blk + 2 < WK_NBLK) tab_cvt_load(tg, pu, pv, gi + 256); }
#endif
                __syncthreads();
            }
            wk_flush(yb1, yr, b, h, qd, WK_NBLK - 1, s, kseg);
        } else {
            f32x4 S = (f32x4){0.f, 0.f, 0.f, 0.f};
            __syncthreads();
            for (int blk = 0; blk < WK_NBLK; blk += 2) {
                wk_consume(buf0, yb0, S, row, ks);
                __syncthreads();
                wk_consume(buf1, yb1, S, row, ks);
                __syncthreads();
            }
        }
        __builtin_amdgcn_s_setprio(0);
        __syncthreads();
    }
}

constexpr int W2_PF = 624, W2_NP = 16, W2_BF = W2_NP * W2_PF;
struct Wk2Load { u32x2 r0, r1, r2, k0, k1, k2, d1, d2, a1, a2, v0, v1, v2; };
DEV void up4(const u32x2 w, f32x4& o) { o[0] = __uint_as_float(w[0] << 16); o[1] = __uint_as_float(w[0] & 0xffff0000u); o[2] = __uint_as_float(w[1] << 16); o[3] = __uint_as_float(w[1] & 0xffff0000u); }
DEV void wk2_issue(Wk2Load& L, const bf16_t* praw, const bf16_t* dd, const bf16_t* aa, int b, int h, int qd, int blk, int j, int q) {
    const int t1 = blk * 32 + 2 * j; const size_t m1 = (size_t)b * SEQ + t1, m2 = m1 + 1, m0 = (t1 > 0) ? m1 - 1 : m1; const int c = h * 64 + q * 4;
    L.r0 = *(const u32x2*)(praw + pr_off((size_t)(m0), c)); L.r1 = *(const u32x2*)(praw + pr_off((size_t)(m1), c)); L.r2 = *(const u32x2*)(praw + pr_off((size_t)(m2), c));
    L.k0 = *(const u32x2*)(praw + pr_off((size_t)(m0), 512 + c)); L.k1 = *(const u32x2*)(praw + pr_off((size_t)(m1), 512 + c)); L.k2 = *(const u32x2*)(praw + pr_off((size_t)(m2), 512 + c));
    L.d1 = *(const u32x2*)(dd + da_off(m1, c)); L.d2 = *(const u32x2*)(dd + da_off(m2, c)); L.a1 = *(const u32x2*)(aa + da_off(m1, c)); L.a2 = *(const u32x2*)(aa + da_off(m2, c));
    if (q < 4) { const int cv = 1024 + h * 64 + qd * 16 + q * 4; L.v0 = *(const u32x2*)(praw + pr_off((size_t)(m0), cv)); L.v1 = *(const u32x2*)(praw + pr_off((size_t)(m1), cv)); L.v2 = *(const u32x2*)(praw + pr_off((size_t)(m2), cv)); }
}
DEV void wk2_produce(const Wk2Load& L, LAS float* buf, int blk, int j, int q, const f32x4 mur, const f32x4 muk, const f32x4 kkc, const f32x4 kac, const f32x4 muv) {
    const bool first = (blk == 0 && j == 0);
    f32x4 r0, r1, r2, k0, k1, k2, d1, d2, a1, a2;
    up4(L.r0, r0); up4(L.r1, r1); up4(L.r2, r2); up4(L.k0, k0); up4(L.k1, k1); up4(L.k2, k2); up4(L.d1, d1); up4(L.d2, d2); up4(L.a1, a1); up4(L.a2, a2);
    if (first) { r0 = (f32x4){0.f, 0.f, 0.f, 0.f}; k0 = r0; }
    const f32x4 rl1 = r1 + (r0 - r1) * mur, rl2 = r2 + (r1 - r2) * mur, kl1 = k1 + (k0 - k1) * muk, kl2 = k2 + (k1 - k2) * muk;
    const f32x4 q1 = kl1 * kkc, q2 = kl2 * kkc;
    float n1 = (q1[0] * q1[0] + q1[1] * q1[1]) + (q1[2] * q1[2] + q1[3] * q1[3]), n2 = (q2[0] * q2[0] + q2[1] * q2[1]) + (q2[2] * q2[2] + q2[3] * q2[3]);
    n1 += dpp_f<0xB1>(n1); n2 += dpp_f<0xB1>(n2); n1 += dpp_f<0x4E>(n1); n2 += dpp_f<0x4E>(n2); n1 += dpp_f<0x124>(n1); n2 += dpp_f<0x124>(n2); n1 += dpp_f<0x128>(n1); n2 += dpp_f<0x128>(n2);
    const float i1 = 1.0f / fmaxf(sqrtf(n1), 1e-12f), i2 = 1.0f / fmaxf(sqrtf(n2), 1e-12f);
    const f32x4 kn1 = q1 * i1, kn2 = q2 * i2, ah1 = -kn1, ah2 = -kn2, bh1 = kn1 * a1, bh2 = kn2 * a2;
    const f32x4 k21 = kl1 * (1.0f + (a1 - 1.0f) * kac), k22 = kl2 * (1.0f + (a2 - 1.0f) * kac), w1 = 1.0f - d1, w2 = 1.0f - d2;
    const f32x4 A2 = w1 * ah2, Q1 = w1 * rl1, W12 = w1 * w2, Q2 = W12 * rl2, B1 = bh1 * w2, K1 = k21 * w2;
    LAS float* P = buf + j * W2_PF + q * 4;
    *(LAS f32x4*)(P) = ah1; *(LAS f32x4*)(P + 64) = A2; *(LAS f32x4*)(P + 128) = Q1; *(LAS f32x4*)(P + 192) = Q2; *(LAS f32x4*)(P + 256) = W12;
    *(LAS f32x4*)(P + 320) = B1; *(LAS f32x4*)(P + 384) = K1; *(LAS f32x4*)(P + 448) = bh2; *(LAS f32x4*)(P + 512) = k22;
#if OPT_WKV == 3
    float sc0, sc1; { const f32x4 t0 = bh1 * ah2, t1 = k21 * ah2; sc0 = (t0[0] + t0[1]) + (t0[2] + t0[3]); sc1 = (t1[0] + t1[1]) + (t1[2] + t1[3]); }
    sc0 += dpp_f<0xB1>(sc0); sc1 += dpp_f<0xB1>(sc1); sc0 += dpp_f<0x4E>(sc0); sc1 += dpp_f<0x4E>(sc1); sc0 += dpp_f<0x124>(sc0); sc1 += dpp_f<0x124>(sc1); sc0 += dpp_f<0x128>(sc0); sc1 += dpp_f<0x128>(sc1);
    if (q == 0) *(LAS f32x2*)(buf + j * W2_PF + 608) = (f32x2){sc0, sc1};
#else
    float sc[8]; { const f32x4 t0 = bh1 * ah2, t1 = k21 * ah2, t2 = bh1 * rl1, t3 = k21 * rl1, t4 = B1 * rl2, t5 = K1 * rl2, t6 = bh2 * rl2, t7 = k22 * rl2;
        sc[0] = (t0[0] + t0[1]) + (t0[2] + t0[3]); sc[1] = (t1[0] + t1[1]) + (t1[2] + t1[3]); sc[2] = (t2[0] + t2[1]) + (t2[2] + t2[3]); sc[3] = (t3[0] + t3[1]) + (t3[2] + t3[3]);
        sc[4] = (t4[0] + t4[1]) + (t4[2] + t4[3]); sc[5] = (t5[0] + t5[1]) + (t5[2] + t5[3]); sc[6] = (t6[0] + t6[1]) + (t6[2] + t6[3]); sc[7] = (t7[0] + t7[1]) + (t7[2] + t7[3]); }
#pragma unroll
    for (int i = 0; i < 8; ++i) sc[i] += dpp_f<0xB1>(sc[i]);
#pragma unroll
    for (int i = 0; i < 8; ++i) sc[i] += dpp_f<0x4E>(sc[i]);
#pragma unroll
    for (int i = 0; i < 8; ++i) sc[i] += dpp_f<0x124>(sc[i]);
#pragma unroll
    for (int i = 0; i < 8; ++i) sc[i] += dpp_f<0x128>(sc[i]);
    if (q == 0) { *(LAS f32x4*)(buf + j * W2_PF + 608) = (f32x4){sc[0], sc[1], sc[2], sc[3]}; *(LAS f32x4*)(buf + j * W2_PF + 612) = (f32x4){sc[4], sc[5], sc[6], sc[7]}; }
#endif
    if (q < 4) { f32x4 v0, v1, v2; up4(L.v0, v0); up4(L.v1, v1); up4(L.v2, v2); if (first) v0 = (f32x4){0.f, 0.f, 0.f, 0.f};
        *(LAS f32x4*)(buf + j * W2_PF + 576 + q * 4) = v1 + (v0 - v1) * muv; *(LAS f32x4*)(buf + j * W2_PF + 592 + q * 4) = v2 + (v1 - v2) * muv; }
}
struct Wk2Op { f32x4 a1, a2, q1, q2, w12, b1, k1, b2, k2, s0, s1; float v1, v2; };
DEV void wk2_ld(Wk2Op& o, const LAS float* P, int row, int ks) {
    o.a1 = *(const LAS f32x4*)(P + ks * 4); o.a2 = *(const LAS f32x4*)(P + 64 + ks * 4); o.q1 = *(const LAS f32x4*)(P + 128 + ks * 4); o.q2 = *(const LAS f32x4*)(P + 192 + ks * 4); o.w12 = *(const LAS f32x4*)(P + 256 + ks * 4);
    o.b1 = *(const LAS f32x4*)(P + 320 + ks * 4); o.k1 = *(const LAS f32x4*)(P + 384 + ks * 4); o.b2 = *(const LAS f32x4*)(P + 448 + ks * 4); o.k2 = *(const LAS f32x4*)(P + 512 + ks * 4);
    o.v1 = P[576 + row]; o.v2 = P[592 + row]; o.s0 = *(const LAS f32x4*)(P + 608); o.s1 = *(const LAS f32x4*)(P + 612);
}
DEV float dot4(const f32x4 a, const f32x4 b) { f32x2 t = (f32x2){a[0], a[1]} * (f32x2){b[0], b[1]}; t = __builtin_elementwise_fma((f32x2){a[2], a[3]}, (f32x2){b[2], b[3]}, t); return t[0] + t[1]; }
DEV void wk2_step(const Wk2Op& c, LAS float* yb, f32x4& S, int j, int row) {
    float p1 = dot4(S, c.a1), p2 = dot4(S, c.a2), p3 = dot4(S, c.q1), p4 = dot4(S, c.q2);
    p1 += dpp_f<0xB1>(p1); p2 += dpp_f<0xB1>(p2); p3 += dpp_f<0xB1>(p3); p4 += dpp_f<0xB1>(p4);
    p1 += dpp_f<0x4E>(p1); p2 += dpp_f<0x4E>(p2); p3 += dpp_f<0x4E>(p3); p4 += dpp_f<0x4E>(p4);
    p1 += dpp_f<0x124>(p1); p2 += dpp_f<0x124>(p2); p3 += dpp_f<0x124>(p3); p4 += dpp_f<0x124>(p4);
    p1 += dpp_f<0x128>(p1); p2 += dpp_f<0x128>(p2); p3 += dpp_f<0x128>(p3); p4 += dpp_f<0x128>(p4);
    const float sa1 = p1, sa2 = (p2 + c.v1 * c.s0[1]) + sa1 * c.s0[0];
    S = ((S * c.w12 + c.v1 * c.k1) + c.v2 * c.k2) + sa1 * c.b1 + sa2 * c.b2;
    yb[(2 * j) * 16 + row] = (p3 + c.v1 * c.s0[3]) + sa1 * c.s0[2];
    yb[(2 * j + 1) * 16 + row] = ((p4 + c.v1 * c.s1[1]) + c.v2 * c.s1[3]) + sa1 * c.s1[0] + sa2 * c.s1[2];
}
DEV void wk2_consume(const LAS float* buf, LAS float* yb, f32x4& S, int row, int ks) {
    Wk2Op A, B; wk2_ld(A, buf, row, ks);
#pragma unroll 2
    for (int j = 0; j < W2_NP; j += 2) {
        wk2_ld(B, buf + (j + 1) * W2_PF, row, ks);
        wk2_step(A, yb, S, j, row);
        __builtin_amdgcn_sched_barrier(0);
        if (j + 2 < W2_NP) wk2_ld(A, buf + (j + 2) * W2_PF, row, ks);
        wk2_step(B, yb, S, j + 1, row);
        __builtin_amdgcn_sched_barrier(0);
    }
}
DEV void phase4_wkv2(unsigned char* ws, LAS float* lds, int wg, int nwg, const float* pu, const float* pv, const float* gn) {
    const bf16_t* praw = (const bf16_t*)(ws + WS_PRAW); const bf16_t* dd = (const bf16_t*)(ws + WS_DD); const bf16_t* aa = (const bf16_t*)(ws + WS_AA); bf16_t* yr = (bf16_t*)(ws + WS_YR);
    const float* par = (const float*)(ws + WS_PAR);
    const int tid = threadIdx.x, wid = __builtin_amdgcn_readfirstlane(tid >> 6), lane = tid & 63; const bool producer = wid >= 4;
    LAS float* buf0 = lds; LAS float* buf1 = lds + W2_BF; LAS float* yb0 = lds + 2 * W2_BF; LAS float* yb1 = yb0 + WK_YF;
    const int p = tid & 255, j = p >> 4, q = p & 15, s = p >> 3, kseg = p & 7;
    const int row = (wid & 3) * 4 + (lane >> 4), ks = lane & 15;
    for (int it = wg; it < 256; it += nwg) {
        const int bh = (it & 7) * 8 + ((it >> 3) >> 2), qd = (it >> 3) & 3, b = bh >> 3, h = bh & 7;
        if (producer) {
            const int c = h * 64 + q * 4;
            const f32x4 mur = *(const f32x4*)(par + PAR_MU + c), muk = *(const f32x4*)(par + PAR_MU + 512 + c), kkc = *(const f32x4*)(par + PAR_KK + c), kac = *(const f32x4*)(par + PAR_KA + c);
            const f32x4 muv = *(const f32x4*)(par + PAR_MU + 1024 + h * 64 + qd * 16 + (q & 3) * 4);
            Wk2Load L0, L1;
            wk2_issue(L0, praw, dd, aa, b, h, qd, 0, j, q); wk2_issue(L1, praw, dd, aa, b, h, qd, 1, j, q);
            wk2_produce(L0, buf0, 0, j, q, mur, muk, kkc, kac, muv);
            wk2_issue(L0, praw, dd, aa, b, h, qd, 2, j, q);
#if OPT_PEER == 2
            TabGrp tg; tab_cvt_load(tg, pu, pv, (it * 64) * 256 + p);
#endif
            __syncthreads();
            for (int blk = 0; blk < WK_NBLK; blk += 2) {
                wk2_produce(L1, buf1, blk + 1, j, q, mur, muk, kkc, kac, muv);
                if (blk + 3 < WK_NBLK) wk2_issue(L1, praw, dd, aa, b, h, qd, blk + 3, j, q);
                if (blk > 0) wk_flush(yb1, yr, b, h, qd, blk - 1, s, kseg);
                __syncthreads();
                if (blk + 2 < WK_NBLK) wk2_produce(L0, buf0, blk + 2, j, q, mur, muk, kkc, kac, muv);
                if (blk + 4 < WK_NBLK) wk2_issue(L0, praw, dd, aa, b, h, qd, blk + 4, j, q);
                wk_flush(yb0, yr, b, h, qd, blk, s, kseg);
#if OPT_PEER == 2
                { const int gi = (it * 64 + (blk >> 1)) * 256 + p; tab_cvt_store(tg, gn, ws, gi); if (blk + 2 < WK_NBLK) tab_cvt_load(tg, pu, pv, gi + 256); }
#endif
                __syncthreads();
            }
            wk_flush(yb1, yr, b, h, qd, WK_NBLK - 1, s, kseg);
        } else {
            f32x4 S = (f32x4){0.f, 0.f, 0.f, 0.f};
            __syncthreads();
            for (int blk = 0; blk < WK_NBLK; blk += 2) {
                wk2_consume(buf0, yb0, S, row, ks);
                __syncthreads();
                wk2_consume(buf1, yb1, S, row, ks);
                __syncthreads();
            }
        }
        __syncthreads();
    }
}

constexpr int W3_SIDE0 = 79872, W3_SIDESZ = 15360, W3_BT = 4608, W3_KT = 9216, W3_VT = 13824;
constexpr int W3_SA0 = 110592, W3_SASZ = 2304, W3_H00 = 115200, W3_H0SZ = 4352, W3_GS0 = 123904, W3_GSSZ = 2560;
static_assert(W3_GS0 + 2 * W3_GSSZ <= 131072, "wkv3 LDS map");
template <int CTRL> DEV float dpp_shr_id1(float x) { return __builtin_bit_cast(float, __builtin_amdgcn_update_dpp(0x3f800000, __builtin_bit_cast(int, x), CTRL, 0xf, 0xf, false)); }
DEV bf16x8 f8_to_bf16x8(const f32x4 a, const f32x4 b) { const u32x4 w = pack8(a, b); return __builtin_bit_cast(bf16x8, w); }
struct Wk3Op { f32x4 a1, a2, w12, b1, k1, b2, k2; float v1, v2, be, ka; };
DEV void wk3_ld(Wk3Op& o, const LAS float* P, int row, int ks) {
    o.a1 = *(const LAS f32x4*)(P + ks * 4); o.a2 = *(const LAS f32x4*)(P + 64 + ks * 4); o.w12 = *(const LAS f32x4*)(P + 256 + ks * 4);
    o.b1 = *(const LAS f32x4*)(P + 320 + ks * 4); o.k1 = *(const LAS f32x4*)(P + 384 + ks * 4); o.b2 = *(const LAS f32x4*)(P + 448 + ks * 4); o.k2 = *(const LAS f32x4*)(P + 512 + ks * 4);
    o.v1 = P[576 + row]; o.v2 = P[592 + row]; const f32x2 s = *(const LAS f32x2*)(P + 608); o.be = s[0]; o.ka = s[1];
}
DEV void wk3_step(const Wk3Op& c, LAS float* sa, f32x4& S, int j) {
    float p1 = dot4(S, c.a1), p2 = dot4(S, c.a2);
    p1 += dpp_f<0xB1>(p1); p2 += dpp_f<0xB1>(p2); p1 += dpp_f<0x4E>(p1); p2 += dpp_f<0x4E>(p2); p1 += dpp_f<0x124>(p1); p2 += dpp_f<0x124>(p2); p1 += dpp_f<0x128>(p1); p2 += dpp_f<0x128>(p2);
    const float sa1 = p1, sa2 = (p2 + c.v1 * c.ka) + sa1 * c.be;
    S = ((S * c.w12 + c.v1 * c.k1) + c.v2 * c.k2) + sa1 * c.b1 + sa2 * c.b2;
    *(LAS f32x2*)(sa + 2 * j) = (f32x2){sa1, sa2};
}
DEV void wk3_consume(const LAS float* buf, LAS unsigned char* sab, LAS unsigned char* h0b, f32x4& S, int row, int ks) {
    *(LAS f32x4*)(h0b + row * 272 + ks * 16) = S;
    LAS float* sa = (LAS float*)(sab + row * 144);
    Wk3Op A, B; wk3_ld(A, buf, row, ks);
#pragma unroll 2
    for (int j = 0; j < W2_NP; j += 2) {
        wk3_ld(B, buf + (j + 1) * W2_PF, row, ks);
        wk3_step(A, sa, S, j);
        __builtin_amdgcn_sched_barrier(0);
        if (j + 2 < W2_NP) wk3_ld(A, buf + (j + 2) * W2_PF, row, ks);
        wk3_step(B, sa, S, j + 1);
        __builtin_amdgcn_sched_barrier(0);
    }
}
DEV void wk3_side(const LAS float* buf, LAS unsigned char* side, int pw, int lane) {
    const int qq = lane >> 4, j = lane & 15, kq = 4 * pw + qq; const LAS float* P = buf + j * W2_PF + kq * 4;
    const f32x4 Q1 = *(const LAS f32x4*)(P + 128), Q2 = *(const LAS f32x4*)(P + 192), W12 = *(const LAS f32x4*)(P + 256), B1 = *(const LAS f32x4*)(P + 320), K1 = *(const LAS f32x4*)(P + 384), B2 = *(const LAS f32x4*)(P + 448), K2 = *(const LAS f32x4*)(P + 512);
    f32x4 g2 = W12;
#pragma unroll
    for (int c = 0; c < 4; ++c) { float x = g2[c]; x *= dpp_shr_id1<0x111>(x); x *= dpp_shr_id1<0x112>(x); x *= dpp_shr_id1<0x114>(x); x *= dpp_shr_id1<0x118>(x); g2[c] = x; }
    f32x4 g0, inv;
#pragma unroll
    for (int c = 0; c < 4; ++c) { g0[c] = dpp_shr_id1<0x111>(g2[c]); inv[c] = 1.0f / g2[c]; }
    const f32x4 r1 = g0 * Q1, r2 = g0 * Q2, b1 = B1 * inv, k1 = K1 * inv, b2 = B2 * inv, k2 = K2 * inv;
    LAS unsigned char* o = side + (2 * j) * 144 + kq * 8;
    *(LAS u32x2*)(o) = (u32x2){cvt_pk_bf16(r1[0], r1[1]), cvt_pk_bf16(r1[2], r1[3])}; *(LAS u32x2*)(o + 144) = (u32x2){cvt_pk_bf16(r2[0], r2[1]), cvt_pk_bf16(r2[2], r2[3])};
    *(LAS u32x2*)(o + W3_BT) = (u32x2){cvt_pk_bf16(b1[0], b1[1]), cvt_pk_bf16(b1[2], b1[3])}; *(LAS u32x2*)(o + W3_BT + 144) = (u32x2){cvt_pk_bf16(b2[0], b2[1]), cvt_pk_bf16(b2[2], b2[3])};
    *(LAS u32x2*)(o + W3_KT) = (u32x2){cvt_pk_bf16(k1[0], k1[1]), cvt_pk_bf16(k1[2], k1[3])}; *(LAS u32x2*)(o + W3_KT + 144) = (u32x2){cvt_pk_bf16(k2[0], k2[1]), cvt_pk_bf16(k2[2], k2[3])};
    if (pw == 0) { const f32x4 v1 = *(const LAS f32x4*)(buf + j * W2_PF + 576 + 4 * qq), v2 = *(const LAS f32x4*)(buf + j * W2_PF + 592 + 4 * qq);
#pragma unroll
        for (int rr = 0; rr < 4; ++rr) *(LAS unsigned*)(side + W3_VT + (4 * qq + rr) * 80 + (2 * j) * 2) = cvt_pk_bf16(v1[rr], v2[rr]); }
}
DEV void wk3_ymma(const LAS unsigned char* side, const LAS unsigned char* sab, const LAS unsigned char* h0b, LAS unsigned char* gs, bf16_t* yrow, int mt, int lane) {
    const int tl = lane & 15, lq = lane >> 4; const f32x4 z4 = (f32x4){0.f, 0.f, 0.f, 0.f};
    bf16x8 fR[2];
#pragma unroll
    for (int ks = 0; ks < 2; ++ks) fR[ks] = *(const LAS bf16x8*)(side + (16 * mt + tl) * 144 + (32 * ks + 8 * lq) * 2);
#pragma unroll
    for (int nt = 0; nt < 2; ++nt) { f32x4 g1 = z4, g2 = z4;
        if (nt <= mt) {
#pragma unroll
            for (int ks = 0; ks < 2; ++ks) { const bf16x8 fB = *(const LAS bf16x8*)(side + W3_BT + (16 * nt + tl) * 144 + (32 * ks + 8 * lq) * 2), fK = *(const LAS bf16x8*)(side + W3_KT + (16 * nt + tl) * 144 + (32 * ks + 8 * lq) * 2);
                g1 = __builtin_amdgcn_mfma_f32_16x16x32_bf16(fB, fR[ks], g1, 0, 0, 0); g2 = __builtin_amdgcn_mfma_f32_16x16x32_bf16(fK, fR[ks], g2, 0, 0, 0); } }
#pragma unroll
        for (int i = 0; i < 4; ++i) { const bool keep = (nt <= mt) && (16 * nt + 4 * lq + i <= 16 * mt + tl); g1[i] = keep ? g1[i] : 0.f; g2[i] = keep ? g2[i] : 0.f; }
        *(LAS u32x2*)(gs + tl * 80 + (16 * nt + 4 * lq) * 2) = (u32x2){cvt_pk_bf16(g1[0], g1[1]), cvt_pk_bf16(g1[2], g1[3])};
        *(LAS u32x2*)(gs + 1280 + tl * 80 + (16 * nt + 4 * lq) * 2) = (u32x2){cvt_pk_bf16(g2[0], g2[1]), cvt_pk_bf16(g2[2], g2[3])}; }
    asm volatile("s_waitcnt lgkmcnt(0)" ::: "memory");
    const bf16x8 fG1 = *(const LAS bf16x8*)(gs + tl * 80 + (8 * lq) * 2), fG2 = *(const LAS bf16x8*)(gs + 1280 + tl * 80 + (8 * lq) * 2);
    const LAS float* sp = (const LAS float*)(sab + tl * 144) + 8 * lq; const bf16x8 fS = f8_to_bf16x8(*(const LAS f32x4*)sp, *(const LAS f32x4*)(sp + 4));
    const bf16x8 fV = *(const LAS bf16x8*)(side + W3_VT + tl * 80 + (8 * lq) * 2);
    f32x4 y = __builtin_amdgcn_mfma_f32_16x16x32_bf16(fS, fG1, z4, 0, 0, 0);
    y = __builtin_amdgcn_mfma_f32_16x16x32_bf16(fV, fG2, y, 0, 0, 0);
#pragma unroll
    for (int ks = 0; ks < 2; ++ks) { const LAS float* hp = (const LAS float*)(h0b + tl * 272) + 32 * ks + 8 * lq; const bf16x8 fH = f8_to_bf16x8(*(const LAS f32x4*)hp, *(const LAS f32x4*)(hp + 4));
        y = __builtin_amdgcn_mfma_f32_16x16x32_bf16(fH, fR[ks], y, 0, 0, 0); }
    asm volatile("s_nop 15" : "+v"(y));
    *(u32x2*)(yrow + (size_t)(16 * mt + tl) * 512 + 4 * lq) = (u32x2){cvt_pk_bf16(y[0], y[1]), cvt_pk_bf16(y[2], y[3])};
    asm volatile("s_waitcnt lgkmcnt(0)" ::: "memory");
}
DEV void phase4_wkv3(unsigned char* ws, LAS float* lds, int wg, int nwg, const float* pu, const float* pv, const float* gn) {
    const bf16_t* praw = (const bf16_t*)(ws + WS_PRAW); const bf16_t* dd = (const bf16_t*)(ws + WS_DD); const bf16_t* aa = (const bf16_t*)(ws + WS_AA); bf16_t* yr = (bf16_t*)(ws + WS_YR);
    const float* par = (const float*)(ws + WS_PAR); LAS unsigned char* lb = (LAS unsigned char*)lds;
    const int tid = threadIdx.x, wid = __builtin_amdgcn_readfirstlane(tid >> 6), lane = tid & 63; const bool producer = wid >= 4; const int pw = wid & 3;
    LAS float* buf0 = lds; LAS float* buf1 = lds + W2_BF;
    const int p = tid & 255, j = p >> 4, q = p & 15;
    const int row = (wid & 3) * 4 + (lane >> 4), ks = lane & 15;
    for (int it = wg; it < 256; it += nwg) {
        const int bh = (it & 7) * 8 + ((it >> 3) >> 2), qd = (it >> 3) & 3, b = bh >> 3, h = bh & 7;
        bf16_t* ybase = yr + (size_t)b * SEQ * 512 + h * 64 + qd * 16;
        if (producer) {
            const int c = h * 64 + q * 4;
            const f32x4 mur = *(const f32x4*)(par + PAR_MU + c), muk = *(const f32x4*)(par + PAR_MU + 512 + c), kkc = *(const f32x4*)(par + PAR_KK + c), kac = *(const f32x4*)(par + PAR_KA + c);
            const f32x4 muv = *(const f32x4*)(par + PAR_MU + 1024 + h * 64 + qd * 16 + (q & 3) * 4);
            Wk2Load L0, L1;
            wk2_issue(L0, praw, dd, aa, b, h, qd, 0, j, q); wk2_issue(L1, praw, dd, aa, b, h, qd, 1, j, q);
            wk2_produce(L0, buf0, 0, j, q, mur, muk, kkc, kac, muv);
            wk2_issue(L0, praw, dd, aa, b, h, qd, 2, j, q);
#if OPT_PEER == 2
            TabGrp tg; tab_cvt_load(tg, pu, pv, (it * 64) * 256 + p);
#endif
            __syncthreads();
            for (int blk = 0; blk < WK_NBLK; blk += 2) {
                wk2_produce(L1, buf1, blk + 1, j, q, mur, muk, kkc, kac, muv);
                if (blk + 3 < WK_NBLK) wk2_issue(L1, praw, dd, aa, b, h, qd, blk + 3, j, q);
                wk3_side(buf0, lb + W3_SIDE0, pw, lane);
                if (blk > 0 && pw < 2) wk3_ymma(lb + W3_SIDE0 + W3_SIDESZ, lb + W3_SA0 + W3_SASZ, lb + W3_H00 + W3_H0SZ, lb + W3_GS0 + pw * W3_GSSZ, ybase + (size_t)(blk - 1) * WK_TB * 512, pw, lane);
                __syncthreads();
                if (blk + 2 < WK_NBLK) wk2_produce(L0, buf0, blk + 2, j, q, mur, muk, kkc, kac, muv);
                if (blk + 4 < WK_NBLK) wk2_issue(L0, praw, dd, aa, b, h, qd, blk + 4, j, q);
                wk3_side(buf1, lb + W3_SIDE0 + W3_SIDESZ, pw, lane);
                if (pw < 2) wk3_ymma(lb + W3_SIDE0, lb + W3_SA0, lb + W3_H00, lb + W3_GS0 + pw * W3_GSSZ, ybase + (size_t)blk * WK_TB * 512, pw, lane);
#if OPT_PEER == 2
                { const int gi = (it * 64 + (blk >> 1)) * 256 + p; tab_cvt_store(tg, gn, ws, gi); if (blk + 2 < WK_NBLK) tab_cvt_load(tg, pu, pv, gi + 256); }
#endif
                __syncthreads();
            }
            if (pw < 2) wk3_ymma(lb + W3_SIDE0 + W3_SIDESZ, lb + W3_SA0 + W3_SASZ, lb + W3_H00 + W3_H0SZ, lb + W3_GS0 + pw * W3_GSSZ, ybase + (size_t)(WK_NBLK - 1) * WK_TB * 512, pw, lane);
        } else {
            f32x4 S = (f32x4){0.f, 0.f, 0.f, 0.f};
            __syncthreads();
            for (int blk = 0; blk < WK_NBLK; blk += 2) {
                wk3_consume(buf0, lb + W3_SA0, lb + W3_H00, S, row, ks);
                __syncthreads();
                wk3_consume(buf1, lb + W3_SA0 + W3_SASZ, lb + W3_H00 + W3_H0SZ, S, row, ks);
                __syncthreads();
            }
        }
        __syncthreads();
    }
}

DEV void phase3_invn(unsigned char* ws, int gtid, int gsize) {
    const bf16_t* praw = (const bf16_t*)(ws + WS_PRAW); float* invn = (float*)(ws + WS_INVN); const float* par = (const float*)(ws + WS_PAR);
    const int lane = threadIdx.x & 63, gw = gtid >> 6, ngw = gsize >> 6, c0 = lane * 8;
    f32x4 muk[2], kkc[2];
#pragma unroll
    for (int j = 0; j < 2; ++j) { muk[j] = *(const f32x4*)(par + PAR_MU + 512 + c0 + 4 * j); kkc[j] = *(const f32x4*)(par + PAR_KK + c0 + 4 * j); }
    for (int m = gw; m < T; m += ngw) { const bool first = (m & (SEQ - 1)) == 0; const size_t mp = first ? m : m - 1;
        f32x4 k[2], kp[2]; unpack8(*(const u32x4*)(praw + pr_off((size_t)((size_t)m), 512 + c0)), k[0], k[1]); unpack8(*(const u32x4*)(praw + pr_off((size_t)(mp), 512 + c0)), kp[0], kp[1]);
        float n2 = 0.f;
#pragma unroll
        for (int j = 0; j < 2; ++j) { if (first) kp[j] = (f32x4){0.f, 0.f, 0.f, 0.f}; const f32x4 q = (k[j] + (kp[j] - k[j]) * muk[j]) * kkc[j]; n2 += (q[0] * q[0] + q[1] * q[1]) + (q[2] * q[2] + q[3] * q[3]); }
        n2 += dpp_f<0xB1>(n2); n2 += dpp_f<0x4E>(n2); n2 += dpp_f<0x141>(n2);
        if ((lane & 7) == 0) invn[(size_t)m * 8 + (lane >> 3)] = 1.0f / fmaxf(sqrtf(n2), 1e-12f);
    }
}

constexpr int W4_AT = 0, W4_BT = 2304, W4_KT = 4608, W4_RT = 6912, W4_BTT = 9216, W4_KTT = 12288, W4_VT = 15360, W4_GL = 16128, W4_SLOT = 16384;
constexpr int W4_PO = 3 * W4_SLOT, W4_POSZ = 3072, W4_PT = 0, W4_PM = 768, W4_PG1 = 1536, W4_PG2 = 2304;
constexpr int W4_PS = W4_PO + 2 * W4_POSZ, W4_NR = 0, W4_PR = 768, W4_VB = 1536, W4_SS = W4_PS + 2304, W4_RB = 0, W4_SB = 768, W4_HB = 1536, W4_NBLK = SEQ / 16;
static_assert(W4_SS + W4_HB + 2304 <= 131072, "wkv4 LDS map");
DEV bf16x8 ld16(const LAS unsigned char* base, int tl, int lq) { const bf16x8 v = *(const LAS bf16x8*)(base + tl * 48 + (lq & 1) * 16); const bf16x8 z = {0, 0, 0, 0, 0, 0, 0, 0}; return (lq < 2) ? v : z; }
typedef __bf16 bf16x4n __attribute__((ext_vector_type(4)));
DEV u32x2 cvt4(f32x4 x) { return __builtin_bit_cast(u32x2, __builtin_convertvector(x, bf16x4n)); }
DEV void wr16(LAS unsigned char* base, f32x4 x, int tl, int lq) { *(LAS u32x2*)(base + tl * 48 + lq * 8) = cvt4(x); }
DEV f32x4 mm(const bf16x8 a, const bf16x8 b, const f32x4 c) { return __builtin_amdgcn_mfma_f32_16x16x32_bf16(a, b, c, 0, 0, 0); }
struct W4Load { u32x2 r0, r1, k0, k1, d, a, v0, v1; float inv; };
DEV void wk4_issue(W4Load& L, const bf16_t* praw, const bf16_t* dd, const bf16_t* aa, const float* invn, int b, int h, int qd, int bi, int s, int kq, int qq, int pw) {
    const int t = min(bi, W4_NBLK - 1) * 16 + s; const size_t m = (size_t)b * SEQ + t, mp = (t > 0) ? m - 1 : m; const int c = h * 64 + kq * 4;
    L.r1 = *(const u32x2*)(praw + pr_off((size_t)(m), c)); L.r0 = *(const u32x2*)(praw + pr_off((size_t)(mp), c)); L.k1 = *(const u32x2*)(praw + pr_off((size_t)(m), 512 + c)); L.k0 = *(const u32x2*)(praw + pr_off((size_t)(mp), 512 + c));
    L.d = *(const u32x2*)(dd + da_off(m, c)); L.a = *(const u32x2*)(aa + da_off(m, c)); L.inv = invn[m * 8 + h];
    { const int cv = 1024 + h * 64 + qd * 16 + qq * 4; L.v1 = *(const u32x2*)(praw + pr_off((size_t)(m), cv)); L.v0 = *(const u32x2*)(praw + pr_off((size_t)(mp), cv)); }
}
DEV void wk4_produce(const W4Load& L, LAS unsigned char* slot, int bi, int s, int kq, int qq, int pw, const f32x4 mur, const f32x4 muk, const f32x4 kkc, const f32x4 kac, const f32x4 muv) {
    const bool first = (bi == 0 && s == 0);
    f32x4 r0, r1, k0, k1, d, a; up4(L.r0, r0); up4(L.r1, r1); up4(L.k0, k0); up4(L.k1, k1); up4(L.d, d); up4(L.a, a);
    if (first) { r0 = (f32x4){0.f, 0.f, 0.f, 0.f}; k0 = r0; }
    const f32x4 rl = r1 + (r0 - r1) * mur, kl = k1 + (k0 - k1) * muk, kk = kl * kkc * L.inv;
    const f32x4 bh = kk * a, k2 = kl * (1.0f + (a - 1.0f) * kac), w = 1.0f - d;
    f32x4 g = w, gx, ig;
#pragma unroll
    for (int c = 0; c < 4; ++c) { float x = g[c]; x *= dpp_shr_id1<0x111>(x); x *= dpp_shr_id1<0x112>(x); x *= dpp_shr_id1<0x114>(x); x *= dpp_shr_id1<0x118>(x); g[c] = x; gx[c] = dpp_shr_id1<0x111>(x); ig[c] = 1.0f / x; }
    const f32x4 at = -(kk * gx), bt = bh * ig, kt = k2 * ig, rt = rl * g;
    LAS unsigned char* o = slot + s * 144 + kq * 8;
    *(LAS u32x2*)(o + W4_AT) = (u32x2){cvt_pk_bf16(at[0], at[1]), cvt_pk_bf16(at[2], at[3])}; *(LAS u32x2*)(o + W4_BT) = (u32x2){cvt_pk_bf16(bt[0], bt[1]), cvt_pk_bf16(bt[2], bt[3])};
    *(LAS u32x2*)(o + W4_KT) = (u32x2){cvt_pk_bf16(kt[0], kt[1]), cvt_pk_bf16(kt[2], kt[3])}; *(LAS u32x2*)(o + W4_RT) = (u32x2){cvt_pk_bf16(rt[0], rt[1]), cvt_pk_bf16(rt[2], rt[3])};
#pragma unroll
    for (int c = 0; c < 4; ++c) { *(LAS bf16_t*)(slot + W4_BTT + (4 * kq + c) * 48 + s * 2) = f2bf(bt[c]); *(LAS bf16_t*)(slot + W4_KTT + (4 * kq + c) * 48 + s * 2) = f2bf(kt[c]); }
    if (s == 15) *(LAS f32x4*)(slot + W4_GL + kq * 16) = g;
    if (pw == 0) { f32x4 v0, v1; up4(L.v0, v0); up4(L.v1, v1); if (first) v0 = (f32x4){0.f, 0.f, 0.f, 0.f}; const f32x4 vl = v1 + (v0 - v1) * muv;
#pragma unroll
        for (int c = 0; c < 4; ++c) *(LAS bf16_t*)(slot + W4_VT + (4 * qq + c) * 48 + s * 2) = f2bf(vl[c]); }
}
DEV bf16x8 fa(f32x4 x) { const u32x2 c = cvt4(x); const u32x4 w = (u32x4){c[0], c[1], 0u, 0u}; return __builtin_bit_cast(bf16x8, w); }
DEV bf16x8 ld16p(const LAS unsigned char* base, int tl, int lq) { const u32x2 v = *(const LAS u32x2*)(base + tl * 48 + lq * 8); const u32x4 w = (u32x4){v[0], v[1], 0u, 0u}; return __builtin_bit_cast(bf16x8, w); }
DEV bf16x8 ld64p(const LAS unsigned char* rowbase, int ks, int lq) { const u32x2 a = *(const LAS u32x2*)(rowbase + (32 * ks + 4 * lq) * 2), b = *(const LAS u32x2*)(rowbase + (32 * ks + 16 + 4 * lq) * 2); const u32x4 w = (u32x4){a[0], a[1], b[0], b[1]}; return __builtin_bit_cast(bf16x8, w); }
DEV void wk4_prep(const LAS unsigned char* slot, LAS unsigned char* po, int lane) {
    const int tl = lane & 15, lq = lane >> 4; const f32x4 z4 = (f32x4){0.f, 0.f, 0.f, 0.f};
    f32x4 aN = z4, aP = z4, aM = z4, aG1 = z4, aG2 = z4;
#pragma unroll
    for (int ks = 0; ks < 2; ++ks) { const int off = tl * 144 + (32 * ks + 8 * lq) * 2;
        const bf16x8 fA = *(const LAS bf16x8*)(slot + W4_AT + off), fB = *(const LAS bf16x8*)(slot + W4_BT + off), fK = *(const LAS bf16x8*)(slot + W4_KT + off), fR = *(const LAS bf16x8*)(slot + W4_RT + off);
        aN = mm(fA, fB, aN); aP = mm(fB, fA, aP); aM = mm(fK, fA, aM); aG1 = mm(fB, fR, aG1); aG2 = mm(fK, fR, aG2); }
    f32x4 aV;
#pragma unroll
    for (int i = 0; i < 4; ++i) { const int r = 4 * lq + i;
        aN[i] = (tl < r) ? aN[i] : 0.f;
        aP[i] = (r < tl) ? aP[i] : 0.f;
        aM[i] = (r < tl) ? aM[i] : 0.f;
        aG1[i] = (r <= tl) ? aG1[i] : 0.f; aG2[i] = (r <= tl) ? aG2[i] : 0.f;
        aV[i] = aP[i] + ((r == tl) ? 1.0f : 0.f); }
    wr16(po + W4_PM, aM, tl, lq); wr16(po + W4_PG1, aG1, tl, lq); wr16(po + W4_PG2, aG2, tl, lq);
#pragma unroll
    for (int lv = 1; lv <= 3; ++lv) {
        const bf16x8 fN = fa(aN), fP = fa(aP);
        aN = mm(fP, fN, z4);
        if (lv < 3) aP = mm(fN, fP, z4);
        aV = mm(fa(aN), fa(aV), aV);
    }
    wr16(po + W4_PT, aV, tl, lq);
    asm volatile("s_waitcnt lgkmcnt(0)" ::: "memory");
}
DEV void wk4_solve(const LAS unsigned char* slot, const LAS unsigned char* po, f32x4 (&H)[4], bf16_t* yrow, int lane) {
    const int tl = lane & 15, lq = lane >> 4; const f32x4 z4 = (f32x4){0.f, 0.f, 0.f, 0.f};
    bf16x8 fH[2], fA[2], fR[2];
#pragma unroll
    for (int ks = 0; ks < 2; ++ks) { fA[ks] = ld64p(slot + W4_AT + tl * 144, ks, lq); fR[ks] = ld64p(slot + W4_RT + tl * 144, ks, lq);
        const u32x2 c0 = cvt4(H[2 * ks]), c1 = cvt4(H[2 * ks + 1]); const u32x4 w = (u32x4){c0[0], c0[1], c1[0], c1[1]}; fH[ks] = __builtin_bit_cast(bf16x8, w); }
    const bf16x8 fM = ld16p(po + W4_PM, tl, lq), fT = ld16p(po + W4_PT, tl, lq), fG1 = ld16p(po + W4_PG1, tl, lq), fG2 = ld16p(po + W4_PG2, tl, lq), fV = ld16p(slot + W4_VT, tl, lq);
    f32x4 rhs = mm(fA[0], fH[0], z4); rhs = mm(fA[1], fH[1], rhs); rhs = mm(fM, fV, rhs);
    const f32x4 sa = mm(fT, fa(rhs), z4);
    const bf16x8 fS = fa(sa);
    f32x4 y = mm(fS, fG1, z4); y = mm(fV, fG2, y); y = mm(fH[0], fR[0], y); y = mm(fH[1], fR[1], y);
#pragma unroll
    for (int kt = 0; kt < 4; ++kt) { H[kt] = mm(ld16p(slot + W4_BTT + kt * 768, tl, lq), fS, H[kt]); H[kt] = mm(ld16p(slot + W4_KTT + kt * 768, tl, lq), fV, H[kt]);
        H[kt] = H[kt] * *(const LAS f32x4*)(slot + W4_GL + (16 * kt + 4 * lq) * 4); }
    *(u32x2*)(yrow + (size_t)tl * 512 + 4 * lq) = cvt4(y);
}
DEV void phase4_wkv4(unsigned char* ws, LAS float* lds, int wg, int nwg, const float* pu, const float* pv, const float* gn, const int abl) {
    const bf16_t* praw = (const bf16_t*)(ws + WS_PRAW); const bf16_t* dd = (const bf16_t*)(ws + WS_DD); const bf16_t* aa = (const bf16_t*)(ws + WS_AA); bf16_t* yr = (bf16_t*)(ws + WS_YR);
    const float* par = (const float*)(ws + WS_PAR); const float* invn = (const float*)(ws + WS_INVN); LAS unsigned char* lb = (LAS unsigned char*)lds;
    const int tid = threadIdx.x, wid = __builtin_amdgcn_readfirstlane(tid >> 6), lane = tid & 63; const int pw = wid & 3, qq = lane >> 4, s = lane & 15, kq = 4 * pw + qq;
    const bool producer = wid >= 4;
    for (int it = wg; it < 256; it += nwg) {
        const int bh = (it & 7) * 8 + ((it >> 3) >> 2), qd = (it >> 3) & 3, b = bh >> 3, h = bh & 7;
        bf16_t* ybase = yr + (size_t)b * SEQ * 512 + h * 64 + qd * 16;
        const int c = h * 64 + kq * 4;
        const f32x4 mur = *(const f32x4*)(par + PAR_MU + c), muk = *(const f32x4*)(par + PAR_MU + 512 + c), kkc = *(const f32x4*)(par + PAR_KK + c), kac = *(const f32x4*)(par + PAR_KA + c);
        const f32x4 muv = *(const f32x4*)(par + PAR_MU + 1024 + h * 64 + qd * 16 + qq * 4);
        W4Load La, Lb; f32x4 H[4];
#pragma unroll
        for (int kt = 0; kt < 4; ++kt) H[kt] = (f32x4){0.f, 0.f, 0.f, 0.f};
#if OPT_PEER == 2
        TabGrp tg0, tg1, tg2, tg3; const int p2 = tid & 127;
#endif
        if (producer) {
            wk4_issue(La, praw, dd, aa, invn, b, h, qd, 0, s, kq, qq, pw); wk4_issue(Lb, praw, dd, aa, invn, b, h, qd, 1, s, kq, qq, pw);
            wk4_produce(La, lb, 0, s, kq, qq, pw, mur, muk, kkc, kac, muv); wk4_issue(La, praw, dd, aa, invn, b, h, qd, 2, s, kq, qq, pw);
            __syncthreads();
            wk4_produce(Lb, lb + W4_SLOT, 1, s, kq, qq, pw, mur, muk, kkc, kac, muv); wk4_issue(Lb, praw, dd, aa, invn, b, h, qd, 3, s, kq, qq, pw);
            __syncthreads();
            int s0 = 0, s2 = 2;
            for (int bi = 0; bi < W4_NBLK; bi += 2) {
                if (!(abl & 4)) wk4_produce(La, lb + s2 * W4_SLOT, bi + 2, s, kq, qq, pw, mur, muk, kkc, kac, muv); if (!(abl & 8)) wk4_issue(La, praw, dd, aa, invn, b, h, qd, bi + 4, s, kq, qq, pw);
                __syncthreads();
                if (!(abl & 4)) wk4_produce(Lb, lb + s0 * W4_SLOT, bi + 3, s, kq, qq, pw, mur, muk, kkc, kac, muv); if (!(abl & 8)) wk4_issue(Lb, praw, dd, aa, invn, b, h, qd, bi + 5, s, kq, qq, pw);
                __syncthreads();
                const int s1 = 3 - s0 - s2, t0 = s0; s0 = s2; s2 = s1; (void)t0;
            }
        } else if (wid == 1) {
            __syncthreads();
            wk4_prep(lb, lb + W4_PO, lane);
            __syncthreads();
            int s1 = 1, s2 = 2;
            for (int bi = 0; bi < W4_NBLK; bi += 2) {
                if (!(abl & 2)) wk4_prep(lb + s1 * W4_SLOT, lb + W4_PO + W4_POSZ, lane);
                __syncthreads();
                if (!(abl & 2)) wk4_prep(lb + s2 * W4_SLOT, lb + W4_PO, lane);
                __syncthreads();
                const int s0 = 3 - s1 - s2; s2 = s1; s1 = s0;
            }
        } else if (wid == 0) {
            __syncthreads();
            __syncthreads();
            int s0 = 0, s1 = 1;
            for (int bi = 0; bi < W4_NBLK; bi += 2) {
                if (!(abl & 1)) wk4_solve(lb + s0 * W4_SLOT, lb + W4_PO, H, ybase + (size_t)bi * 16 * 512, lane);
                __syncthreads();
                if (!(abl & 1)) wk4_solve(lb + s1 * W4_SLOT, lb + W4_PO + W4_POSZ, H, ybase + (size_t)(bi + 1) * 16 * 512, lane);
                __syncthreads();
                const int s2 = 3 - s0 - s1; s1 = s0; s0 = s2;
            }
        } else {
#if OPT_PEER == 2
            { const int gi = (it * 128) * 128 + p2; tab_cvt_load(tg0, pu, pv, gi); tab_cvt_load(tg1, pu, pv, gi + 128); tab_cvt_load(tg2, pu, pv, gi + 256); tab_cvt_load(tg3, pu, pv, gi + 384); }
#endif
            __syncthreads();
            __syncthreads();
            for (int bi = 0; bi < W4_NBLK; bi += 2) {
#if OPT_PEER == 2
                if ((bi & 7) == 0 && !(abl & 16)) { const int gi = (it * 128 + (bi >> 1)) * 128 + p2;
                    tab_cvt_store(tg0, gn, ws, gi); tab_cvt_store(tg1, gn, ws, gi + 128); tab_cvt_store(tg2, gn, ws, gi + 256); tab_cvt_store(tg3, gn, ws, gi + 384);
                    if (bi + 8 < W4_NBLK) { tab_cvt_load(tg0, pu, pv, gi + 512); tab_cvt_load(tg1, pu, pv, gi + 640); tab_cvt_load(tg2, pu, pv, gi + 768); tab_cvt_load(tg3, pu, pv, gi + 896); } }
#endif
                __syncthreads();
                __syncthreads();
            }
        }
        __syncthreads();
    }
}

struct XcdBarrier; DEV void xcd_barrier(const XcdBarrier& b);
constexpr int W5_NBH = 128, W5_STEPS = W5_NBH + 8, W5_NCH = 256 / W5_NBH;
constexpr int R_FA = 0, R_FR = 2048, R_FBT = 4096, R_FKT = 6144, R_FM = 8192, R_FT = 8704, R_FG1 = 9216, R_FG2 = 9728, R_GL = 10240, R_FV = 10752, R_SIZE = 10752, W5_SLOT = 11264;
constexpr int P5_AT = 0, P5_BT = 2304, P5_KT = 4608, P5_RT = 6912, P5_BS = 9216, P5_KS = 11520, P5_VT = 13824, P5_GL = 16128, P5_SIZE = 16384;
typedef short bf16x4s __attribute__((ext_vector_type(4)));
DEV f32x4 mm16(const u32x2 a, const u32x2 b, const f32x4 c) { return __builtin_amdgcn_mfma_f32_16x16x16bf16_1k(__builtin_bit_cast(bf16x4s, a), __builtin_bit_cast(bf16x4s, b), c, 0, 0, 0); }
DEV f32x4 mm16p(const u32x2 a, const u32x2 b, const f32x4 c) { const u32x4 a4 = (u32x4){a[0], a[1], 0u, 0u}, b4 = (u32x4){b[0], b[1], 0u, 0u}; return __builtin_amdgcn_mfma_f32_16x16x32_bf16(__builtin_bit_cast(bf16x8, a4), __builtin_bit_cast(bf16x8, b4), c, 0, 0, 0); }
DEV f32x4 mm32(const u32x4 a, const u32x4 b, const f32x4 c) { return __builtin_amdgcn_mfma_f32_16x16x32_bf16(__builtin_bit_cast(bf16x8, a), __builtin_bit_cast(bf16x8, b), c, 0, 0, 0); }
struct W5Load { u32x4 r0, r1, k0, k1, d, a; };
constexpr int P5_CONST = 131072 + 1024;
DEV void wk5_issue(W5Load& L, const bf16_t* praw, const bf16_t* dd, const bf16_t* aa, const float* invn, int b, int h, int blk, int s, int g8) {
    const int t = blk * 16 + s; const size_t m = (size_t)b * SEQ + t, mp = (t > 0) ? m - 1 : m; const int c = h * 64 + g8 * 8;
    L.r1 = *(const u32x4*)(praw + pr_off((size_t)(m), c)); L.k1 = *(const u32x4*)(praw + pr_off((size_t)(m), 512 + c));
    if (s == 0) { L.r0 = *(const u32x4*)(praw + pr_off((size_t)(mp), c)); L.k0 = *(const u32x4*)(praw + pr_off((size_t)(mp), 512 + c)); }
    L.d = *(const u32x4*)(dd + da_off(m, c)); L.a = *(const u32x4*)(aa + da_off(m, c)); (void)invn;
}
struct W5Half { f32x4 g, at, bt, kt, rt; float bsum; };
DEV void wk5_math(W5Half& R, const u32x2 r0w, const u32x2 r1w, const u32x2 k0w, const u32x2 k1w, const u32x2 dw, const u32x2 aw, const float inv, const bool first, const LAS float* cst, const int kq) {
    const f32x4 mur = *(const LAS f32x4*)(cst + kq * 4), muk = *(const LAS f32x4*)(cst + 64 + kq * 4), kkc = *(const LAS f32x4*)(cst + 192 + kq * 4), kac = *(const LAS f32x4*)(cst + 256 + kq * 4);
    f32x4 r0, r1, k0, k1, d, a; up4(r0w, r0); up4(r1w, r1); up4(k0w, k0); up4(k1w, k1); up4(dw, d); up4(aw, a);
    if (first) { r0 = (f32x4){0.f, 0.f, 0.f, 0.f}; k0 = r0; }
    const f32x4 rl = r1 + (r0 - r1) * mur, kl = k1 + (k0 - k1) * muk, kk = kl * kkc * inv;
    const f32x4 bh = kk * a, k2 = kl * (1.0f + (a - 1.0f) * kac), w = 1.0f - d;
    { const f32x4 tb = rl * k2 * *(const LAS f32x4*)(cst + 320 + kq * 4); R.bsum = (tb[0] + tb[1]) + (tb[2] + tb[3]); }
    f32x4 g = w, gx, ig;
#pragma unroll
    for (int c = 0; c < 4; ++c) { float x = g[c]; x *= dpp_shr_id1<0x111>(x); x *= dpp_shr_id1<0x112>(x); x *= dpp_shr_id1<0x114>(x); x *= dpp_shr_id1<0x118>(x); g[c] = x; gx[c] = dpp_shr_id1<0x111>(x); ig[c] = __builtin_amdgcn_rcpf(x); }
    R.g = g; R.at = -(kk * gx); R.bt = bh * ig; R.kt = k2 * ig; R.rt = rl * g;
}
DEV float wk5_knorm2(const W5Load& L, const LAS float* cst, const bool first, const int g8) {
    float n2 = 0.f;
#pragma unroll
    for (int hf = 0; hf < 2; ++hf) { const int kq = 2 * g8 + hf;
        const f32x4 muk = *(const LAS f32x4*)(cst + 64 + kq * 4), kkc = *(const LAS f32x4*)(cst + 192 + kq * 4);
        u32x2 k0w, k1w = (u32x2){L.k1[2 * hf], L.k1[2 * hf + 1]};
        k0w[0] = (unsigned)__builtin_amdgcn_update_dpp((int)L.k0[2 * hf], (int)L.k1[2 * hf], 0x111, 0xf, 0xf, false); k0w[1] = (unsigned)__builtin_amdgcn_update_dpp((int)L.k0[2 * hf + 1], (int)L.k1[2 * hf + 1], 0x111, 0xf, 0xf, false);
        f32x4 k0, k1; up4(k0w, k0); up4(k1w, k1); if (first) k0 = (f32x4){0.f, 0.f, 0.f, 0.f};
        const f32x4 q = (k1 + (k0 - k1) * muk) * kkc; n2 += (q[0] * q[0] + q[1] * q[1]) + (q[2] * q[2] + q[3] * q[3]); }
    return n2;
}
DEV u32x4 pk8(const f32x4 lo, const f32x4 hi) { const u32x2 a = cvt4(lo), b = cvt4(hi); return (u32x4){a[0], a[1], b[0], b[1]}; }
DEV float wk5_produce(const W5Load& L, const float inv, LAS unsigned char* pl, const LAS float* cst, unsigned char* rec, int blk, int s, int g8) {
    const bool first = (blk == 0 && s == 0);
    W5Half A, B; u32x4 r0, k0;
#pragma unroll
    for (int i = 0; i < 4; ++i) { r0[i] = (unsigned)__builtin_amdgcn_update_dpp((int)L.r0[i], (int)L.r1[i], 0x111, 0xf, 0xf, false); k0[i] = (unsigned)__builtin_amdgcn_update_dpp((int)L.k0[i], (int)L.k1[i], 0x111, 0xf, 0xf, false); }
    wk5_math(A, (u32x2){r0[0], r0[1]}, (u32x2){L.r1[0], L.r1[1]}, (u32x2){k0[0], k0[1]}, (u32x2){L.k1[0], L.k1[1]}, (u32x2){L.d[0], L.d[1]}, (u32x2){L.a[0], L.a[1]}, inv, first, cst, 2 * g8);
    wk5_math(B, (u32x2){r0[2], r0[3]}, (u32x2){L.r1[2], L.r1[3]}, (u32x2){k0[2], k0[3]}, (u32x2){L.k1[2], L.k1[3]}, (u32x2){L.d[2], L.d[3]}, (u32x2){L.a[2], L.a[3]}, inv, first, cst, 2 * g8 + 1);
    if (s == 15) { *(LAS f32x4*)(pl + P5_GL + g8 * 32) = A.g; *(LAS f32x4*)(pl + P5_GL + g8 * 32 + 16) = B.g; *(f32x4*)(rec + R_GL + g8 * 32) = A.g; *(f32x4*)(rec + R_GL + g8 * 32 + 16) = B.g; }
    LAS unsigned char* o = pl + s * 144 + g8 * 16;
    *(LAS u32x4*)(o + P5_AT) = pk8(A.at, B.at); *(LAS u32x4*)(o + P5_BT) = pk8(A.bt, B.bt); *(LAS u32x4*)(o + P5_KT) = pk8(A.kt, B.kt); *(LAS u32x4*)(o + P5_RT) = pk8(A.rt, B.rt);
    asm volatile("" ::: "memory");
    const f32x4 gl0 = *(const LAS f32x4*)(pl + P5_GL + g8 * 32), gl1 = *(const LAS f32x4*)(pl + P5_GL + g8 * 32 + 16);
    *(LAS u32x4*)(o + P5_BS) = pk8(A.bt * gl0, B.bt * gl1); *(LAS u32x4*)(o + P5_KS) = pk8(A.kt * gl0, B.kt * gl1);
    float bs = A.bsum + B.bsum; bs += __shfl_xor(bs, 16); bs += __shfl_xor(bs, 32); return bs;
}
DEV u32x2 ld4t(const LAS unsigned char* tab, int lq, int col) {
    const LAS unsigned char* p = tab + (4 * lq) * 144 + col * 2;
    const unsigned x0 = *(const LAS unsigned short*)(p), x1 = *(const LAS unsigned short*)(p + 144), x2 = *(const LAS unsigned short*)(p + 288), x3 = *(const LAS unsigned short*)(p + 432);
    return (u32x2){x0 | (x1 << 16), x2 | (x3 << 16)};
}
DEV u32x4 ld64q(const LAS unsigned char* rowbase, int ks, int lq) { const u32x2 a = *(const LAS u32x2*)(rowbase + (32 * ks + 4 * lq) * 2), b = *(const LAS u32x2*)(rowbase + (32 * ks + 16 + 4 * lq) * 2); return (u32x4){a[0], a[1], b[0], b[1]}; }
DEV void wk5_emit(const LAS unsigned char* pl, unsigned char* rec, int lane) {
    const int tl = lane & 15, lq = lane >> 4; const f32x4 z4 = (f32x4){0.f, 0.f, 0.f, 0.f};
    f32x4 aN = z4, aP = z4, aM = z4, aG1 = z4, aG2 = z4;
#pragma unroll
    for (int ks = 0; ks < 2; ++ks) { const int off = tl * 144 + (32 * ks + 8 * lq) * 2;
        const bf16x8 fA = *(const LAS bf16x8*)(pl + P5_AT + off), fB = *(const LAS bf16x8*)(pl + P5_BT + off), fK = *(const LAS bf16x8*)(pl + P5_KT + off), fR = *(const LAS bf16x8*)(pl + P5_RT + off);
        aN = mm(fA, fB, aN); aP = mm(fB, fA, aP); aM = mm(fK, fA, aM); aG1 = mm(fB, fR, aG1); aG2 = mm(fK, fR, aG2); }
    f32x4 aV;
#pragma unroll
    for (int i = 0; i < 4; ++i) { const int r = 4 * lq + i;
        aN[i] = (tl < r) ? aN[i] : 0.f;
        aP[i] = (r < tl) ? aP[i] : 0.f;
        aM[i] = (r < tl) ? aM[i] : 0.f;
        aG1[i] = (r <= tl) ? aG1[i] : 0.f; aG2[i] = (r <= tl) ? aG2[i] : 0.f;
        aV[i] = aP[i] + ((r == tl) ? 1.0f : 0.f); }
#pragma unroll
    for (int lv = 1; lv <= 3; ++lv) {
        const u32x2 fN = cvt4(aN), fP = cvt4(aP);
        aN = mm16p(fP, fN, z4);
        if (lv < 3) aP = mm16p(fN, fP, z4);
        aV = mm16p(cvt4(aN), cvt4(aV), aV);
    }
    const u32x2 fM = cvt4(aM), fT = cvt4(aV), fG1 = cvt4(aG1), fG2 = cvt4(aG2);
    const unsigned one = 0x3F80u, jsel = (unsigned)(tl & 7), lsel = (unsigned)(tl >> 3);
    u32x4 slo, shi;
#pragma unroll
    for (int p = 0; p < 4; ++p) { const unsigned e0 = (jsel == 2u * p) ? one : 0u, e1 = (jsel == 2u * p + 1u) ? (one << 16) : 0u; slo[p] = ((unsigned)lq == lsel) ? (e0 | e1) : 0u; shi[p] = ((unsigned)lq == lsel + 2u) ? (e0 | e1) : 0u; }
    u32x2 fb[4], fk[4];
#pragma unroll
    for (int ks = 0; ks < 2; ++ks) { const u32x4 xb = *(const LAS u32x4*)(pl + P5_BS + tl * 144 + (32 * ks + 8 * lq) * 2), xk = *(const LAS u32x4*)(pl + P5_KS + tl * 144 + (32 * ks + 8 * lq) * 2);
        fb[2 * ks] = cvt4(mm32(xb, slo, z4)); fb[2 * ks + 1] = cvt4(mm32(xb, shi, z4)); fk[2 * ks] = cvt4(mm32(xk, slo, z4)); fk[2 * ks + 1] = cvt4(mm32(xk, shi, z4)); }
    unsigned char* o = rec + lane * 16;
    *(u32x4*)(o) = ld64q(pl + P5_AT + tl * 144, 0, lq); *(u32x4*)(o + 1024) = ld64q(pl + P5_AT + tl * 144, 1, lq);
    *(u32x4*)(o + 2048) = ld64q(pl + P5_RT + tl * 144, 0, lq); *(u32x4*)(o + 3072) = ld64q(pl + P5_RT + tl * 144, 1, lq);
    *(u32x4*)(o + 4096) = (u32x4){fb[0][0], fb[0][1], fb[1][0], fb[1][1]}; *(u32x4*)(o + 5120) = (u32x4){fb[2][0], fb[2][1], fb[3][0], fb[3][1]};
    *(u32x4*)(o + 6144) = (u32x4){fk[0][0], fk[0][1], fk[1][0], fk[1][1]}; *(u32x4*)(o + 7168) = (u32x4){fk[2][0], fk[2][1], fk[3][0], fk[3][1]};
    *(u32x4*)(o + 8192) = (u32x4){fM[0], fM[1], fT[0], fT[1]}; *(u32x4*)(o + 9216) = (u32x4){fG1[0], fG1[1], fG2[0], fG2[1]};
}
struct W5Ops { u32x4 fA0, fA1; };
DEV void wk5_ld(W5Ops& P, const LAS unsigned char* slot, int lane) { P.fA0 = *(const LAS u32x4*)(slot + R_FA + lane * 16); P.fA1 = *(const LAS u32x4*)(slot + R_FA + 1024 + lane * 16); }
DEV void mm16_guard(f32x4& x) { asm volatile("s_nop 15\n\ts_nop 3" : "+v"(x)); }
DEV void wk5_block(const W5Ops& P, const LAS unsigned char* slot, f32x4 (&H)[4], bf16_t* yrow, int lane) {
    const int tl = lane & 15, lq = lane >> 4; const f32x4 z4 = (f32x4){0.f, 0.f, 0.f, 0.f};
    const u32x2 c0 = cvt4(H[0]), c1 = cvt4(H[1]), c2 = cvt4(H[2]), c3 = cvt4(H[3]);
    const u32x4 fH0 = (u32x4){c0[0], c0[1], c1[0], c1[1]}, fH1 = (u32x4){c2[0], c2[1], c3[0], c3[1]};
    const LAS unsigned char* sl = slot + lane * 16;
    const u32x2 fV = *(const LAS u32x2*)(slot + R_FV + lane * 8);
    const u32x4 mt = *(const LAS u32x4*)(sl + 8192);
    f32x4 rhs = mm32(P.fA0, fH0, z4); rhs = mm32(P.fA1, fH1, rhs); rhs = mm16p((u32x2){mt[0], mt[1]}, fV, rhs);
    const u32x4 k01 = *(const LAS u32x4*)(sl + 6144), k23 = *(const LAS u32x4*)(sl + 7168);
    H[0] = mm16p((u32x2){k01[0], k01[1]}, fV, H[0] * *(const LAS f32x4*)(slot + R_GL + (4 * lq) * 4));
    H[1] = mm16p((u32x2){k01[2], k01[3]}, fV, H[1] * *(const LAS f32x4*)(slot + R_GL + (16 + 4 * lq) * 4));
    H[2] = mm16p((u32x2){k23[0], k23[1]}, fV, H[2] * *(const LAS f32x4*)(slot + R_GL + (32 + 4 * lq) * 4));
    H[3] = mm16p((u32x2){k23[2], k23[3]}, fV, H[3] * *(const LAS f32x4*)(slot + R_GL + (48 + 4 * lq) * 4));
    const u32x4 g12 = *(const LAS u32x4*)(sl + 9216);
    f32x4 y = mm32(fH0, *(const LAS u32x4*)(sl + 2048), z4); y = mm32(fH1, *(const LAS u32x4*)(sl + 3072), y);
    y = mm16p(fV, (u32x2){g12[2], g12[3]}, y);
    const f32x4 sa = mm16p((u32x2){mt[2], mt[3]}, cvt4(rhs), z4);
    const u32x2 fS = cvt4(sa);
    const u32x4 b01 = *(const LAS u32x4*)(sl + 4096), b23 = *(const LAS u32x4*)(sl + 5120);
    H[0] = mm16p((u32x2){b01[0], b01[1]}, fS, H[0]); H[1] = mm16p((u32x2){b01[2], b01[3]}, fS, H[1]); H[2] = mm16p((u32x2){b23[0], b23[1]}, fS, H[2]); H[3] = mm16p((u32x2){b23[2], b23[3]}, fS, H[3]);
    y = mm16p(fS, (u32x2){g12[0], g12[1]}, y);
    *(u32x2*)(yrow + (size_t)tl * 512 + 4 * lq) = cvt4(y);
}
struct W5Rec { u32x4 c0, c1, c2, c3, c4, c5, c6, c7, c8, c9, c10; };
DEV void wk5_rissue(W5Rec& L, const unsigned char* rec0, int B, int lane, int off10) {
    const unsigned char* r = rec0 + (size_t)min(B, W5_NBH - 1) * R_SIZE + lane * 16;
    L.c0 = *(const u32x4*)(r); L.c1 = *(const u32x4*)(r + 1024); L.c2 = *(const u32x4*)(r + 2048); L.c3 = *(const u32x4*)(r + 3072); L.c4 = *(const u32x4*)(r + 4096); L.c5 = *(const u32x4*)(r + 5120);
    L.c6 = *(const u32x4*)(r + 6144); L.c7 = *(const u32x4*)(r + 7168); L.c8 = *(const u32x4*)(r + 8192); L.c9 = *(const u32x4*)(r + 9216); L.c10 = *(const u32x4*)(r + off10);
}
DEV void wk5_rwrite(const W5Rec& L, LAS unsigned char* slot, int lane) {
    LAS unsigned char* o = slot + lane * 16;
    *(LAS u32x4*)(o) = L.c0; *(LAS u32x4*)(o + 1024) = L.c1; *(LAS u32x4*)(o + 2048) = L.c2; *(LAS u32x4*)(o + 3072) = L.c3; *(LAS u32x4*)(o + 4096) = L.c4; *(LAS u32x4*)(o + 5120) = L.c5;
    *(LAS u32x4*)(o + 6144) = L.c6; *(LAS u32x4*)(o + 7168) = L.c7; *(LAS u32x4*)(o + 8192) = L.c8; *(LAS u32x4*)(o + 9216) = L.c9; *(LAS u32x4*)(o + 10240) = L.c10;
}
DEV void phase5_post_b(unsigned char* ws, int gw, int ngw, int t_lo, int t_hi);
constexpr int W6_LOADER = 1;
constexpr int W6_NBH = 64, W6_NCH = 256 / W6_NBH, W6_UNITS = 8 * (W6_NBH / 32), W6_HTAB = 4 * W5_SLOT, W6_CONST = W6_HTAB + 6 * P5_SIZE, W6_FLAGS = W6_CONST + 1536;
static_assert(W6_FLAGS + 32 <= LDSCTL_OFF, "wkv6 LDS map overruns the barrier words");
constexpr size_t W6_BUF = (size_t)64 * W6_NBH * R_SIZE;
constexpr int W6_TPOST = (W6_NCH - 1) * W6_NBH * 16;
DEV void w6_wait_ge(const volatile LAS unsigned* p, int need) { while ((int)*p < need) __builtin_amdgcn_s_sleep(1); asm volatile("" ::: "memory"); }
template <bool TAB> DEV void wk6_units(unsigned char* ws, unsigned char* rbuf, LAS unsigned char* pl, const LAS float* cst, int wg, int c, int q0, int qstep, int lane, const float* pu, const float* pv, const float* gn, int tabbase) {
    const bf16_t* praw = (const bf16_t*)(ws + WS_PRAW); const bf16_t* dd = (const bf16_t*)(ws + WS_DD); const bf16_t* aa = (const bf16_t*)(ws + WS_AA); const float* invn = (const float*)(ws + WS_INVN);
    const int qq = lane >> 4, s = lane & 15, b = wg & 7, lwb = (wg >> 3) * 8, h = lwb >> 5;
    unsigned char* rec0 = rbuf + (size_t)(b * 8 + h) * W6_NBH * R_SIZE;
    int bl = ((lwb + (q0 & 7)) & 31) + 32 * (q0 >> 3);
    W5Load La, Lb;
    wk5_issue(La, praw, dd, aa, invn, b, h, c * W6_NBH + bl, s, qq); wk5_issue(Lb, praw, dd, aa, invn, b, h, c * W6_NBH + bl, s, 4 + qq);
    for (int q = q0; q < W6_UNITS; q += qstep) {
        const int qn = min(q + qstep, W6_UNITS - 1), bn = ((lwb + (qn & 7)) & 31) + 32 * (qn >> 3);
        const int blk = c * W6_NBH + bl, bln = c * W6_NBH + bn;
        unsigned char* rec = rec0 + (size_t)bl * R_SIZE;
        TabGrp tg0, tg1; const int ti = tabbase + q * 256 + lane;
        if (TAB) { tab_cvt_load(tg0, pu, pv, ti); tab_cvt_load(tg1, pu, pv, ti + 64); }
        float n2 = wk5_knorm2(La, cst, blk == 0 && s == 0, qq) + wk5_knorm2(Lb, cst, blk == 0 && s == 0, 4 + qq); n2 += __shfl_xor(n2, 16); n2 += __shfl_xor(n2, 32);
        const float inv = 1.0f / fmaxf(sqrtf(n2), 1e-12f);
        float bonus = wk5_produce(La, inv, pl, cst, rec, blk, s, qq);     wk5_issue(La, praw, dd, aa, invn, b, h, bln, s, qq);
        if (TAB) { tab_cvt_store(tg0, gn, ws, ti); tab_cvt_store(tg1, gn, ws, ti + 64); tab_cvt_load(tg0, pu, pv, ti + 128); tab_cvt_load(tg1, pu, pv, ti + 192); }
        bonus += wk5_produce(Lb, inv, pl, cst, rec, blk, s, 4 + qq); wk5_issue(Lb, praw, dd, aa, invn, b, h, bln, s, 4 + qq);
        if (qq == 0) ((float*)(ws + WS_BONUS))[((size_t)b * SEQ + blk * 16 + s) * 8 + h] = bonus;
        asm volatile("s_waitcnt lgkmcnt(0)" ::: "memory");
        wk5_emit(pl, rec, lane);
        asm volatile("s_waitcnt lgkmcnt(0)" ::: "memory");
        if (TAB) { tab_cvt_store(tg0, gn, ws, ti + 128); tab_cvt_store(tg1, gn, ws, ti + 192); }
        bl = bn;
    }
}
DEV void wk6_rissue(W5Rec& L, const unsigned char* rec0, int B, int lane, int off10) {
    const unsigned char* r = rec0 + (size_t)min(B, W6_NBH - 1) * R_SIZE + lane * 16;
    L.c0 = *(const u32x4*)(r); L.c1 = *(const u32x4*)(r + 1024); L.c2 = *(const u32x4*)(r + 2048); L.c3 = *(const u32x4*)(r + 3072); L.c4 = *(const u32x4*)(r + 4096); L.c5 = *(const u32x4*)(r + 5120);
    L.c6 = *(const u32x4*)(r + 6144); L.c7 = *(const u32x4*)(r + 7168); L.c8 = *(const u32x4*)(r + 8192); L.c9 = *(const u32x4*)(r + 9216); L.c10 = *(const u32x4*)(r + off10);
}
struct W6V { unsigned p, a, b, c, d; };
DEV void wk6_vissue(W6V& V, const bf16_t* vcol, int gB, int lq) {
    const int t0 = gB * 16 + 4 * lq; const bf16_t* q = vcol + (size_t)t0 * PRV;
    V.p = q[(t0 > 0) ? -PRV : 0]; V.a = q[0]; V.b = q[PRV]; V.c = q[2 * PRV]; V.d = q[3 * PRV];
}
DEV void wk6_hand(const W5Rec& L, const W6V& V, float muv, LAS unsigned char* lb, const volatile LAS unsigned* fl, int slot, int gB, int lane) {
    const int lq = lane >> 4;
    const float vp = (gB == 0 && lq == 0) ? 0.f : __uint_as_float(V.p << 16), va = __uint_as_float(V.a << 16), vb = __uint_as_float(V.b << 16), vc = __uint_as_float(V.c << 16), vd = __uint_as_float(V.d << 16);
    const f32x4 vl = (f32x4){va + (vp - va) * muv, vb + (va - vb) * muv, vc + (vb - vc) * muv, vd + (vc - vd) * muv};
    w6_wait_ge(fl + 4, gB - 3);
    wk5_rwrite(L, lb + slot * W5_SLOT, lane); *(LAS u32x2*)(lb + slot * W5_SLOT + R_FV + lane * 8) = cvt4(vl);
    asm volatile("s_waitcnt lgkmcnt(0)" ::: "memory"); *(volatile LAS unsigned*)(fl + slot) = (unsigned)(gB + 1);
}
DEV void phase4_wkv6(unsigned char* ws, unsigned char* recbase, LAS float* lds, const int wg_in, const float* pu, const float* pv, const float* gn, const XcdBarrier& bar) {
    bf16_t* yr = (bf16_t*)(ws + WS_YR); LAS unsigned char* lb = (LAS unsigned char*)lds; const float* par = (const float*)(ws + WS_PAR);
    const int tid = threadIdx.x, wid = __builtin_amdgcn_readfirstlane(tid >> 6), lane_in = tid & 63;
    asm volatile("s_waitcnt vmcnt(0)" ::: "memory");
    __syncthreads();
    { const int h = ((wg_in >> 3) * 8) >> 5;
      if (tid < 384) { const int v = tid >> 6, c = tid & 63; ((LAS float*)(lb + W6_CONST))[tid] = par[(v < 3 ? PAR_MU + 512 * v : (v == 3 ? PAR_KK : (v == 4 ? PAR_KA : PAR_RK))) + h * 64 + c]; }
      if (tid < 8) *(volatile LAS unsigned*)(lb + W6_FLAGS + tid * 4) = 0u; }
    __syncthreads();
    const LAS float* cst = (const LAS float*)(lb + W6_CONST);
    wk6_units<false>(ws, recbase, lb + wid * P5_SIZE, cst, wg_in, 0, wid, 8, lane_in, pu, pv, gn, 0);
    f32x4 H[4];
#pragma unroll
    for (int kt = 0; kt < 4; ++kt) H[kt] = (f32x4){0.f, 0.f, 0.f, 0.f};
    for (int c = 0; c < W6_NCH; ++c) {
        xcd_barrier(bar);
        int lane = lane_in, wg = wg_in; asm volatile("" : "+v"(lane), "+s"(wg));
        const int it = wg, bh = (it & 7) * 8 + ((it >> 3) >> 2), qd = (it >> 3) & 3, b = bh >> 3, h = bh & 7;
        const unsigned char* rec0 = recbase + (size_t)(c & 1) * W6_BUF + (size_t)bh * W6_NBH * R_SIZE;
        const volatile LAS unsigned* fl = (const volatile LAS unsigned*)(lb + W6_FLAGS);
        const int g0 = c * W6_NBH;
        if (wid == W6_LOADER) {
            const int o10 = (lane < 32) ? 10240 : 10240 - 512;
            const int tl = lane & 15, lq = lane >> 4;
            const bf16_t* vcol = (const bf16_t*)(ws + WS_PRAW) + pr_off((size_t)b * SEQ, 1024 + h * 64 + qd * 16 + tl);
            const float muv = par[PAR_MU + 1024 + h * 64 + qd * 16 + tl];
            W5Rec La, Lb, Lc, Ld; W6V Va, Vb, Vc, Vd;
            wk6_rissue(La, rec0, 0, lane, o10); wk6_vissue(Va, vcol, g0, lq); wk6_rissue(Lb, rec0, 1, lane, o10); wk6_vissue(Vb, vcol, g0 + 1, lq);
            wk6_rissue(Lc, rec0, 2, lane, o10); wk6_vissue(Vc, vcol, g0 + 2, lq); wk6_rissue(Ld, rec0, 3, lane, o10); wk6_vissue(Vd, vcol, g0 + 3, lq);
            for (int B = 0; B < W6_NBH; B += 4) {
                wk6_hand(La, Va, muv, lb, fl, 0, g0 + B, lane);     wk6_rissue(La, rec0, B + 4, lane, o10); wk6_vissue(Va, vcol, g0 + min(B + 4, W6_NBH - 1), lq);
                wk6_hand(Lb, Vb, muv, lb, fl, 1, g0 + B + 1, lane); wk6_rissue(Lb, rec0, B + 5, lane, o10); wk6_vissue(Vb, vcol, g0 + min(B + 5, W6_NBH - 1), lq);
                wk6_hand(Lc, Vc, muv, lb, fl, 2, g0 + B + 2, lane); wk6_rissue(Lc, rec0, B + 6, lane, o10); wk6_vissue(Vc, vcol, g0 + min(B + 6, W6_NBH - 1), lq);
                wk6_hand(Ld, Vd, muv, lb, fl, 3, g0 + B + 3, lane); wk6_rissue(Ld, rec0, B + 7, lane, o10); wk6_vissue(Vd, vcol, g0 + min(B + 7, W6_NBH - 1), lq);
            }
        } else if (wid == 0) {
            W5Ops P0, P1; bf16_t* yh = yr + (size_t)b * SEQ * 512 + h * 64 + qd * 16 + (size_t)g0 * 16 * 512;
            volatile LAS unsigned* done = (volatile LAS unsigned*)(lb + W6_FLAGS + 16);
            w6_wait_ge(fl, g0 + 1); wk5_ld(P0, lb, lane);
            for (int B = 0; B < W6_NBH; B += 2) {
                w6_wait_ge(fl + ((B + 1) & 3), g0 + B + 2); wk5_ld(P1, lb + ((B + 1) & 3) * W5_SLOT, lane);
                wk5_block(P0, lb + (B & 3) * W5_SLOT, H, yh + (size_t)B * 16 * 512, lane);
                asm volatile("s_waitcnt lgkmcnt(0)" ::: "memory"); *done = (unsigned)(g0 + B + 1);
                if (B + 2 < W6_NBH) { w6_wait_ge(fl + ((B + 2) & 3), g0 + B + 3); wk5_ld(P0, lb + ((B + 2) & 3) * W5_SLOT, lane); }
                wk5_block(P1, lb + ((B + 1) & 3) * W5_SLOT, H, yh + (size_t)(B + 1) * 16 * 512, lane);
                asm volatile("s_waitcnt lgkmcnt(0)" ::: "memory"); *done = (unsigned)(g0 + B + 2);
            }
        } else {
            const int hw = (wid < W6_LOADER) ? wid - 1 : wid - 2;
            if (c + 1 < W6_NCH) wk6_units<false>(ws, recbase + (size_t)((c + 1) & 1) * W6_BUF, lb + W6_HTAB + hw * P5_SIZE, cst, wg, c + 1, hw, 6, lane, pu, pv, gn, 0);
            else { unsigned char* ws2 = ws; asm volatile("" : "+s"(ws2)); phase5_post_b(ws2, wg * 6 + hw, 256 * 6, 0, W6_TPOST); }
        }
    }
    __syncthreads();
}

DEV void phase5_post(unsigned char* ws, int gtid, int gsize) {
    const bf16_t* praw = (const bf16_t*)(ws + WS_PRAW); const bf16_t* aa = (const bf16_t*)(ws + WS_AA); const bf16_t* gr = (const bf16_t*)(ws + WS_GR); const bf16_t* yr = (const bf16_t*)(ws + WS_YR); bf16_t* yo = (bf16_t*)(ws + WS_YO);
    const float* par = (const float*)(ws + WS_PAR); const float* mu = par + PAR_MU; const int lane = threadIdx.x & 63, gw = gtid >> 6, ngw = gsize >> 6;
    for (int i = gw; i < T * 8; i += ngw) { const int m = i >> 3, h = i & 7, c = h * 64 + lane;
        const float y = bf2f(yr[(size_t)m * 512 + c]); const float mean = wave_sum(y) * (1.0f / 64.0f); const float dy = y - mean; const float var = wave_sum(dy * dy) * (1.0f / 64.0f);
        const float yn = dy * rsqrtf(var + 64e-5f) * par[PAR_LNW + c] + par[PAR_LNB + c];
        const float rl = lerp_prev(praw, m, c, mu[c]), kl = lerp_prev(praw, m, 512 + c, mu[512 + c]), vl = lerp_prev(praw, m, 1024 + c, mu[1024 + c]);
        const float av = bf2f(aa[da_off((size_t)m, c)]); const float k2 = kl * (1.0f + (av - 1.0f) * par[PAR_KA + c]);
        const float bonus = wave_sum(rl * k2 * par[PAR_RK + c]) * vl;
        yo[(size_t)m * 512 + c] = f2bf((yn + bonus) * bf2f(gr[(size_t)m * 512 + c]));
    }
}

DEV void phase8_tables(const float* pu, const float* pv, const float* gn, unsigned char* ws, int gtid, int gsize) {
#if TAB_FP8 && OPT_PEER
    unsigned* u8 = (unsigned*)(ws + WS_U16); unsigned* v8 = (unsigned*)(ws + WS_V16);
    for (int i = gtid; i < 16384 * 1024 / 4; i += gsize) { const f32x4 u = ((const f32x4*)pu)[i], v = ((const f32x4*)pv)[i]; const f32x4 g = ((const f32x4*)gn)[i & 255];
        int pu_ = 0, pv_ = 0;
#if OPT_PEER == 2
        pu_ = (int)q8x4(u[0] * g[0] * U8_SCALE, u[1] * g[1] * U8_SCALE, u[2] * g[2] * U8_SCALE, u[3] * g[3] * U8_SCALE);
#else
        pu_ = __builtin_amdgcn_cvt_pk_fp8_f32(u[0] * g[0] * 256.0f, u[1] * g[1] * 256.0f, pu_, false); pu_ = __builtin_amdgcn_cvt_pk_fp8_f32(u[2] * g[2] * 256.0f, u[3] * g[3] * 256.0f, pu_, true);
#endif
        pv_ = __builtin_amdgcn_cvt_pk_fp8_f32(v[0] * 16.0f, v[1] * 16.0f, pv_, false); pv_ = __builtin_amdgcn_cvt_pk_fp8_f32(v[2] * 16.0f, v[3] * 16.0f, pv_, true);
#if OPT_PEER == 2
        { const size_t o = ((size_t)((i & 255) >> 5) * 16384 + (i >> 8)) * 32 + (i & 31); u8[o] = (unsigned)pu_; v8[o] = (unsigned)pv_; }
    }
#else
        u8[i] = (unsigned)pu_; v8[i] = (unsigned)pv_; }
#endif
#else
    bf16_t* u16 = (bf16_t*)(ws + WS_U16); bf16_t* v16 = (bf16_t*)(ws + WS_V16);
    for (int i = gtid; i < 16384 * 1024 / 4; i += gsize) { const f32x4 u = ((const f32x4*)pu)[i], v = ((const f32x4*)pv)[i]; const f32x4 g = ((const f32x4*)gn)[i & 255];
        u32x2 o; o[0] = (unsigned)f2bf(u[0] * g[0]) | ((unsigned)f2bf(u[1] * g[1]) << 16); o[1] = (unsigned)f2bf(u[2] * g[2]) | ((unsigned)f2bf(u[3] * g[3]) << 16); ((u32x2*)u16)[i] = o;
        u32x2 p; p[0] = (unsigned)f2bf(v[0]) | ((unsigned)f2bf(v[1]) << 16); p[1] = (unsigned)f2bf(v[2]) | ((unsigned)f2bf(v[3]) << 16); ((u32x2*)v16)[i] = p; }
#endif
}

DEV void wave_argmax(float& v, int& idx) {
#pragma unroll
    for (int o = 1; o < 64; o <<= 1) { const float ov = __shfl_xor(v, o); const int oi = __shfl_xor(idx, o); if (ov > v || (ov == v && oi < idx)) { v = ov; idx = oi; } }
}

DEV void phase9_topk(unsigned char* ws, float* lds, int gtid, int gsize) {
    const bf16_t* q = (const bf16_t*)(ws + WS_Q); const bf16_t* sk = (const bf16_t*)(ws + WS_SK); int* ids = (int*)(ws + WS_IDS); float* gwt = (float*)(ws + WS_GW);
    const int lane = threadIdx.x & 63, wv = threadIdx.x >> 6, gw = gtid >> 6, ngw = gsize >> 6;
    float* svl = lds + wv * 64; int* sil = (int*)(lds + 512) + wv * 64;
    for (int i = gw; i < T * 8; i += ngw) { const int m = i >> 3, hh = i & 7;
        float sc[2][2];
#pragma unroll
        for (int c = 0; c < 2; ++c)
#pragma unroll
            for (int w2 = 0; w2 < 2; ++w2) { const int n = lane + 64 * w2; const bf16_t* qp = q + (size_t)m * DM + hh * 128 + c * 64; const bf16_t* kp = sk + ((size_t)(hh * 2 + c) * 128 + n) * 64; float s = 0.f;
                for (int d = 0; d < 64; ++d) s += bf2f(qp[d]) * bf2f(kp[d]);
                sc[c][w2] = s; }
#pragma unroll
        for (int c = 0; c < 2; ++c) { float c0 = sc[c][0], c1 = sc[c][1];
            for (int r = 0; r < 16; ++r) { float bv; int bi; if (c0 >= c1) { bv = c0; bi = lane; } else { bv = c1; bi = lane + 64; }
                wave_argmax(bv, bi);
                if (bi == lane) c0 = -INFINITY; if (bi == lane + 64) c1 = -INFINITY;
                if (lane == 0) { svl[c * 16 + r] = bv; sil[c * 16 + r] = bi; } } }
        __builtin_amdgcn_wave_barrier(); asm volatile("s_waitcnt lgkmcnt(0)" ::: "memory");
        float cd[4];
#pragma unroll
        for (int w4 = 0; w4 < 4; ++w4) { const int ci = lane + 64 * w4; cd[w4] = svl[ci >> 4] + svl[16 + (ci & 15)]; }
        float myv = 0.f; int mye = 0;
        for (int r = 0; r < 16; ++r) { float bv = cd[0]; int bi = lane;
#pragma unroll
            for (int w4 = 1; w4 < 4; ++w4) if (cd[w4] > bv) { bv = cd[w4]; bi = lane + 64 * w4; }
            wave_argmax(bv, bi);
#pragma unroll
            for (int w4 = 0; w4 < 4; ++w4) if (bi == lane + 64 * w4) cd[w4] = -INFINITY;
            if (lane == r) { myv = bv; mye = sil[bi >> 4] * 128 + sil[16 + (bi & 15)]; } }
        float mx = (lane < 16) ? myv : -INFINITY;
#pragma unroll
        for (int o = 1; o < 16; o <<= 1) mx = fmaxf(mx, __shfl_xor(mx, o));
        float ex = (lane < 16) ? __expf(myv - mx) : 0.f; float sm = ex;
#pragma unroll
        for (int o = 1; o < 16; o <<= 1) sm += __shfl_xor(sm, o);
        if (lane < 16) { ids[(size_t)m * 128 + hh * 16 + lane] = mye; gwt[(size_t)m * 128 + hh * 16 + lane] = ex / sm; }
        __builtin_amdgcn_wave_barrier(); asm volatile("s_waitcnt lgkmcnt(0)" ::: "memory");
    }
}

DEV void phase10_peer(float* out, unsigned char* ws, int gtid, int gsize) {
    const bf16_t* h1b = (const bf16_t*)(ws + WS_H1B); const bf16_t* u16 = (const bf16_t*)(ws + WS_U16); const bf16_t* v16 = (const bf16_t*)(ws + WS_V16);
    const int* ids = (const int*)(ws + WS_IDS); const float* gwt = (const float*)(ws + WS_GW); const float* rss = (const float*)(ws + WS_RSS); const float* nf = (const float*)(ws + WS_PAR) + PAR_NF;
    const int lane = threadIdx.x & 63, gw = gtid >> 6, ngw = gsize >> 6, d0 = lane * 16;
    for (int m = gw; m < T; m += ngw) {
        float hb[16], acc[16];
        { const u32x4 x0 = *(const u32x4*)(h1b + (size_t)m * DM + d0), x1 = *(const u32x4*)(h1b + (size_t)m * DM + d0 + 8);
#pragma unroll
          for (int j = 0; j < 4; ++j) { hb[2 * j] = __uint_as_float(x0[j] << 16); hb[2 * j + 1] = __uint_as_float(x0[j] & 0xffff0000u); hb[8 + 2 * j] = __uint_as_float(x1[j] << 16); hb[8 + 2 * j + 1] = __uint_as_float(x1[j] & 0xffff0000u); } }
#pragma unroll
        for (int j = 0; j < 16; ++j) acc[j] = 0.f;
        const float rstd = rsqrtf(rss[m] * (1.0f / DM) + EPS);
        for (int i = 0; i < 128; ++i) { const int e = ids[(size_t)m * 128 + i]; const float gt = gwt[(size_t)m * 128 + i];
            const u32x4 u0 = *(const u32x4*)(u16 + (size_t)e * DM + d0), u1 = *(const u32x4*)(u16 + (size_t)e * DM + d0 + 8);
            float s = 0.f;
#pragma unroll
            for (int j = 0; j < 4; ++j) { s += hb[2 * j] * __uint_as_float(u0[j] << 16) + hb[2 * j + 1] * __uint_as_float(u0[j] & 0xffff0000u) + hb[8 + 2 * j] * __uint_as_float(u1[j] << 16) + hb[8 + 2 * j + 1] * __uint_as_float(u1[j] & 0xffff0000u); }
            const float hid = wave_sum(s) * rstd; const float w = gt * gelu_tanh(hid);
            const u32x4 v0 = *(const u32x4*)(v16 + (size_t)e * DM + d0), v1 = *(const u32x4*)(v16 + (size_t)e * DM + d0 + 8);
#pragma unroll
            for (int j = 0; j < 4; ++j) { acc[2 * j] += w * __uint_as_float(v0[j] << 16); acc[2 * j + 1] += w * __uint_as_float(v0[j] & 0xffff0000u); acc[8 + 2 * j] += w * __uint_as_float(v1[j] << 16); acc[8 + 2 * j + 1] += w * __uint_as_float(v1[j] & 0xffff0000u); }
        }
        float ss = 0.f;
#pragma unroll
        for (int j = 0; j < 16; ++j) { acc[j] += hb[j]; ss += acc[j] * acc[j]; }
        const float r2 = rsqrtf(wave_sum(ss) * (1.0f / DM) + EPS);
#pragma unroll
        for (int j = 0; j < 4; ++j) { const f32x4 g = *(const f32x4*)(nf + d0 + 4 * j); f32x4 o; o[0] = acc[4 * j] * r2 * g[0]; o[1] = acc[4 * j + 1] * r2 * g[1]; o[2] = acc[4 * j + 2] * r2 * g[2]; o[3] = acc[4 * j + 3] * r2 * g[3];
            *(f32x4*)(out + (size_t)m * DM + d0 + 4 * j) = o; }
    }
}


constexpr size_t WS_KT = 30 * MiB;
struct RowId { DEV int operator()(int n0) const { return n0; } };
struct RowGlu { DEV int operator()(int n0) const { return (n0 < 1024) ? (256 * (n0 >> 7) + (n0 & 127)) : (256 * ((n0 - 1024) >> 7) + 128 + ((n0 - 1024) & 127)); } };
template <class RowMap> DEV void p0_transpose_item(const float* W, int K, int N, bf16_t* WT, LAS float* scr, int item, int lane, const float* kscale, RowMap rm) {
    const int nblk = N / 32, kb = item / nblk, nb = item % nblk, k0 = 64 * kb, n0 = 32 * nb;
#pragma unroll 8
    for (int i = 0; i < 32; ++i) { const int kk = 2 * i + (lane >> 5); float v = W[(size_t)(k0 + kk) * N + n0 + (lane & 31)]; if (kscale) v *= kscale[k0 + kk]; scr[kk * 33 + (lane & 31)] = v; }
    asm volatile("s_waitcnt lgkmcnt(0)" ::: "memory");
    const int c = lane & 7; const int r0 = rm(n0);
#pragma unroll
    for (int j = 0; j < 4; ++j) { const int n = (lane >> 3) + 8 * j; const LAS float* s = scr + (8 * c) * 33 + n;
        u32x4 o; o[0] = cvt_pk_bf16(s[0], s[33]); o[1] = cvt_pk_bf16(s[2 * 33], s[3 * 33]); o[2] = cvt_pk_bf16(s[4 * 33], s[5 * 33]); o[3] = cvt_pk_bf16(s[6 * 33], s[7 * 33]);
        *(u32x4*)(WT + (size_t)(r0 + n) * K + k0 + 8 * c) = o; }
    asm volatile("s_waitcnt lgkmcnt(0)" ::: "memory");
}
DEV void phase0_opt(const Args& a, unsigned char* ws, LAS float* lds, int gtid, int gsize) {
    const int lane = threadIdx.x & 63, wv = threadIdx.x >> 6, gw = gtid >> 6, ngw = gsize >> 6;
    {
        LAS float* scr = lds + wv * (64 * 33);
        constexpr int I_IN = 16 * 136, I_O = 8 * 32, I_GLU = 8 * 64, I_OUT = 16 * 32, I_Q = 16 * 32, NIT = I_IN + I_O + I_GLU + I_OUT + I_Q;
        for (int it = gw; it < NIT; it += ngw) { int r = it;
            if (r < I_IN) { p0_transpose_item(a.in[I_W_IN], 1024, NIN, (bf16_t*)(ws + WS_WIN), scr, r, lane, nullptr, RowId()); continue; } r -= I_IN;
            if (r < I_O) { p0_transpose_item(a.in[I_WO], 512, 1024, (bf16_t*)(ws + WS_WO), scr, r, lane, nullptr, RowId()); continue; } r -= I_O;
            if (r < I_GLU) { p0_transpose_item(a.in[I_WGLU], 512, 2048, (bf16_t*)(ws + WS_WGLU), scr, r, lane, nullptr, RowGlu()); continue; } r -= I_GLU;
            if (r < I_OUT) { p0_transpose_item(a.in[I_WOUT], 1024, 1024, (bf16_t*)(ws + WS_WOUT), scr, r, lane, nullptr, RowId()); continue; } r -= I_OUT;
            p0_transpose_item(a.in[I_WQ], 1024, 1024, (bf16_t*)(ws + WS_WQ), scr, r, lane, a.in[I_NORM_FFN], RowId()); }
    }
    {
        bf16_t* xn = (bf16_t*)(ws + WS_XN); const float* x = a.in[I_X]; const float* gain = a.in[I_NORM_MIX];
        f32x4 gn[4];
#pragma unroll
        for (int j = 0; j < 4; ++j) gn[j] = ((const f32x4*)gain)[lane + 64 * j];
        for (int m = gw; m < T; m += ngw) {
            const f32x4* xr = (const f32x4*)(x + (size_t)m * DM) + lane; f32x4 v[4]; float s = 0.f;
#pragma unroll
            for (int j = 0; j < 4; ++j) { v[j] = xr[64 * j]; s += v[j][0] * v[j][0] + v[j][1] * v[j][1] + v[j][2] * v[j][2] + v[j][3] * v[j][3]; }
            const float rstd = rsqrtf(wave_sum(s) * (1.0f / DM) + EPS);
#pragma unroll
            for (int j = 0; j < 4; ++j) { u32x2 o; o[0] = cvt_pk_bf16(v[j][0] * rstd * gn[j][0], v[j][1] * rstd * gn[j][1]); o[1] = cvt_pk_bf16(v[j][2] * rstd * gn[j][2], v[j][3] * rstd * gn[j][3]);
                ((u32x2*)(xn + (size_t)m * DM))[lane + 64 * j] = o; }
        }
    }
    { bf16_t* w = (bf16_t*)(ws + WS_BLK); for (int i = gtid; i < 1536 * 256; i += gsize) { const int n = i >> 8, k = i & 255; float v = 0.f;
            if (n < 512) { if (k < 64) v = a.in[I_W_LORA][k * 512 + n]; }
            else if (n < 1024) { if (k >= 64 && k < 128) v = a.in[I_A_LORA][(k - 64) * 512 + n - 512]; }
            else { if (k >= 128) v = a.in[I_G_LORA][(k - 128) * 512 + n - 1024]; }
            w[i] = f2bf(v); } }
    { bf16_t* w = (bf16_t*)(ws + WS_SK); const float* s = a.in[I_SUBK]; for (int i = gtid; i < 8 * 2 * 128 * 64; i += gsize) w[i] = f2bf(s[i]); }
    { float* par = (float*)(ws + WS_PAR);
      for (int i = gtid; i < PAR_END; i += gsize) { float v;
        if (i < PAR_W0) v = a.in[I_MU][i]; else if (i < PAR_A0) v = a.in[I_W0][i - PAR_W0]; else if (i < PAR_KK) v = a.in[I_A0][i - PAR_A0]; else if (i < PAR_KA) v = a.in[I_KK][i - PAR_KK];
        else if (i < PAR_RK) v = a.in[I_KA][i - PAR_KA]; else if (i < PAR_LNW) v = a.in[I_RK][i - PAR_RK]; else if (i < PAR_LNB) v = a.in[I_LNW][i - PAR_LNW]; else if (i < PAR_BG) v = a.in[I_LNB][i - PAR_LNB];
        else if (i < PAR_NF) v = a.in[I_B_GATE][i - PAR_BG]; else if (i < PAR_LAM16) v = a.in[I_NORM_FINAL][i - PAR_NF];
        else { const int j = i - PAR_LAM16, gp = j >> 1; const S5p q = s5_param(a, gp >> 6, gp & 63); float pr, pi; s5_pow(q, 16, pr, pi); v = (j & 1) ? pi : pr; }
        par[i] = v; } }
    {
        bf16_t* w = (bf16_t*)(ws + WS_EBT);
        for (int i = gtid; i < 32 * 256 * 256; i += gsize) { const int g = i >> 16, n = (i >> 8) & 255, k = i & 255; float v = 0.f;
            if (n < 128) { const int p = n & 63, sp = k >> 4, j = k & 15; const S5p q = s5_param(a, g, p);
                const float br = a.in[I_BRE][(g * 64 + p) * 16 + j], bi = a.in[I_BIM][(g * 64 + p) * 16 + j];
                const float bbr = q.fr * br - q.fi * bi, bbi = q.fr * bi + q.fi * br; float pr, pi; s5_pow(q, 15 - sp, pr, pi);
                v = (n < 64) ? (pr * bbr - pi * bbi) : (pr * bbi + pi * bbr); }
            w[i] = f2bf(v); }
    }
    {
        float* kt = (float*)(ws + WS_KT);
        for (int i4 = gtid; i4 < 32 * 256 * 4; i4 += gsize) { const int i = i4 >> 2, pc = i4 & 3; const int g = i >> 8, h = (i >> 4) & 15, j = i & 15; float acc[16];
#pragma unroll
            for (int n = 0; n < 16; ++n) acc[n] = 0.f;
            for (int pi = 0; pi < 16; ++pi) { const int p = pc * 16 + pi; const S5p q = s5_param(a, g, p);
                const float br = a.in[I_BRE][(g * 64 + p) * 16 + j], bi = a.in[I_BIM][(g * 64 + p) * 16 + j];
                const float bbr = q.fr * br - q.fi * bi, bbi = q.fr * bi + q.fi * br;
                const float cr = a.in[I_CRE][(g * 16 + h) * 64 + p], ci = a.in[I_CIM][(g * 16 + h) * 64 + p];
                float zr = cr * bbr - ci * bbi, zi = cr * bbi + ci * bbr;
#pragma unroll
                for (int n = 0; n < 16; ++n) { acc[n] += zr; const float t = zr * q.lr - zi * q.li; zi = zr * q.li + zi * q.lr; zr = t; } }
#pragma unroll
            for (int n = 0; n < 16; ++n) { acc[n] += dpp_f<0xB1>(acc[n]); acc[n] += dpp_f<0x4E>(acc[n]); }
            if (pc == 0) { if (h == j) acc[0] += a.in[I_SD][g * 16 + h];
#pragma unroll
                for (int n = 0; n < 16; ++n) kt[(((size_t)g * 16 + n) * 16 + h) * 16 + j] = acc[n]; } }
    }
    {
        bf16_t* w = (bf16_t*)(ws + WS_YBT);
        for (int i = gtid; i < 32 * 256 * 64; i += gsize) { const int g = i >> 14, n = (i >> 6) & 255, p = i & 63; const int s = n >> 4, h = n & 15;
            const S5p q = s5_param(a, g, p); float pr, pi; s5_pow(q, s + 1, pr, pi);
            const float cr = a.in[I_CRE][(g * 16 + h) * 64 + p], ci = a.in[I_CIM][(g * 16 + h) * 64 + p];
            w[((size_t)g * 256 + n) * 384 + 256 + p] = f2bf(cr * pr - ci * pi); w[((size_t)g * 256 + n) * 384 + 320 + p] = f2bf(-(cr * pi + ci * pr)); }
    }
}
DEV void phase2_ybt(unsigned char* ws, int gtid, int gsize) {
    const float* kt = (const float*)(ws + WS_KT); bf16_t* w = (bf16_t*)(ws + WS_YBT);
    for (int i = gtid; i < 32 * 256 * 32; i += gsize) { const int g = i >> 13, n = (i >> 5) & 255, k8 = (i & 31) * 8; const int s = n >> 4, h = n & 15, sp = k8 >> 4, j0 = k8 & 15;
        u32x4 o = (u32x4){0u, 0u, 0u, 0u};
        if (sp <= s) { const float* src = kt + (((size_t)g * 16 + (s - sp)) * 16 + h) * 16 + j0; const f32x4 v0 = *(const f32x4*)src, v1 = *(const f32x4*)(src + 4); o = pack8(v0, v1); }
        *(u32x4*)(w + ((size_t)g * 256 + n) * 384 + k8) = o; }
}
DEV void phase3_scan_opt(unsigned char* ws, int gtid, int gsize) {
    const float* e = (const float*)(ws + WS_E); bf16_t* uc = (bf16_t*)(ws + WS_UC); const float* lam16 = (const float*)(ws + WS_PAR) + PAR_LAM16;
    for (int i = gtid; i < NB * 32 * 64; i += gsize) { const int b = i >> 11, g = (i >> 6) & 31, p = i & 63; const float lr = lam16[(g * 64 + p) * 2], li = lam16[(g * 64 + p) * 2 + 1];
        float xr = 0.f, xi = 0.f;
        for (int c0 = 0; c0 < 256; c0 += 16) { float er[16], ei[16];
#pragma unroll
            for (int c = 0; c < 16; ++c) { const size_t crow = (size_t)g * 2048 + b * 256 + c0 + c; er[c] = e[crow * 128 + p]; ei[c] = e[crow * 128 + 64 + p]; }
#pragma unroll
            for (int c = 0; c < 16; ++c) { const size_t crow = (size_t)g * 2048 + b * 256 + c0 + c;
                uc[crow * 384 + 256 + p] = f2bf(xr); uc[crow * 384 + 320 + p] = f2bf(xi);
                const float nr = lr * xr - li * xi + er[c], ni = lr * xi + li * xr + ei[c]; xr = nr; xi = ni; } }
    }
}
DEV void phase3_scan_seg(unsigned char* ws, LAS float* lds, int wg, int nwg) {
    const float* e = (const float*)(ws + WS_E); bf16_t* uc = (bf16_t*)(ws + WS_UC); const float* lam16 = (const float*)(ws + WS_PAR) + PAR_LAM16;
    const int w = threadIdx.x >> 6, p = threadIdx.x & 63;
    for (int pair = wg; pair < NB * 32; pair += nwg) { const int b = pair >> 5, g = pair & 31; const float lr = lam16[(g * 64 + p) * 2], li = lam16[(g * 64 + p) * 2 + 1];
        const size_t crow0 = (size_t)g * 2048 + b * 256 + w * 32;
        float er[32], ei[32];
#pragma unroll
        for (int c = 0; c < 32; ++c) { er[c] = e[(crow0 + c) * 128 + p]; ei[c] = e[(crow0 + c) * 128 + 64 + p]; }
        float xr = 0.f, xi = 0.f;
#pragma unroll
        for (int c = 0; c < 32; ++c) { const float nr = lr * xr - li * xi + er[c], ni = lr * xi + li * xr + ei[c]; xr = nr; xi = ni; }
        __syncthreads();
        lds[(w * 64 + p) * 2] = xr; lds[(w * 64 + p) * 2 + 1] = xi;
        __syncthreads();
        float ar = lr, ai = li;
#pragma unroll
        for (int q = 0; q < 5; ++q) { const float nr = ar * ar - ai * ai, ni = 2.0f * ar * ai; ar = nr; ai = ni; }
        xr = 0.f; xi = 0.f;
        for (int j = 0; j < w; ++j) { const float pr = lds[(j * 64 + p) * 2], pi = lds[(j * 64 + p) * 2 + 1]; const float nr = ar * xr - ai * xi + pr, ni = ar * xi + ai * xr + pi; xr = nr; xi = ni; }
#pragma unroll
        for (int c = 0; c < 32; ++c) { uc[(crow0 + c) * 384 + 256 + p] = f2bf(xr); uc[(crow0 + c) * 384 + 320 + p] = f2bf(xi);
            const float nr = lr * xr - li * xi + er[c], ni = lr * xi + li * xr + ei[c]; xr = nr; xi = ni; }
    }
}
DEV void phase5_post_b(unsigned char* ws, int gw, int ngw, int t_lo, int t_hi) {
    const bf16_t* praw = (const bf16_t*)(ws + WS_PRAW); const bf16_t* gr = (const bf16_t*)(ws + WS_GR); const bf16_t* yr = (const bf16_t*)(ws + WS_YR); bf16_t* yo = (bf16_t*)(ws + WS_YO);
    const float* par = (const float*)(ws + WS_PAR); const float* bonus = (const float*)(ws + WS_BONUS); const int lane = threadIdx.x & 63, c0 = lane * 8, nt = t_hi - t_lo;
    f32x4 muv[2], lw[2], lb[2];
#pragma unroll
    for (int j = 0; j < 2; ++j) { muv[j] = *(const f32x4*)(par + PAR_MU + 1024 + c0 + 4 * j); lw[j] = *(const f32x4*)(par + PAR_LNW + c0 + 4 * j); lb[j] = *(const f32x4*)(par + PAR_LNB + c0 + 4 * j); }
    for (int idx = gw; idx < NB * nt; idx += ngw) { const int m = (idx / nt) * SEQ + t_lo + idx % nt; const bool first = (m & (SEQ - 1)) == 0; const size_t mp = first ? m : m - 1;
        f32x4 y[2], v[2], vp[2], gg[2];
        unpack8(*(const u32x4*)(yr + (size_t)m * 512 + c0), y[0], y[1]); unpack8(*(const u32x4*)(gr + (size_t)m * 512 + c0), gg[0], gg[1]);
        unpack8(*(const u32x4*)(praw + pr_off((size_t)((size_t)m), 1024 + c0)), v[0], v[1]); unpack8(*(const u32x4*)(praw + pr_off((size_t)(mp), 1024 + c0)), vp[0], vp[1]);
        const float bs = bonus[(size_t)m * 8 + (lane >> 3)];
        float sy = 0.f; f32x4 vl[2];
#pragma unroll
        for (int j = 0; j < 2; ++j) { if (first) vp[j] = (f32x4){0.f, 0.f, 0.f, 0.f};
            vl[j] = v[j] + (vp[j] - v[j]) * muv[j]; sy += (y[j][0] + y[j][1]) + (y[j][2] + y[j][3]); }
        sy += dpp_f<0xB1>(sy); sy += dpp_f<0x4E>(sy); sy += dpp_f<0x141>(sy);
        const float mean = sy * (1.0f / 64.0f); float q = 0.f;
#pragma unroll
        for (int j = 0; j < 2; ++j) { const f32x4 d = y[j] - mean; y[j] = d; q += (d[0] * d[0] + d[1] * d[1]) + (d[2] * d[2] + d[3] * d[3]); }
        q += dpp_f<0xB1>(q); q += dpp_f<0x4E>(q); q += dpp_f<0x141>(q);
        const float rs = rsqrtf(q * (1.0f / 64.0f) + 64e-5f);
        const f32x4 o0 = (y[0] * rs * lw[0] + lb[0] + bs * vl[0]) * gg[0], o1 = (y[1] * rs * lw[1] + lb[1] + bs * vl[1]) * gg[1];
        *(u32x4*)(yo + (size_t)m * 512 + c0) = pack8(o0, o1);
    }
}
DEV void phase5_post_opt(unsigned char* ws, int gtid, int gsize) {
    const bf16_t* praw = (const bf16_t*)(ws + WS_PRAW); const bf16_t* aa = (const bf16_t*)(ws + WS_AA); const bf16_t* gr = (const bf16_t*)(ws + WS_GR); const bf16_t* yr = (const bf16_t*)(ws + WS_YR); bf16_t* yo = (bf16_t*)(ws + WS_YO);
    const float* par = (const float*)(ws + WS_PAR); const int lane = threadIdx.x & 63, gw = gtid >> 6, ngw = gsize >> 6, c0 = lane * 8;
    f32x4 mur[2], muk[2], muv[2], ka[2], rk[2], lw[2], lb[2];
#pragma unroll
    for (int j = 0; j < 2; ++j) { mur[j] = *(const f32x4*)(par + PAR_MU + c0 + 4 * j); muk[j] = *(const f32x4*)(par + PAR_MU + 512 + c0 + 4 * j); muv[j] = *(const f32x4*)(par + PAR_MU + 1024 + c0 + 4 * j);
        ka[j] = *(const f32x4*)(par + PAR_KA + c0 + 4 * j); rk[j] = *(const f32x4*)(par + PAR_RK + c0 + 4 * j); lw[j] = *(const f32x4*)(par + PAR_LNW + c0 + 4 * j); lb[j] = *(const f32x4*)(par + PAR_LNB + c0 + 4 * j); }
    for (int m = gw; m < T; m += ngw) { const bool first = (m & (SEQ - 1)) == 0; const size_t mp = first ? m : m - 1;
        f32x4 y[2], r[2], rp[2], k[2], kp[2], v[2], vp[2], av[2], gg[2];
        unpack8(*(const u32x4*)(yr + (size_t)m * 512 + c0), y[0], y[1]); unpack8(*(const u32x4*)(aa + da_off((size_t)m, c0)), av[0], av[1]); unpack8(*(const u32x4*)(gr + (size_t)m * 512 + c0), gg[0], gg[1]);
        unpack8(*(const u32x4*)(praw + pr_off((size_t)((size_t)m), c0)), r[0], r[1]); unpack8(*(const u32x4*)(praw + pr_off((size_t)(mp), c0)), rp[0], rp[1]);
        unpack8(*(const u32x4*)(praw + pr_off((size_t)((size_t)m), 512 + c0)), k[0], k[1]); unpack8(*(const u32x4*)(praw + pr_off((size_t)(mp), 512 + c0)), kp[0], kp[1]);
        unpack8(*(const u32x4*)(praw + pr_off((size_t)((size_t)m), 1024 + c0)), v[0], v[1]); unpack8(*(const u32x4*)(praw + pr_off((size_t)(mp), 1024 + c0)), vp[0], vp[1]);
        float sy = 0.f, bs = 0.f; f32x4 vl[2];
#pragma unroll
        for (int j = 0; j < 2; ++j) { if (first) { rp[j] = (f32x4){0.f, 0.f, 0.f, 0.f}; kp[j] = rp[j]; vp[j] = rp[j]; }
            const f32x4 rl = r[j] + (rp[j] - r[j]) * mur[j], kl = k[j] + (kp[j] - k[j]) * muk[j]; vl[j] = v[j] + (vp[j] - v[j]) * muv[j];
            const f32x4 k2 = kl * (1.0f + (av[j] - 1.0f) * ka[j]), t = rl * k2 * rk[j];
            sy += (y[j][0] + y[j][1]) + (y[j][2] + y[j][3]); bs += (t[0] + t[1]) + (t[2] + t[3]); }
        sy += dpp_f<0xB1>(sy); bs += dpp_f<0xB1>(bs); sy += dpp_f<0x4E>(sy); bs += dpp_f<0x4E>(bs); sy += dpp_f<0x141>(sy); bs += dpp_f<0x141>(bs);
        const float mean = sy * (1.0f / 64.0f); float q = 0.f;
#pragma unroll
        for (int j = 0; j < 2; ++j) { const f32x4 d = y[j] - mean; y[j] = d; q += (d[0] * d[0] + d[1] * d[1]) + (d[2] * d[2] + d[3] * d[3]); }
        q += dpp_f<0xB1>(q); q += dpp_f<0x4E>(q); q += dpp_f<0x141>(q);
        const float rs = rsqrtf(q * (1.0f / 64.0f) + 64e-5f);
        const f32x4 o0 = (y[0] * rs * lw[0] + lb[0] + bs * vl[0]) * gg[0], o1 = (y[1] * rs * lw[1] + lb[1] + bs * vl[1]) * gg[1];
        *(u32x4*)(yo + (size_t)m * 512 + c0) = pack8(o0, o1);
    }
}

template <int CTRL> DEV unsigned dpp_u(unsigned x) { return (unsigned)__builtin_amdgcn_update_dpp(0, (int)x, CTRL, 0xf, 0xf, true); }
DEV unsigned umax_(unsigned a, unsigned b) { return a > b ? a : b; }
DEV unsigned umin_(unsigned a, unsigned b) { return a < b ? a : b; }
DEV unsigned red16max(unsigned x) { x = umax_(x, dpp_u<0xB1>(x)); x = umax_(x, dpp_u<0x4E>(x)); x = umax_(x, dpp_u<0x124>(x)); x = umax_(x, dpp_u<0x128>(x)); return x; }
DEV unsigned f2key(float s) { const unsigned u = __float_as_uint(s); return u ^ ((unsigned)((int)u >> 31) | 0x80000000u); }
DEV float key2f(unsigned k) { return __uint_as_float((k & 0x80000000u) ? (k ^ 0x80000000u) : ~k); }
#define CE_(a, b) { const unsigned hi_ = umax_(a, b), lo_ = umin_(a, b); a = hi_; b = lo_; }
DEV unsigned top16_of_128(unsigned (&k)[8], int l15) {
    CE_(k[0], k[1]) CE_(k[2], k[3]) CE_(k[4], k[5]) CE_(k[6], k[7]) CE_(k[0], k[2]) CE_(k[1], k[3]) CE_(k[4], k[6]) CE_(k[5], k[7]) CE_(k[1], k[2]) CE_(k[5], k[6])
    CE_(k[0], k[4]) CE_(k[1], k[5]) CE_(k[2], k[6]) CE_(k[3], k[7]) CE_(k[2], k[4]) CE_(k[3], k[5]) CE_(k[1], k[2]) CE_(k[3], k[4]) CE_(k[5], k[6])
    unsigned mine = 0u;
#pragma unroll
    for (int r = 0; r < 16; ++r) { const unsigned w = red16max(k[0]); mine = (l15 == r) ? w : mine; const bool pop = (k[0] == w);
#pragma unroll
        for (int i = 0; i < 7; ++i) k[i] = pop ? k[i + 1] : k[i];
        k[7] = pop ? 0u : k[7]; }
    return mine;
}
DEV unsigned top16_of_64(unsigned (&k)[4], int l15) {
    CE_(k[0], k[1]) CE_(k[2], k[3]) CE_(k[0], k[2]) CE_(k[1], k[3]) CE_(k[1], k[2])
    unsigned mine = 0u;
#pragma unroll
    for (int r = 0; r < 16; ++r) { const unsigned w = red16max(k[0]); mine = (l15 == r) ? w : mine; const bool pop = (k[0] == w);
        k[0] = pop ? k[1] : k[0]; k[1] = pop ? k[2] : k[1]; k[2] = pop ? k[3] : k[2]; k[3] = pop ? 0u : k[3]; }
    return mine;
}
DEV void top16x4_of_128(unsigned (&k)[4][8], int l15, unsigned (&mine)[4]) {
#pragma unroll
    for (int t = 0; t < 4; ++t) {
        CE_(k[t][0], k[t][1]) CE_(k[t][2], k[t][3]) CE_(k[t][4], k[t][5]) CE_(k[t][6], k[t][7]) CE_(k[t][0], k[t][2]) CE_(k[t][1], k[t][3]) CE_(k[t][4], k[t][6]) CE_(k[t][5], k[t][7]) CE_(k[t][1], k[t][2]) CE_(k[t][5], k[t][6])
        CE_(k[t][0], k[t][4]) CE_(k[t][1], k[t][5]) CE_(k[t][2], k[t][6]) CE_(k[t][3], k[t][7]) CE_(k[t][2], k[t][4]) CE_(k[t][3], k[t][5]) CE_(k[t][1], k[t][2]) CE_(k[t][3], k[t][4]) CE_(k[t][5], k[t][6])
        mine[t] = 0u; }
#pragma unroll
    for (int r = 0; r < 16; ++r) { unsigned w[4];
#pragma unroll
        for (int t = 0; t < 4; ++t) w[t] = umax_(k[t][0], dpp_u<0xB1>(k[t][0]));
#pragma unroll
        for (int t = 0; t < 4; ++t) w[t] = umax_(w[t], dpp_u<0x4E>(w[t]));
#pragma unroll
        for (int t = 0; t < 4; ++t) w[t] = umax_(w[t], dpp_u<0x124>(w[t]));
#pragma unroll
        for (int t = 0; t < 4; ++t) w[t] = umax_(w[t], dpp_u<0x128>(w[t]));
#pragma unroll
        for (int t = 0; t < 4; ++t) { mine[t] = (l15 == r) ? w[t] : mine[t]; const bool pop = (k[t][0] == w[t]);
#pragma unroll
            for (int i = 0; i < 7; ++i) k[t][i] = pop ? k[t][i + 1] : k[t][i];
            k[t][7] = pop ? 0u : k[t][7]; } }
}
DEV void top16x4_of_64(unsigned (&k)[4][4], int l15, unsigned (&mine)[4]) {
#pragma unroll
    for (int t = 0; t < 4; ++t) { CE_(k[t][0], k[t][1]) CE_(k[t][2], k[t][3]) CE_(k[t][0], k[t][2]) CE_(k[t][1], k[t][3]) CE_(k[t][1], k[t][2]) mine[t] = 0u; }
#pragma unroll
    for (int r = 0; r < 16; ++r) { unsigned w[4];
#pragma unroll
        for (int t = 0; t < 4; ++t) w[t] = umax_(k[t][0], dpp_u<0xB1>(k[t][0]));
#pragma unroll
        for (int t = 0; t < 4; ++t) w[t] = umax_(w[t], dpp_u<0x4E>(w[t]));
#pragma unroll
        for (int t = 0; t < 4; ++t) w[t] = umax_(w[t], dpp_u<0x124>(w[t]));
#pragma unroll
        for (int t = 0; t < 4; ++t) w[t] = umax_(w[t], dpp_u<0x128>(w[t]));
#pragma unroll
        for (int t = 0; t < 4; ++t) { mine[t] = (l15 == r) ? w[t] : mine[t]; const bool pop = (k[t][0] == w[t]);
            k[t][0] = pop ? k[t][1] : k[t][0]; k[t][1] = pop ? k[t][2] : k[t][1]; k[t][2] = pop ? k[t][3] : k[t][2]; k[t][3] = pop ? 0u : k[t][3]; } }
}
#define T9_TAB (OPT_PEER == 2 && OPT_WKV == 6)
DEV void phase9_topk_opt(unsigned char* ws, LAS unsigned char* lds, int wg, int nwg, const float* pu, const float* pv, const float* gn) {
#if T9_TAB
    constexpr int NTG = 16384 * 256; const int tstride = nwg * NTHR; int te = wg * NTHR + (int)threadIdx.x; TabGrp tg;
    if (te < NTG) tab_cvt_load(tg, pu, pv, te);
#define T9_STEP { if (te < NTG) { tab_cvt_store(tg, gn, ws, te); te += tstride; if (te < NTG) tab_cvt_load(tg, pu, pv, te); } }
#else
#define T9_STEP
#endif
    const bf16_t* q = (const bf16_t*)(ws + WS_Q); const bf16_t* sk = (const bf16_t*)(ws + WS_SK); int* ids = (int*)(ws + WS_IDS); float* gwt = (float*)(ws + WS_GW);
    const int tid = threadIdx.x, lane = tid & 63, wv = tid >> 6, l15 = lane & 15, quad = lane >> 4;
    const int i3 = (l15 < 5) ? 2 : (l15 < 9) ? 3 : (l15 < 12) ? 4 : (l15 < 14) ? 5 : 6;
    const int j3 = (l15 < 5) ? l15 : (l15 < 9) ? l15 - 5 : (l15 < 12) ? l15 - 9 : (l15 < 14) ? l15 - 12 : l15 - 14;
    const bool grp = (nwg & 7) == 0; const int nh = grp ? 1 : 8, wix = grp ? ((wg >> 3) * 8 + wv) : (wg * 8 + wv), nwx = grp ? ((nwg >> 3) * 8) : (nwg * 8);
    for (int hi = 0; hi < nh; ++hi) { const int hh = grp ? (wg & 7) : hi;
        __syncthreads();
        for (int i = tid; i < 256 * 8; i += NTHR) { const int key = i >> 3, ch = i & 7; *(LAS u32x4*)(lds + key * 144 + ch * 16) = *(const u32x4*)(sk + ((size_t)hh * 256 + key) * 64 + ch * 8); }
        __syncthreads();
        for (int tile = wix; tile < T / 16; tile += nwx) { const int m0 = tile * 16;
            bf16x8 aq[2][2];
#pragma unroll
            for (int c = 0; c < 2; ++c)
#pragma unroll
                for (int ks = 0; ks < 2; ++ks) aq[c][ks] = *(const bf16x8*)(q + (size_t)(m0 + l15) * DM + hh * 128 + c * 64 + ks * 32 + quad * 8);
            unsigned win[2][4];
#pragma unroll
            for (int c = 0; c < 2; ++c) {
                f32x4 acc[8];
#pragma unroll
                for (int nt = 0; nt < 8; ++nt) acc[nt] = (f32x4){0.f, 0.f, 0.f, 0.f};
#pragma unroll
                for (int ks = 0; ks < 2; ++ks) {
#pragma unroll
                    for (int nt = 0; nt < 8; ++nt) { const bf16x8 bfr = *(const LAS bf16x8*)(lds + (c * 128 + nt * 16 + l15) * 144 + ks * 64 + quad * 16);
                        acc[nt] = __builtin_amdgcn_mfma_f32_16x16x32_bf16(aq[c][ks], bfr, acc[nt], 0, 0, 0); } }
                __builtin_amdgcn_sched_barrier(0);
                { unsigned k[4][8];
#pragma unroll
                  for (int i = 0; i < 4; ++i)
#pragma unroll
                    for (int nt = 0; nt < 8; ++nt) k[i][nt] = (f2key(acc[nt][i]) & 0xFFFFFF80u) | (unsigned)(127 - (nt * 16 + l15));
                  top16x4_of_128(k, l15, win[c]); }
                __builtin_amdgcn_sched_barrier(0);
                T9_STEP
            }
            const int base = lane & 48; unsigned k2[4][4], wk[4];
#pragma unroll
            for (int i = 0; i < 4; ++i) {
                const float sv0 = key2f(win[0][i] & 0xFFFFFF80u), sv1 = key2f(win[1][i] & 0xFFFFFF80u);
                const float s00 = __shfl(sv0, base), s01 = __shfl(sv0, base + 1), s10 = __shfl(sv1, base), s07 = __shfl(sv0, base + 7);
                const float s0i3 = __shfl(sv0, base + i3), s1j3 = __shfl(sv1, base + j3);
                k2[i][0] = (f2key(s00 + sv1) & 0xFFFFFF00u) | (unsigned)(255 - l15);
                k2[i][1] = (l15 < 8) ? ((f2key(s01 + sv1) & 0xFFFFFF00u) | (unsigned)(255 - (16 + l15))) : ((f2key(sv0 + s10) & 0xFFFFFF00u) | (unsigned)(255 - l15 * 16));
                k2[i][2] = (f2key(s0i3 + s1j3) & 0xFFFFFF00u) | (unsigned)(255 - (i3 * 16 + j3));
                k2[i][3] = (l15 < 2) ? ((f2key(s07 + sv1) & 0xFFFFFF00u) | (unsigned)(255 - (7 * 16 + l15))) : 0u; }
            top16x4_of_64(k2, l15, wk);
            T9_STEP
#pragma unroll
            for (int i = 0; i < 4; ++i) {
                const float cv = key2f(wk[i] & 0xFFFFFF00u); const int ci = 255 - (int)(wk[i] & 255u);
                const unsigned k0 = (unsigned)__shfl((int)win[0][i], base + (ci >> 4)), k1 = (unsigned)__shfl((int)win[1][i], base + (ci & 15));
                const int e = (127 - (int)(k0 & 127u)) * 128 + (127 - (int)(k1 & 127u));
                const float mx = __shfl(cv, base); float ex = __expf(cv - mx); float sm = ex;
                sm += dpp_f<0xB1>(sm); sm += dpp_f<0x4E>(sm); sm += dpp_f<0x124>(sm); sm += dpp_f<0x128>(sm);
                const size_t o = (size_t)(m0 + quad * 4 + i) * 128 + hh * 16 + l15;
                ids[o] = e; gwt[o] = ex / sm;
            }
            T9_STEP
        }
    }
#if T9_TAB
    while (te < NTG) T9_STEP
#endif
}

#if TAB_FP8
constexpr float TAB_USCALE = 256.0f, TAB_VSCALE = 16.0f;
typedef u32x4 tabrow_t;
DEV tabrow_t tab_ld(const unsigned char* tab, int e, int lane) { return *(const u32x4*)(tab + (size_t)e * 1024 + lane * 16); }
DEV void tab_dec(const tabrow_t& r, float (&f)[16]) {
#pragma unroll
    for (int i = 0; i < 4; ++i) { const auto lo = __builtin_amdgcn_cvt_pk_f32_fp8((int)r[i], false), hi = __builtin_amdgcn_cvt_pk_f32_fp8((int)r[i], true); f[4 * i] = lo[0]; f[4 * i + 1] = lo[1]; f[4 * i + 2] = hi[0]; f[4 * i + 3] = hi[1]; }
}
#else
constexpr float TAB_USCALE = 1.0f, TAB_VSCALE = 1.0f;
struct tabrow_t { u32x4 a, b; };
DEV tabrow_t tab_ld(const unsigned char* tab, int e, int lane) { tabrow_t r; const u32x4* p = (const u32x4*)(tab + (size_t)e * 2048 + lane * 32); r.a = p[0]; r.b = p[1]; return r; }
DEV void tab_dec(const tabrow_t& r, float (&f)[16]) {
#pragma unroll
    for (int i = 0; i < 4; ++i) { f[2 * i] = __uint_as_float(r.a[i] << 16); f[2 * i + 1] = __uint_as_float(r.a[i] & 0xffff0000u); f[8 + 2 * i] = __uint_as_float(r.b[i] << 16); f[8 + 2 * i + 1] = __uint_as_float(r.b[i] & 0xffff0000u); }
}
#endif
DEV float wave_total(float x) { x = red16(x); x += __shfl_xor(x, 16); x += __shfl_xor(x, 32); return x; }
DEV void phase10_peer_opt(float* out, unsigned char* ws, int gtid, int gsize) {
    const bf16_t* h1b = (const bf16_t*)(ws + WS_H1B); const unsigned char* utab = ws + WS_U16; const unsigned char* vtab = ws + WS_V16;
    const int* ids = (const int*)(ws + WS_IDS); const float* gwt = (const float*)(ws + WS_GW); const float* rss = (const float*)(ws + WS_RSS); const float* nf = (const float*)(ws + WS_PAR) + PAR_NF;
    const int lane = threadIdx.x & 63, gw = gtid >> 6, ngw = gsize >> 6, d0 = lane * 16;
    for (int m = gw; m < T; m += ngw) {
        float xf[16];
        { const u32x4 x0 = *(const u32x4*)(h1b + (size_t)m * DM + d0), x1 = *(const u32x4*)(h1b + (size_t)m * DM + d0 + 8); f32x4 a, b, c, d; unpack8(x0, a, b); unpack8(x1, c, d);
#pragma unroll
          for (int j = 0; j < 4; ++j) { xf[j] = a[j]; xf[4 + j] = b[j]; xf[8 + j] = c[j]; xf[12 + j] = d[j]; } }
        const int id0 = ids[(size_t)m * 128 + lane], id1 = ids[(size_t)m * 128 + 64 + lane];
        const float g0 = gwt[(size_t)m * 128 + lane], g1 = gwt[(size_t)m * 128 + 64 + lane];
        const float rstd = rsqrtf(rss[m] * (1.0f / DM) + EPS);
        float hid0 = 0.f, hid1 = 0.f;
        for (int c = 0; c < 128 / PEER_CH; ++c) {
            const int idv = (c * PEER_CH < 64) ? id0 : id1; tabrow_t rows[PEER_CH];
#pragma unroll
            for (int j = 0; j < PEER_CH; ++j) { const int e = __builtin_amdgcn_readlane(idv, (c * PEER_CH + j) & 63); rows[j] = tab_ld(utab, e, lane); }
            float hv = 0.f;
#pragma unroll
            for (int j = 0; j < PEER_CH; ++j) { float f[16]; tab_dec(rows[j], f); float s = 0.f;
#pragma unroll
                for (int i = 0; i < 16; ++i) s += xf[i] * f[i];
                s = wave_total(s); hv = (lane == ((c * PEER_CH + j) & 63)) ? s : hv; }
            if (c * PEER_CH < 64) hid0 += hv; else hid1 += hv;
        }
        const float w0 = g0 * gelu_tanh(hid0 * (rstd / TAB_USCALE)) * (1.0f / TAB_VSCALE), w1 = g1 * gelu_tanh(hid1 * (rstd / TAB_USCALE)) * (1.0f / TAB_VSCALE);
        float acc[16];
#pragma unroll
        for (int i = 0; i < 16; ++i) acc[i] = 0.f;
        for (int c = 0; c < 128 / PEER_CH; ++c) {
            const int idv = (c * PEER_CH < 64) ? id0 : id1; const float wv = (c * PEER_CH < 64) ? w0 : w1; tabrow_t rows[PEER_CH];
#pragma unroll
            for (int j = 0; j < PEER_CH; ++j) { const int e = __builtin_amdgcn_readlane(idv, (c * PEER_CH + j) & 63); rows[j] = tab_ld(vtab, e, lane); }
#pragma unroll
            for (int j = 0; j < PEER_CH; ++j) { const float w = __builtin_bit_cast(float, __builtin_amdgcn_readlane(__builtin_bit_cast(int, wv), (c * PEER_CH + j) & 63)); float f[16]; tab_dec(rows[j], f);
#pragma unroll
                for (int i = 0; i < 16; ++i) acc[i] += w * f[i]; }
        }
        float ss = 0.f;
#pragma unroll
        for (int i = 0; i < 16; ++i) { acc[i] += xf[i]; ss += acc[i] * acc[i]; }
        const float r2 = rsqrtf(wave_total(ss) * (1.0f / DM) + EPS);
#pragma unroll
        for (int j = 0; j < 4; ++j) { const f32x4 g = *(const f32x4*)(nf + d0 + 4 * j); f32x4 o; o[0] = acc[4 * j] * r2 * g[0]; o[1] = acc[4 * j + 1] * r2 * g[1]; o[2] = acc[4 * j + 2] * r2 * g[2]; o[3] = acc[4 * j + 3] * r2 * g[3];
            *(f32x4*)(out + (size_t)m * DM + d0 + 4 * j) = o; }
    }
}

#if TAB_FP8
DEV void peer_dec16(const u32x4& r, float (&f)[16]) {
#pragma unroll
    for (int i = 0; i < 4; ++i) { const auto lo = __builtin_amdgcn_cvt_pk_f32_fp8((int)r[i], false), hi = __builtin_amdgcn_cvt_pk_f32_fp8((int)r[i], true); f[4 * i] = lo[0]; f[4 * i + 1] = lo[1]; f[4 * i + 2] = hi[0]; f[4 * i + 3] = hi[1]; }
}
constexpr size_t WS_PART = 256 * MiB;
DEV void phase10a_part(unsigned char* ws, LAS float* lds, int wg, int nwg) {
    const unsigned char* x8 = ws + WS_X8; const unsigned char* utab = ws + WS_U16;
    const int* ids = (const int*)(ws + WS_IDS); float* part = (float*)(ws + WS_PART);
    const int lane = threadIdx.x & 63, wv = threadIdx.x >> 6, g = lane >> 3, p = lane & 7; const bool grp = (nwg & 7) == 0;
    const int nsl = grp ? 1 : 8, wix = grp ? ((wg >> 3) * 8 + wv) : (wg * 8 + wv), nwx = grp ? ((nwg >> 3) * 8) : (nwg * 8);
    LAS int* il = (LAS int*)(lds + wv * 1024);
    for (int sl = 0; sl < nsl; ++sl) { const int x = grp ? (wg & 7) : sl; const unsigned char* us = utab + (size_t)x * 16384 * 128; const unsigned pofs = (unsigned)p * 16u;
        for (int tile = wix; tile < T / 8; tile += nwx) { const int m0 = tile * 8;
            { const u32x4* si = (const u32x4*)(ids + (size_t)m0 * 128);
#pragma unroll
              for (int i = 0; i < 4; ++i) *(LAS u32x4*)(il + (i * 64 + lane) * 4) = si[i * 64 + lane]; }
            const int m = m0 + g; const u32x4 xq = *(const u32x4*)(x8 + (size_t)m * DM + x * 128 + p * 16);
            int pt[16];
#pragma unroll
            for (int i = 0; i < 16; ++i) pt[i] = 0;
            asm volatile("s_waitcnt lgkmcnt(0)" ::: "memory");
            u32x4 rA[8], rB[8];
#define P10_ISSUE(R, c) { _Pragma("unroll") for (int h = 0; h < 2; ++h) { const u32x4 e4 = *(const LAS u32x4*)(il + g * 128 + (c) * 8 + h * 4); \
                _Pragma("unroll") for (int r = 0; r < 4; ++r) R[h * 4 + r] = *(const u32x4*)(us + ((e4[r] << 7) | pofs)); } }
#define P10_DOT(R, c) { _Pragma("unroll") for (int r = 0; r < 8; ++r) { int s = __builtin_amdgcn_sdot4((int)R[r][0], (int)xq[0], 0, false); s = __builtin_amdgcn_sdot4((int)R[r][1], (int)xq[1], s, false); \
                s = __builtin_amdgcn_sdot4((int)R[r][2], (int)xq[2], s, false); s = __builtin_amdgcn_sdot4((int)R[r][3], (int)xq[3], s, false); \
                s += (int)dpp_u<0xB1>((unsigned)s); s += (int)dpp_u<0x4E>((unsigned)s); s += (int)dpp_u<0x141>((unsigned)s); \
                pt[((c) & 1) * 8 + r] = (p == ((c) >> 1)) ? s : pt[((c) & 1) * 8 + r]; } }
            P10_ISSUE(rA, 0)
#pragma unroll
            for (int c = 0; c < 16; c += 2) {
                P10_ISSUE(rB, c + 1)
                P10_DOT(rA, c)
                if (c + 2 < 16) P10_ISSUE(rA, c + 2)
                P10_DOT(rB, c + 1)
            }
            { bf16_t* d16 = (bf16_t*)part + ((size_t)x * T + m) * 128 + p * 16;
              *(u32x4*)(d16) = pack8((f32x4){(float)pt[0], (float)pt[1], (float)pt[2], (float)pt[3]}, (f32x4){(float)pt[4], (float)pt[5], (float)pt[6], (float)pt[7]});
              *(u32x4*)(d16 + 8) = pack8((f32x4){(float)pt[8], (float)pt[9], (float)pt[10], (float)pt[11]}, (f32x4){(float)pt[12], (float)pt[13], (float)pt[14], (float)pt[15]}); }
        }
    }
}
DEV void phase10r_reduce(unsigned char* ws, int gtid, int gsize) {
    const bf16_t* part = (const bf16_t*)(ws + WS_PART); const float* gwt = (const float*)(ws + WS_GW); const float* rss = (const float*)(ws + WS_RSS); float* w2 = (float*)(ws + WS_W2);
    for (int i8 = gtid; i8 < T * 16; i8 += gsize) { const int m = i8 >> 4; f32x4 s0 = (f32x4){0.f, 0.f, 0.f, 0.f}, s1 = s0;
#pragma unroll
        for (int x = 0; x < 8; ++x) { f32x4 a, b; unpack8(*(const u32x4*)(part + (size_t)x * T * 128 + (size_t)i8 * 8), a, b); s0 += a; s1 += b; }
        const float sc = rsqrtf(rss[m] * (1.0f / DM) + EPS) / (U8_SCALE * X8_SCALE); const f32x4 g0 = *(const f32x4*)(gwt + (size_t)i8 * 8), g1 = *(const f32x4*)(gwt + (size_t)i8 * 8 + 4); f32x4 o0, o1;
#pragma unroll
        for (int i = 0; i < 4; ++i) { o0[i] = g0[i] * gelu_tanh(s0[i] * sc) * (1.0f / TAB_VSCALE); o1[i] = g1[i] * gelu_tanh(s1[i] * sc) * (1.0f / TAB_VSCALE); }
        *(f32x4*)(w2 + (size_t)i8 * 8) = o0; *(f32x4*)(w2 + (size_t)i8 * 8 + 4) = o1; }
}
#define RLX_AGENT_ __ATOMIC_RELAXED, __HIP_MEMORY_SCOPE_AGENT
DEV void p12_norm_tile(float* out, unsigned char* ws, const __amdgpu_buffer_rsrc_t h2rs, int tile, int lane) {
    unsigned* rss2 = (unsigned*)(ws + WS_RSS2); const float* nf = (const float*)(ws + WS_PAR) + PAR_NF;
    const int m0 = tile * 8;
    const float rq = rsqrtf(__uint_as_float(__hip_atomic_load(rss2 + m0 + (lane & 7), RLX_AGENT_)) * (1.0f / DM) + EPS);
    const f32x4 g00 = *(const f32x4*)(nf + lane * 8), g01 = *(const f32x4*)(nf + lane * 8 + 4), g10 = *(const f32x4*)(nf + 512 + lane * 8), g11 = *(const f32x4*)(nf + 512 + lane * 8 + 4);
    const unsigned sb = (unsigned)m0 * (DM * 2) + (unsigned)lane * 16u; f32x4* dst = (f32x4*)(out + (size_t)m0 * DM) + lane * 2;
#pragma unroll
    for (int hb = 0; hb < 2; ++hb) { u32x4 v[8];
#pragma unroll
        for (int i = 0; i < 8; ++i) v[i] = __builtin_amdgcn_raw_buffer_load_b128(h2rs, sb + (unsigned)((hb * 8 + i) * 1024), 0, 16);
#pragma unroll
        for (int i = 0; i < 8; ++i) { const int it = hb * 8 + i; const float r2 = __shfl(rq, it >> 1); f32x4 a, b; unpack8(v[i], a, b);
            dst[it * 128] = a * r2 * ((it & 1) ? g10 : g00); dst[it * 128 + 1] = b * r2 * ((it & 1) ? g11 : g01); } }
}
DEV void phase10b_out(float* out, unsigned char* ws, LAS float* lds, int wg, int nwg) {
    const bf16_t* h1b = (const bf16_t*)(ws + WS_H1B); const unsigned char* vtab = ws + WS_V16;
    const int* ids = (const int*)(ws + WS_IDS); const float* w2 = (const float*)(ws + WS_W2); float* rss2 = (float*)(ws + WS_RSS2);
    const int lane = threadIdx.x & 63, wv = __builtin_amdgcn_readfirstlane(threadIdx.x >> 6), g = lane >> 3, p = lane & 7; const bool grp = (nwg & 7) == 0;
    const int nsl = grp ? 1 : 8, wix = grp ? ((wg >> 3) * 8 + wv) : (wg * 8 + wv), nwx = grp ? ((nwg >> 3) * 8) : (nwg * 8);
    LAS float* wl = lds + wv * 2048; LAS int* il = (LAS int*)(lds + wv * 2048 + 1024);
    const __amdgpu_buffer_rsrc_t h2rs = __builtin_amdgcn_make_buffer_rsrc(ws + WS_H2B, 0, T * DM * 2, 0x00020000);
    unsigned* tcnt = (unsigned*)(ws + WS_TCNT) + (size_t)wix * 128; int pend0 = -1, pend1 = -1, due = -1, kk = 0;
    for (int sl = 0; sl < nsl; ++sl) { const int x = grp ? (wg & 7) : sl; const unsigned char* vs = vtab + (size_t)x * 16384 * 128; const unsigned pofs = (unsigned)p * 16u;
        f32x4 Lw[4]; u32x4 Li[4];
#define P12_LISTS(t) { const int tq = min((t), T / 8 - 1); const f32x4* sw = (const f32x4*)(w2 + (size_t)tq * 1024); const u32x4* si = (const u32x4*)(ids + (size_t)tq * 1024); \
            _Pragma("unroll") for (int i = 0; i < 4; ++i) { Lw[i] = sw[i * 64 + lane]; Li[i] = si[i * 64 + lane]; } }
        P12_LISTS(wix)
        for (int tile = wix; tile < T / 8; tile += nwx, ++kk) { const int m0 = tile * 8;
            unsigned cv = 0u; if (grp && pend0 >= 0) cv = __hip_atomic_load(tcnt + (pend0 >> 2) * 16, RLX_AGENT_);
#pragma unroll
            for (int i = 0; i < 4; ++i) { *(LAS f32x4*)(wl + (i * 64 + lane) * 4) = Lw[i]; *(LAS u32x4*)(il + (i * 64 + lane) * 4) = Li[i]; }
            const int m = m0 + g;
            float acc[16];
#pragma unroll
            for (int i = 0; i < 16; ++i) acc[i] = 0.f;
            asm volatile("s_waitcnt lgkmcnt(0)" ::: "memory");
            if (grp && due >= 0) { asm volatile("s_waitcnt vmcnt(0)" ::: "memory"); if (lane == 0) __hip_atomic_fetch_add(tcnt + due * 16, 1u, RLX_AGENT_); due = -1; }
            u32x4 rA[8], rB[8]; f32x4 wA[2], wB[2];
#define P12_ISSUE(R, W, c) { _Pragma("unroll") for (int h = 0; h < 2; ++h) { const u32x4 e4 = *(const LAS u32x4*)(il + g * 128 + (c) * 8 + h * 4); W[h] = *(const LAS f32x4*)(wl + g * 128 + (c) * 8 + h * 4); \
                _Pragma("unroll") for (int r = 0; r < 4; ++r) { const unsigned go_ = (e4[r] << 7) | pofs; asm volatile("global_load_dwordx4 %0, %1, %2" : "=v"(R[h * 4 + r]) : "v"(go_), "s"(vs) : "memory"); } } }
#define P12_WAIT(R, n) asm volatile("s_waitcnt vmcnt(" #n ")" : "+v"(R[0]), "+v"(R[1]), "+v"(R[2]), "+v"(R[3]), "+v"(R[4]), "+v"(R[5]), "+v"(R[6]), "+v"(R[7]) :: "memory")
#define P12_ACC(R, W) { _Pragma("unroll") for (int r = 0; r < 8; ++r) { float f[16]; peer_dec16(R[r], f); const float w = W[r >> 2][r & 3]; _Pragma("unroll") for (int i = 0; i < 16; ++i) acc[i] += w * f[i]; } }
            P12_ISSUE(rA, wA, 0)
            for (int c = 0; c < 14; c += 2) {
                P12_ISSUE(rB, wB, c + 1)
                P12_WAIT(rA, 8); P12_ACC(rA, wA)
                P12_ISSUE(rA, wA, c + 2)
                P12_WAIT(rB, 8); P12_ACC(rB, wB)
            }
            P12_ISSUE(rB, wB, 15)
            const u32x4 hx0 = *(const u32x4*)(h1b + (size_t)m * DM + x * 128 + p * 8), hx1 = *(const u32x4*)(h1b + (size_t)m * DM + x * 128 + 64 + p * 8);
            P12_WAIT(rA, 10); P12_ACC(rA, wA)
            P12_WAIT(rB, 2); P12_ACC(rB, wB)
            P12_LISTS(tile + nwx)
            f32x4 a0, a1, a2, a3; unpack8(hx0, a0, a1); unpack8(hx1, a2, a3);
            f32x4 o0, o1, o2, o3; float ss = 0.f;
#pragma unroll
            for (int i = 0; i < 4; ++i) { o0[i] = a0[i] + acc[i]; o1[i] = a1[i] + acc[4 + i]; o2[i] = a2[i] + acc[8 + i]; o3[i] = a3[i] + acc[12 + i]; ss += o0[i] * o0[i] + o1[i] * o1[i] + o2[i] * o2[i] + o3[i] * o3[i]; }
            { const u32x4 w0 = pack8(o0, o1), w1 = pack8(o2, o3); const unsigned ob = (unsigned)(((size_t)m * DM + x * 128 + p * 8) * 2);
              if (grp) { __builtin_amdgcn_raw_buffer_store_b128(w0, h2rs, ob, 0, 16); __builtin_amdgcn_raw_buffer_store_b128(w1, h2rs, ob + 128u, 0, 16); }
              else { *(u32x4*)(ws + WS_H2B + ob) = w0; *(u32x4*)(ws + WS_H2B + ob + 128u) = w1; } }
            ss += dpp_f<0xB1>(ss); ss += dpp_f<0x4E>(ss); ss += dpp_f<0x141>(ss);
            if (p == 0) atomicAdd(rss2 + m, ss);
            if (grp) { if ((kk & 3) == 3) due = kk >> 2;
                if (pend0 >= 0 && __builtin_amdgcn_readfirstlane(cv) == 8u) { p12_norm_tile(out, ws, h2rs, wix + pend0 * nwx, lane); pend0 = pend1; pend1 = -1; }
                if ((kk & 7) == x) { if (pend0 < 0) pend0 = kk; else pend1 = kk; } }
        }
    }
    if (grp) {
        if (due < 0 && (kk & 3) != 0) due = kk >> 2;
        if (due >= 0) { asm volatile("s_waitcnt vmcnt(0)" ::: "memory"); if (lane == 0) __hip_atomic_fetch_add(tcnt + due * 16, 1u, RLX_AGENT_); }
        while (pend0 >= 0) {
            for (unsigned sp = 0; sp < (1u << 22); ++sp) { if (__builtin_amdgcn_readfirstlane(__hip_atomic_load(tcnt + (pend0 >> 2) * 16, RLX_AGENT_)) == 8u) break; __builtin_amdgcn_s_sleep(4); }
            p12_norm_tile(out, ws, h2rs, wix + pend0 * nwx, lane); pend0 = pend1; pend1 = -1; }
    }
}
DEV void phase10c_norm(float* out, unsigned char* ws, int gtid, int gsize) {
    const float* rss2 = (const float*)(ws + WS_RSS2); const float* nf = (const float*)(ws + WS_PAR) + PAR_NF; const bf16_t* h2 = (const bf16_t*)(ws + WS_H2B);
    for (int i = gtid; i < T * DM / 8; i += gsize) { const int m = i >> 7, c8 = i & 127; const float r2 = rsqrtf(rss2[m] * (1.0f / DM) + EPS); const f32x4 g0 = ((const f32x4*)nf)[2 * c8], g1 = ((const f32x4*)nf)[2 * c8 + 1];
        f32x4 a, b; unpack8(((const u32x4*)h2)[i], a, b); ((f32x4*)out)[2 * i] = a * r2 * g0; ((f32x4*)out)[2 * i + 1] = b * r2 * g1; }
}
#endif

#define XB_TMO      128
#define XB_XCNT(j)  (256  + 64 * (j))
#define XB_XSUB(j)  (1280 + 64 * (j))
#define XB_XGEN(j)  (2304 + 64 * (j))
#define XB_TOP      3328
#define XB_TOPGEN   3392
#define XCD_BAR_WORDS 3456
#define XB_SPIN_CAP (1u << 20)
DEV unsigned xb_ld(unsigned* p)              { return __hip_atomic_load(p, __ATOMIC_RELAXED, __HIP_MEMORY_SCOPE_AGENT); }
DEV unsigned xb_add(unsigned* p, unsigned v) { return __hip_atomic_fetch_add(p, v, __ATOMIC_RELAXED, __HIP_MEMORY_SCOPE_AGENT); }
DEV unsigned xb_xcc_id() { return (unsigned)__builtin_amdgcn_s_getreg((3 << 11) | 20) & 0xFu; }
#define XB_SPIN(cond, bar) do { unsigned _sp = 0; while (cond) { __builtin_amdgcn_s_sleep(1); \
    if ((++_sp & 255u) == 0u) { if (xb_ld(&(bar)[XB_TMO])) break; if (_sp > XB_SPIN_CAP) { atomicAdd(&(bar)[XB_TMO], 1u); break; } } } } while (0)
struct XcdBarrier { unsigned* bar; unsigned x; volatile LAS unsigned* st; };
DEV XcdBarrier xcd_barrier_post(unsigned* bar, volatile LAS unsigned* st) {
    XcdBarrier b; b.bar = bar; b.x = xb_xcc_id(); b.st = st;
    if (threadIdx.x == 0) (void)xb_add(&bar[XB_XCNT(b.x)], 1u);
    return b;
}
DEV void xcd_barrier_complete(unsigned* bar, unsigned x, unsigned& nloc, unsigned& nx) {
    const unsigned G = gridDim.x * gridDim.y * gridDim.z;
    unsigned sum, cnt, mine, sp = 0u;
    for (;;) {
        sum = 0u; cnt = 0u; mine = 0u;
#pragma unroll
        for (unsigned j = 0; j < 16; ++j) { const unsigned c = xb_ld(&bar[XB_XCNT(j)]); sum += c; cnt += (c > 0u) ? 1u : 0u; mine = (j == x) ? c : mine; }
        if (sum == G) break;
        __builtin_amdgcn_s_sleep(1);
        if ((++sp & 255u) == 0u) { if (xb_ld(&bar[XB_TMO])) break; if (sp > XB_SPIN_CAP) { atomicAdd(&bar[XB_TMO], 1u); break; } }
    }
    nloc = mine > 0u ? mine : 1u; nx = cnt > 0u ? cnt : 1u;
}
DEV void xcd_barrier(const XcdBarrier& b) {
    asm volatile("s_waitcnt vmcnt(0)" ::: "memory");
    __syncthreads();
    if (threadIdx.x == 0) {
        unsigned* bar = b.bar;
        __builtin_amdgcn_s_waitcnt(0);
        unsigned nloc = b.st[0], nx = b.st[1];
        if (nloc == 0u) { xcd_barrier_complete(bar, b.x, nloc, nx); b.st[0] = nloc; b.st[1] = nx; }
        const unsigned old = xb_add(&bar[XB_XSUB(b.x)], 1u);
        const unsigned gen = old / nloc;
        if (old + 1u == (gen + 1u) * nloc) {
            __builtin_amdgcn_fence(__ATOMIC_RELEASE, "agent");
            asm volatile("s_waitcnt vmcnt(0)" ::: "memory");
            const unsigned og = xb_add(&bar[XB_TOP], 1u);
            const unsigned tg = og / nx;
            if (og + 1u == (tg + 1u) * nx) xb_add(&bar[XB_TOPGEN], 1u);
            else XB_SPIN(xb_ld(&bar[XB_TOPGEN]) == tg, bar);
            xb_add(&bar[XB_XGEN(b.x)], 1u);
            __builtin_amdgcn_fence(__ATOMIC_ACQUIRE, "agent");
            asm volatile("s_waitcnt vmcnt(0)" ::: "memory");
        } else {
            XB_SPIN(xb_ld(&bar[XB_XGEN(b.x)]) == gen, bar);
            __builtin_amdgcn_fence(__ATOMIC_ACQUIRE, "agent");
            asm volatile("s_waitcnt vmcnt(0)" ::: "memory");
        }
    }
    __syncthreads();
}
constexpr int LDS_BYTES = 147456;
constexpr int CW_BAR = 4096;

__global__ void __launch_bounds__(NTHR, 2) fwd_kernel(Args a) {
    extern __shared__ __attribute__((aligned(16))) unsigned char lds_raw[];
    float* lds = (float*)lds_raw;
    PG8_LAS unsigned char* ldsl = (PG8_LAS unsigned char*)lds_raw;
    unsigned char* ws = a.ws;
    const int wg = blockIdx.x, nwg = gridDim.x, gtid = wg * NTHR + threadIdx.x, gsize = nwg * NTHR;
    volatile LAS unsigned* misc = (volatile LAS unsigned*)((LAS unsigned char*)lds_raw + LDSCTL_OFF);
    if (threadIdx.x < 64) misc[threadIdx.x] = 0u;
    __syncthreads();
    XcdBarrier bar = xcd_barrier_post((unsigned*)(ws + WS_CTL) + CW_BAR, misc + 8);
#if PROBE_PH >= 0
    const int abl = a.ph_lo >> 8, phlo = a.ph_lo & 255;
#else
    constexpr int abl = 0; const int phlo = a.ph_lo;
#endif
#define PH(k) if (phlo <= (k) && (k) < a.ph_hi)
#define SEAM(k) if (phlo <= (k) && (k) + 1 < a.ph_hi) xcd_barrier(bar)
    const float* par = (const float*)(ws + WS_PAR);
#if OPT_P0
    PH(0) { phase0_opt(a, ws, (LAS float*)lds_raw, gtid, gsize); }
#else
    PH(0) { phase0(a, ws, gtid, gsize); }
#endif
    SEAM(0);
    PH(1) {
#if (OPT_GEMM >> 1) & 1
            SchedStd S; S.init(T, NIN, nwg, wg, 1024, 1024); Epi1V E{(bf16_t*)(ws + WS_PRAW), (bf16_t*)(ws + WS_UC), (bf16_t*)(ws + WS_GATES), par + PAR_BG};
            gemm_phase<Epi1V, SchedStd, true, true>(ldsl, Gemm{(const bf16_t*)(ws + WS_XN), (const bf16_t*)(ws + WS_WIN), 1024, 1024, 1024}, S, E);
#else
            Epi1 E{(bf16_t*)(ws + WS_PRAW), (bf16_t*)(ws + WS_UC), (bf16_t*)(ws + WS_GATES), par + PAR_BG};
            gemm_naive<Epi1, false>(lds, (const bf16_t*)(ws + WS_XN), 1024, (const bf16_t*)(ws + WS_WIN), 1024, T, NIN, 1024, E, wg, nwg);
#endif
            }
    SEAM(1);
    PH(2) { phase2_prep(ws, gtid, gsize);
#if OPT_P0
            phase2_ybt(ws, gtid, gsize);
#endif
#if (OPT_GEMM >> 2) & 1
            __syncthreads();
            SchedGrp S{nwg, wg, 384, (size_t)2048 * 384, (size_t)256 * 256}; EpiEV E{(float*)(ws + WS_E)};
            gemm_phase<EpiEV, SchedGrp, true, true>(ldsl, Gemm{(const bf16_t*)(ws + WS_UC), (const bf16_t*)(ws + WS_EBT), 384, 256, 256}, S, E);
#else
            for (int g = 0; g < 32; ++g) { EpiE E{(float*)(ws + WS_E) + (size_t)g * 2048 * 128};
                gemm_naive<EpiE, false>(lds, (const bf16_t*)(ws + WS_UC) + (size_t)g * 2048 * 384, 384, (const bf16_t*)(ws + WS_EBT) + (size_t)g * 256 * 256, 256, 2048, 128, 256, E, wg, nwg); }
#endif
            }
    SEAM(2);
    PH(3) { phase3_scan_seg(ws, (LAS float*)lds_raw, wg, nwg);
#if OPT_WKV >= 4
            if (OPT_WKV != 6 || nwg != 256) phase3_invn(ws, gtid, gsize);
#endif
#if (OPT_GEMM >> 3) & 1
            __syncthreads();
            SchedStd S; S.init(T, 1536, nwg, wg, 256, 256); EpiLoraV E{(bf16_t*)(ws + WS_DD), (bf16_t*)(ws + WS_AA), (bf16_t*)(ws + WS_GR), par + PAR_W0, par + PAR_A0};
            gemm_phase<EpiLoraV, SchedStd, true, true>(ldsl, Gemm{(const bf16_t*)(ws + WS_A2), (const bf16_t*)(ws + WS_BLK), 256, 256, 256}, S, E);
#else
            EpiLora E{(bf16_t*)(ws + WS_DD), (bf16_t*)(ws + WS_AA), (bf16_t*)(ws + WS_GR), par + PAR_W0, par + PAR_A0};
            gemm_naive<EpiLora, false>(lds, (const bf16_t*)(ws + WS_A2), 256, (const bf16_t*)(ws + WS_BLK), 256, T, 1536, 256, E, wg, nwg);
#endif
            }
    SEAM(3);
    PH(4) {
#if (OPT_GEMM >> 4) & 1
            if (!(abl & 32)) { SchedGrp S{nwg, wg, 384, (size_t)2048 * 384, (size_t)256 * 384}; EpiYV E{(bf16_t*)(ws + WS_YS)};
              gemm_phase<EpiYV, SchedGrp, true, true>(ldsl, Gemm{(const bf16_t*)(ws + WS_UC), (const bf16_t*)(ws + WS_YBT), 384, 384, 384}, S, E); }
            __syncthreads();
#else
            for (int g = 0; g < 32; ++g) { EpiY E{(bf16_t*)(ws + WS_YS), g};
                gemm_naive<EpiY, false>(lds, (const bf16_t*)(ws + WS_UC) + (size_t)g * 2048 * 384, 384, (const bf16_t*)(ws + WS_YBT) + (size_t)g * 256 * 384, 384, 2048, 256, 384, E, wg, nwg); }
#endif
#if OPT_WKV == 6
#if W6_ABL
            if (nwg == 256) { phase4_wkv6(ws, (unsigned char*)a.out, (LAS float*)lds_raw, wg, a.in[I_PU], a.in[I_PV], a.in[I_NORM_FFN], bar); xcd_barrier(bar); phase4_wkv4(ws, (LAS float*)lds_raw, wg, nwg, a.in[I_PU], a.in[I_PV], a.in[I_NORM_FFN], 0); }
#else
            if (nwg == 256) phase4_wkv6(ws, (unsigned char*)a.out, (LAS float*)lds_raw, wg, a.in[I_PU], a.in[I_PV], a.in[I_NORM_FFN], bar);
#endif
            else phase4_wkv4(ws, (LAS float*)lds_raw, wg, nwg, a.in[I_PU], a.in[I_PV], a.in[I_NORM_FFN], 0); }
#elif OPT_WKV == 4
            phase4_wkv4(ws, (LAS float*)lds_raw, wg, nwg, a.in[I_PU], a.in[I_PV], a.in[I_NORM_FFN], abl); }
#elif OPT_WKV == 3
            phase4_wkv3(ws, (LAS float*)lds_raw, wg, nwg, a.in[I_PU], a.in[I_PV], a.in[I_NORM_FFN]); }
#elif OPT_WKV == 2
            phase4_wkv2(ws, (LAS float*)lds_raw, wg, nwg, a.in[I_PU], a.in[I_PV], a.in[I_NORM_FFN]); }
#elif OPT_WKV
            phase4_wkv_opt(ws, (LAS float*)lds_raw, wg, nwg, a.in[I_PU], a.in[I_PV], a.in[I_NORM_FFN]); }
#else
            phase4_wkv(ws, wg, nwg); }
#endif
    SEAM(4);
    PH(5) {
#if OPT_WKV == 6
            if (nwg == 256) phase5_post_b(ws, gtid >> 6, gsize >> 6, W6_TPOST, SEQ);
            else
#endif
            phase5_post_opt(ws, gtid, gsize);
#if (OPT_GEMM >> 5) & 1
            __syncthreads();
            SchedStd S; S.init(T, 2048, nwg, wg, 512, 512); EpiGluV E{(bf16_t*)(ws + WS_GATES)};
            gemm_phase<EpiGluV, SchedStd, true, true>(ldsl, Gemm{(const bf16_t*)(ws + WS_YS), (const bf16_t*)(ws + WS_WGLU), 512, 512, 512}, S, E);
#else
            EpiGlu E{(bf16_t*)(ws + WS_GATES)};
            gemm_naive<EpiGlu, true>(lds, (const bf16_t*)(ws + WS_YS), 512, (const bf16_t*)(ws + WS_WGLU), 512, T, 1024, 512, E, wg, nwg);
#endif
            }
    SEAM(5);
    PH(6) {
#if (OPT_GEMM >> 6) & 1
            SchedStd S; S.init(T, 1024, nwg, wg, 512, 512); EpiYaV E{(bf16_t*)(ws + WS_GATES)};
            gemm_phase<EpiYaV, SchedStd, true, true>(ldsl, Gemm{(const bf16_t*)(ws + WS_YO), (const bf16_t*)(ws + WS_WO), 512, 512, 512}, S, E);
#else
            EpiYa E{(bf16_t*)(ws + WS_GATES)};
            gemm_naive<EpiYa, false>(lds, (const bf16_t*)(ws + WS_YO), 512, (const bf16_t*)(ws + WS_WO), 512, T, 1024, 512, E, wg, nwg);
#endif
            }
    SEAM(6);
    PH(7) {
#if (OPT_GEMM >> 7) & 1
            SchedStd S; S.init(T, 1024, nwg, wg, 2048, 1024); EpiOutV E{a.in[I_X], (bf16_t*)(ws + WS_H1B), (float*)(ws + WS_RSS), ws + WS_X8};
            gemm_phase<EpiOutV, SchedStd, true, true>(ldsl, Gemm{(const bf16_t*)(ws + WS_GATES), (const bf16_t*)(ws + WS_WOUT), 2048, 1024, 1024}, S, E);
#else
            EpiOut E{a.in[I_X], (bf16_t*)(ws + WS_H1B), (float*)(ws + WS_RSS)};
            gemm_naive<EpiOut, false>(lds, (const bf16_t*)(ws + WS_GATES), 2048, (const bf16_t*)(ws + WS_WOUT), 1024, T, 1024, 1024, E, wg, nwg);
#endif
            }
    SEAM(7);
    PH(8) {
#if !(OPT_PEER == 2 && OPT_WKV)
            phase8_tables(a.in[I_PU], a.in[I_PV], a.in[I_NORM_FFN], ws, gtid, gsize);
#endif
#if (OPT_GEMM >> 8) & 1
            __syncthreads();
            SchedStd S; S.init(T, 1024, nwg, wg, 1024, 1024); EpiQV E{(bf16_t*)(ws + WS_Q), (const float*)(ws + WS_RSS)};
            gemm_phase<EpiQV, SchedStd, true, true>(ldsl, Gemm{(const bf16_t*)(ws + WS_H1B), (const bf16_t*)(ws + WS_WQ), 1024, 1024, 1024}, S, E);
#else
            EpiQ E{(bf16_t*)(ws + WS_Q), (const float*)(ws + WS_RSS)};
            gemm_naive<EpiQ, false>(lds, (const bf16_t*)(ws + WS_H1B), 1024, (const bf16_t*)(ws + WS_WQ), 1024, T, 1024, 1024, E, wg, nwg);
#endif
            }
    SEAM(8);
#if OPT_TOPK
    PH(9) { phase9_topk_opt(ws, (LAS unsigned char*)lds_raw, wg, nwg, a.in[I_PU], a.in[I_PV], a.in[I_NORM_FFN]); }
#else
    PH(9) { phase9_topk(ws, lds, gtid, gsize); }
#endif
    SEAM(9);
#if OPT_PEER == 2
    PH(10) { phase10a_part(ws, (LAS float*)lds_raw, wg, nwg); }
    SEAM(10);
    PH(11) { phase10r_reduce(ws, gtid, gsize); }
    SEAM(11);
    PH(12) { phase10b_out(a.out, ws, (LAS float*)lds_raw, wg, nwg); }
    if ((nwg & 7) != 0) {
    SEAM(12);
    PH(13) { phase10c_norm(a.out, ws, gtid, gsize); }
    }
#elif OPT_PEER
    PH(10) { phase10_peer_opt(a.out, ws, gtid, gsize); }
#else
    PH(10) { phase10_peer(a.out, ws, gtid, gsize); }
#endif
#undef PH
#undef SEAM
}

extern "C" void kernel_launch(void* const* d_in, const int* in_sizes, int n_in, void* d_out, int out_size, void* d_ws, size_t ws_size, hipStream_t stream) {
    if (n_in != N_INPUTS || out_size != T * DM || ws_size < WS_END) { fprintf(stderr, "kernel_launch: unexpected shapes (n_in %d, out %d, ws %zu)\n", n_in, out_size, ws_size); return; }
    (void)in_sizes;
    static int grid = 0;
    if (grid == 0) {
        int dev = 0, cus = 0, per_cu = 0;
        if (hipGetDevice(&dev) != hipSuccess || hipDeviceGetAttribute(&cus, hipDeviceAttributeMultiprocessorCount, dev) != hipSuccess) { fprintf(stderr, "kernel_launch: device query failed\n"); grid = -1; return; }
        if (hipFuncSetAttribute((const void*)fwd_kernel, hipFuncAttributeMaxDynamicSharedMemorySize, LDS_BYTES) != hipSuccess) { fprintf(stderr, "kernel_launch: hipFuncSetAttribute failed\n"); grid = -1; return; }
        if (hipOccupancyMaxActiveBlocksPerMultiprocessor(&per_cu, (const void*)fwd_kernel, NTHR, LDS_BYTES) != hipSuccess || per_cu < 1) { fprintf(stderr, "kernel_launch: occupancy query says %d blocks per CU\n", per_cu); (void)hipGetLastError(); }
        grid = cus;
    }
    if (grid < 0) return;
    if (hipMemsetAsync((char*)d_ws + WS_CTL, 0, CTL_BYTES, stream) != hipSuccess) { fprintf(stderr, "kernel_launch: memset failed\n"); return; }
    Args a{};
    for (int i = 0; i < N_INPUTS; ++i) a.in[i] = (const float*)d_in[i];
    a.out = (float*)d_out; a.ws = (unsigned char*)d_ws; a.ph_lo = 0; a.ph_hi = 14;
    void* kargs[] = {&a};
    hipError_t e = hipLaunchCooperativeKernel((const void*)fwd_kernel, dim3(grid), dim3(NTHR), kargs, LDS_BYTES, stream);
    if (e != hipSuccess) { fprintf(stderr, "kernel_launch: cooperative launch failed: %s (grid %d)\n", hipGetErrorString(e), grid); }
#if PROBE_PH >= 0
    a.ph_lo = PROBE_PH | (PROBE_ABL << 8); a.ph_hi = PROBE_PH + 1; (void)hipLaunchCooperativeKernel((const void*)fwd_kernel, dim3(grid), dim3(NTHR), kargs, LDS_BYTES, stream);
#endif
}
```
